# Optimizing an MI355X kernel written in HIP

```python
import math
import jax
import jax.numpy as jnp
from jax import lax
import numpy as np

D_MODEL = 1024
BATCH = 2
SEQ = 16384
DEPTH = 1

HEAD_DIM = 64
DIFF_WIDTH = D_MODEL // 2
DIFF_V_DIM = 2 * HEAD_DIM
N_DIFF_HEADS = DIFF_WIDTH // DIFF_V_DIM
MOBA_WIDTH = D_MODEL - DIFF_WIDTH
N_MOBA_HEADS = MOBA_WIDTH // HEAD_DIM
MIX_WIDTH = DIFF_WIDTH + MOBA_WIDTH
DQ_COLS = N_DIFF_HEADS * 2 * HEAD_DIM
DK_COLS = N_DIFF_HEADS * 2 * HEAD_DIM
DV_COLS = N_DIFF_HEADS * DIFF_V_DIM
MQ_COLS = N_MOBA_HEADS * HEAD_DIM
MK_COLS = N_MOBA_HEADS * HEAD_DIM
MV_COLS = N_MOBA_HEADS * HEAD_DIM
IN_WIDTH = DQ_COLS + DK_COLS + DV_COLS + MQ_COLS + MK_COLS + MV_COLS

Q_BLOCK = 128
MOBA_Q_BLOCK = 64
MOBA_BLOCK = 256
MOBA_TOPK = 3

N_BUCKETS = 32
MAX_DISTANCE = 128
N_BIAS_HEADS = N_DIFF_HEADS + N_MOBA_HEADS

N_GROUPS = 4
EXPERTS_PER_GROUP = 8
N_EXPERTS = N_GROUPS * EXPERTS_PER_GROUP
EXPERT_TOPK = 2
EXPERT_FF = D_MODEL // 2

EPS = 1e-6
NEG = -1e30

kernel_name = "hymba_diff_moba_hmoe_block"


def rmsnorm(x, gain):
    xf = x.astype(jnp.float32)
    y = xf * lax.rsqrt(jnp.mean(xf * xf, axis=-1, keepdims=True) + EPS)
    return (y * gain.astype(jnp.float32)).astype(x.dtype)


def rel_bucket(dist):
    n = jnp.maximum(dist, 0)
    max_exact = N_BUCKETS // 2
    nf = jnp.maximum(n, 1).astype(jnp.float32)
    large = max_exact + (jnp.log(nf / max_exact) / math.log(MAX_DISTANCE / max_exact)
                         * (N_BUCKETS - max_exact)).astype(jnp.int32)
    large = jnp.minimum(large, N_BUCKETS - 1)
    return jnp.where(n < max_exact, n, large)


def diff_attention(q, k, v, lam, bias_table):
    b, h, _, s, dh = q.shape
    nqb = s // Q_BLOCK
    qb = q.reshape(b, h, 2, nqb, Q_BLOCK, dh).transpose(3, 0, 1, 2, 4, 5)
    k_pos = jnp.arange(s)
    scale = dh ** -0.5

    def block(args):
        qi, i = args
        q_pos = i * Q_BLOCK + jnp.arange(Q_BLOCK)
        dist = q_pos[:, None] - k_pos[None, :]
        bias = jnp.moveaxis(bias_table[rel_bucket(dist)], -1, 0).astype(jnp.float32)
        sc = jnp.einsum('bhmqd,bhmkd->bhmqk', qi, k).astype(jnp.float32) * scale
        sc = sc + bias[None, :, None]
        sc = jnp.where(dist >= 0, sc, NEG)
        p = jax.nn.softmax(sc, axis=-1)
        a = p[:, :, 0] - lam * p[:, :, 1]
        return jnp.einsum('bhqk,bhkd->bhqd', a.astype(v.dtype), v)

    out = lax.map(block, (qb, jnp.arange(nqb)))
    return out.transpose(1, 2, 0, 3, 4).reshape(b, h, s, v.shape[-1])


def moba_attention(q, k, v, bias_table):
    b, h, s, dh = q.shape
    nkb = -(-s // MOBA_BLOCK)
    s_pad = nkb * MOBA_BLOCK
    pad = ((0, 0), (0, 0), (0, s_pad - s), (0, 0))
    k_p = jnp.pad(k, pad)
    v_p = jnp.pad(v, pad)
    kb = k_p.reshape(b, h, nkb, MOBA_BLOCK, dh)
    vb = v_p.reshape(b, h, nkb, MOBA_BLOCK, dh)
    k_mean = jnp.mean(kb.astype(jnp.float32), axis=3)
    topk = min(MOBA_TOPK, nkb)
    nqb = s // MOBA_Q_BLOCK
    qb = q.reshape(b, h, nqb, MOBA_Q_BLOCK, dh).transpose(2, 0, 1, 3, 4)
    blk_pos = jnp.arange(MOBA_BLOCK)
    tab_t = bias_table.T.astype(jnp.float32)
    h_idx = jnp.arange(h)[None, :, None, None, None]
    scale = dh ** -0.5
    gather = jax.vmap(jax.vmap(lambda blocks, idx: blocks[idx]))

    def block(args):
        qi, i = args
        q_pos = i * MOBA_Q_BLOCK + jnp.arange(MOBA_Q_BLOCK)
        own = (i * MOBA_Q_BLOCK) // MOBA_BLOCK
        g = jnp.einsum('bhqd,bhnd->bhqn', qi.astype(jnp.float32), k_mean)
        g = jnp.where(jnp.arange(nkb) < own, g, -jnp.inf)
        _, sel = lax.top_k(g, topk)
        valid = sel < own
        ks = gather(kb, sel)
        vs = gather(vb, sel)
        kpos_sel = sel[..., None] * MOBA_BLOCK + blk_pos
        dist_sel = q_pos[None, None, :, None, None] - kpos_sel
        s_sel = jnp.einsum('bhqd,bhqjkd->bhqjk', qi, ks).astype(jnp.float32) * scale
        s_sel = s_sel + tab_t[h_idx, rel_bucket(dist_sel)]
        s_sel = jnp.where(valid[..., None], s_sel, NEG)
        k_own = lax.dynamic_slice_in_dim(k_p, own * MOBA_BLOCK, MOBA_BLOCK, axis=2)
        v_own = lax.dynamic_slice_in_dim(v_p, own * MOBA_BLOCK, MOBA_BLOCK, axis=2)
        dist_own = q_pos[:, None] - (own * MOBA_BLOCK + blk_pos)[None, :]
        bias_own = jnp.moveaxis(bias_table[rel_bucket(dist_own)], -1, 0).astype(jnp.float32)
        s_own = jnp.einsum('bhqd,bhkd->bhqk', qi, k_own).astype(jnp.float32) * scale
        s_own = jnp.where(dist_own >= 0, s_own + bias_own[None], NEG)
        n_sel = topk * MOBA_BLOCK
        sc = jnp.concatenate([s_sel.reshape(b, h, MOBA_Q_BLOCK, n_sel), s_own], axis=-1)
        p = jax.nn.softmax(sc, axis=-1).astype(v.dtype)
        p_sel = p[..., :n_sel].reshape(b, h, MOBA_Q_BLOCK, topk, MOBA_BLOCK)
        p_own = p[..., n_sel:]
        return (jnp.einsum('bhqjk,bhqjkd->bhqd', p_sel, vs)
                + jnp.einsum('bhqk,bhkd->bhqd', p_own, v_own))

    out = lax.map(block, (qb, jnp.arange(nqb)))
    return out.transpose(1, 2, 0, 3, 4).reshape(b, h, s, dh)


def token_mixer(h, w_in, lq1, lk1, lq2, lk2, head_gain, w_out, rel_bias, lambda_init):
    b, s, _ = h.shape
    proj = h @ w_in
    splits = np.cumsum([DQ_COLS, DK_COLS, DV_COLS, MQ_COLS, MK_COLS]).tolist()
    dq, dk, dv, mq, mk, mv = jnp.split(proj, splits, axis=-1)
    dq = dq.reshape(b, s, N_DIFF_HEADS, 2, HEAD_DIM).transpose(0, 2, 3, 1, 4)
    dk = dk.reshape(b, s, N_DIFF_HEADS, 2, HEAD_DIM).transpose(0, 2, 3, 1, 4)
    dv = dv.reshape(b, s, N_DIFF_HEADS, DIFF_V_DIM).transpose(0, 2, 1, 3)
    mq = mq.reshape(b, s, N_MOBA_HEADS, HEAD_DIM).transpose(0, 2, 1, 3)
    mk = mk.reshape(b, s, N_MOBA_HEADS, HEAD_DIM).transpose(0, 2, 1, 3)
    mv = mv.reshape(b, s, N_MOBA_HEADS, HEAD_DIM).transpose(0, 2, 1, 3)

    lam = (jnp.exp(jnp.sum(lq1.astype(jnp.float32) * lk1.astype(jnp.float32)))
           - jnp.exp(jnp.sum(lq2.astype(jnp.float32) * lk2.astype(jnp.float32)))
           + lambda_init)
    y_diff = diff_attention(dq, dk, dv, lam, rel_bias[:, :N_DIFF_HEADS])
    y_diff = rmsnorm(y_diff, head_gain) * (1.0 - lambda_init)
    y_moba = moba_attention(mq, mk, mv, rel_bias[:, N_DIFF_HEADS:])

    y = jnp.concatenate([y_diff.transpose(0, 2, 1, 3).reshape(b, s, DIFF_WIDTH),
                         y_moba.transpose(0, 2, 1, 3).reshape(b, s, MOBA_WIDTH)], axis=-1)
    return y @ w_out


def hier_moe(h, w_group, b_group, w_expert, b_expert, w_gate, w_up, w_down):
    n = h.shape[0]
    rows = jnp.arange(n)
    gl = (h @ w_group + b_group).astype(jnp.float32)
    gp = jax.nn.softmax(gl, axis=-1)
    g_idx = jnp.argmax(gl, axis=-1)
    g_w = gp[rows, g_idx]
    el = (h @ w_expert + b_expert).astype(jnp.float32).reshape(n, N_GROUPS, EXPERTS_PER_GROUP)
    ep = jax.nn.softmax(el[rows, g_idx], axis=-1)
    tv, ti = lax.top_k(ep, EXPERT_TOPK)
    tv = tv / jnp.sum(tv, axis=-1, keepdims=True)
    wts = g_w[:, None] * tv
    e_idx = g_idx[:, None] * EXPERTS_PER_GROUP + ti
    gates = jnp.sum(jax.nn.one_hot(e_idx, N_EXPERTS, dtype=jnp.float32) * wts[..., None], axis=1)
    gates = gates.astype(h.dtype)

    def expert(acc, prm):
        wg, wu, wd, gt = prm
        hid = jax.nn.silu(h @ wg) * (h @ wu)
        return acc + gt[:, None] * (hid @ wd), None

    out, _ = lax.scan(expert, jnp.zeros_like(h), (w_gate, w_up, w_down, gates.T))
    return out


def setup_inputs(seed: int = 0) -> dict:
    key = jax.random.key(seed)
    ks = jax.random.split(key, 24)
    f32 = jnp.float32
    nrm = lambda k, shape, s: jax.random.normal(k, shape, f32) * s
    gain = lambda k, shape: 1.0 + 0.05 * jax.random.normal(k, shape, f32)
    d = D_MODEL
    return {
        "x": nrm(ks[0], (BATCH, SEQ, d), 1.0),
        "c": nrm(ks[1], (BATCH, d), 1.0),
        "w_ada": nrm(ks[2], (DEPTH, d, 6 * d), 0.5 * d ** -0.5),
        "b_ada": nrm(ks[3], (DEPTH, 6 * d), 0.01),
        "pre_mix_gain": gain(ks[4], (DEPTH, d)),
        "post_mix_gain": gain(ks[5], (DEPTH, d)),
        "pre_ffn_gain": gain(ks[6], (DEPTH, d)),
        "post_ffn_gain": gain(ks[7], (DEPTH, d)),
        "w_in": nrm(ks[8], (DEPTH, d, IN_WIDTH), d ** -0.5),
        "lambda_q1": nrm(ks[9], (DEPTH, HEAD_DIM), 0.1),
        "lambda_k1": nrm(ks[10], (DEPTH, HEAD_DIM), 0.1),
        "lambda_q2": nrm(ks[11], (DEPTH, HEAD_DIM), 0.1),
        "lambda_k2": nrm(ks[12], (DEPTH, HEAD_DIM), 0.1),
        "diff_head_gain": gain(ks[13], (DEPTH, DIFF_V_DIM)),
        "w_out": nrm(ks[14], (DEPTH, MIX_WIDTH, d), MIX_WIDTH ** -0.5),
        "rel_bias": nrm(ks[15], (N_BUCKETS, N_BIAS_HEADS), 0.5),
        "w_group": nrm(ks[16], (DEPTH, d, N_GROUPS), d ** -0.5),
        "b_group": nrm(ks[17], (DEPTH, N_GROUPS), 0.01),
        "w_expert": nrm(ks[18], (DEPTH, d, N_EXPERTS), d ** -0.5),
        "b_expert": nrm(ks[19], (DEPTH, N_EXPERTS), 0.01),
        "w_gate": nrm(ks[20], (DEPTH, N_EXPERTS, d, EXPERT_FF), d ** -0.5),
        "w_up": nrm(ks[21], (DEPTH, N_EXPERTS, d, EXPERT_FF), d ** -0.5),
        "w_down": nrm(ks[22], (DEPTH, N_EXPERTS, EXPERT_FF, d), EXPERT_FF ** -0.5),
    }


def reference(x, c, w_ada, b_ada, pre_mix_gain, post_mix_gain, pre_ffn_gain, post_ffn_gain,
              w_in, lambda_q1, lambda_k1, lambda_q2, lambda_k2, diff_head_gain, w_out,
              rel_bias, w_group, b_group, w_expert, b_expert, w_gate, w_up, w_down):
    b, s, d = x.shape
    for l in range(DEPTH):
        lambda_init = 0.8 - 0.6 * math.exp(-0.3 * l)
        mod = jax.nn.silu(c) @ w_ada[l] + b_ada[l]
        sh1, sc1, g1, sh2, sc2, g2 = jnp.split(mod, 6, axis=-1)
        h = rmsnorm(x, pre_mix_gain[l]) * (1.0 + sc1[:, None]) + sh1[:, None]
        y = token_mixer(h, w_in[l], lambda_q1[l], lambda_k1[l], lambda_q2[l], lambda_k2[l],
                        diff_head_gain[l], w_out[l], rel_bias, lambda_init)
        x = x + g1[:, None] * rmsnorm(y, post_mix_gain[l])
        h = rmsnorm(x, pre_ffn_gain[l]) * (1.0 + sc2[:, None]) + sh2[:, None]
        y = hier_moe(h.reshape(b * s, d), w_group[l], b_group[l], w_expert[l], b_expert[l],
                     w_gate[l], w_up[l], w_down[l]).reshape(b, s, d)
        x = x + g2[:, None] * rmsnorm(y, post_ffn_gain[l])
    return x
```

```cpp
#include <hip/hip_runtime.h>
#include <hip/hip_bf16.h>
#include <cstdio>
#include <cstdint>
#include <cmath>

namespace pg8 {
#define PG8_LAS __attribute__((address_space(3)))
typedef unsigned short bf16_t;
typedef short bf16x8 __attribute__((ext_vector_type(8)));
typedef float f32x4 __attribute__((ext_vector_type(4)));
typedef unsigned u32x4 __attribute__((ext_vector_type(4)));
constexpr int BM = 256, BK = 64, HALF = 128, HTB = HALF * BK * 2  , STAGE_BYTES = 8 * HTB, NXCD = 8, WGM = 8;

__host__ __device__ __forceinline__ int lds_byte(int r, int c) { const int st = (r >> 4) * 2 + (c >> 5), rr = r & 15, cc = c & 31, ob = rr * 64 + cc * 2; return st * 1024 + (ob ^ (((ob >> 9) & 1) << 5)); }
__host__ __device__ __forceinline__ void stage_rc(int b, int& R, int& C) { const int st = b / 1024, sb = b % 1024, swz = sb ^ (((sb >> 9) & 1) << 5); R = (st >> 1) * 16 + swz / 64; C = (st & 1) * 32 + (swz % 64) / 2; }
__host__ __device__ __forceinline__ int perm32(int rho) { const int n = rho >> 4, i = rho & 15; return 8 * (i >> 2) + 4 * n + (i & 3); }

struct Unit { int pm, pn; int nvalid; const int* rows; };
struct Gemm { const bf16_t* A; const bf16_t* Bt; int M, N, K; };

struct StaticOrder {
    int nM, nN, nwg, G, c;
    __host__ __device__ void init(int M, int N, int G_, int c_) { nM = M / BM; nN = N / BM; nwg = nM * nN; G = G_; c = c_; }
    __host__ __device__ bool next(int i, Unit& u) const {
        const long L = (long)i * G + c; if (L >= nwg) return false;
        int wgid = (int)L; { const int q = nwg / NXCD, r = nwg % NXCD, xcd = wgid % NXCD, off = wgid / NXCD; wgid = (xcd < r ? xcd * (q + 1) : r * (q + 1) + (xcd - r) * q) + off; }
        const int nig = WGM * nN, gid = wgid / nig, fm = gid * WGM, gsz = (nM - fm) < WGM ? (nM - fm) : WGM;
        u.pm = fm + ((wgid % nig) % gsz); u.pn = (wgid % nig) / gsz; u.nvalid = 256; u.rows = nullptr; return true;
    }
    __device__ __forceinline__ int arow(const Unit&, int r) const { return r; }
};

__device__ __forceinline__ unsigned cvt_pk_bf16(float lo, float hi) { unsigned r; asm volatile("v_cvt_pk_bf16_f32 %0, %1, %2" : "=v"(r) : "v"(lo), "v"(hi)); return r; }

struct EpiQKV {
    static constexpr bool PERM = true;
    bf16_t* O; int ldc; unsigned qmask; float qscale;
    __device__ __forceinline__ void operator()(const f32x4 (&acc)[2][2][4][2], const Unit& u, int wr, int wc, int fr, int fq) const {
        const int row0 = u.pm * BM + wr * 64 + fr; const int col0 = u.pn * BM + wc * 32 + 8 * fq;
        const float sc = ((qmask >> u.pn) & 1u) ? qscale : 1.f;
#pragma unroll
        for (int ai = 0; ai < 2; ++ai)
#pragma unroll
            for (int m = 0; m < 4; ++m) { bf16_t* rowp = O + (size_t)(row0 + ai * HALF + m * 16) * ldc + col0;
#pragma unroll
                for (int bj = 0; bj < 2; ++bj) { const f32x4 v0 = acc[ai][bj][m][0] * sc, v1 = acc[ai][bj][m][1] * sc;
                    u32x4 w; w.x = cvt_pk_bf16(v0[0], v0[1]); w.y = cvt_pk_bf16(v0[2], v0[3]); w.z = cvt_pk_bf16(v1[0], v1[1]); w.w = cvt_pk_bf16(v1[2], v1[3]);
                    *(u32x4*)(rowp + bj * HALF) = w; } }
    }
};
struct EpiF32 {
    static constexpr bool PERM = false;
    float* O; int ldc;
    __device__ __forceinline__ void operator()(const f32x4 (&acc)[2][2][4][2], const Unit& u, int wr, int wc, int fr, int fq) const {
        const int col0 = u.pn * BM + wc * 32 + 4 * fq;
#pragma unroll
        for (int ai = 0; ai < 2; ++ai)
#pragma unroll
            for (int m = 0; m < 4; ++m) { float* rowp = O + (size_t)(u.pm * BM + ai * HALF + wr * 64 + m * 16 + fr) * ldc + col0;
#pragma unroll
                for (int bj = 0; bj < 2; ++bj)
#pragma unroll
                    for (int n = 0; n < 2; ++n) *(f32x4*)(rowp + bj * HALF + n * 16) = acc[ai][bj][m][n]; }
    }
};
struct EpiSwiGLU {
    static constexpr bool PERM = true;
    bf16_t* H;
    __device__ __forceinline__ void operator()(const f32x4 (&acc)[2][2][4][2], const Unit& u, int wr, int wc, int fr, int fq) const {
        const int col0 = (u.pn & 3) * 128 + wc * 32 + 8 * fq;
#pragma unroll
        for (int ai = 0; ai < 2; ++ai)
#pragma unroll
            for (int m = 0; m < 4; ++m) { bf16_t* rowp = H + (size_t)(u.pm * BM + ai * HALF + wr * 64 + m * 16 + fr) * 512 + col0;
                float h[8];
#pragma unroll
                for (int n = 0; n < 2; ++n)
#pragma unroll
                    for (int k = 0; k < 4; ++k) { const float gt = acc[ai][0][m][n][k], up = acc[ai][1][m][n][k];
                        h[n * 4 + k] = gt * __builtin_amdgcn_rcpf(1.f + __builtin_amdgcn_exp2f(-1.4426950408889634f * gt)) * up; }
                u32x4 w; w.x = cvt_pk_bf16(h[0], h[1]); w.y = cvt_pk_bf16(h[2], h[3]); w.z = cvt_pk_bf16(h[4], h[5]); w.w = cvt_pk_bf16(h[6], h[7]);
                *(u32x4*)rowp = w; }
    }
};
struct EpiDown {
    static constexpr bool PERM = true;
    bf16_t* SO;
    __device__ __forceinline__ void operator()(const f32x4 (&acc)[2][2][4][2], const Unit& u, int wr, int wc, int fr, int fq) const {
        const int col0 = (u.pn & 3) * BM + wc * 32 + 8 * fq;
#pragma unroll
        for (int ai = 0; ai < 2; ++ai)
#pragma unroll
            for (int m = 0; m < 4; ++m) { const int r = ai * HALF + wr * 64 + m * 16 + fr;
                if (r < u.nvalid) { const int ent = u.rows[r]; bf16_t* rowp = SO + (size_t)ent * 1024 + col0;
#pragma unroll
                    for (int bj = 0; bj < 2; ++bj) { const f32x4 v0 = acc[ai][bj][m][0], v1 = acc[ai][bj][m][1];
                        u32x4 w; w.x = cvt_pk_bf16(v0[0], v0[1]); w.y = cvt_pk_bf16(v0[2], v0[3]); w.z = cvt_pk_bf16(v1[0], v1[1]); w.w = cvt_pk_bf16(v1[2], v1[3]);
                        *(u32x4*)(rowp + bj * HALF) = w; } } }
    }
};

template <class Epi, class Sched, bool GATHER>
__device__ __forceinline__ void gemm_phase(PG8_LAS unsigned char* lds, const Gemm g, const Sched& S, const Epi& E) {
    const int tid = threadIdx.x, wid = __builtin_amdgcn_readfirstlane(tid >> 6), lane = tid & 63, wr = wid >> 2, wc = wid & 3, fr = lane & 15, fq = lane >> 4;
    const int K = g.K, nt = K / BK;
    int Rr[2], Cc[2]; unsigned voffB[2];
#pragma unroll
    for (int i = 0; i < 2; ++i) { int R, C; stage_rc(tid * 16 + i * 8192, R, C); Rr[i] = R; Cc[i] = C; const int Rb = Epi::PERM ? ((R & ~31) + perm32(R & 31)) : R; voffB[i] = (unsigned)(Rb * K + C) * 2u; }
    const size_t kstep = (size_t)(BK * 2);
    const size_t hstep = (size_t)HALF * K * 2;
    const size_t tstep = 2 * hstep;
    const unsigned ldsw = (unsigned)wid * 1024u;
    const int aoff = lds_byte(wr * 64 + fr, fq * 8), boff = lds_byte(wc * 32 + fr, fq * 8);
#define PG8_SA(b, h) (((b) * 2 + (h)) * HTB)
#define PG8_SB(b, h) ((4 + (b) * 2 + (h)) * HTB)
#define PG8_STAGE(bufoff, gbase, voff) do { _Pragma("unroll") for (int _i = 0; _i < 2; ++_i) \
        __builtin_amdgcn_global_load_lds((const unsigned*)((const char*)(gbase) + (voff)[_i]), (PG8_LAS unsigned*)(lds + (bufoff) + ldsw + _i * 8192), 16, 0, 0); } while (0)
#define PG8_LDA(dst, b, h) do { _Pragma("unroll") for (int m = 0; m < 4; ++m) _Pragma("unroll") for (int k = 0; k < 2; ++k) dst[m][k] = *(const PG8_LAS bf16x8*)(lds + PG8_SA(b, h) + aoff + m * 2048 + k * 1024); } while (0)
#define PG8_LDB(dst, b, h) do { _Pragma("unroll") for (int n = 0; n < 2; ++n) _Pragma("unroll") for (int k = 0; k < 2; ++k) dst[n][k] = *(const PG8_LAS bf16x8*)(lds + PG8_SB(b, h) + boff + n * 2048 + k * 1024); } while (0)
#define PG8_MMA(ai, bj, At, Bt) do { __builtin_amdgcn_s_setprio(1); _Pragma("unroll") for (int m = 0; m < 4; ++m) _Pragma("unroll") for (int n = 0; n < 2; ++n) _Pragma("unroll") for (int k = 0; k < 2; ++k) \
        acc[ai][bj][m][n] = __builtin_amdgcn_mfma_f32_16x16x32_bf16(Bt[n][k], At[m][k], acc[ai][bj][m][n], 0, 0, 0); __builtin_amdgcn_s_setprio(0); } while (0)
#define PG8_WAIT_V(n) asm volatile("s_waitcnt vmcnt(" #n ")" ::: "memory")
#define PG8_WAIT_L(n) asm volatile("s_waitcnt lgkmcnt(" #n ")" ::: "memory")
#define PG8_BAR __builtin_amdgcn_s_barrier()
#define PG8_SCHED __builtin_amdgcn_sched_barrier(0)
#define PG8_CALC_VOFF(u, vo) do { _Pragma("unroll") for (int h_ = 0; h_ < 2; ++h_) _Pragma("unroll") for (int i_ = 0; i_ < 2; ++i_) { \
        if constexpr (GATHER) { const int tok_ = S.arow(u, h_ * HALF + Rr[i_]); vo[h_][i_] = (unsigned)(tok_ * K + Cc[i_]) * 2u; } \
        else vo[h_][i_] = (unsigned)(Rr[i_] * K + Cc[i_]) * 2u + (unsigned)(h_ * hstep); } } while (0)
    Unit cur, nxt; int ui = 0;
    if (!S.next(0, cur)) return;
    unsigned vA[2][2], nvA[2][2];
    PG8_CALC_VOFF(cur, vA);
    if constexpr (GATHER) asm volatile("" : "+v"(vA[0][0]), "+v"(vA[0][1]), "+v"(vA[1][0]), "+v"(vA[1][1]));
    f32x4 acc[2][2][4][2];
#pragma unroll
    for (int a = 0; a < 2; ++a)
#pragma unroll
        for (int b = 0; b < 2; ++b)
#pragma unroll
            for (int m = 0; m < 4; ++m)
#pragma unroll
                for (int n = 0; n < 2; ++n) acc[a][b][m][n] = (f32x4){0.f, 0.f, 0.f, 0.f};
    bf16x8 At[4][2], B0[2][2], B1[2][2];
    const char* cA = GATHER ? (const char*)g.A : (const char*)g.A + (size_t)cur.pm * tstep; const char* cB = (const char*)g.Bt + (size_t)cur.pn * tstep;
    PG8_STAGE(PG8_SB(0, 0), cB, voffB); PG8_STAGE(PG8_SB(0, 1), cB + hstep, voffB); PG8_STAGE(PG8_SA(0, 0), cA, vA[0]); PG8_STAGE(PG8_SA(0, 1), cA, vA[1]);
    if (wr == 1) PG8_BAR;
    PG8_WAIT_V(2); PG8_BAR;
    PG8_STAGE(PG8_SB(1, 0), cB + kstep, voffB); PG8_STAGE(PG8_SA(1, 0), cA + kstep, vA[0]); PG8_STAGE(PG8_SB(1, 1), cB + hstep + kstep, voffB);
    PG8_WAIT_V(6); PG8_BAR;
    for (;;) {
        const bool has_next = S.next(ui + 1, nxt);
        const char* nA = has_next ? (GATHER ? (const char*)g.A : (const char*)g.A + (size_t)nxt.pm * tstep) : cA; const char* nB = has_next ? (const char*)g.Bt + (size_t)nxt.pn * tstep : cB;
        if constexpr (GATHER) {
            if (has_next) { PG8_CALC_VOFF(nxt, nvA); }
            else {
#pragma unroll
                for (int h_ = 0; h_ < 2; ++h_)
#pragma unroll
                    for (int i_ = 0; i_ < 2; ++i_) nvA[h_][i_] = vA[h_][i_]; }
            asm volatile("" : "+v"(nvA[0][0]), "+v"(nvA[0][1]), "+v"(nvA[1][0]), "+v"(nvA[1][1]));
        }
        for (int t = 0; t < nt; t += 2) {
            const bool last = (t == nt - 2);
            const char* a1 = cA + (size_t)(t + 1) * kstep;
            const char* a2 = last ? nA : cA + (size_t)(t + 2) * kstep; const char* b2 = last ? nB : cB + (size_t)(t + 2) * kstep;
            const char* a3 = a2 + kstep; const char* b3 = b2 + kstep;
            unsigned w0[2], w1[2];
#pragma unroll
            for (int i_ = 0; i_ < 2; ++i_) { w0[i_] = (GATHER && last) ? nvA[0][i_] : vA[0][i_]; w1[i_] = (GATHER && last) ? nvA[1][i_] : vA[1][i_]; }
            PG8_LDB(B0, 0, 0); PG8_LDB(B1, 0, 1); PG8_SCHED; PG8_LDA(At, 0, 0); PG8_STAGE(PG8_SA(1, 1), a1, vA[1]);
            PG8_WAIT_V(8); PG8_WAIT_L(0); PG8_BAR; PG8_MMA(0, 0, At, B0); PG8_MMA(0, 1, At, B1); PG8_BAR; PG8_SCHED;
            PG8_LDA(At, 0, 1); PG8_STAGE(PG8_SB(0, 0), b2, voffB); PG8_STAGE(PG8_SB(0, 1), b2 + hstep, voffB); PG8_STAGE(PG8_SA(0, 0), a2, w0);
            PG8_WAIT_V(8); PG8_WAIT_L(0); PG8_BAR; PG8_MMA(1, 0, At, B0); PG8_MMA(1, 1, At, B1); PG8_BAR; PG8_SCHED;
            PG8_LDB(B0, 1, 0); PG8_LDB(B1, 1, 1); PG8_SCHED; PG8_LDA(At, 1, 0); PG8_STAGE(PG8_SA(0, 1), a2, w1);
            PG8_WAIT_V(8); PG8_WAIT_L(0); PG8_BAR; PG8_MMA(0, 0, At, B0); PG8_MMA(0, 1, At, B1); PG8_BAR; PG8_SCHED;
            PG8_LDA(At, 1, 1); PG8_STAGE(PG8_SB(1, 0), b3, voffB); PG8_STAGE(PG8_SB(1, 1), b3 + hstep, voffB); PG8_STAGE(PG8_SA(1, 0), a3, w0);
            PG8_WAIT_V(8); PG8_WAIT_L(0); PG8_BAR; PG8_MMA(1, 0, At, B0); PG8_MMA(1, 1, At, B1); PG8_BAR; PG8_SCHED;
        }
        if (wr == 0) PG8_BAR;
        E(acc, cur, wr, wc, fr, fq);
        if (!has_next) break;
#pragma unroll
        for (int a = 0; a < 2; ++a)
#pragma unroll
            for (int b = 0; b < 2; ++b)
#pragma unroll
                for (int m = 0; m < 4; ++m)
#pragma unroll
                    for (int n = 0; n < 2; ++n) acc[a][b][m][n] = (f32x4){0.f, 0.f, 0.f, 0.f};
        cur = nxt; cA = nA; cB = nB; ++ui;
        if constexpr (GATHER) {
#pragma unroll
            for (int h_ = 0; h_ < 2; ++h_)
#pragma unroll
                for (int i_ = 0; i_ < 2; ++i_) vA[h_][i_] = nvA[h_][i_]; }
        if (wr == 1) PG8_BAR;
    }
    PG8_WAIT_V(0);
    PG8_BAR;
#undef PG8_SA
#undef PG8_SB
#undef PG8_STAGE
#undef PG8_LDA
#undef PG8_LDB
#undef PG8_MMA
#undef PG8_WAIT_V
#undef PG8_WAIT_L
#undef PG8_BAR
#undef PG8_SCHED
#undef PG8_CALC_VOFF
}
}

namespace attn_body {
using bf16=__hip_bfloat16;
using bf16x8=__attribute__((ext_vector_type(8)))short;
using s16x4=__attribute__((ext_vector_type(4)))short;
using f32x16=__attribute__((ext_vector_type(16)))float;
using u32x4=__attribute__((ext_vector_type(4)))unsigned;
constexpr int SEQ=16384,D=64;
constexpr int LDQ=3072;
constexpr int LDO=1024;
constexpr int NW=8,QBLK=32,QB=QBLK*NW,KVBLK=64,NQB=SEQ/QB;
__device__ __forceinline__ int crow(int r,int hi){return (r&3)+8*(r>>2)+4*hi;}
#define SBAR() __builtin_amdgcn_sched_barrier(0)
typedef __attribute__((address_space(3))) const float* lds_cfptr;
__device__ __forceinline__ void biasmask(f32x16&p0,f32x16&p1,int jb,int qrel,int hi,lds_cfptr bl){
  const float NEG=-INFINITY; const int kb=64*jb+4*hi;
  #pragma unroll
  for(int r=0;r<16;++r){const int kv=kb+(r&3)+8*(r>>2); const int d0=qrel-kv,d1=d0-32;
    const int i0=d0<0?0:(d0>127?127:d0), i1=d1<0?0:(d1>127?127:d1);
    const float b0=bl[i0],b1=bl[i1];
    p0[r]=d0<0?NEG:p0[r]+b0; p1[r]=d1<0?NEG:p1[r]+b1;}
}

constexpr int NSLOT=3, SLOTB=8192;
constexpr int LDS_K=0, LDS_V=NSLOT*SLOTB, LDS_WS=2*NSLOT*SLOTB, LDS_OST=LDS_WS+NW*128*4, LDS_BIAS=LDS_OST+NW*4096, LDS_BYTES=LDS_BIAS+512;
constexpr float C2=0.125f*1.4426950408889634f;
__device__ __forceinline__ void glds16(const void*gsrc,unsigned lds_dst){unsigned keep;
  asm volatile("s_mov_b32 %0, m0\n\ts_mov_b32 m0, %2\n\ts_nop 0\n\tglobal_load_lds_dwordx4 %1, off\n\ts_mov_b32 m0, %0":"=&s"(keep):"v"(gsrc),"s"(lds_dst):"memory");}
__device__ __forceinline__ float max3f(float a,float b,float c){float r;asm("v_max3_f32 %0, %1, %2, %3":"=v"(r):"v"(a),"v"(b),"v"(c));return r;}
__device__ __forceinline__ float max2f(float a,float b){float r;asm("v_max_f32_e32 %0, %1, %2":"=v"(r):"v"(a),"v"(b));return r;}
__device__ __forceinline__ float fadd_s(float a,float b){float r;asm("v_add_f32_e32 %0, %1, %2":"=v"(r):"v"(a),"v"(b));return r;}
__device__ __forceinline__ float fsub_s(float a,float b){float r;asm("v_sub_f32_e32 %0, %1, %2":"=v"(r):"v"(a),"v"(b));return r;}
typedef float f32x2_t __attribute__((ext_vector_type(2))); typedef __bf16 bf16x2_t __attribute__((ext_vector_type(2)));
__device__ __forceinline__ unsigned cvtpk_s(float lo,float hi){f32x2_t v={lo,hi};bf16x2_t b=__builtin_convertvector(v,bf16x2_t);return __builtin_bit_cast(unsigned,b);}
#define WAIT_BAR(N) asm volatile("s_waitcnt vmcnt(" #N ") lgkmcnt(0)\n\ts_barrier":::"memory")

__device__ __forceinline__ void qkt(f32x16&p0,f32x16&p1,const char*Kslot,const bf16x8*qr,const f32x16&negm,int r32,int hi){
  const char*kb=Kslot+hi*1024+r32*16;
  #pragma unroll
  for(int d0=0;d0<4;++d0){
    const bf16x8 b0=*reinterpret_cast<const bf16x8*>(kb+d0*2048);
    const bf16x8 b1=*reinterpret_cast<const bf16x8*>(kb+d0*2048+512);
    if(d0==0){p0=__builtin_amdgcn_mfma_f32_32x32x16_bf16(b0,qr[0],negm,0,0,0);p1=__builtin_amdgcn_mfma_f32_32x32x16_bf16(b1,qr[0],negm,0,0,0);}
    else{p0=__builtin_amdgcn_mfma_f32_32x32x16_bf16(b0,qr[d0],p0,0,0,0);p1=__builtin_amdgcn_mfma_f32_32x32x16_bf16(b1,qr[d0],p1,0,0,0);}}
}
typedef __attribute__((address_space(3))) const char* lds_cptr;
typedef short v4i16_t __attribute__((ext_vector_type(4)));
__device__ __forceinline__ void kload8(bf16x8*kf,lds_cptr kp){
  kf[0]=*(const __attribute__((address_space(3))) bf16x8*)(kp);      kf[1]=*(const __attribute__((address_space(3))) bf16x8*)(kp+512);
  kf[2]=*(const __attribute__((address_space(3))) bf16x8*)(kp+2048); kf[3]=*(const __attribute__((address_space(3))) bf16x8*)(kp+2560);
  kf[4]=*(const __attribute__((address_space(3))) bf16x8*)(kp+4096); kf[5]=*(const __attribute__((address_space(3))) bf16x8*)(kp+4608);
  kf[6]=*(const __attribute__((address_space(3))) bf16x8*)(kp+6144); kf[7]=*(const __attribute__((address_space(3))) bf16x8*)(kp+6656);
}
__device__ __forceinline__ void kload2(bf16x8*kf,lds_cptr kp,int j){ kf[2*j]=*(const __attribute__((address_space(3))) bf16x8*)(kp+j*2048); kf[2*j+1]=*(const __attribute__((address_space(3))) bf16x8*)(kp+j*2048+512); }
__device__ __forceinline__ s16x4 vtr(lds_cptr p){ return __builtin_bit_cast(s16x4,__builtin_amdgcn_ds_read_tr16_b64_v4i16((__attribute__((address_space(3))) v4i16_t*)p)); }
__device__ __forceinline__ float rowmax(const f32x16&p0,const f32x16&p1){
  float a=max3f(p0[0],p0[1],p1[0]),b=max3f(p0[2],p0[3],p1[1]);a=max3f(a,p1[2],p1[3]);
  #pragma unroll
  for(int r=4;r<16;r+=4){a=max3f(a,p0[r],p0[r+1]);b=max3f(b,p0[r+2],p0[r+3]);a=max3f(a,p1[r],p1[r+1]);b=max3f(b,p1[r+2],p1[r+3]);}
  const float m=max2f(a,b);
  auto rr=__builtin_amdgcn_permlane32_swap(__float_as_uint(m),__float_as_uint(m),false,false);
  return max2f(__uint_as_float(rr[0]),__uint_as_float(rr[1]));
}
__device__ __forceinline__ float rowmax_c(const f32x16&p0,const f32x16&p1){
  float a=__builtin_fmaxf(p0[0],p1[0]);
  #pragma unroll
  for(int r=1;r<16;++r){a=__builtin_fmaxf(a,__builtin_fmaxf(p0[r],p1[r]));}
  auto rr=__builtin_amdgcn_permlane32_swap(__float_as_uint(a),__float_as_uint(a),false,false);
  return __builtin_fmaxf(__uint_as_float(rr[0]),__uint_as_float(rr[1]));
}
__device__ __forceinline__ void pv(f32x16*o,int vb,bf16x8 pa0,bf16x8 pa1,bf16x8 pa2,bf16x8 pa3){
  #pragma unroll
  for(int d0=0;d0<2;++d0){s16x4 lo[4],hi[4];
    #pragma unroll
    for(int ks=0;ks<4;++ks){
      asm volatile("ds_read_b64_tr_b16 %0,%1 offset:%c2":"=&v"(lo[ks]):"v"(vb),"i"(d0*4096+ks*1024):"memory");
      asm volatile("ds_read_b64_tr_b16 %0,%1 offset:%c2":"=&v"(hi[ks]):"v"(vb),"i"(d0*4096+ks*1024+512):"memory");}
    asm volatile("s_waitcnt lgkmcnt(0)":::"memory");SBAR();
    #define PK(k) (bf16x8){lo[k][0],lo[k][1],lo[k][2],lo[k][3],hi[k][0],hi[k][1],hi[k][2],hi[k][3]}
    o[d0]=__builtin_amdgcn_mfma_f32_32x32x16_bf16(pa0,PK(0),o[d0],0,0,0);
    o[d0]=__builtin_amdgcn_mfma_f32_32x32x16_bf16(pa1,PK(1),o[d0],0,0,0);
    o[d0]=__builtin_amdgcn_mfma_f32_32x32x16_bf16(pa2,PK(2),o[d0],0,0,0);
    o[d0]=__builtin_amdgcn_mfma_f32_32x32x16_bf16(pa3,PK(3),o[d0],0,0,0);
    #undef PK
  }
}
__device__ __forceinline__ float bflo(unsigned u){return __uint_as_float(u<<16);}
__device__ __forceinline__ float bfhi(unsigned u){return __uint_as_float(u&0xffff0000u);}

struct MobaMerge { const float* pml; const bf16* po; long grow0; int h; int ns; };
constexpr long MROWS=2L*SEQ;

template<int THRL,int MODE> __device__ __forceinline__ void attn_unit(const bf16*Qp,const bf16*__restrict__ Kp,const bf16*__restrict__ Vp,bf16*Op,int q0,int kv0,int NT,const float*biasG,const MobaMerge&mm,char*shm){
  const int tid=threadIdx.x,lane=tid&63,r32=lane&31,hi=lane>>5; const int wid=__builtin_amdgcn_readfirstlane(tid>>6);
  const bf16*Qw=Qp+(long)(q0+wid*QBLK)*LDQ;
  const bf16*Kh=Kp+(long)kv0*LDQ,*Vh=Vp+(long)kv0*LDQ;
  const unsigned lds0=(unsigned)(uintptr_t)shm;
  float*wsf=(float*)(shm+LDS_WS)+wid*128;
  const lds_cptr shm3=(lds_cptr)shm;
  asm volatile("":"+s"(biasG));
  { __attribute__((address_space(3))) float* blw=(__attribute__((address_space(3))) float*)(shm3+LDS_BIAS); if(tid<128)blw[tid]=biasG[tid]; }
  const lds_cfptr bl=(lds_cfptr)(shm3+LDS_BIAS);
  const bf16*ksrc=Kh+(long)lane*LDQ+wid*8;
  const bf16*vsrc=Vh+(long)(16*(wid&3)+(lane>>2))*LDQ+(wid>>2)*32+(lane&3)*8;
  const unsigned kdst=lds0+LDS_K+wid*1024, vdst=lds0+LDS_V+wid*1024;
  #define DMA_K(t,slot) glds16(ksrc+(long)(t)*KVBLK*LDQ,(unsigned)__builtin_amdgcn_readfirstlane(kdst+(slot)))
  #define DMA_V(t,slot) glds16(vsrc+(long)(t)*KVBLK*LDQ,(unsigned)__builtin_amdgcn_readfirstlane(vdst+(slot)))
  const int vb0=(int)(lds0+LDS_V)+((lane>>4)&1)*32+(lane&3)*8+(4*hi+((lane&15)>>2))*64;
  const char*Kbase=shm+LDS_K; bf16x8 kf[8];
  const lds_cptr kp0=shm3+LDS_K+hi*1024+r32*16; const lds_cptr vp0=shm3+LDS_V+((lane>>4)&1)*32+(lane&3)*8+(4*hi+((lane&15)>>2))*64;
  asm volatile("s_waitcnt vmcnt(0)":::"memory");
  DMA_K(0,0);DMA_V(0,0);DMA_K(1,SLOTB);
  bf16x8 qr[4];
  #pragma unroll
  for(int d0=0;d0<4;++d0)qr[d0]=*reinterpret_cast<const bf16x8*>(&Qw[(long)r32*LDQ+d0*16+hi*8]);
  float mhat=0.f,l_reg=0.f;f32x16 o[2];o[0]=f32x16{};o[1]=f32x16{};f32x16 negm=f32x16{};asm volatile("":"+v"(negm));
  const int qrel=wid*QBLK+r32;
  #define CMASK(P0,P1,t) do{int jb_=(t)-(NT-4); if(jb_>=-2 && (32*wid-(64*jb_+63))<113)biasmask(P0,P1,jb_,qrel,hi,bl);}while(0)
  bool resc=false;
  #define START(P0,P1) do{ const float rm=rowmax(P0,P1); resc=false; \
    { const float dl=rm; mhat=fadd_s(mhat,dl); \
      _Pragma("unroll") for(int r=0;r<16;++r){P0[r]=fsub_s(P0[r],dl);P1[r]=fsub_s(P1[r],dl);} \
      _Pragma("unroll") for(int r=0;r<16;++r)negm[r]=-mhat; asm volatile("":"+v"(negm)); } \
    _Pragma("unroll") for(int r=0;r<16;++r)P0[r]=__builtin_amdgcn_exp2f(P0[r]); }while(0)
  #define RESC() do{ if(resc){ asm volatile("s_waitcnt lgkmcnt(0)":::"memory"); \
      _Pragma("unroll") for(int d_=0;d_<2;++d_) _Pragma("unroll") for(int r=0;r<16;++r)o[d_][r]*=wsf[crow(r,hi)]; } }while(0)
  f32x16 pA0,pA1,pB0,pB1;
  int sl_prev=0,sl_cur=0,sl_next=SLOTB;
  #define ROT() do{sl_prev=sl_cur;sl_cur=sl_next;sl_next=(sl_next==(NSLOT-1)*SLOTB)?0:sl_next+SLOTB;}while(0)
  DMA_K(2,2*SLOTB);
  WAIT_BAR(3);
  qkt(pA0,pA1,Kbase,qr,negm,r32,hi);asm volatile("s_nop 15\n\ts_nop 7":"+v"(pA0),"+v"(pA1));CMASK(pA0,pA1,0);
  START(pA0,pA1);
  _Pragma("unroll") for(int r=0;r<16;++r)pA1[r]=__builtin_amdgcn_exp2f(pA1[r]);
  WAIT_BAR(0);
  DMA_K(3,0);DMA_V(1,SLOTB);
  ROT();
  kload8(kf,kp0+sl_cur);
  WAIT_BAR(2);
  s16x4 vlo[8],vhi[8]; u32x4 pw0,pw1,pw2,pw3;
  #define PKW(P,B) cvtpk_s(P[B],P[B+1])
  #define PAF(k) __builtin_bit_cast(bf16x8,pw##k)
  #define VFR(i) (bf16x8){vlo[i][0],vlo[i][1],vlo[i][2],vlo[i][3],vhi[i][0],vhi[i][1],vhi[i][2],vhi[i][3]}
  #define PIN(x) asm volatile("":"+v"(x))
  #define MX3(a,b,c) __builtin_fmaxf(__builtin_fmaxf((a),(b)),(c))
  #define GAPA(MF,A0,A1,A2,A3,W0,W1,PW) do{ MF; sacc+=A0; sacc+=A1; sacc+=A2; sacc+=A3; PIN(sacc); W0; W1; PIN(PW); SBAR(); }while(0)
  #define EX(v) __builtin_amdgcn_exp2f(v)
  #define GAPB(MF,X,B) do{ MF; X[B]=EX(X[B]); X[B+1]=EX(X[B+1]); X[B+2]=EX(X[B+2]); X[B+3]=EX(X[B+3]); PIN(X); SBAR(); }while(0)
  #define VRD(i) do{ vlo[i]=vtr(vp_+(((i)>>2)*4096+((i)&3)*1024)); vhi[i]=vtr(vp_+(((i)>>2)*4096+((i)&3)*1024+512)); }while(0)
  #define KRD(G,j) do{ if(G){ kload2(kf,kp0+sl_next,j); SBAR(); } }while(0)
  #define STEP(C0,C1,P0,P1,t,GK,GV,GL) do{ SBAR(); \
    const lds_cptr vp_=vp0+sl_prev; \
    VRD(0); SBAR(); float sacc=(P0[0]+P0[1]); \
    GAPA(C0=__builtin_amdgcn_mfma_f32_32x32x16_bf16(kf[0],qr[0],negm,0,0,0), P0[2],P0[3],P0[4],P0[5],     pw0[0]=PKW(P0,0), pw0[1]=PKW(P0,2), pw0); \
    VRD(4); SBAR(); GAPA(C1=__builtin_amdgcn_mfma_f32_32x32x16_bf16(kf[1],qr[0],negm,0,0,0), P0[6],P0[7],P0[8],P0[9],     pw0[2]=PKW(P0,4), pw0[3]=PKW(P0,6), pw0); \
    VRD(1); SBAR(); GAPA(C0=__builtin_amdgcn_mfma_f32_32x32x16_bf16(kf[2],qr[1],C0,0,0,0),   P0[10],P0[11],P0[12],P0[13], pw1[0]=PKW(P0,8), pw1[1]=PKW(P0,10), pw1); \
    VRD(5); SBAR(); GAPA(C1=__builtin_amdgcn_mfma_f32_32x32x16_bf16(kf[3],qr[1],C1,0,0,0),   P0[14],P0[15],P1[0],P1[1],   pw1[2]=PKW(P0,12),pw1[3]=PKW(P0,14), pw1); \
    VRD(2); SBAR(); GAPA(C0=__builtin_amdgcn_mfma_f32_32x32x16_bf16(kf[4],qr[2],C0,0,0,0),   P1[2],P1[3],P1[4],P1[5],     pw2[0]=PKW(P1,0), pw2[1]=PKW(P1,2), pw2); \
    VRD(6); SBAR(); GAPA(C1=__builtin_amdgcn_mfma_f32_32x32x16_bf16(kf[5],qr[2],C1,0,0,0),   P1[6],P1[7],P1[8],P1[9],     pw2[2]=PKW(P1,4), pw2[3]=PKW(P1,6), pw2); \
    VRD(3); SBAR(); GAPA(C0=__builtin_amdgcn_mfma_f32_32x32x16_bf16(kf[6],qr[3],C0,0,0,0),   P1[10],P1[11],P1[12],P1[13], pw3[0]=PKW(P1,8), pw3[1]=PKW(P1,10), pw3); \
    VRD(7); SBAR(); GAPA(C1=__builtin_amdgcn_mfma_f32_32x32x16_bf16(kf[7],qr[3],C1,0,0,0),   P1[14],P1[15],0.f,0.f,       pw3[2]=PKW(P1,12),pw3[3]=PKW(P1,14), pw3); \
    l_reg+=sacc; \
    if(GK){DMA_K((t)+3,sl_cur);} if(GV){DMA_V((t)+1,sl_next);} \
    CMASK(C0,C1,t); \
    { float a=MX3(C0[0],C0[1],C1[0]),b=MX3(C0[2],C0[3],C1[1]); a=MX3(a,C1[2],C1[3]); \
      _Pragma("unroll") for(int r=4;r<16;r+=4){a=MX3(a,C0[r],C0[r+1]);b=MX3(b,C0[r+2],C0[r+3]);a=MX3(a,C1[r],C1[r+1]);b=MX3(b,C1[r+2],C1[r+3]);} \
      float rm=__builtin_fmaxf(a,b); { auto rr=__builtin_amdgcn_permlane32_swap(__float_as_uint(rm),__float_as_uint(rm),false,false); rm=__builtin_fmaxf(__uint_as_float(rr[0]),__uint_as_float(rr[1])); } \
      resc=false; \
      if(__builtin_expect(__any(rm>(float)THRL),0)){ const float dl=__builtin_fmaxf(rm,0.f); mhat+=dl; \
        _Pragma("unroll") for(int r=0;r<16;++r){C0[r]-=dl;C1[r]-=dl;} \
        _Pragma("unroll") for(int r=0;r<16;++r)negm[r]=-mhat; asm volatile("":"+v"(negm)); \
        const float f=__builtin_amdgcn_exp2f(-dl); l_reg*=f; if(hi==0)wsf[r32]=f; resc=true; } } \
    SBAR(); \
    GAPB(o[0]=__builtin_amdgcn_mfma_f32_32x32x16_bf16(PAF(0),VFR(0),o[0],0,0,0), C0,0); \
    GAPB(o[1]=__builtin_amdgcn_mfma_f32_32x32x16_bf16(PAF(0),VFR(4),o[1],0,0,0), C0,4); \
    KRD(GL,0); GAPB(o[0]=__builtin_amdgcn_mfma_f32_32x32x16_bf16(PAF(1),VFR(1),o[0],0,0,0), C0,8); \
    KRD(GL,1); GAPB(o[1]=__builtin_amdgcn_mfma_f32_32x32x16_bf16(PAF(1),VFR(5),o[1],0,0,0), C0,12); \
    KRD(GL,2); GAPB(o[0]=__builtin_amdgcn_mfma_f32_32x32x16_bf16(PAF(2),VFR(2),o[0],0,0,0), C1,0); \
    KRD(GL,3); GAPB(o[1]=__builtin_amdgcn_mfma_f32_32x32x16_bf16(PAF(2),VFR(6),o[1],0,0,0), C1,4); \
    GAPB(o[0]=__builtin_amdgcn_mfma_f32_32x32x16_bf16(PAF(3),VFR(3),o[0],0,0,0), C1,8); \
    GAPB(o[1]=__builtin_amdgcn_mfma_f32_32x32x16_bf16(PAF(3),VFR(7),o[1],0,0,0), C1,12); \
    }while(0)
  int t=1;
  #undef CMASK
  #define CMASK(P0,P1,t) do{}while(0)
  for(;t+7<NT;t+=2){
    STEP(pB0,pB1,pA0,pA1,t,true,true,true);     WAIT_BAR(2); RESC(); ROT();
    STEP(pA0,pA1,pB0,pB1,t+1,true,true,true);   WAIT_BAR(2); RESC(); ROT();
  }
  #undef CMASK
  #define CMASK(P0,P1,t) do{int jb_=(t)-(NT-4); if(jb_>=-2 && (32*wid-(64*jb_+63))<113)biasmask(P0,P1,jb_,qrel,hi,bl);}while(0)
  #define ENDW(tt) do{ if((tt)+3<NT){WAIT_BAR(2);} else if((tt)+2<NT){WAIT_BAR(1);} else {WAIT_BAR(0);} }while(0)
  for(;t+1<NT;t+=2){
    STEP(pB0,pB1,pA0,pA1,t,(t+3<NT),(t+1<NT),(t+1<NT));       ENDW(t);   RESC(); ROT();
    STEP(pA0,pA1,pB0,pB1,t+1,(t+4<NT),(t+2<NT),(t+2<NT));     ENDW(t+1); RESC(); ROT();
  }
  STEP(pB0,pB1,pA0,pA1,NT-1,false,false,false); RESC();
  { float sacc=pB0[0]+pB0[1]; _Pragma("unroll") for(int r=2;r<16;++r)sacc+=pB0[r]; _Pragma("unroll") for(int r=0;r<16;++r)sacc+=pB1[r]; l_reg+=sacc;
    pw0=(u32x4){PKW(pB0,0),PKW(pB0,2),PKW(pB0,4),PKW(pB0,6)};pw1=(u32x4){PKW(pB0,8),PKW(pB0,10),PKW(pB0,12),PKW(pB0,14)};pw2=(u32x4){PKW(pB1,0),PKW(pB1,2),PKW(pB1,4),PKW(pB1,6)};pw3=(u32x4){PKW(pB1,8),PKW(pB1,10),PKW(pB1,12),PKW(pB1,14)};
    SBAR(); pv(o,vb0+sl_cur,PAF(0),PAF(1),PAF(2),PAF(3)); }
  #undef PKW
  #undef PAF
  #undef VFR
  #undef PIN
  #undef MX3
  #undef GAPA
  #undef GAPB
  #undef EX
  #undef VRD
  #undef KRD
  #undef STEP
  #undef ENDW
  {auto rr=__builtin_amdgcn_permlane32_swap(__float_as_uint(l_reg),__float_as_uint(l_reg),false,false);l_reg=__uint_as_float(rr[0])+__uint_as_float(rr[1]);}
  const float*pml_=mm.pml; const bf16*po_=mm.po; if constexpr(MODE==1){ asm volatile("":"+s"(pml_),"+s"(po_)); }
  if constexpr(MODE==1){
    const long gr=mm.grow0+wid*QBLK+r32; float ms[3],ls[3],as[3]; float Mx=mhat;
    #pragma unroll
    for(int s=0;s<3;++s){ ms[s]=-INFINITY; ls[s]=0.f; if(s<mm.ns){ const f32x2_t v=*(const f32x2_t*)(pml_+((long)s*MROWS+gr)*16+mm.h*2); ms[s]=v.x; ls[s]=v.y; Mx=__builtin_fmaxf(Mx,ms[s]); } }
    const float a0=__builtin_amdgcn_exp2f(mhat-Mx); float L=a0*l_reg;
    #pragma unroll
    for(int s=0;s<3;++s){ as[s]=(s<mm.ns)?__builtin_amdgcn_exp2f(ms[s]-Mx):0.f; L+=as[s]*ls[s]; }
    const float inv=1.0f/L;
    if(hi==0){wsf[32+r32]=a0*inv;wsf[64+r32]=as[0]*inv;wsf[96+r32]=as[1]*inv;wsf[r32]=as[2]*inv;}
  } else {
    if(hi==0)wsf[32+r32]=1.0f/l_reg;
  }
  asm volatile("s_waitcnt lgkmcnt(0)":::"memory");
  float rli[16];
  #pragma unroll
  for(int r=0;r<16;++r)rli[r]=wsf[32+crow(r,hi)];
  { asm volatile("":"+s"(Op)); }
  bf16*Ow=Op+(long)(q0+wid*QBLK)*LDO;
  { bf16*stg=(bf16*)(shm+LDS_OST)+wid*2048;
    #pragma unroll
    for(int r=0;r<16;++r){const int orow=crow(r,hi);
      #pragma unroll
      for(int d0=0;d0<2;++d0)stg[orow*64+d0*32+r32]=__float2bfloat16(o[d0][r]*rli[r]);}
    asm volatile("s_waitcnt lgkmcnt(0)":::"memory");
    int lane_e=lane; asm volatile("":"+v"(lane_e));
    #pragma unroll
    for(int i=0;i<4;++i){const int row=i*8+(lane_e>>3),ch=lane_e&7; u32x4 v=*(const u32x4*)(stg+row*64+ch*8);
      if constexpr(MODE==1){
        float a[8]={bflo(v.x),bfhi(v.x),bflo(v.y),bfhi(v.y),bflo(v.z),bfhi(v.z),bflo(v.w),bfhi(v.w)};
        #pragma unroll
        for(int s=0;s<3;++s){ if(s<mm.ns){ const float c=wsf[(s==0?64:(s==1?96:0))+row];
            const u32x4 pp=*(const u32x4*)(po_+(((long)s*MROWS+mm.grow0+wid*QBLK+row)*8+mm.h)*64+ch*8);
            a[0]+=c*bflo(pp.x);a[1]+=c*bfhi(pp.x);a[2]+=c*bflo(pp.y);a[3]+=c*bfhi(pp.y);a[4]+=c*bflo(pp.z);a[5]+=c*bfhi(pp.z);a[6]+=c*bflo(pp.w);a[7]+=c*bfhi(pp.w);} }
        v.x=cvtpk_s(a[0],a[1]);v.y=cvtpk_s(a[2],a[3]);v.z=cvtpk_s(a[4],a[5]);v.w=cvtpk_s(a[6],a[7]);
      }
      *(u32x4*)(Ow+(long)row*LDO+ch*8)=v;} }
  asm volatile("s_waitcnt lgkmcnt(0)\n\ts_barrier":::"memory");
  #undef DMA_K
  #undef DMA_V
  #undef CMASK
  #undef START
  #undef RESC
  #undef ROT
}

constexpr int LDS_GK=0, LDS_GV=4*SLOTB, LDS_GWS=8*SLOTB, LDS_GOST=LDS_GWS+NW*128*4, LDS_GBIAS=LDS_GOST+NW*4096, LDS_GBYTES=LDS_GBIAS+512;
__device__ __forceinline__ void moba_gather_unit(const bf16*QKVb  ,int h,int j,const unsigned*ent,int n,long growb  ,const float*biasG,float*pml,bf16*po,char*shm){
  const int tid=threadIdx.x,lane=tid&63,r32=lane&31,hi=lane>>5; const int wid=__builtin_amdgcn_readfirstlane(tid>>6);
  const unsigned lds0=(unsigned)(uintptr_t)shm; const lds_cptr shm3=(lds_cptr)shm;
  float*wsf=(float*)(shm+LDS_GWS)+wid*128;
  { __attribute__((address_space(3))) float* blw=(__attribute__((address_space(3))) float*)(shm3+LDS_GBIAS); if(tid<128)blw[tid]=biasG[tid]; }
  const lds_cfptr bl=(lds_cfptr)(shm3+LDS_GBIAS);
  const int ei=wid*QBLK+r32; const unsigned e=ent[ei<n?ei:n-1];
  const int qloc=(int)(e&0x3FFFu), slot=(int)(e>>14);
  const bf16*Qrow=QKVb+(long)qloc*LDQ+1536+h*64;
  bf16x8 qr[4];
  #pragma unroll
  for(int d0=0;d0<4;++d0)qr[d0]=*reinterpret_cast<const bf16x8*>(Qrow+d0*16+hi*8);
  const bf16*Kh=QKVb+(long)(j*256)*LDQ+2048+h*64,*Vh=QKVb+(long)(j*256)*LDQ+2560+h*64;
  const bf16*ksrc=Kh+(long)lane*LDQ+wid*8;
  const bf16*vsrc=Vh+(long)(16*(wid&3)+(lane>>2))*LDQ+(wid>>2)*32+(lane&3)*8;
  #pragma unroll
  for(int t=0;t<4;++t){ glds16(ksrc+(long)t*KVBLK*LDQ,(unsigned)__builtin_amdgcn_readfirstlane(lds0+LDS_GK+t*SLOTB+wid*1024)); glds16(vsrc+(long)t*KVBLK*LDQ,(unsigned)__builtin_amdgcn_readfirstlane(lds0+LDS_GV+t*SLOTB+wid*1024)); }
  asm volatile("s_waitcnt vmcnt(0) lgkmcnt(0)\n\ts_barrier":::"memory");
  const int vb0=(int)(lds0+LDS_GV)+((lane>>4)&1)*32+(lane&3)*8+(4*hi+((lane&15)>>2))*64;
  float mhat=0.f,l_reg=0.f; f32x16 o[2]; o[0]=f32x16{}; o[1]=f32x16{}; f32x16 negm=f32x16{};
  const bool nearq=__any(qloc-(j*256+128)<128+113);
  #pragma unroll
  for(int t=0;t<4;++t){
    f32x16 p0,p1; qkt(p0,p1,shm+LDS_GK+t*SLOTB,qr,negm,r32,hi);
    if(t>=2 && nearq){ const int kb=j*256+t*64+4*hi;
      #pragma unroll
      for(int r=0;r<16;++r){ const int kv=kb+(r&3)+8*(r>>2); const int d0=qloc-kv,d1=d0-32; const int i0=d0>127?127:(d0<0?0:d0), i1=d1>127?127:(d1<0?0:d1); p0[r]+=bl[i0]; p1[r]+=bl[i1]; } }
    const float rm=rowmax_c(p0,p1);
    const float dl=(t==0)?rm:__builtin_fmaxf(rm,0.f);
    mhat+=dl;
    #pragma unroll
    for(int r=0;r<16;++r){p0[r]-=dl;p1[r]-=dl;}
    #pragma unroll
    for(int r=0;r<16;++r)negm[r]=-mhat;
    if(t>0){ const float f=__builtin_amdgcn_exp2f(-dl); l_reg*=f; if(hi==0)wsf[r32]=f; asm volatile("s_waitcnt lgkmcnt(0)":::"memory");
      #pragma unroll
      for(int d_=0;d_<2;++d_)
        #pragma unroll
        for(int r=0;r<16;++r)o[d_][r]*=wsf[crow(r,hi)]; }
    float sacc=0.f;
    #pragma unroll
    for(int r=0;r<16;++r){p0[r]=__builtin_amdgcn_exp2f(p0[r]);p1[r]=__builtin_amdgcn_exp2f(p1[r]);sacc+=p0[r]+p1[r];}
    l_reg+=sacc;
    u32x4 pw0,pw1,pw2,pw3;
    pw0=(u32x4){cvtpk_s(p0[0],p0[1]),cvtpk_s(p0[2],p0[3]),cvtpk_s(p0[4],p0[5]),cvtpk_s(p0[6],p0[7])};
    pw1=(u32x4){cvtpk_s(p0[8],p0[9]),cvtpk_s(p0[10],p0[11]),cvtpk_s(p0[12],p0[13]),cvtpk_s(p0[14],p0[15])};
    pw2=(u32x4){cvtpk_s(p1[0],p1[1]),cvtpk_s(p1[2],p1[3]),cvtpk_s(p1[4],p1[5]),cvtpk_s(p1[6],p1[7])};
    pw3=(u32x4){cvtpk_s(p1[8],p1[9]),cvtpk_s(p1[10],p1[11]),cvtpk_s(p1[12],p1[13]),cvtpk_s(p1[14],p1[15])};
    pv(o,vb0+t*SLOTB,__builtin_bit_cast(bf16x8,pw0),__builtin_bit_cast(bf16x8,pw1),__builtin_bit_cast(bf16x8,pw2),__builtin_bit_cast(bf16x8,pw3));
  }
  {auto rr=__builtin_amdgcn_permlane32_swap(__float_as_uint(l_reg),__float_as_uint(l_reg),false,false);l_reg=__uint_as_float(rr[0])+__uint_as_float(rr[1]);}
  if(hi==0 && ei<n){ f32x2_t v={mhat,l_reg}; *(f32x2_t*)(pml+((long)slot*MROWS+growb+qloc)*16+h*2)=v; }
  { bf16*stg=(bf16*)(shm+LDS_GOST)+wid*2048;
    #pragma unroll
    for(int r=0;r<16;++r){const int orow=crow(r,hi);
      #pragma unroll
      for(int d0=0;d0<2;++d0)stg[orow*64+d0*32+r32]=__float2bfloat16(o[d0][r]);}
    asm volatile("s_waitcnt lgkmcnt(0)":::"memory");
    #pragma unroll
    for(int i=0;i<4;++i){const int row=i*8+(lane>>3),ch=lane&7; const u32x4 v=*(const u32x4*)(stg+row*64+ch*8);
      const unsigned er=(unsigned)__shfl((int)e,row); const int ql=(int)(er&0x3FFFu), sl=(int)(er>>14);
      if(wid*QBLK+row<n) *(u32x4*)(po+(((long)sl*MROWS+growb+ql)*8+h)*64+ch*8)=v; } }
  asm volatile("s_waitcnt lgkmcnt(0)\n\ts_barrier":::"memory");
}
#undef SBAR
#undef WAIT_BAR
}

constexpr int NWAVES = 8;
#ifndef MK_N_LAUNCHES
#define MK_N_LAUNCHES 13
#endif
constexpr int N_PHASES = 13;
constexpr int N_LAUNCHES = MK_N_LAUNCHES;

constexpr int BATCH = 2, T = 16384, D = 1024, M = BATCH * T;
constexpr int NPROJ = 3072;
constexpr int NEXP = 32, EFF = 512;
constexpr float EPS = 1e-6f, LOG2E = 1.4426950408889634f;
constexpr float LAMBDA_INIT = 0.2f;
constexpr int MOBA_CAP = 256 * 2016;

constexpr size_t MiB = 1u << 20;
constexpr size_t WS_CTL = 0, CTL_ZERO_BYTES = 1 * MiB;
constexpr size_t WS_MOD = 1 * MiB;
constexpr size_t WS_BIASG = 1 * MiB + 64 * 1024;
constexpr size_t WS_KMEAN = 1 * MiB + 256 * 1024;
constexpr size_t WS_TOKW = 2 * MiB;
constexpr size_t WS_ELIST = 3 * MiB;
constexpr size_t WS_WIN = 8 * MiB, WS_WOUT = 14 * MiB;
constexpr size_t WS_XN = 16 * MiB;
constexpr size_t WS_QKV = 80 * MiB;
constexpr size_t WS_OD = 272 * MiB;
constexpr size_t WS_PO = 336 * MiB;
constexpr size_t WS_PML = 432 * MiB;
constexpr size_t WS_MLIST = 438 * MiB;
constexpr size_t WS_WGU = 336 * MiB, WS_WD = 400 * MiB;
constexpr size_t WS_YO = 80 * MiB;
constexpr size_t WS_HID = 208 * MiB;
constexpr size_t WS_SO = 80 * MiB;
constexpr size_t WS_END = 472 * MiB;
static_assert(WS_MLIST + (size_t)16 * MOBA_CAP * 4 <= WS_END && WS_PML + (size_t)3 * M * 16 * 4 <= WS_MLIST && WS_PO + (size_t)3 * M * 512 * 2 <= WS_PML, "d_ws map");
static_assert(WS_HID + (size_t)73728 * 512 * 2 <= WS_WGU && WS_SO + (size_t)M * 2 * 1024 * 2 <= WS_HID && WS_WD + (size_t)32 * 1024 * 512 * 2 <= WS_PML, "d_ws map");
constexpr int CW_BAR = 4096;
constexpr int CW_MCNT = 16384;
constexpr int CW_ECNT = 16384 + 1024 * 16;
static_assert((CW_ECNT + 32 * 64) * 4 <= (int)CTL_ZERO_BYTES, "CTL words inside the memset region");

constexpr int RING_OFF = 0, RING_BYTES = 131072;
constexpr int LDSCTL_OFF = 147456, MISC_OFF = LDSCTL_OFF + 320;
constexpr int LDS_BYTES = 148480;
static_assert(MISC_OFF + 128 <= LDS_BYTES, "LDS map");

#define GAS __attribute__((address_space(1)))
#define LAS __attribute__((address_space(3)))
typedef unsigned short bf16;
typedef unsigned v4u __attribute__((ext_vector_type(4)));
typedef unsigned v2u __attribute__((ext_vector_type(2)));
typedef float f32x4 __attribute__((ext_vector_type(4)));
typedef float f32x2 __attribute__((ext_vector_type(2)));
typedef GAS unsigned gu32;
#define RLX_AGENT __ATOMIC_RELAXED, __HIP_MEMORY_SCOPE_AGENT
#define LDS_WAIT() asm volatile("s_waitcnt lgkmcnt(0)" ::: "memory")
#define VM_WAIT() asm volatile("s_waitcnt vmcnt(0)" ::: "memory")
__device__ __forceinline__ unsigned f2bf(float f) { unsigned u = __builtin_bit_cast(unsigned, f); return (u + 0x7fffu + ((u >> 16) & 1u)) >> 16; }
__device__ __forceinline__ unsigned pk2(float lo, float hi) { return f2bf(lo) | (f2bf(hi) << 16); }
__device__ __forceinline__ float bf_lo(unsigned u) { return __uint_as_float(u << 16); }
__device__ __forceinline__ float bf_hi(unsigned u) { return __uint_as_float(u & 0xffff0000u); }

#define XB_TMO      128
#define XB_XCNT(j)  (256  + 64 * (j))
#define XB_XSUB(j)  (1280 + 64 * (j))
#define XB_XGEN(j)  (2304 + 64 * (j))
#define XB_TOP      3328
#define XB_TOPGEN   3392
#define XCD_BAR_WORDS 3456
#define XB_SPIN_CAP (1u << 18)

__device__ __forceinline__ unsigned xb_ld(unsigned* p)              { return __hip_atomic_load(p, __ATOMIC_RELAXED, __HIP_MEMORY_SCOPE_AGENT); }
__device__ __forceinline__ unsigned xb_add(unsigned* p, unsigned v) { return __hip_atomic_fetch_add(p, v, __ATOMIC_RELAXED, __HIP_MEMORY_SCOPE_AGENT); }
__device__ __forceinline__ unsigned xb_xcc_id() { return (unsigned)__builtin_amdgcn_s_getreg((3 << 11) | 20) & 0xFu; }
#define XB_SPIN(cond, bar) do { unsigned _sp = 0; while (cond) { __builtin_amdgcn_s_sleep(1); \
    if ((++_sp & 255u) == 0u) { if (xb_ld(&(bar)[XB_TMO])) break; if (_sp > XB_SPIN_CAP) { atomicAdd(&(bar)[XB_TMO], 1u); break; } } } } while (0)

struct XcdBarrier {
    unsigned* bar; unsigned x;
    volatile LAS unsigned* st;
};
__device__ __forceinline__ XcdBarrier xcd_barrier_post(unsigned* bar, volatile LAS unsigned* st) {
    XcdBarrier b; b.bar = bar; b.x = xb_xcc_id(); b.st = st;
    if (threadIdx.x == 0) (void)xb_add(&bar[XB_XCNT(b.x)], 1u);
    return b;
}
__device__ __forceinline__ void xcd_barrier_complete(unsigned* bar, unsigned x, unsigned& nloc, unsigned& nx) {
    const unsigned G = gridDim.x * gridDim.y * gridDim.z;
    unsigned sum, cnt, mine, sp = 0u;
    for (;;) {
        sum = 0u; cnt = 0u; mine = 0u;
#pragma unroll
        for (unsigned j = 0; j < 16; ++j) { const unsigned c = xb_ld(&bar[XB_XCNT(j)]); sum += c; cnt += (c > 0u) ? 1u : 0u; mine = (j == x) ? c : mine; }
        if (sum == G) break;
        __builtin_amdgcn_s_sleep(1);
        if ((++sp & 255u) == 0u) { if (xb_ld(&bar[XB_TMO])) break; if (sp > XB_SPIN_CAP) { atomicAdd(&bar[XB_TMO], 1u); break; } }
    }
    nloc = mine > 0u ? mine : 1u; nx = cnt > 0u ? cnt : 1u;
}
__device__ __forceinline__ void xcd_barrier(const XcdBarrier& b) {
    asm volatile("s_waitcnt vmcnt(0)" ::: "memory");
    __syncthreads();
    if (threadIdx.x == 0) {
        unsigned* bar = b.bar;
        __builtin_amdgcn_s_waitcnt(0);
        unsigned nloc = b.st[0], nx = b.st[1];
        if (nloc == 0u) { xcd_barrier_complete(bar, b.x, nloc, nx); b.st[0] = nloc; b.st[1] = nx; }
        const unsigned old = xb_add(&bar[XB_XSUB(b.x)], 1u);
        const unsigned gen = old / nloc;
        if (old + 1u == (gen + 1u) * nloc) {
            __builtin_amdgcn_fence(__ATOMIC_RELEASE, "agent");
            asm volatile("s_waitcnt vmcnt(0)" ::: "memory");
            const unsigned og = xb_add(&bar[XB_TOP], 1u);
            const unsigned tg = og / nx;
            if (og + 1u == (tg + 1u) * nx) xb_add(&bar[XB_TOPGEN], 1u);
            else XB_SPIN(xb_ld(&bar[XB_TOPGEN]) == tg, bar);
            __builtin_amdgcn_fence(__ATOMIC_ACQUIRE, "agent");
            xb_add(&bar[XB_XGEN(b.x)], 1u);
            asm volatile("s_waitcnt vmcnt(0)" ::: "memory");
        } else {
            XB_SPIN(xb_ld(&bar[XB_XGEN(b.x)]) == gen, bar);
            __builtin_amdgcn_fence(__ATOMIC_ACQUIRE, "agent");
            asm volatile("s_waitcnt vmcnt(0)" ::: "memory");
        }
    }
    __syncthreads();
}

struct Frame {
    LAS unsigned char* lds;
    volatile LAS unsigned* MISC;
    gu32* ctl;
    int tid, lane, wave;
    int vcu, G;
    float* out; unsigned char* ws;
};
typedef __attribute__((address_space(4))) const unsigned char* kptr_t;
__device__ __forceinline__ kptr_t karg() { kptr_t p = (kptr_t)__builtin_amdgcn_kernarg_segment_ptr(); asm volatile("" : "+s"(p)); return p; }
#define INP(kp, i) (*(const float* const __attribute__((address_space(4)))*)((kp) + 8 * (i)))
__device__ __forceinline__ float wave_sum(float v) {
#pragma unroll
    for (int o = 1; o < 64; o <<= 1) v += __shfl_xor(v, o);
    return v;
}
#define PHASE_BEGIN(F) do { asm volatile("" : "+v"((F).tid)); (F).lane = (F).tid & 63; } while (0)
__device__ __forceinline__ float silu_f(float v) { return v / (1.f + __expf(-v)); }
__device__ __forceinline__ int rel_bucket(int d) {
    if (d < 16) return d;
    const int thr[15] = {19, 21, 24, 27, 31, 35, 40, 46, 52, 59, 67, 77, 87, 99, 113};
    int b = 16;
#pragma unroll
    for (int i = 0; i < 15; ++i) b += (d >= thr[i]) ? 1 : 0;
    return b;
}
__device__ __forceinline__ void p0_transpose_item(const float* W, int K, int N, bf16* WT, size_t dst_row0, LAS float* scr, int k0, int n0, int lane) {
#pragma unroll 8
    for (int i = 0; i < 32; ++i) { const int kk = 2 * i + (lane >> 5); scr[kk * 33 + (lane & 31)] = W[(size_t)(k0 + kk) * N + n0 + (lane & 31)]; }
    LDS_WAIT(); asm volatile("" ::: "memory");
    const int c = lane & 7;
#pragma unroll
    for (int j = 0; j < 4; ++j) { const int n = (lane >> 3) + 8 * j; const LAS float* s = scr + (8 * c) * 33 + n;
        v4u o; o.x = pk2(s[0 * 33], s[1 * 33]); o.y = pk2(s[2 * 33], s[3 * 33]); o.z = pk2(s[4 * 33], s[5 * 33]); o.w = pk2(s[6 * 33], s[7 * 33]);
        *(GAS v4u*)(WT + (dst_row0 + n) * K + k0 + 8 * c) = o; }
    LDS_WAIT(); asm volatile("" ::: "memory");
}

__device__ __forceinline__ void p0_prologue(Frame& F) {
    PHASE_BEGIN(F);
    const kptr_t kp = karg();
    const float* c = INP(kp, 1); const float* w_ada = INP(kp, 2); const float* b_ada = INP(kp, 3);
    float* mod = (float*)(F.ws + WS_MOD);
    LAS float* cs = (LAS float*)(F.lds);
    LAS float* part = (LAS float*)(F.lds + 8192);
    for (int cg = blockIdx.x; cg < 96; cg += F.G) {
        for (int i = F.tid; i < 2048; i += NWAVES * 64) cs[i] = silu_f(c[i]);
        __syncthreads();
        const int col = cg * 64 + F.lane; float a0 = 0.f, a1 = 0.f;
#pragma unroll 8
        for (int k = F.wave * 128; k < F.wave * 128 + 128; ++k) { const float w = w_ada[(size_t)k * 6144 + col]; a0 += cs[k] * w; a1 += cs[1024 + k] * w; }
        part[(F.wave * 2 + 0) * 64 + F.lane] = a0; part[(F.wave * 2 + 1) * 64 + F.lane] = a1;
        __syncthreads();
        if (F.wave < 2) { float s = 0.f;
#pragma unroll
            for (int w = 0; w < 8; ++w) s += part[(w * 2 + F.wave) * 64 + F.lane];
            mod[F.wave * 6144 + col] = s + b_ada[col]; }
        __syncthreads();
    }
    if (blockIdx.x == F.G - 1) {
        const float* rb = INP(kp, 15); float* bg = (float*)(F.ws + WS_BIASG);
        for (int i = F.tid; i < 12 * 128; i += NWAVES * 64) { const int h = i >> 7, d = i & 127; bg[i] = (rb[rel_bucket(d) * 12 + h] - rb[31 * 12 + h]) * LOG2E; }
    }
    __syncthreads();
    LAS float* scr = (LAS float*)(F.lds + RING_OFF + F.wave * 16384);
    const int gw = F.vcu * NWAVES + F.wave, NGW = F.G * NWAVES;
    constexpr int I_IN = 16 * 96, I_OUT = 16 * 32;
    for (int it = gw; it < I_IN + I_OUT; it += NGW) {
        if (it < I_IN) { const int kb = it / 96, nb = it % 96; p0_transpose_item(INP(kp, 8), 1024, 3072, (bf16*)(F.ws + WS_WIN), (size_t)(32 * nb), scr, 64 * kb, 32 * nb, F.lane); }
        else { const int r = it - I_IN, kb = r / 32, nb = r % 32; p0_transpose_item(INP(kp, 14), 1024, 1024, (bf16*)(F.ws + WS_WOUT), (size_t)(32 * nb), scr, 64 * kb, 32 * nb, F.lane); }
    }
}
__device__ __forceinline__ void expert_weights(Frame& F) {
    PHASE_BEGIN(F);
    const kptr_t kp = karg();
    LAS float* scr = (LAS float*)(F.lds + RING_OFF + F.wave * 16384);
    const int gw = F.vcu * NWAVES + F.wave, NGW = F.G * NWAVES;
    constexpr int I_G = 32 * 16 * 16, I_D = 32 * 8 * 32;
    for (int it = gw; it < 2 * I_G + I_D; it += NGW) {
        if (it < 2 * I_G) { const int up = it >= I_G ? 1 : 0, r = it - up * I_G, e = r >> 8, kb = (r >> 4) & 15, nb = r & 15, n0 = 32 * nb;
            p0_transpose_item(INP(kp, 20 + up) + (size_t)e * 1024 * 512, 1024, 512, (bf16*)(F.ws + WS_WGU), (size_t)e * 1024 + (n0 >> 7) * 256 + up * 128 + (n0 & 127), scr, 64 * kb, n0, F.lane); }
        else { const int r = it - 2 * I_G, e = r >> 8, kb = (r >> 5) & 7, nb = r & 31;
            p0_transpose_item(INP(kp, 22) + (size_t)e * 512 * 1024, 512, 1024, (bf16*)(F.ws + WS_WD), (size_t)e * 1024 + 32 * nb, scr, 64 * kb, 32 * nb, F.lane); }
    }
}
__device__ __forceinline__ void p1_prenorm(Frame& F) {
    PHASE_BEGIN(F);
    const kptr_t kp = karg();
    const float* x = INP(kp, 0); const float* gain = INP(kp, 4); const float* mod = (const float*)(F.ws + WS_MOD); bf16* XN = (bf16*)(F.ws + WS_XN);
    const int gw = F.vcu * NWAVES + F.wave, NGW = F.G * NWAVES;
    for (int b = 0; b < BATCH; ++b) {
        f32x4 ge[4], sh[4];
#pragma unroll
        for (int j = 0; j < 4; ++j) { const int c = 4 * F.lane + 256 * j; const f32x4 g = *(const f32x4*)(gain + c), sc = *(const f32x4*)(mod + b * 6144 + 1024 + c); ge[j] = g * (sc + 1.f); sh[j] = *(const f32x4*)(mod + b * 6144 + c); }
        for (int m = b * T + gw; m < (b + 1) * T; m += NGW) {
            const GAS f32x4* xr = (const GAS f32x4*)(x + (size_t)m * D) + F.lane;
            f32x4 v[4]; float s = 0.f;
#pragma unroll
            for (int j = 0; j < 4; ++j) { v[j] = xr[64 * j]; s += (v[j].x * v[j].x + v[j].y * v[j].y) + (v[j].z * v[j].z + v[j].w * v[j].w); }
            const float r = 1.f / sqrtf(wave_sum(s) * (1.f / D) + EPS);
            GAS unsigned long long* o8 = (GAS unsigned long long*)(XN + (size_t)m * D) + F.lane;
#pragma unroll
            for (int j = 0; j < 4; ++j) { const f32x4 h = v[j] * r * ge[j] + sh[j]; o8[64 * j] = (unsigned long long)pk2(h.x, h.y) | ((unsigned long long)pk2(h.z, h.w) << 32); }
        }
    }
}
__device__ __forceinline__ void p3_kmean(Frame& F) {
    PHASE_BEGIN(F);
    const bf16* QKV = (const bf16*)(F.ws + WS_QKV); float* km = (float*)(F.ws + WS_KMEAN);
    const int gw = F.vcu * NWAVES + F.wave, NGW = F.G * NWAVES;
    for (int it = gw; it < 1024; it += NGW) {
        const int b = it >> 9, h = (it >> 6) & 7, j = it & 63; const int ch = F.lane & 7, rg = F.lane >> 3;
        const bf16* base = QKV + ((size_t)(b * T + j * 256 + rg)) * NPROJ + 2048 + h * 64 + ch * 8;
        float a[8] = {0.f, 0.f, 0.f, 0.f, 0.f, 0.f, 0.f, 0.f};
#pragma unroll 8
        for (int i = 0; i < 32; ++i) { const v4u v = *(const GAS v4u*)(base + (size_t)(8 * i) * NPROJ);
            a[0] += bf_lo(v.x); a[1] += bf_hi(v.x); a[2] += bf_lo(v.y); a[3] += bf_hi(v.y); a[4] += bf_lo(v.z); a[5] += bf_hi(v.z); a[6] += bf_lo(v.w); a[7] += bf_hi(v.w); }
#pragma unroll
        for (int k = 0; k < 8; ++k) { a[k] += __shfl_xor(a[k], 8); a[k] += __shfl_xor(a[k], 16); a[k] += __shfl_xor(a[k], 32); }
        if (rg == 0) {
#pragma unroll
            for (int k = 0; k < 8; ++k) km[(size_t)it * 64 + ch * 8 + k] = a[k] * (1.f / 256.f); }
    }
}
__device__ __forceinline__ int moba_list_base(int bh, int j) { return bh * MOBA_CAP + 256 * (63 * j - (j * (j - 1)) / 2); }
__device__ __forceinline__ void p4_moba_select(Frame& F) {
    PHASE_BEGIN(F);
    const bf16* QKV = (const bf16*)(F.ws + WS_QKV); const float* km = (const float*)(F.ws + WS_KMEAN); unsigned* mlist = (unsigned*)(F.ws + WS_MLIST);
    LAS float* kml = (LAS float*)(F.lds);
    for (int bi = blockIdx.x; bi < 512; bi += F.G) {
        const int bh = bi >> 5, qg = bi & 31, b = bh >> 3, h = bh & 7;
        for (int i = F.tid; i < 1024; i += NWAVES * 64) ((LAS f32x4*)kml)[i] = ((const f32x4*)(km + (size_t)bh * 4096))[i];
        __syncthreads();
        const int q = qg * 512 + F.wave * 64 + F.lane, own = (qg * 512 + F.wave * 64) >> 8;
        if (own > 0) {
            float qf[64];
            const bf16* qp = QKV + ((size_t)(b * T + q)) * NPROJ + 1536 + h * 64;
#pragma unroll
            for (int c8 = 0; c8 < 8; ++c8) { const v4u v = *(const GAS v4u*)(qp + c8 * 8);
                qf[c8 * 8 + 0] = bf_lo(v.x); qf[c8 * 8 + 1] = bf_hi(v.x); qf[c8 * 8 + 2] = bf_lo(v.y); qf[c8 * 8 + 3] = bf_hi(v.y); qf[c8 * 8 + 4] = bf_lo(v.z); qf[c8 * 8 + 5] = bf_hi(v.z); qf[c8 * 8 + 6] = bf_lo(v.w); qf[c8 * 8 + 7] = bf_hi(v.w); }
            float v0 = -INFINITY, v1 = -INFINITY, v2 = -INFINITY; int i0 = 64, i1 = 64, i2 = 64;
            for (int j = 0; j < own; ++j) {
                float g = 0.f;
#pragma unroll
                for (int d4 = 0; d4 < 16; ++d4) { const f32x4 kv = ((const LAS f32x4*)kml)[j * 16 + d4]; g += qf[d4 * 4] * kv.x + qf[d4 * 4 + 1] * kv.y + qf[d4 * 4 + 2] * kv.z + qf[d4 * 4 + 3] * kv.w; }
                if (g > v0) { v2 = v1; i2 = i1; v1 = v0; i1 = i0; v0 = g; i0 = j; }
                else if (g > v1) { v2 = v1; i2 = i1; v1 = g; i1 = j; }
                else if (g > v2) { v2 = g; i2 = j; }
            }
            for (int j = 0; j < own; ++j) {
                const bool sel = (i0 == j) || (i1 == j) || (i2 == j);
                const unsigned long long mask = __ballot(sel);
                if (mask) {
                    unsigned base = 0;
                    if (F.lane == 0) base = __hip_atomic_fetch_add(F.ctl + CW_MCNT + (bh * 64 + j) * 16, (unsigned)__popcll(mask), RLX_AGENT);
                    base = (unsigned)__builtin_amdgcn_readfirstlane((int)base);
                    if (sel) { const unsigned pos = base + (unsigned)__popcll(mask & ((1ull << F.lane) - 1ull)); const unsigned slot = (i0 == j) ? 0u : ((i1 == j) ? 1u : 2u);
                        mlist[(size_t)moba_list_base(bh, j) + pos] = (unsigned)q | (slot << 14); }
                }
            }
        }
        __syncthreads();
    }
}
__device__ __forceinline__ void p5_moba_gather(Frame& F, char* lds_generic) {
    PHASE_BEGIN(F);
    LAS int* pre = (LAS int*)(F.lds + 106496);
    LAS int* tmp = (LAS int*)(F.lds + 106496 + 4224);
    for (int i = F.tid; i < 1024; i += NWAVES * 64) { const unsigned c = __hip_atomic_load(F.ctl + CW_MCNT + i * 16, RLX_AGENT); tmp[i] = (int)((c + 255u) >> 8); }
    __syncthreads();
    if (F.wave == 0) { int loc[16]; int s = 0;
#pragma unroll
        for (int k = 0; k < 16; ++k) { loc[k] = s; s += tmp[F.lane * 16 + k]; }
        int incl = s;
#pragma unroll
        for (int o = 1; o < 64; o <<= 1) { const int t = __shfl_up(incl, o); if (F.lane >= o) incl += t; }
        const int excl = incl - s;
#pragma unroll
        for (int k = 0; k < 16; ++k) pre[F.lane * 16 + k] = excl + loc[k];
        if (F.lane == 63) pre[1024] = incl; }
    __syncthreads();
    const int U = pre[1024];
    const bf16* QKV = (const bf16*)(F.ws + WS_QKV); const unsigned* mlist = (const unsigned*)(F.ws + WS_MLIST);
    for (int L = blockIdx.x; L < U; L += F.G) {
        int lo = 0, hi = 1024;
        while (hi - lo > 1) { const int mid = (lo + hi) >> 1; if (pre[mid] <= L) lo = mid; else hi = mid; }
        const int x = lo, chunk = L - pre[x], bh = x >> 6, j = x & 63, b = bh >> 3, h = bh & 7;
        const int cnt = (int)__hip_atomic_load(F.ctl + CW_MCNT + x * 16, RLX_AGENT); const int n = (cnt - chunk * 256) < 256 ? (cnt - chunk * 256) : 256;
        attn_body::moba_gather_unit((const attn_body::bf16*)QKV + (size_t)b * T * NPROJ, h, j, mlist + (size_t)moba_list_base(bh, j) + chunk * 256, n, (long)b * T,
                                    (const float*)(F.ws + WS_BIASG) + (4 + h) * 128, (float*)(F.ws + WS_PML), (attn_body::bf16*)(F.ws + WS_PO), lds_generic);
    }
}
__device__ __forceinline__ void p6_attention(Frame& F, char* lds_generic) {
    PHASE_BEGIN(F);
    const attn_body::bf16* QKV = (const attn_body::bf16*)(F.ws + WS_QKV);
    const int c = blockIdx.x, G = F.G;
    for (int i = 0;; ++i) {
        const long L = (long)i * G + ((i & 1) ? (G - 1 - c) : c);
        if (L >= 3072) break;
        if (L < 2048) {
            const int qb = 63 - (int)(L >> 5), st = (int)(L & 31), b = st >> 4, vh = st & 15, hd = vh >> 2, mp = (vh >> 1) & 1, vhalf = vh & 1;
            const attn_body::bf16* base = QKV + (size_t)b * T * NPROJ;
            attn_body::MobaMerge mm{nullptr, nullptr, 0, 0, 0};
            attn_body::attn_unit<8, 0>(base + hd * 128 + mp * 64, base + 512 + hd * 128 + mp * 64, base + 1024 + hd * 128 + vhalf * 64,
                                       (attn_body::bf16*)(F.ws + WS_OD) + (size_t)b * T * 1024 + vh * 64, qb * 256, 0, 4 * (qb + 1),
                                       (const float*)(F.ws + WS_BIASG) + hd * 128, mm, lds_generic);
        } else {
            const int o = (int)(L - 2048), b = o >> 9, h = (o >> 6) & 7, qb = o & 63;
            const attn_body::bf16* base = QKV + (size_t)b * T * NPROJ;
            attn_body::MobaMerge mm{(const float*)(F.ws + WS_PML), (const attn_body::bf16*)(F.ws + WS_PO), (long)b * T + qb * 256, h, qb < 3 ? qb : 3};
            attn_body::attn_unit<8, 1>(base + 1536 + h * 64, base + 2048 + h * 64, base + 2560 + h * 64,
                                       (attn_body::bf16*)(F.ws + WS_XN) + (size_t)b * T * 1024 + 512 + h * 64, qb * 256, qb * 256, 4,
                                       (const float*)(F.ws + WS_BIASG) + (4 + h) * 128, mm, lds_generic);
        }
    }
}
__device__ __forceinline__ void p7_ydiff(Frame& F) {
    PHASE_BEGIN(F);
    const kptr_t kp = karg();
    const float l1 = wave_sum(INP(kp, 9)[F.lane] * INP(kp, 10)[F.lane]), l2 = wave_sum(INP(kp, 11)[F.lane] * INP(kp, 12)[F.lane]);
    const float lam = expf(l1) - expf(l2) + LAMBDA_INIT;
    const bf16* OD = (const bf16*)(F.ws + WS_OD); bf16* Y = (bf16*)(F.ws + WS_XN);
    const int gw = F.vcu * NWAVES + F.wave, NGW = F.G * NWAVES;
    const int hd = F.lane >> 4, i = F.lane & 15;
    float gn[8];
#pragma unroll
    for (int k = 0; k < 8; ++k) gn[k] = INP(kp, 13)[i * 8 + k] * (1.f - LAMBDA_INIT);
    for (int m = gw; m < M; m += NGW) {
        const v4u a = *(const GAS v4u*)(OD + (size_t)m * 1024 + hd * 256 + i * 8), bb = *(const GAS v4u*)(OD + (size_t)m * 1024 + hd * 256 + 128 + i * 8);
        float v[8] = {bf_lo(a.x) - lam * bf_lo(bb.x), bf_hi(a.x) - lam * bf_hi(bb.x), bf_lo(a.y) - lam * bf_lo(bb.y), bf_hi(a.y) - lam * bf_hi(bb.y),
                      bf_lo(a.z) - lam * bf_lo(bb.z), bf_hi(a.z) - lam * bf_hi(bb.z), bf_lo(a.w) - lam * bf_lo(bb.w), bf_hi(a.w) - lam * bf_hi(bb.w)};
        float s = 0.f;
#pragma unroll
        for (int k = 0; k < 8; ++k) s += v[k] * v[k];
        s += __shfl_xor(s, 1); s += __shfl_xor(s, 2); s += __shfl_xor(s, 4); s += __shfl_xor(s, 8);
        const float r = 1.f / sqrtf(s * (1.f / 128.f) + EPS);
        v4u o; o.x = pk2(v[0] * r * gn[0], v[1] * r * gn[1]); o.y = pk2(v[2] * r * gn[2], v[3] * r * gn[3]); o.z = pk2(v[4] * r * gn[4], v[5] * r * gn[5]); o.w = pk2(v[6] * r * gn[6], v[7] * r * gn[7]);
        *(GAS v4u*)(Y + (size_t)m * 1024 + hd * 128 + i * 8) = o;
    }
    expert_weights(F);
}
__device__ __forceinline__ void p9_postmix_route(Frame& F) {
    PHASE_BEGIN(F);
    const kptr_t kp = karg();
    const float* x = INP(kp, 0); const float* yo = (const float*)(F.ws + WS_YO); const float* mod = (const float*)(F.ws + WS_MOD);
    bf16* XN = (bf16*)(F.ws + WS_XN); float* tokw = (float*)(F.ws + WS_TOKW); int* elist = (int*)(F.ws + WS_ELIST);
    LAS float* WE = (LAS float*)(F.lds); LAS float* WG = (LAS float*)(F.lds + 131072);
    for (int f = F.tid; f < 32768; f += NWAVES * 64) { const int k = f >> 5, cc = f & 31; const int l = (k & 255) >> 2, kk = ((k >> 8) << 2) | (k & 3), g = cc >> 3, hf = (cc >> 2) & 1, ii = cc & 3;
        WE[((((g * 16 + kk) * 2 + hf) * 64 + l) << 2) + ii] = INP(kp, 18)[f]; }
    for (int f = F.tid; f < 4096; f += NWAVES * 64) { const int k = f >> 2, ii = f & 3; const int l = (k & 255) >> 2, kk = ((k >> 8) << 2) | (k & 3); WG[((kk * 64 + l) << 2) + ii] = INP(kp, 16)[f]; }
    __syncthreads();
    const int gw = F.vcu * NWAVES + F.wave, NGW = F.G * NWAVES;
    const float bg0 = INP(kp, 17)[0], bg1 = INP(kp, 17)[1], bg2 = INP(kp, 17)[2], bg3 = INP(kp, 17)[3];
    for (int b = 0; b < BATCH; ++b) {
        f32x4 a1[4], ge[4], sh[4];
#pragma unroll
        for (int j = 0; j < 4; ++j) { const int c = 4 * F.lane + 256 * j; a1[j] = *(const f32x4*)(INP(kp, 5) + c) * *(const f32x4*)(mod + b * 6144 + 2048 + c);
            ge[j] = *(const f32x4*)(INP(kp, 6) + c) * (*(const f32x4*)(mod + b * 6144 + 4096 + c) + 1.f); sh[j] = *(const f32x4*)(mod + b * 6144 + 3072 + c); }
        for (int m = b * T + gw; m < (b + 1) * T; m += NGW) {
            const GAS f32x4* yr = (const GAS f32x4*)(yo + (size_t)m * D) + F.lane; const GAS f32x4* xr = (const GAS f32x4*)(x + (size_t)m * D) + F.lane;
            f32x4 xv[4]; float s = 0.f, s2 = 0.f;
            {   f32x4 y[4];
#pragma unroll
                for (int j = 0; j < 4; ++j) { y[j] = yr[64 * j]; xv[j] = xr[64 * j]; s += (y[j].x * y[j].x + y[j].y * y[j].y) + (y[j].z * y[j].z + y[j].w * y[j].w); }
                const float r1 = 1.f / sqrtf(wave_sum(s) * (1.f / D) + EPS);
                GAS f32x4* orow = (GAS f32x4*)(F.out + (size_t)m * D) + F.lane;
#pragma unroll
                for (int j = 0; j < 4; ++j) { xv[j] = xv[j] + a1[j] * (y[j] * r1); orow[64 * j] = xv[j]; s2 += (xv[j].x * xv[j].x + xv[j].y * xv[j].y) + (xv[j].z * xv[j].z + xv[j].w * xv[j].w); }
            }
            const float r2 = 1.f / sqrtf(wave_sum(s2) * (1.f / D) + EPS);
            GAS unsigned long long* o8 = (GAS unsigned long long*)(XN + (size_t)m * D) + F.lane;
            float gl[4] = {0.f, 0.f, 0.f, 0.f};
#pragma unroll
            for (int j = 0; j < 4; ++j) { xv[j] = xv[j] * r2 * ge[j] + sh[j]; o8[64 * j] = (unsigned long long)pk2(xv[j].x, xv[j].y) | ((unsigned long long)pk2(xv[j].z, xv[j].w) << 32);
#pragma unroll
                for (int ii = 0; ii < 4; ++ii) { const f32x4 w = ((const LAS f32x4*)WG)[(j * 4 + ii) * 64 + F.lane]; const float hv = xv[j][ii]; gl[0] += hv * w.x; gl[1] += hv * w.y; gl[2] += hv * w.z; gl[3] += hv * w.w; }
                __builtin_amdgcn_sched_barrier(0); }
            gl[0] = wave_sum(gl[0]) + bg0; gl[1] = wave_sum(gl[1]) + bg1; gl[2] = wave_sum(gl[2]) + bg2; gl[3] = wave_sum(gl[3]) + bg3;
            int g = 0; float gm = gl[0];
            if (gl[1] > gm) { gm = gl[1]; g = 1; } if (gl[2] > gm) { gm = gl[2]; g = 2; } if (gl[3] > gm) { gm = gl[3]; g = 3; }
            const float gw_ = 1.f / (expf(gl[0] - gm) + expf(gl[1] - gm) + expf(gl[2] - gm) + expf(gl[3] - gm));
            g = __builtin_amdgcn_readfirstlane(g);
            float el[8] = {0.f, 0.f, 0.f, 0.f, 0.f, 0.f, 0.f, 0.f};
#pragma unroll
            for (int j = 0; j < 4; ++j) {
#pragma unroll
                for (int ii = 0; ii < 4; ++ii) { const int kk = j * 4 + ii; const f32x4 wa = ((const LAS f32x4*)WE)[((g * 16 + kk) * 2 + 0) * 64 + F.lane], wb = ((const LAS f32x4*)WE)[((g * 16 + kk) * 2 + 1) * 64 + F.lane]; const float hv = xv[j][ii];
                    el[0] += hv * wa.x; el[1] += hv * wa.y; el[2] += hv * wa.z; el[3] += hv * wa.w; el[4] += hv * wb.x; el[5] += hv * wb.y; el[6] += hv * wb.z; el[7] += hv * wb.w; }
                __builtin_amdgcn_sched_barrier(0); }
            float ea = -INFINITY, eb = -INFINITY; int ia = 0, ib = 0;
#pragma unroll
            for (int k = 0; k < 8; ++k) { const float v = wave_sum(el[k]) + INP(kp, 19)[g * 8 + k];
                if (v > ea) { eb = ea; ib = ia; ea = v; ia = k; } else if (v > eb) { eb = v; ib = k; } }
            const float pb = expf(eb - ea), wa_ = gw_ / (1.f + pb), wb_ = gw_ * pb / (1.f + pb);
            if (F.lane == 0) {
                const int e0 = g * 8 + ia, e1 = g * 8 + ib;
                const unsigned p0 = __hip_atomic_fetch_add(F.ctl + CW_ECNT + e0 * 64, 1u, RLX_AGENT), p1 = __hip_atomic_fetch_add(F.ctl + CW_ECNT + e1 * 64, 1u, RLX_AGENT);
                elist[e0 * 32768 + (int)p0] = m * 2; elist[e1 * 32768 + (int)p1] = m * 2 + 1;
                *(f32x2*)(tokw + (size_t)m * 2) = (f32x2){wa_, wb_};
            }
        }
    }
}
struct MoeOrder {
    const LAS int* tp;
    const gu32* ecnt; const int* elist; int G, c;
    __device__ __forceinline__ bool next(int i, pg8::Unit& u) const {
        const long L = (long)i * G + c; const int U = tp[32] * 4; if (L >= U) return false;
        const int rt = (int)(L >> 2), pn = (int)(L & 3); int e = 0;
#pragma unroll 1
        for (int k = 1; k < 32; ++k) e += (tp[k] <= rt) ? 1 : 0;
        const int t = rt - tp[e]; const int cnt = (int)__hip_atomic_load(ecnt + e * 64, RLX_AGENT);
        u.pm = rt; u.pn = e * 4 + pn; u.nvalid = (cnt - t * 256) < 256 ? (cnt - t * 256) : 256; u.rows = elist + e * 32768 + t * 256; return true;
    }
    __device__ __forceinline__ int arow(const pg8::Unit& u, int r) const { return r < u.nvalid ? (u.rows[r] >> 1) : 0; }
};
__device__ __forceinline__ void moe_prefix(Frame& F, LAS int* tp) {
    if (F.tid == 0) { int s = 0; for (int e = 0; e < 32; ++e) { tp[e] = s; s += ((int)__hip_atomic_load(F.ctl + CW_ECNT + e * 64, RLX_AGENT) + 255) >> 8; } tp[32] = s; }
    __syncthreads();
}
__device__ __forceinline__ void p12_final(Frame& F) {
    PHASE_BEGIN(F);
    const kptr_t kp = karg();
    const float* mod = (const float*)(F.ws + WS_MOD); const bf16* SO = (const bf16*)(F.ws + WS_SO); const float* tokw = (const float*)(F.ws + WS_TOKW);
    const int gw = F.vcu * NWAVES + F.wave, NGW = F.G * NWAVES;
    for (int b = 0; b < BATCH; ++b) {
        f32x4 pg[4], g2[4];
#pragma unroll
        for (int j = 0; j < 4; ++j) { const int c = 4 * F.lane + 256 * j; pg[j] = *(const f32x4*)(INP(kp, 7) + c); g2[j] = *(const f32x4*)(mod + b * 6144 + 5120 + c); }
        for (int m = b * T + gw; m < (b + 1) * T; m += NGW) {
            const f32x2 w = *(const f32x2*)(tokw + (size_t)m * 2);
            const GAS v2u* s0 = (const GAS v2u*)(SO + (size_t)m * 2048) + F.lane; const GAS v2u* s1 = (const GAS v2u*)(SO + (size_t)m * 2048 + 1024) + F.lane;
            GAS f32x4* orow = (GAS f32x4*)(F.out + (size_t)m * D) + F.lane;
            f32x4 y[4], xv[4]; float s = 0.f;
#pragma unroll
            for (int j = 0; j < 4; ++j) { const v2u a = s0[64 * j], bq = s1[64 * j]; xv[j] = orow[64 * j];
                y[j] = (f32x4){w.x * bf_lo(a.x) + w.y * bf_lo(bq.x), w.x * bf_hi(a.x) + w.y * bf_hi(bq.x), w.x * bf_lo(a.y) + w.y * bf_lo(bq.y), w.x * bf_hi(a.y) + w.y * bf_hi(bq.y)};
                s += (y[j].x * y[j].x + y[j].y * y[j].y) + (y[j].z * y[j].z + y[j].w * y[j].w); }
            const float r = 1.f / sqrtf(wave_sum(s) * (1.f / D) + EPS);
#pragma unroll
            for (int j = 0; j < 4; ++j) orow[64 * j] = xv[j] + g2[j] * (y[j] * r * pg[j]);
        }
    }
}

struct Args { const float* in[23]; float* out; unsigned char* ws; int ph_lo, ph_hi; };
__global__ void __launch_bounds__(NWAVES * 64, 2) hymba_fwd(Args args) {
    extern __shared__ __attribute__((aligned(16))) unsigned char lds[];
    Frame F;
    F.lds = (LAS unsigned char*)lds;
    F.MISC = (volatile LAS unsigned*)(F.lds + MISC_OFF);
    F.tid = threadIdx.x; F.lane = F.tid & 63; F.wave = __builtin_amdgcn_readfirstlane(F.tid >> 6);
    F.G = gridDim.x; { const int bx = blockIdx.x; F.vcu = (F.G % 8 == 0) ? (bx % 8) * (F.G / 8) + bx / 8 : bx; }
    F.ws = args.ws; F.out = args.out; F.ctl = (gu32*)(args.ws + WS_CTL);
    for (int u = F.tid; u < (LDS_BYTES - LDSCTL_OFF) / 4; u += NWAVES * 64) ((LAS unsigned*)(F.lds + LDSCTL_OFF))[u] = 0u;
    __syncthreads();
    XcdBarrier bar; bar.bar = (unsigned*)(F.ctl + CW_BAR); bar.x = 0; bar.st = nullptr;
    if (N_LAUNCHES == 1) bar = xcd_barrier_post((unsigned*)(F.ctl + CW_BAR), F.MISC + 8);
#define GRID_BAR() do { if (N_LAUNCHES == 1) xcd_barrier(bar); } while (0)
    const int lo = args.ph_lo, hi = args.ph_hi;
#define IN(k) (lo <= (k) && (k) < hi)
#define BOTH(k) (IN(k) && IN((k) + 1))
    bf16* XN = (bf16*)(args.ws + WS_XN);

    if (IN(0)) { p0_prologue(F); if (BOTH(0)) GRID_BAR(); }
    if (IN(1)) { p1_prenorm(F); if (BOTH(1)) GRID_BAR(); }
    if (IN(2)) {
        pg8::Gemm g{XN, (const bf16*)(args.ws + WS_WIN), M, NPROJ, D}; pg8::StaticOrder S; S.init(M, NPROJ, F.G, (int)blockIdx.x);
        pg8::EpiQKV E{(bf16*)(args.ws + WS_QKV), NPROJ, 0xC3u, attn_body::C2};
        pg8::gemm_phase<pg8::EpiQKV, pg8::StaticOrder, false>(F.lds + RING_OFF, g, S, E);
        if (BOTH(2)) GRID_BAR();
    }
    if (IN(3)) { p3_kmean(F); if (BOTH(3)) GRID_BAR(); }
    if (IN(4)) { p4_moba_select(F); if (BOTH(4)) GRID_BAR(); }
    if (IN(5)) { p5_moba_gather(F, (char*)lds + RING_OFF); if (BOTH(5)) GRID_BAR(); }
    if (IN(6)) { p6_attention(F, (char*)lds + RING_OFF); if (BOTH(6)) GRID_BAR(); }
    if (IN(7)) { p7_ydiff(F); if (BOTH(7)) GRID_BAR(); }
    if (IN(8)) {
        pg8::Gemm g{XN, (const bf16*)(args.ws + WS_WOUT), M, D, D}; pg8::StaticOrder S; S.init(M, D, F.G, (int)blockIdx.x);
        pg8::EpiF32 E{(float*)(args.ws + WS_YO), D};
        pg8::gemm_phase<pg8::EpiF32, pg8::StaticOrder, false>(F.lds + RING_OFF, g, S, E);
        if (BOTH(8)) GRID_BAR();
    }
    if (IN(9)) { p9_postmix_route(F); if (BOTH(9)) GRID_BAR(); }
    if (IN(10)) {
        LAS int* tp = (LAS int*)(F.lds + RING_BYTES); moe_prefix(F, tp);
        MoeOrder S{tp, F.ctl + CW_ECNT, (const int*)(args.ws + WS_ELIST), F.G, (int)blockIdx.x};
        pg8::Gemm g{XN, (const bf16*)(args.ws + WS_WGU), M, 1024, D};
        pg8::EpiSwiGLU E{(bf16*)(args.ws + WS_HID)};
        pg8::gemm_phase<pg8::EpiSwiGLU, MoeOrder, true>(F.lds + RING_OFF, g, S, E);
        if (BOTH(10)) GRID_BAR();
    }
    if (IN(11)) {
        LAS int* tp = (LAS int*)(F.lds + RING_BYTES); moe_prefix(F, tp);
        MoeOrder S{tp, F.ctl + CW_ECNT, (const int*)(args.ws + WS_ELIST), F.G, (int)blockIdx.x};
        pg8::Gemm g{(const bf16*)(args.ws + WS_HID), (const bf16*)(args.ws + WS_WD), 73728, 1024, EFF};
        pg8::EpiDown E{(bf16*)(args.ws + WS_SO)};
        pg8::gemm_phase<pg8::EpiDown, MoeOrder, false>(F.lds + RING_OFF, g, S, E);
        if (BOTH(11)) GRID_BAR();
    }
    if (IN(12)) { p12_final(F); }
#undef IN
#undef BOTH
#undef GRID_BAR
}

extern "C" void kernel_launch(void* const* d_in, const int* in_sizes, int n_in, void* d_out, int out_size, void* d_ws, size_t ws_size, hipStream_t stream) {
    static int grid = 0;
    if (grid == 0) {
        if (n_in != 23 || in_sizes[0] != M * D || out_size != M * D || ws_size < WS_END) { fprintf(stderr, "kernel_launch: unexpected shapes (n_in %d, in0 %d, out %d, ws %zu); nothing launched\n", n_in, n_in > 0 ? in_sizes[0] : -1, out_size, ws_size); grid = -1; return; }
        int dev = 0, cus = 0, per_cu = 0;
        if (hipGetDevice(&dev) != hipSuccess || hipDeviceGetAttribute(&cus, hipDeviceAttributeMultiprocessorCount, dev) != hipSuccess) { fprintf(stderr, "kernel_launch: device query failed\n"); grid = -1; return; }
        if (hipFuncSetAttribute((const void*)hymba_fwd, hipFuncAttributeMaxDynamicSharedMemorySize, LDS_BYTES) != hipSuccess) { fprintf(stderr, "kernel_launch: hipFuncSetAttribute failed\n"); grid = -1; return; }
        if (hipOccupancyMaxActiveBlocksPerMultiprocessor(&per_cu, (const void*)hymba_fwd, NWAVES * 64, LDS_BYTES) != hipSuccess || per_cu < 1)
            fprintf(stderr, "kernel_launch: note: occupancy query reports %d workgroups per CU\n", per_cu);
        (void)hipGetLastError();
        grid = cus;
    }
    if (grid < 0) return;
    if (hipMemsetAsync((char*)d_ws + WS_CTL, 0, CTL_ZERO_BYTES, stream) != hipSuccess) { fprintf(stderr, "kernel_launch: hipMemsetAsync failed\n"); return; }
    Args a{};
    for (int i = 0; i < 23; ++i) a.in[i] = (const float*)d_in[i];
    a.out = (float*)d_out; a.ws = (unsigned char*)d_ws;
    for (int li = 0; li < N_LAUNCHES; ++li) {
        a.ph_lo = (N_LAUNCHES == 1) ? 0 : li; a.ph_hi = (N_LAUNCHES == 1) ? N_PHASES : li + 1;
        hipLaunchKernelGGL(hymba_fwd, dim3(grid), dim3(NWAVES * 64), LDS_BYTES, stream, a);
        const hipError_t le = hipPeekAtLastError();
        if (le != hipSuccess) { fprintf(stderr, "kernel_launch: launch %d failed: %s\n", li, hipGetErrorName(le)); break; }
    }
}
```

```cpp
#include <hip/hip_runtime.h>
#include <hip/hip_bf16.h>
#include <cstdio>
#include <cstdint>
#include <cmath>

namespace pg8 {
#define PG8_LAS __attribute__((address_space(3)))
typedef unsigned short bf16_t;
typedef short bf16x8 __attribute__((ext_vector_type(8)));
typedef float f32x4 __attribute__((ext_vector_type(4)));
typedef unsigned u32x4 __attribute__((ext_vector_type(4)));
constexpr int BM = 256, BK = 64, HALF = 128, HTB = HALF * BK * 2  , STAGE_BYTES = 8 * HTB, NXCD = 8, WGM = 8;

__host__ __device__ __forceinline__ int lds_byte(int r, int c) { const int st = (r >> 4) * 2 + (c >> 5), rr = r & 15, cc = c & 31, ob = rr * 64 + cc * 2; return st * 1024 + (ob ^ (((ob >> 9) & 1) << 5)); }
__host__ __device__ __forceinline__ void stage_rc(int b, int& R, int& C) { const int st = b / 1024, sb = b % 1024, swz = sb ^ (((sb >> 9) & 1) << 5); R = (st >> 1) * 16 + swz / 64; C = (st & 1) * 32 + (swz % 64) / 2; }
__host__ __device__ __forceinline__ int perm32(int rho) { const int n = rho >> 4, i = rho & 15; return 8 * (i >> 2) + 4 * n + (i & 3); }

struct Unit { int pm, pn; int nvalid; const int* rows; };
struct Gemm { const bf16_t* A; const bf16_t* Bt; int M, N, K; };

struct StaticOrder {
    int nM, nN, nwg, G, c;
    __host__ __device__ void init(int M, int N, int G_, int c_) { nM = M / BM; nN = N / BM; nwg = nM * nN; G = G_; c = c_; }
    __host__ __device__ bool next(int i, Unit& u) const {
        const long L = (long)i * G + c; if (L >= nwg) return false;
        int wgid = (int)L; { const int q = nwg / NXCD, r = nwg % NXCD, xcd = wgid % NXCD, off = wgid / NXCD; wgid = (xcd < r ? xcd * (q + 1) : r * (q + 1) + (xcd - r) * q) + off; }
        const int nig = WGM * nN, gid = wgid / nig, fm = gid * WGM, gsz = (nM - fm) < WGM ? (nM - fm) : WGM;
        u.pm = fm + ((wgid % nig) % gsz); u.pn = (wgid % nig) / gsz; u.nvalid = 256; u.rows = nullptr; return true;
    }
    __device__ __forceinline__ int arow(const Unit&, int r) const { return r; }
};

__device__ __forceinline__ unsigned cvt_pk_bf16(float lo, float hi) { unsigned r; asm volatile("v_cvt_pk_bf16_f32 %0, %1, %2" : "=v"(r) : "v"(lo), "v"(hi)); return r; }

struct EpiQKV {
    static constexpr bool PERM = true;
    bf16_t* O; int ldc; unsigned qmask; float qscale;
    __device__ __forceinline__ void operator()(const f32x4 (&acc)[2][2][4][2], const Unit& u, int wr, int wc, int fr, int fq) const {
        const int row0 = u.pm * BM + wr * 64 + fr; const int col0 = u.pn * BM + wc * 32 + 8 * fq;
        const float sc = ((qmask >> u.pn) & 1u) ? qscale : 1.f;
#pragma unroll
        for (int ai = 0; ai < 2; ++ai)
#pragma unroll
            for (int m = 0; m < 4; ++m) { bf16_t* rowp = O + (size_t)(row0 + ai * HALF + m * 16) * ldc + col0;
#pragma unroll
                for (int bj = 0; bj < 2; ++bj) { const f32x4 v0 = acc[ai][bj][m][0] * sc, v1 = acc[ai][bj][m][1] * sc;
                    u32x4 w; w.x = cvt_pk_bf16(v0[0], v0[1]); w.y = cvt_pk_bf16(v0[2], v0[3]); w.z = cvt_pk_bf16(v1[0], v1[1]); w.w = cvt_pk_bf16(v1[2], v1[3]);
                    *(u32x4*)(rowp + bj * HALF) = w; } }
    }
};
struct EpiF32 {
    static constexpr bool PERM = false;
    float* O; int ldc;
    __device__ __forceinline__ void operator()(const f32x4 (&acc)[2][2][4][2], const Unit& u, int wr, int wc, int fr, int fq) const {
        const int col0 = u.pn * BM + wc * 32 + 4 * fq;
#pragma unroll
        for (int ai = 0; ai < 2; ++ai)
#pragma unroll
            for (int m = 0; m < 4; ++m) { float* rowp = O + (size_t)(u.pm * BM + ai * HALF + wr * 64 + m * 16 + fr) * ldc + col0;
#pragma unroll
                for (int bj = 0; bj < 2; ++bj)
#pragma unroll
                    for (int n = 0; n < 2; ++n) *(f32x4*)(rowp + bj * HALF + n * 16) = acc[ai][bj][m][n]; }
    }
};
struct EpiSwiGLU {
    static constexpr bool PERM = true;
    bf16_t* H;
    __device__ __forceinline__ void operator()(const f32x4 (&acc)[2][2][4][2], const Unit& u, int wr, int wc, int fr, int fq) const {
        const int col0 = (u.pn & 3) * 128 + wc * 32 + 8 * fq;
#pragma unroll
        for (int ai = 0; ai < 2; ++ai)
#pragma unroll
            for (int m = 0; m < 4; ++m) { bf16_t* rowp = H + (size_t)(u.pm * BM + ai * HALF + wr * 64 + m * 16 + fr) * 512 + col0;
                float h[8];
#pragma unroll
                for (int n = 0; n < 2; ++n)
#pragma unroll
                    for (int k = 0; k < 4; ++k) { const float gt = acc[ai][0][m][n][k], up = acc[ai][1][m][n][k];
                        h[n * 4 + k] = gt * __builtin_amdgcn_rcpf(1.f + __builtin_amdgcn_exp2f(-1.4426950408889634f * gt)) * up; }
                u32x4 w; w.x = cvt_pk_bf16(h[0], h[1]); w.y = cvt_pk_bf16(h[2], h[3]); w.z = cvt_pk_bf16(h[4], h[5]); w.w = cvt_pk_bf16(h[6], h[7]);
                *(u32x4*)rowp = w; }
    }
};
struct EpiDown {
    static constexpr bool PERM = true;
    bf16_t* SO;
    __device__ __forceinline__ void operator()(const f32x4 (&acc)[2][2][4][2], const Unit& u, int wr, int wc, int fr, int fq) const {
        const int col0 = (u.pn & 3) * BM + wc * 32 + 8 * fq;
#pragma unroll
        for (int ai = 0; ai < 2; ++ai)
#pragma unroll
            for (int m = 0; m < 4; ++m) { const int r = ai * HALF + wr * 64 + m * 16 + fr;
                if (r < u.nvalid) { const int ent = u.rows[r]; bf16_t* rowp = SO + (size_t)ent * 1024 + col0;
#pragma unroll
                    for (int bj = 0; bj < 2; ++bj) { const f32x4 v0 = acc[ai][bj][m][0], v1 = acc[ai][bj][m][1];
                        u32x4 w; w.x = cvt_pk_bf16(v0[0], v0[1]); w.y = cvt_pk_bf16(v0[2], v0[3]); w.z = cvt_pk_bf16(v1[0], v1[1]); w.w = cvt_pk_bf16(v1[2], v1[3]);
                        *(u32x4*)(rowp + bj * HALF) = w; } } }
    }
};

template <class Epi, class Sched, bool GATHER>
__device__ __forceinline__ void gemm_phase(PG8_LAS unsigned char* lds, const Gemm g, const Sched& S, const Epi& E) {
    const int tid = threadIdx.x, wid = __builtin_amdgcn_readfirstlane(tid >> 6), lane = tid & 63, wr = wid >> 2, wc = wid & 3, fr = lane & 15, fq = lane >> 4;
    const int K = g.K, nt = K / BK;
    int Rr[2], Cc[2]; unsigned voffB[2];
#pragma unroll
    for (int i = 0; i < 2; ++i) { int R, C; stage_rc(tid * 16 + i * 8192, R, C); Rr[i] = R; Cc[i] = C; const int Rb = Epi::PERM ? ((R & ~31) + perm32(R & 31)) : R; voffB[i] = (unsigned)(Rb * K + C) * 2u; }
    const size_t kstep = (size_t)(BK * 2);
    const size_t hstep = (size_t)HALF * K * 2;
    const size_t tstep = 2 * hstep;
    const unsigned ldsw = (unsigned)wid * 1024u;
    const int aoff = lds_byte(wr * 64 + fr, fq * 8), boff = lds_byte(wc * 32 + fr, fq * 8);
#define PG8_SA(b, h) (((b) * 2 + (h)) * HTB)
#define PG8_SB(b, h) ((4 + (b) * 2 + (h)) * HTB)
#define PG8_STAGE(bufoff, gbase, voff) do { _Pragma("unroll") for (int _i = 0; _i < 2; ++_i) \
        __builtin_amdgcn_global_load_lds((const unsigned*)((const char*)(gbase) + (voff)[_i]), (PG8_LAS unsigned*)(lds + (bufoff) + ldsw + _i * 8192), 16, 0, 0); } while (0)
#define PG8_LDA(dst, b, h) do { _Pragma("unroll") for (int m = 0; m < 4; ++m) _Pragma("unroll") for (int k = 0; k < 2; ++k) dst[m][k] = *(const PG8_LAS bf16x8*)(lds + PG8_SA(b, h) + aoff + m * 2048 + k * 1024); } while (0)
#define PG8_LDB(dst, b, h) do { _Pragma("unroll") for (int n = 0; n < 2; ++n) _Pragma("unroll") for (int k = 0; k < 2; ++k) dst[n][k] = *(const PG8_LAS bf16x8*)(lds + PG8_SB(b, h) + boff + n * 2048 + k * 1024); } while (0)
#define PG8_MMA(ai, bj, At, Bt) do { __builtin_amdgcn_s_setprio(1); _Pragma("unroll") for (int m = 0; m < 4; ++m) _Pragma("unroll") for (int n = 0; n < 2; ++n) _Pragma("unroll") for (int k = 0; k < 2; ++k) \
        acc[ai][bj][m][n] = __builtin_amdgcn_mfma_f32_16x16x32_bf16(Bt[n][k], At[m][k], acc[ai][bj][m][n], 0, 0, 0); __builtin_amdgcn_s_setprio(0); } while (0)
#define PG8_WAIT_V(n) asm volatile("s_waitcnt vmcnt(" #n ")" ::: "memory")
#define PG8_WAIT_L(n) asm volatile("s_waitcnt lgkmcnt(" #n ")" ::: "memory")
#define PG8_BAR __builtin_amdgcn_s_barrier()
#define PG8_SCHED __builtin_amdgcn_sched_barrier(0)
#define PG8_CALC_VOFF(u, vo) do { _Pragma("unroll") for (int h_ = 0; h_ < 2; ++h_) _Pragma("unroll") for (int i_ = 0; i_ < 2; ++i_) { \
        if constexpr (GATHER) { const int tok_ = S.arow(u, h_ * HALF + Rr[i_]); vo[h_][i_] = (unsigned)(tok_ * K + Cc[i_]) * 2u; } \
        else vo[h_][i_] = (unsigned)(Rr[i_] * K + Cc[i_]) * 2u + (unsigned)(h_ * hstep); } } while (0)
    Unit cur, nxt; int ui = 0;
    if (!S.next(0, cur)) return;
    unsigned vA[2][2], nvA[2][2];
    PG8_CALC_VOFF(cur, vA);
    if constexpr (GATHER) asm volatile("" : "+v"(vA[0][0]), "+v"(vA[0][1]), "+v"(vA[1][0]), "+v"(vA[1][1]));
    f32x4 acc[2][2][4][2];
#pragma unroll
    for (int a = 0; a < 2; ++a)
#pragma unroll
        for (int b = 0; b < 2; ++b)
#pragma unroll
            for (int m = 0; m < 4; ++m)
#pragma unroll
                for (int n = 0; n < 2; ++n) acc[a][b][m][n] = (f32x4){0.f, 0.f, 0.f, 0.f};
    bf16x8 At[4][2], B0[2][2], B1[2][2];
    const char* cA = GATHER ? (const char*)g.A : (const char*)g.A + (size_t)cur.pm * tstep; const char* cB = (const char*)g.Bt + (size_t)cur.pn * tstep;
    PG8_STAGE(PG8_SB(0, 0), cB, voffB); PG8_STAGE(PG8_SB(0, 1), cB + hstep, voffB); PG8_STAGE(PG8_SA(0, 0), cA, vA[0]); PG8_STAGE(PG8_SA(0, 1), cA, vA[1]);
    if (wr == 1) PG8_BAR;
    PG8_WAIT_V(2); PG8_BAR;
    PG8_STAGE(PG8_SB(1, 0), cB + kstep, voffB); PG8_STAGE(PG8_SA(1, 0), cA + kstep, vA[0]); PG8_STAGE(PG8_SB(1, 1), cB + hstep + kstep, voffB);
    PG8_WAIT_V(6); PG8_BAR;
    for (;;) {
        const bool has_next = S.next(ui + 1, nxt);
        const char* nA = has_next ? (GATHER ? (const char*)g.A : (const char*)g.A + (size_t)nxt.pm * tstep) : cA; const char* nB = has_next ? (const char*)g.Bt + (size_t)nxt.pn * tstep : cB;
        if constexpr (GATHER) {
            if (has_next) { PG8_CALC_VOFF(nxt, nvA); }
            else {
#pragma unroll
                for (int h_ = 0; h_ < 2; ++h_)
#pragma unroll
                    for (int i_ = 0; i_ < 2; ++i_) nvA[h_][i_] = vA[h_][i_]; }
            asm volatile("" : "+v"(nvA[0][0]), "+v"(nvA[0][1]), "+v"(nvA[1][0]), "+v"(nvA[1][1]));
        }
        for (int t = 0; t < nt; t += 2) {
            const bool last = (t == nt - 2);
            const char* a1 = cA + (size_t)(t + 1) * kstep;
            const char* a2 = last ? nA : cA + (size_t)(t + 2) * kstep; const char* b2 = last ? nB : cB + (size_t)(t + 2) * kstep;
            const char* a3 = a2 + kstep; const char* b3 = b2 + kstep;
            unsigned w0[2], w1[2];
#pragma unroll
            for (int i_ = 0; i_ < 2; ++i_) { w0[i_] = (GATHER && last) ? nvA[0][i_] : vA[0][i_]; w1[i_] = (GATHER && last) ? nvA[1][i_] : vA[1][i_]; }
            PG8_LDB(B0, 0, 0); PG8_LDB(B1, 0, 1); PG8_SCHED; PG8_LDA(At, 0, 0); PG8_STAGE(PG8_SA(1, 1), a1, vA[1]);
            PG8_WAIT_V(8); PG8_WAIT_L(0); PG8_BAR; PG8_MMA(0, 0, At, B0); PG8_MMA(0, 1, At, B1); PG8_BAR; PG8_SCHED;
            PG8_LDA(At, 0, 1); PG8_STAGE(PG8_SB(0, 0), b2, voffB); PG8_STAGE(PG8_SB(0, 1), b2 + hstep, voffB); PG8_STAGE(PG8_SA(0, 0), a2, w0);
            PG8_WAIT_V(8); PG8_WAIT_L(0); PG8_BAR; PG8_MMA(1, 0, At, B0); PG8_MMA(1, 1, At, B1); PG8_BAR; PG8_SCHED;
            PG8_LDB(B0, 1, 0); PG8_LDB(B1, 1, 1); PG8_SCHED; PG8_LDA(At, 1, 0); PG8_STAGE(PG8_SA(0, 1), a2, w1);
            PG8_WAIT_V(8); PG8_WAIT_L(0); PG8_BAR; PG8_MMA(0, 0, At, B0); PG8_MMA(0, 1, At, B1); PG8_BAR; PG8_SCHED;
            PG8_LDA(At, 1, 1); PG8_STAGE(PG8_SB(1, 0), b3, voffB); PG8_STAGE(PG8_SB(1, 1), b3 + hstep, voffB); PG8_STAGE(PG8_SA(1, 0), a3, w0);
            PG8_WAIT_V(8); PG8_WAIT_L(0); PG8_BAR; PG8_MMA(1, 0, At, B0); PG8_MMA(1, 1, At, B1); PG8_BAR; PG8_SCHED;
        }
        if (wr == 0) PG8_BAR;
        E(acc, cur, wr, wc, fr, fq);
        if (!has_next) break;
#pragma unroll
        for (int a = 0; a < 2; ++a)
#pragma unroll
            for (int b = 0; b < 2; ++b)
#pragma unroll
                for (int m = 0; m < 4; ++m)
#pragma unroll
                    for (int n = 0; n < 2; ++n) acc[a][b][m][n] = (f32x4){0.f, 0.f, 0.f, 0.f};
        cur = nxt; cA = nA; cB = nB; ++ui;
        if constexpr (GATHER) {
#pragma unroll
            for (int h_ = 0; h_ < 2; ++h_)
#pragma unroll
                for (int i_ = 0; i_ < 2; ++i_) vA[h_][i_] = nvA[h_][i_]; }
        if (wr == 1) PG8_BAR;
    }
    PG8_WAIT_V(0);
    PG8_BAR;
#undef PG8_SA
#undef PG8_SB
#undef PG8_STAGE
#undef PG8_LDA
#undef PG8_LDB
#undef PG8_MMA
#undef PG8_WAIT_V
#undef PG8_WAIT_L
#undef PG8_BAR
#undef PG8_SCHED
#undef PG8_CALC_VOFF
}
}

namespace attn_body {
using bf16=__hip_bfloat16;
using bf16x8=__attribute__((ext_vector_type(8)))short;
using s16x4=__attribute__((ext_vector_type(4)))short;
using f32x16=__attribute__((ext_vector_type(16)))float;
using u32x4=__attribute__((ext_vector_type(4)))unsigned;
constexpr int SEQ=16384,D=64;
constexpr int LDQ=3072;
constexpr int LDO=1024;
constexpr int NW=8,QBLK=32,QB=QBLK*NW,KVBLK=64,NQB=SEQ/QB;
__device__ __forceinline__ int crow(int r,int hi){return (r&3)+8*(r>>2)+4*hi;}
#define SBAR() __builtin_amdgcn_sched_barrier(0)
typedef __attribute__((address_space(3))) const float* lds_cfptr;
__device__ __forceinline__ void biasmask(f32x16&p0,f32x16&p1,int jb,int qrel,int hi,lds_cfptr bl){
  const float NEG=-INFINITY; const int kb=64*jb+4*hi;
  #pragma unroll
  for(int r=0;r<16;++r){const int kv=kb+(r&3)+8*(r>>2); const int d0=qrel-kv,d1=d0-32;
    const int i0=d0<0?0:(d0>127?127:d0), i1=d1<0?0:(d1>127?127:d1);
    const float b0=bl[i0],b1=bl[i1];
    p0[r]=d0<0?NEG:p0[r]+b0; p1[r]=d1<0?NEG:p1[r]+b1;}
}

constexpr int NSLOT=3, SLOTB=8192;
constexpr int LDS_K=0, LDS_V=NSLOT*SLOTB, LDS_WS=2*NSLOT*SLOTB, LDS_OST=LDS_WS+NW*128*4, LDS_BIAS=LDS_OST+NW*4096, LDS_BYTES=LDS_BIAS+512;
constexpr float C2=0.125f*1.4426950408889634f;
__device__ __forceinline__ void glds16(const void*gsrc,unsigned lds_dst){unsigned keep;
  asm volatile("s_mov_b32 %0, m0\n\ts_mov_b32 m0, %2\n\ts_nop 0\n\tglobal_load_lds_dwordx4 %1, off\n\ts_mov_b32 m0, %0":"=&s"(keep):"v"(gsrc),"s"(lds_dst):"memory");}
__device__ __forceinline__ float max3f(float a,float b,float c){float r;asm("v_max3_f32 %0, %1, %2, %3":"=v"(r):"v"(a),"v"(b),"v"(c));return r;}
__device__ __forceinline__ float max2f(float a,float b){float r;asm("v_max_f32_e32 %0, %1, %2":"=v"(r):"v"(a),"v"(b));return r;}
__device__ __forceinline__ float fadd_s(float a,float b){float r;asm("v_add_f32_e32 %0, %1, %2":"=v"(r):"v"(a),"v"(b));return r;}
__device__ __forceinline__ float fsub_s(float a,float b){float r;asm("v_sub_f32_e32 %0, %1, %2":"=v"(r):"v"(a),"v"(b));return r;}
typedef float f32x2_t __attribute__((ext_vector_type(2))); typedef __bf16 bf16x2_t __attribute__((ext_vector_type(2)));
__device__ __forceinline__ unsigned cvtpk_s(float lo,float hi){f32x2_t v={lo,hi};bf16x2_t b=__builtin_convertvector(v,bf16x2_t);return __builtin_bit_cast(unsigned,b);}
#define WAIT_BAR(N) asm volatile("s_waitcnt vmcnt(" #N ") lgkmcnt(0)\n\ts_barrier":::"memory")

__device__ __forceinline__ void qkt(f32x16&p0,f32x16&p1,const char*Kslot,const bf16x8*qr,const f32x16&negm,int r32,int hi){
  const char*kb=Kslot+hi*1024+r32*16;
  #pragma unroll
  for(int d0=0;d0<4;++d0){
    const bf16x8 b0=*reinterpret_cast<const bf16x8*>(kb+d0*2048);
    const bf16x8 b1=*reinterpret_cast<const bf16x8*>(kb+d0*2048+512);
    if(d0==0){p0=__builtin_amdgcn_mfma_f32_32x32x16_bf16(b0,qr[0],negm,0,0,0);p1=__builtin_amdgcn_mfma_f32_32x32x16_bf16(b1,qr[0],negm,0,0,0);}
    else{p0=__builtin_amdgcn_mfma_f32_32x32x16_bf16(b0,qr[d0],p0,0,0,0);p1=__builtin_amdgcn_mfma_f32_32x32x16_bf16(b1,qr[d0],p1,0,0,0);}}
}
typedef __attribute__((address_space(3))) const char* lds_cptr;
typedef short v4i16_t __attribute__((ext_vector_type(4)));
__device__ __forceinline__ void kload8(bf16x8*kf,lds_cptr kp){
  kf[0]=*(const __attribute__((address_space(3))) bf16x8*)(kp);      kf[1]=*(const __attribute__((address_space(3))) bf16x8*)(kp+512);
  kf[2]=*(const __attribute__((address_space(3))) bf16x8*)(kp+2048); kf[3]=*(const __attribute__((address_space(3))) bf16x8*)(kp+2560);
  kf[4]=*(const __attribute__((address_space(3))) bf16x8*)(kp+4096); kf[5]=*(const __attribute__((address_space(3))) bf16x8*)(kp+4608);
  kf[6]=*(const __attribute__((address_space(3))) bf16x8*)(kp+6144); kf[7]=*(const __attribute__((address_space(3))) bf16x8*)(kp+6656);
}
__device__ __forceinline__ void kload2(bf16x8*kf,lds_cptr kp,int j){ kf[2*j]=*(const __attribute__((address_space(3))) bf16x8*)(kp+j*2048); kf[2*j+1]=*(const __attribute__((address_space(3))) bf16x8*)(kp+j*2048+512); }
__device__ __forceinline__ s16x4 vtr(lds_cptr p){ return __builtin_bit_cast(s16x4,__builtin_amdgcn_ds_read_tr16_b64_v4i16((__attribute__((address_space(3))) v4i16_t*)p)); }
__device__ __forceinline__ float rowmax(const f32x16&p0,const f32x16&p1){
  float a=max3f(p0[0],p0[1],p1[0]),b=max3f(p0[2],p0[3],p1[1]);a=max3f(a,p1[2],p1[3]);
  #pragma unroll
  for(int r=4;r<16;r+=4){a=max3f(a,p0[r],p0[r+1]);b=max3f(b,p0[r+2],p0[r+3]);a=max3f(a,p1[r],p1[r+1]);b=max3f(b,p1[r+2],p1[r+3]);}
  const float m=max2f(a,b);
  auto rr=__builtin_amdgcn_permlane32_swap(__float_as_uint(m),__float_as_uint(m),false,false);
  return max2f(__uint_as_float(rr[0]),__uint_as_float(rr[1]));
}
__device__ __forceinline__ float rowmax_c(const f32x16&p0,const f32x16&p1){
  float a=__builtin_fmaxf(p0[0],p1[0]);
  #pragma unroll
  for(int r=1;r<16;++r){a=__builtin_fmaxf(a,__builtin_fmaxf(p0[r],p1[r]));}
  auto rr=__builtin_amdgcn_permlane32_swap(__float_as_uint(a),__float_as_uint(a),false,false);
  return __builtin_fmaxf(__uint_as_float(rr[0]),__uint_as_float(rr[1]));
}
__device__ __forceinline__ void pv(f32x16*o,int vb,bf16x8 pa0,bf16x8 pa1,bf16x8 pa2,bf16x8 pa3){
  #pragma unroll
  for(int d0=0;d0<2;++d0){s16x4 lo[4],hi[4];
    #pragma unroll
    for(int ks=0;ks<4;++ks){
      asm volatile("ds_read_b64_tr_b16 %0,%1 offset:%c2":"=&v"(lo[ks]):"v"(vb),"i"(d0*4096+ks*1024):"memory");
      asm volatile("ds_read_b64_tr_b16 %0,%1 offset:%c2":"=&v"(hi[ks]):"v"(vb),"i"(d0*4096+ks*1024+512):"memory");}
    asm volatile("s_waitcnt lgkmcnt(0)":::"memory");SBAR();
    #define PK(k) (bf16x8){lo[k][0],lo[k][1],lo[k][2],lo[k][3],hi[k][0],hi[k][1],hi[k][2],hi[k][3]}
    o[d0]=__builtin_amdgcn_mfma_f32_32x32x16_bf16(pa0,PK(0),o[d0],0,0,0);
    o[d0]=__builtin_amdgcn_mfma_f32_32x32x16_bf16(pa1,PK(1),o[d0],0,0,0);
    o[d0]=__builtin_amdgcn_mfma_f32_32x32x16_bf16(pa2,PK(2),o[d0],0,0,0);
    o[d0]=__builtin_amdgcn_mfma_f32_32x32x16_bf16(pa3,PK(3),o[d0],0,0,0);
    #undef PK
  }
}
__device__ __forceinline__ float bflo(unsigned u){return __uint_as_float(u<<16);}
__device__ __forceinline__ float bfhi(unsigned u){return __uint_as_float(u&0xffff0000u);}

struct MobaMerge { const float* pml; const bf16* po; long grow0; int h; int ns; };
constexpr long MROWS=2L*SEQ;

template<int THRL,int MODE> __device__ __forceinline__ void attn_unit(const bf16*Qp,const bf16*__restrict__ Kp,const bf16*__restrict__ Vp,bf16*Op,int q0,int kv0,int NT,const float*biasG,const MobaMerge&mm,char*shm){
  const int tid=threadIdx.x,lane=tid&63,r32=lane&31,hi=lane>>5; const int wid=__builtin_amdgcn_readfirstlane(tid>>6);
  const bf16*Qw=Qp+(long)(q0+wid*QBLK)*LDQ;
  const bf16*Kh=Kp+(long)kv0*LDQ,*Vh=Vp+(long)kv0*LDQ;
  const unsigned lds0=(unsigned)(uintptr_t)shm;
  float*wsf=(float*)(shm+LDS_WS)+wid*128;
  const lds_cptr shm3=(lds_cptr)shm;
  asm volatile("":"+s"(biasG));
  { __attribute__((address_space(3))) float* blw=(__attribute__((address_space(3))) float*)(shm3+LDS_BIAS); if(tid<128)blw[tid]=biasG[tid]; }
  const lds_cfptr bl=(lds_cfptr)(shm3+LDS_BIAS);
  const bf16*ksrc=Kh+(long)lane*LDQ+wid*8;
  const bf16*vsrc=Vh+(long)(16*(wid&3)+(lane>>2))*LDQ+(wid>>2)*32+(lane&3)*8;
  const unsigned kdst=lds0+LDS_K+wid*1024, vdst=lds0+LDS_V+wid*1024;
  #define DMA_K(t,slot) glds16(ksrc+(long)(t)*KVBLK*LDQ,(unsigned)__builtin_amdgcn_readfirstlane(kdst+(slot)))
  #define DMA_V(t,slot) glds16(vsrc+(long)(t)*KVBLK*LDQ,(unsigned)__builtin_amdgcn_readfirstlane(vdst+(slot)))
  const int vb0=(int)(lds0+LDS_V)+((lane>>4)&1)*32+(lane&3)*8+(4*hi+((lane&15)>>2))*64;
  const char*Kbase=shm+LDS_K; bf16x8 kf[8];
  const lds_cptr kp0=shm3+LDS_K+hi*1024+r32*16; const lds_cptr vp0=shm3+LDS_V+((lane>>4)&1)*32+(lane&3)*8+(4*hi+((lane&15)>>2))*64;
  asm volatile("s_waitcnt vmcnt(0)":::"memory");
  DMA_K(0,0);DMA_V(0,0);DMA_K(1,SLOTB);
  bf16x8 qr[4];
  #pragma unroll
  for(int d0=0;d0<4;++d0)qr[d0]=*reinterpret_cast<const bf16x8*>(&Qw[(long)r32*LDQ+d0*16+hi*8]);
  float mhat=0.f,l_reg=0.f;f32x16 o[2];o[0]=f32x16{};o[1]=f32x16{};f32x16 negm=f32x16{};asm volatile("":"+v"(negm));
  const int qrel=wid*QBLK+r32;
  #define CMASK(P0,P1,t) do{int jb_=(t)-(NT-4); if(jb_>=-2 && (32*wid-(64*jb_+63))<113)biasmask(P0,P1,jb_,qrel,hi,bl);}while(0)
  bool resc=false;
  #define START(P0,P1) do{ const float rm=rowmax(P0,P1); resc=false; \
    { const float dl=rm; mhat=fadd_s(mhat,dl); \
      _Pragma("unroll") for(int r=0;r<16;++r){P0[r]=fsub_s(P0[r],dl);P1[r]=fsub_s(P1[r],dl);} \
      _Pragma("unroll") for(int r=0;r<16;++r)negm[r]=-mhat; asm volatile("":"+v"(negm)); } \
    _Pragma("unroll") for(int r=0;r<16;++r)P0[r]=__builtin_amdgcn_exp2f(P0[r]); }while(0)
  #define RESC() do{ if(resc){ asm volatile("s_waitcnt lgkmcnt(0)":::"memory"); \
      _Pragma("unroll") for(int d_=0;d_<2;++d_) _Pragma("unroll") for(int r=0;r<16;++r)o[d_][r]*=wsf[crow(r,hi)]; } }while(0)
  f32x16 pA0,pA1,pB0,pB1;
  int sl_prev=0,sl_cur=0,sl_next=SLOTB;
  #define ROT() do{sl_prev=sl_cur;sl_cur=sl_next;sl_next=(sl_next==(NSLOT-1)*SLOTB)?0:sl_next+SLOTB;}while(0)
  DMA_K(2,2*SLOTB);
  WAIT_BAR(3);
  qkt(pA0,pA1,Kbase,qr,negm,r32,hi);asm volatile("s_nop 15\n\ts_nop 7":"+v"(pA0),"+v"(pA1));CMASK(pA0,pA1,0);
  START(pA0,pA1);
  _Pragma("unroll") for(int r=0;r<16;++r)pA1[r]=__builtin_amdgcn_exp2f(pA1[r]);
  WAIT_BAR(0);
  DMA_K(3,0);DMA_V(1,SLOTB);
  ROT();
  kload8(kf,kp0+sl_cur);
  WAIT_BAR(2);
  s16x4 vlo[8],vhi[8]; u32x4 pw0,pw1,pw2,pw3;
  #define PKW(P,B) cvtpk_s(P[B],P[B+1])
  #define PAF(k) __builtin_bit_cast(bf16x8,pw##k)
  #define VFR(i) (bf16x8){vlo[i][0],vlo[i][1],vlo[i][2],vlo[i][3],vhi[i][0],vhi[i][1],vhi[i][2],vhi[i][3]}
  #define PIN(x) asm volatile("":"+v"(x))
  #define MX3(a,b,c) __builtin_fmaxf(__builtin_fmaxf((a),(b)),(c))
  #define GAPA(MF,A0,A1,A2,A3,W0,W1,PW) do{ MF; sacc+=A0; sacc+=A1; sacc+=A2; sacc+=A3; PIN(sacc); W0; W1; PIN(PW); SBAR(); }while(0)
  #define EX(v) __builtin_amdgcn_exp2f(v)
  #define GAPB(MF,X,B) do{ MF; X[B]=EX(X[B]); X[B+1]=EX(X[B+1]); X[B+2]=EX(X[B+2]); X[B+3]=EX(X[B+3]); PIN(X); SBAR(); }while(0)
  #define VRD(i) do{ vlo[i]=vtr(vp_+(((i)>>2)*4096+((i)&3)*1024)); vhi[i]=vtr(vp_+(((i)>>2)*4096+((i)&3)*1024+512)); }while(0)
  #define KRD(G,j) do{ if(G){ kload2(kf,kp0+sl_next,j); SBAR(); } }while(0)
  #define STEP(C0,C1,P0,P1,t,GK,GV,GL) do{ SBAR(); \
    const lds_cptr vp_=vp0+sl_prev; \
    VRD(0); SBAR(); float sacc=(P0[0]+P0[1]); \
    GAPA(C0=__builtin_amdgcn_mfma_f32_32x32x16_bf16(kf[0],qr[0],negm,0,0,0), P0[2],P0[3],P0[4],P0[5],     pw0[0]=PKW(P0,0), pw0[1]=PKW(P0,2), pw0); \
    VRD(4); SBAR(); GAPA(C1=__builtin_amdgcn_mfma_f32_32x32x16_bf16(kf[1],qr[0],negm,0,0,0), P0[6],P0[7],P0[8],P0[9],     pw0[2]=PKW(P0,4), pw0[3]=PKW(P0,6), pw0); \
    VRD(1); SBAR(); GAPA(C0=__builtin_amdgcn_mfma_f32_32x32x16_bf16(kf[2],qr[1],C0,0,0,0),   P0[10],P0[11],P0[12],P0[13], pw1[0]=PKW(P0,8), pw1[1]=PKW(P0,10), pw1); \
    VRD(5); SBAR(); GAPA(C1=__builtin_amdgcn_mfma_f32_32x32x16_bf16(kf[3],qr[1],C1,0,0,0),   P0[14],P0[15],P1[0],P1[1],   pw1[2]=PKW(P0,12),pw1[3]=PKW(P0,14), pw1); \
    VRD(2); SBAR(); GAPA(C0=__builtin_amdgcn_mfma_f32_32x32x16_bf16(kf[4],qr[2],C0,0,0,0),   P1[2],P1[3],P1[4],P1[5],     pw2[0]=PKW(P1,0), pw2[1]=PKW(P1,2), pw2); \
    VRD(6); SBAR(); GAPA(C1=__builtin_amdgcn_mfma_f32_32x32x16_bf16(kf[5],qr[2],C1,0,0,0),   P1[6],P1[7],P1[8],P1[9],     pw2[2]=PKW(P1,4), pw2[3]=PKW(P1,6), pw2); \
    VRD(3); SBAR(); GAPA(C0=__builtin_amdgcn_mfma_f32_32x32x16_bf16(kf[6],qr[3],C0,0,0,0),   P1[10],P1[11],P1[12],P1[13], pw3[0]=PKW(P1,8), pw3[1]=PKW(P1,10), pw3); \
    VRD(7); SBAR(); GAPA(C1=__builtin_amdgcn_mfma_f32_32x32x16_bf16(kf[7],qr[3],C1,0,0,0),   P1[14],P1[15],0.f,0.f,       pw3[2]=PKW(P1,12),pw3[3]=PKW(P1,14), pw3); \
    l_reg+=sacc; \
    if(GK){DMA_K((t)+3,sl_cur);} if(GV){DMA_V((t)+1,sl_next);} \
    CMASK(C0,C1,t); \
    { float a=MX3(C0[0],C0[1],C1[0]),b=MX3(C0[2],C0[3],C1[1]); a=MX3(a,C1[2],C1[3]); \
      _Pragma("unroll") for(int r=4;r<16;r+=4){a=MX3(a,C0[r],C0[r+1]);b=MX3(b,C0[r+2],C0[r+3]);a=MX3(a,C1[r],C1[r+1]);b=MX3(b,C1[r+2],C1[r+3]);} \
      float rm=__builtin_fmaxf(a,b); { auto rr=__builtin_amdgcn_permlane32_swap(__float_as_uint(rm),__float_as_uint(rm),false,false); rm=__builtin_fmaxf(__uint_as_float(rr[0]),__uint_as_float(rr[1])); } \
      resc=false; \
      if(__builtin_expect(__any(rm>(float)THRL),0)){ const float dl=__builtin_fmaxf(rm,0.f); mhat+=dl; \
        _Pragma("unroll") for(int r=0;r<16;++r){C0[r]-=dl;C1[r]-=dl;} \
        _Pragma("unroll") for(int r=0;r<16;++r)negm[r]=-mhat; asm volatile("":"+v"(negm)); \
        const float f=__builtin_amdgcn_exp2f(-dl); l_reg*=f; if(hi==0)wsf[r32]=f; resc=true; } } \
    SBAR(); \
    GAPB(o[0]=__builtin_amdgcn_mfma_f32_32x32x16_bf16(PAF(0),VFR(0),o[0],0,0,0), C0,0); \
    GAPB(o[1]=__builtin_amdgcn_mfma_f32_32x32x16_bf16(PAF(0),VFR(4),o[1],0,0,0), C0,4); \
    KRD(GL,0); GAPB(o[0]=__builtin_amdgcn_mfma_f32_32x32x16_bf16(PAF(1),VFR(1),o[0],0,0,0), C0,8); \
    KRD(GL,1); GAPB(o[1]=__builtin_amdgcn_mfma_f32_32x32x16_bf16(PAF(1),VFR(5),o[1],0,0,0), C0,12); \
    KRD(GL,2); GAPB(o[0]=__builtin_amdgcn_mfma_f32_32x32x16_bf16(PAF(2),VFR(2),o[0],0,0,0), C1,0); \
    KRD(GL,3); GAPB(o[1]=__builtin_amdgcn_mfma_f32_32x32x16_bf16(PAF(2),VFR(6),o[1],0,0,0), C1,4); \
    GAPB(o[0]=__builtin_amdgcn_mfma_f32_32x32x16_bf16(PAF(3),VFR(3),o[0],0,0,0), C1,8); \
    GAPB(o[1]=__builtin_amdgcn_mfma_f32_32x32x16_bf16(PAF(3),VFR(7),o[1],0,0,0), C1,12); \
    }while(0)
  int t=1;
  #undef CMASK
  #define CMASK(P0,P1,t) do{}while(0)
  for(;t+7<NT;t+=2){
    STEP(pB0,pB1,pA0,pA1,t,true,true,true);     WAIT_BAR(2); RESC(); ROT();
    STEP(pA0,pA1,pB0,pB1,t+1,true,true,true);   WAIT_BAR(2); RESC(); ROT();
  }
  #undef CMASK
  #define CMASK(P0,P1,t) do{int jb_=(t)-(NT-4); if(jb_>=-2 && (32*wid-(64*jb_+63))<113)biasmask(P0,P1,jb_,qrel,hi,bl);}while(0)
  #define ENDW(tt) do{ if((tt)+3<NT){WAIT_BAR(2);} else if((tt)+2<NT){WAIT_BAR(1);} else {WAIT_BAR(0);} }while(0)
  for(;t+1<NT;t+=2){
    STEP(pB0,pB1,pA0,pA1,t,(t+3<NT),(t+1<NT),(t+1<NT));       ENDW(t);   RESC(); ROT();
    STEP(pA0,pA1,pB0,pB1,t+1,(t+4<NT),(t+2<NT),(t+2<NT));     ENDW(t+1); RESC(); ROT();
  }
  STEP(pB0,pB1,pA0,pA1,NT-1,false,false,false); RESC();
  { float sacc=pB0[0]+pB0[1]; _Pragma("unroll") for(int r=2;r<16;++r)sacc+=pB0[r]; _Pragma("unroll") for(int r=0;r<16;++r)sacc+=pB1[r]; l_reg+=sacc;
    pw0=(u32x4){PKW(pB0,0),PKW(pB0,2),PKW(pB0,4),PKW(pB0,6)};pw1=(u32x4){PKW(pB0,8),PKW(pB0,10),PKW(pB0,12),PKW(pB0,14)};pw2=(u32x4){PKW(pB1,0),PKW(pB1,2),PKW(pB1,4),PKW(pB1,6)};pw3=(u32x4){PKW(pB1,8),PKW(pB1,10),PKW(pB1,12),PKW(pB1,14)};
    SBAR(); pv(o,vb0+sl_cur,PAF(0),PAF(1),PAF(2),PAF(3)); }
  #undef PKW
  #undef PAF
  #undef VFR
  #undef PIN
  #undef MX3
  #undef GAPA
  #undef GAPB
  #undef EX
  #undef VRD
  #undef KRD
  #undef STEP
  #undef ENDW
  {auto rr=__builtin_amdgcn_permlane32_swap(__float_as_uint(l_reg),__float_as_uint(l_reg),false,false);l_reg=__uint_as_float(rr[0])+__uint_as_float(rr[1]);}
  const float*pml_=mm.pml; const bf16*po_=mm.po; if constexpr(MODE==1){ asm volatile("":"+s"(pml_),"+s"(po_)); }
  if constexpr(MODE==1){
    const long gr=mm.grow0+wid*QBLK+r32; float ms[3],ls[3],as[3]; float Mx=mhat;
    #pragma unroll
    for(int s=0;s<3;++s){ ms[s]=-INFINITY; ls[s]=0.f; if(s<mm.ns){ const f32x2_t v=*(const f32x2_t*)(pml_+((long)s*MROWS+gr)*16+mm.h*2); ms[s]=v.x; ls[s]=v.y; Mx=__builtin_fmaxf(Mx,ms[s]); } }
    const float a0=__builtin_amdgcn_exp2f(mhat-Mx); float L=a0*l_reg;
    #pragma unroll
    for(int s=0;s<3;++s){ as[s]=(s<mm.ns)?__builtin_amdgcn_exp2f(ms[s]-Mx):0.f; L+=as[s]*ls[s]; }
    const float inv=1.0f/L;
    if(hi==0){wsf[32+r32]=a0*inv;wsf[64+r32]=as[0]*inv;wsf[96+r32]=as[1]*inv;wsf[r32]=as[2]*inv;}
  } else {
    if(hi==0)wsf[32+r32]=1.0f/l_reg;
  }
  asm volatile("s_waitcnt lgkmcnt(0)":::"memory");
  float rli[16];
  #pragma unroll
  for(int r=0;r<16;++r)rli[r]=wsf[32+crow(r,hi)];
  { asm volatile("":"+s"(Op)); }
  bf16*Ow=Op+(long)(q0+wid*QBLK)*LDO;
  { bf16*stg=(bf16*)(shm+LDS_OST)+wid*2048;
    #pragma unroll
    for(int r=0;r<16;++r){const int orow=crow(r,hi);
      #pragma unroll
      for(int d0=0;d0<2;++d0)stg[orow*64+d0*32+r32]=__float2bfloat16(o[d0][r]*rli[r]);}
    asm volatile("s_waitcnt lgkmcnt(0)":::"memory");
    int lane_e=lane; asm volatile("":"+v"(lane_e));
    #pragma unroll
    for(int i=0;i<4;++i){const int row=i*8+(lane_e>>3),ch=lane_e&7; u32x4 v=*(const u32x4*)(stg+row*64+ch*8);
      if constexpr(MODE==1){
        float a[8]={bflo(v.x),bfhi(v.x),bflo(v.y),bfhi(v.y),bflo(v.z),bfhi(v.z),bflo(v.w),bfhi(v.w)};
        #pragma unroll
        for(int s=0;s<3;++s){ if(s<mm.ns){ const float c=wsf[(s==0?64:(s==1?96:0))+row];
            const u32x4 pp=*(const u32x4*)(po_+(((long)s*MROWS+mm.grow0+wid*QBLK+row)*8+mm.h)*64+ch*8);
            a[0]+=c*bflo(pp.x);a[1]+=c*bfhi(pp.x);a[2]+=c*bflo(pp.y);a[3]+=c*bfhi(pp.y);a[4]+=c*bflo(pp.z);a[5]+=c*bfhi(pp.z);a[6]+=c*bflo(pp.w);a[7]+=c*bfhi(pp.w);} }
        v.x=cvtpk_s(a[0],a[1]);v.y=cvtpk_s(a[2],a[3]);v.z=cvtpk_s(a[4],a[5]);v.w=cvtpk_s(a[6],a[7]);
      }
      *(u32x4*)(Ow+(long)row*LDO+ch*8)=v;} }
  asm volatile("s_waitcnt lgkmcnt(0)\n\ts_barrier":::"memory");
  #undef DMA_K
  #undef DMA_V
  #undef CMASK
  #undef START
  #undef RESC
  #undef ROT
}

constexpr int LDS_GK=0, LDS_GV=4*SLOTB, LDS_GWS=8*SLOTB, LDS_GOST=LDS_GWS+NW*128*4, LDS_GBIAS=LDS_GOST+NW*4096, LDS_GBYTES=LDS_GBIAS+512;
__device__ __forceinline__ void moba_gather_unit(const bf16*QKVb  ,int h,int j,const unsigned*ent,int n,long growb  ,const float*biasG,float*pml,bf16*po,char*shm){
  const int tid=threadIdx.x,lane=tid&63,r32=lane&31,hi=lane>>5; const int wid=__builtin_amdgcn_readfirstlane(tid>>6);
  const unsigned lds0=(unsigned)(uintptr_t)shm; const lds_cptr shm3=(lds_cptr)shm;
  float*wsf=(float*)(shm+LDS_GWS)+wid*128;
  { __attribute__((address_space(3))) float* blw=(__attribute__((address_space(3))) float*)(shm3+LDS_GBIAS); if(tid<128)blw[tid]=biasG[tid]; }
  const lds_cfptr bl=(lds_cfptr)(shm3+LDS_GBIAS);
  const int ei=wid*QBLK+r32; const unsigned e=ent[ei<n?ei:n-1];
  const int qloc=(int)(e&0x3FFFu), slot=(int)(e>>14);
  const bf16*Qrow=QKVb+(long)qloc*LDQ+1536+h*64;
  bf16x8 qr[4];
  #pragma unroll
  for(int d0=0;d0<4;++d0)qr[d0]=*reinterpret_cast<const bf16x8*>(Qrow+d0*16+hi*8);
  const bf16*Kh=QKVb+(long)(j*256)*LDQ+2048+h*64,*Vh=QKVb+(long)(j*256)*LDQ+2560+h*64;
  const bf16*ksrc=Kh+(long)lane*LDQ+wid*8;
  const bf16*vsrc=Vh+(long)(16*(wid&3)+(lane>>2))*LDQ+(wid>>2)*32+(lane&3)*8;
  #pragma unroll
  for(int t=0;t<4;++t){ glds16(ksrc+(long)t*KVBLK*LDQ,(unsigned)__builtin_amdgcn_readfirstlane(lds0+LDS_GK+t*SLOTB+wid*1024)); glds16(vsrc+(long)t*KVBLK*LDQ,(unsigned)__builtin_amdgcn_readfirstlane(lds0+LDS_GV+t*SLOTB+wid*1024)); }
  asm volatile("s_waitcnt vmcnt(0) lgkmcnt(0)\n\ts_barrier":::"memory");
  const int vb0=(int)(lds0+LDS_GV)+((lane>>4)&1)*32+(lane&3)*8+(4*hi+((lane&15)>>2))*64;
  float mhat=0.f,l_reg=0.f; f32x16 o[2]; o[0]=f32x16{}; o[1]=f32x16{}; f32x16 negm=f32x16{};
  const bool nearq=__any(qloc-(j*256+128)<128+113);
  #pragma unroll
  for(int t=0;t<4;++t){
    f32x16 p0,p1; qkt(p0,p1,shm+LDS_GK+t*SLOTB,qr,negm,r32,hi);
    if(t>=2 && nearq){ const int kb=j*256+t*64+4*hi;
      #pragma unroll
      for(int r=0;r<16;++r){ const int kv=kb+(r&3)+8*(r>>2); const int d0=qloc-kv,d1=d0-32; const int i0=d0>127?127:(d0<0?0:d0), i1=d1>127?127:(d1<0?0:d1); p0[r]+=bl[i0]; p1[r]+=bl[i1]; } }
    const float rm=rowmax_c(p0,p1);
    const float dl=(t==0)?rm:__builtin_fmaxf(rm,0.f);
    mhat+=dl;
    #pragma unroll
    for(int r=0;r<16;++r){p0[r]-=dl;p1[r]-=dl;}
    #pragma unroll
    for(int r=0;r<16;++r)negm[r]=-mhat;
    if(t>0){ const float f=__builtin_amdgcn_exp2f(-dl); l_reg*=f; if(hi==0)wsf[r32]=f; asm volatile("s_waitcnt lgkmcnt(0)":::"memory");
      #pragma unroll
      for(int d_=0;d_<2;++d_)
        #pragma unroll
        for(int r=0;r<16;++r)o[d_][r]*=wsf[crow(r,hi)]; }
    float sacc=0.f;
    #pragma unroll
    for(int r=0;r<16;++r){p0[r]=__builtin_amdgcn_exp2f(p0[r]);p1[r]=__builtin_amdgcn_exp2f(p1[r]);sacc+=p0[r]+p1[r];}
    l_reg+=sacc;
    u32x4 pw0,pw1,pw2,pw3;
    pw0=(u32x4){cvtpk_s(p0[0],p0[1]),cvtpk_s(p0[2],p0[3]),cvtpk_s(p0[4],p0[5]),cvtpk_s(p0[6],p0[7])};
    pw1=(u32x4){cvtpk_s(p0[8],p0[9]),cvtpk_s(p0[10],p0[11]),cvtpk_s(p0[12],p0[13]),cvtpk_s(p0[14],p0[15])};
    pw2=(u32x4){cvtpk_s(p1[0],p1[1]),cvtpk_s(p1[2],p1[3]),cvtpk_s(p1[4],p1[5]),cvtpk_s(p1[6],p1[7])};
    pw3=(u32x4){cvtpk_s(p1[8],p1[9]),cvtpk_s(p1[10],p1[11]),cvtpk_s(p1[12],p1[13]),cvtpk_s(p1[14],p1[15])};
    pv(o,vb0+t*SLOTB,__builtin_bit_cast(bf16x8,pw0),__builtin_bit_cast(bf16x8,pw1),__builtin_bit_cast(bf16x8,pw2),__builtin_bit_cast(bf16x8,pw3));
  }
  {auto rr=__builtin_amdgcn_permlane32_swap(__float_as_uint(l_reg),__float_as_uint(l_reg),false,false);l_reg=__uint_as_float(rr[0])+__uint_as_float(rr[1]);}
  if(hi==0 && ei<n){ f32x2_t v={mhat,l_reg}; *(f32x2_t*)(pml+((long)slot*MROWS+growb+qloc)*16+h*2)=v; }
  { bf16*stg=(bf16*)(shm+LDS_GOST)+wid*2048;
    #pragma unroll
    for(int r=0;r<16;++r){const int orow=crow(r,hi);
      #pragma unroll
      for(int d0=0;d0<2;++d0)stg[orow*64+d0*32+r32]=__float2bfloat16(o[d0][r]);}
    asm volatile("s_waitcnt lgkmcnt(0)":::"memory");
    #pragma unroll
    for(int i=0;i<4;++i){const int row=i*8+(lane>>3),ch=lane&7; const u32x4 v=*(const u32x4*)(stg+row*64+ch*8);
      const unsigned er=(unsigned)__shfl((int)e,row); const int ql=(int)(er&0x3FFFu), sl=(int)(er>>14);
      if(wid*QBLK+row<n) *(u32x4*)(po+(((long)sl*MROWS+growb+ql)*8+h)*64+ch*8)=v; } }
  asm volatile("s_waitcnt lgkmcnt(0)\n\ts_barrier":::"memory");
}
#undef SBAR
#undef WAIT_BAR
}

constexpr int NWAVES = 8;
#ifndef MK_N_LAUNCHES
#define MK_N_LAUNCHES 1
#endif
constexpr int N_PHASES = 13;
constexpr int N_LAUNCHES = MK_N_LAUNCHES;

constexpr int BATCH = 2, T = 16384, D = 1024, M = BATCH * T;
constexpr int NPROJ = 3072;
constexpr int NEXP = 32, EFF = 512;
constexpr float EPS = 1e-6f, LOG2E = 1.4426950408889634f;
constexpr float LAMBDA_INIT = 0.2f;
constexpr int MOBA_CAP = 256 * 2016;

constexpr size_t MiB = 1u << 20;
constexpr size_t WS_CTL = 0, CTL_ZERO_BYTES = 1 * MiB;
constexpr size_t WS_MOD = 1 * MiB;
constexpr size_t WS_BIASG = 1 * MiB + 64 * 1024;
constexpr size_t WS_KMEAN = 1 * MiB + 256 * 1024;
constexpr size_t WS_TOKW = 2 * MiB;
constexpr size_t WS_ELIST = 3 * MiB;
constexpr size_t WS_WIN = 8 * MiB, WS_WOUT = 14 * MiB;
constexpr size_t WS_XN = 16 * MiB;
constexpr size_t WS_QKV = 80 * MiB;
constexpr size_t WS_OD = 272 * MiB;
constexpr size_t WS_PO = 336 * MiB;
constexpr size_t WS_PML = 432 * MiB;
constexpr size_t WS_MLIST = 438 * MiB;
constexpr size_t WS_WGU = 336 * MiB, WS_WD = 400 * MiB;
constexpr size_t WS_YO = 80 * MiB;
constexpr size_t WS_HID = 208 * MiB;
constexpr size_t WS_SO = 80 * MiB;
constexpr size_t WS_END = 472 * MiB;
static_assert(WS_MLIST + (size_t)16 * MOBA_CAP * 4 <= WS_END && WS_PML + (size_t)3 * M * 16 * 4 <= WS_MLIST && WS_PO + (size_t)3 * M * 512 * 2 <= WS_PML, "d_ws map");
static_assert(WS_HID + (size_t)73728 * 512 * 2 <= WS_WGU && WS_SO + (size_t)M * 2 * 1024 * 2 <= WS_HID && WS_WD + (size_t)32 * 1024 * 512 * 2 <= WS_PML, "d_ws map");
constexpr int CW_BAR = 4096;
constexpr int CW_MCNT = 16384;
constexpr int CW_ECNT = 16384 + 1024 * 16;
static_assert((CW_ECNT + 32 * 64) * 4 <= (int)CTL_ZERO_BYTES, "CTL words inside the memset region");

constexpr int RING_OFF = 0, RING_BYTES = 131072;
constexpr int LDSCTL_OFF = 147456, MISC_OFF = LDSCTL_OFF + 320;
constexpr int LDS_BYTES = 148480;
static_assert(MISC_OFF + 128 <= LDS_BYTES, "LDS map");

#define GAS __attribute__((address_space(1)))
#define LAS __attribute__((address_space(3)))
typedef unsigned short bf16;
typedef unsigned v4u __attribute__((ext_vector_type(4)));
typedef unsigned v2u __attribute__((ext_vector_type(2)));
typedef float f32x4 __attribute__((ext_vector_type(4)));
typedef float f32x2 __attribute__((ext_vector_type(2)));
typedef GAS unsigned gu32;
#define RLX_AGENT __ATOMIC_RELAXED, __HIP_MEMORY_SCOPE_AGENT
#define LDS_WAIT() asm volatile("s_waitcnt lgkmcnt(0)" ::: "memory")
#define VM_WAIT() asm volatile("s_waitcnt vmcnt(0)" ::: "memory")
__device__ __forceinline__ unsigned f2bf(float f) { unsigned u = __builtin_bit_cast(unsigned, f); return (u + 0x7fffu + ((u >> 16) & 1u)) >> 16; }
__device__ __forceinline__ unsigned pk2(float lo, float hi) { return f2bf(lo) | (f2bf(hi) << 16); }
__device__ __forceinline__ float bf_lo(unsigned u) { return __uint_as_float(u << 16); }
__device__ __forceinline__ float bf_hi(unsigned u) { return __uint_as_float(u & 0xffff0000u); }

#define XB_TMO      128
#define XB_XCNT(j)  (256  + 64 * (j))
#define XB_XSUB(j)  (1280 + 64 * (j))
#define XB_XGEN(j)  (2304 + 64 * (j))
#define XB_TOP      3328
#define XB_TOPGEN   3392
#define XCD_BAR_WORDS 3456
#define XB_SPIN_CAP (1u << 18)

__device__ __forceinline__ unsigned xb_ld(unsigned* p)              { return __hip_atomic_load(p, __ATOMIC_RELAXED, __HIP_MEMORY_SCOPE_AGENT); }
__device__ __forceinline__ unsigned xb_add(unsigned* p, unsigned v) { return __hip_atomic_fetch_add(p, v, __ATOMIC_RELAXED, __HIP_MEMORY_SCOPE_AGENT); }
__device__ __forceinline__ unsigned xb_xcc_id() { return (unsigned)__builtin_amdgcn_s_getreg((3 << 11) | 20) & 0xFu; }
#define XB_SPIN(cond, bar) do { unsigned _sp = 0; while (cond) { __builtin_amdgcn_s_sleep(1); \
    if ((++_sp & 255u) == 0u) { if (xb_ld(&(bar)[XB_TMO])) break; if (_sp > XB_SPIN_CAP) { atomicAdd(&(bar)[XB_TMO], 1u); break; } } } } while (0)

struct XcdBarrier {
    unsigned* bar; unsigned x;
    volatile LAS unsigned* st;
};
__device__ __forceinline__ XcdBarrier xcd_barrier_post(unsigned* bar, volatile LAS unsigned* st) {
    XcdBarrier b; b.bar = bar; b.x = xb_xcc_id(); b.st = st;
    if (threadIdx.x == 0) (void)xb_add(&bar[XB_XCNT(b.x)], 1u);
    return b;
}
__device__ __forceinline__ void xcd_barrier_complete(unsigned* bar, unsigned x, unsigned& nloc, unsigned& nx) {
    const unsigned G = gridDim.x * gridDim.y * gridDim.z;
    unsigned sum, cnt, mine, sp = 0u;
    for (;;) {
        sum = 0u; cnt = 0u; mine = 0u;
#pragma unroll
        for (unsigned j = 0; j < 16; ++j) { const unsigned c = xb_ld(&bar[XB_XCNT(j)]); sum += c; cnt += (c > 0u) ? 1u : 0u; mine = (j == x) ? c : mine; }
        if (sum == G) break;
        __builtin_amdgcn_s_sleep(1);
        if ((++sp & 255u) == 0u) { if (xb_ld(&bar[XB_TMO])) break; if (sp > XB_SPIN_CAP) { atomicAdd(&bar[XB_TMO], 1u); break; } }
    }
    nloc = mine > 0u ? mine : 1u; nx = cnt > 0u ? cnt : 1u;
}
__device__ __forceinline__ void xcd_barrier(const XcdBarrier& b) {
    asm volatile("s_waitcnt vmcnt(0)" ::: "memory");
    __syncthreads();
    if (threadIdx.x == 0) {
        unsigned* bar = b.bar;
        __builtin_amdgcn_s_waitcnt(0);
        unsigned nloc = b.st[0], nx = b.st[1];
        if (nloc == 0u) { xcd_barrier_complete(bar, b.x, nloc, nx); b.st[0] = nloc; b.st[1] = nx; }
        const unsigned old = xb_add(&bar[XB_XSUB(b.x)], 1u);
        const unsigned gen = old / nloc;
        if (old + 1u == (gen + 1u) * nloc) {
            __builtin_amdgcn_fence(__ATOMIC_RELEASE, "agent");
            asm volatile("s_waitcnt vmcnt(0)" ::: "memory");
            const unsigned og = xb_add(&bar[XB_TOP], 1u);
            const unsigned tg = og / nx;
            if (og + 1u == (tg + 1u) * nx) xb_add(&bar[XB_TOPGEN], 1u);
            else XB_SPIN(xb_ld(&bar[XB_TOPGEN]) == tg, bar);
            __builtin_amdgcn_fence(__ATOMIC_ACQUIRE, "agent");
            xb_add(&bar[XB_XGEN(b.x)], 1u);
            asm volatile("s_waitcnt vmcnt(0)" ::: "memory");
        } else {
            XB_SPIN(xb_ld(&bar[XB_XGEN(b.x)]) == gen, bar);
            __builtin_amdgcn_fence(__ATOMIC_ACQUIRE, "agent");
            asm volatile("s_waitcnt vmcnt(0)" ::: "memory");
        }
    }
    __syncthreads();
}

struct Frame {
    LAS unsigned char* lds;
    volatile LAS unsigned* MISC;
    gu32* ctl;
    int tid, lane, wave;
    int vcu, G;
    float* out; unsigned char* ws;
};
typedef __attribute__((address_space(4))) const unsigned char* kptr_t;
__device__ __forceinline__ kptr_t karg() { kptr_t p = (kptr_t)__builtin_amdgcn_kernarg_segment_ptr(); asm volatile("" : "+s"(p)); return p; }
#define INP(kp, i) (*(const float* const __attribute__((address_space(4)))*)((kp) + 8 * (i)))
__device__ __forceinline__ float wave_sum(float v) {
#pragma unroll
    for (int o = 1; o < 64; o <<= 1) v += __shfl_xor(v, o);
    return v;
}
#define PHASE_BEGIN(F) do { asm volatile("" : "+v"((F).tid)); (F).lane = (F).tid & 63; } while (0)
__device__ __forceinline__ float silu_f(float v) { return v / (1.f + __expf(-v)); }
__device__ __forceinline__ int rel_bucket(int d) {
    if (d < 16) return d;
    const int thr[15] = {19, 21, 24, 27, 31, 35, 40, 46, 52, 59, 67, 77, 87, 99, 113};
    int b = 16;
#pragma unroll
    for (int i = 0; i < 15; ++i) b += (d >= thr[i]) ? 1 : 0;
    return b;
}
__device__ __forceinline__ void p0_transpose_item(const float* W, int K, int N, bf16* WT, size_t dst_row0, LAS float* scr, int k0, int n0, int lane) {
#pragma unroll 8
    for (int i = 0; i < 32; ++i) { const int kk = 2 * i + (lane >> 5); scr[kk * 33 + (lane & 31)] = W[(size_t)(k0 + kk) * N + n0 + (lane & 31)]; }
    LDS_WAIT(); asm volatile("" ::: "memory");
    const int c = lane & 7;
#pragma unroll
    for (int j = 0; j < 4; ++j) { const int n = (lane >> 3) + 8 * j; const LAS float* s = scr + (8 * c) * 33 + n;
        v4u o; o.x = pk2(s[0 * 33], s[1 * 33]); o.y = pk2(s[2 * 33], s[3 * 33]); o.z = pk2(s[4 * 33], s[5 * 33]); o.w = pk2(s[6 * 33], s[7 * 33]);
        *(GAS v4u*)(WT + (dst_row0 + n) * K + k0 + 8 * c) = o; }
    LDS_WAIT(); asm volatile("" ::: "memory");
}

__device__ __forceinline__ void p0_prologue(Frame& F) {
    PHASE_BEGIN(F);
    const kptr_t kp = karg();
    const float* c = INP(kp, 1); const float* w_ada = INP(kp, 2); const float* b_ada = INP(kp, 3);
    float* mod = (float*)(F.ws + WS_MOD);
    LAS float* cs = (LAS float*)(F.lds);
    LAS float* part = (LAS float*)(F.lds + 8192);
    for (int cg = blockIdx.x; cg < 96; cg += F.G) {
        for (int i = F.tid; i < 2048; i += NWAVES * 64) cs[i] = silu_f(c[i]);
        __syncthreads();
        const int col = cg * 64 + F.lane; float a0 = 0.f, a1 = 0.f;
#pragma unroll 8
        for (int k = F.wave * 128; k < F.wave * 128 + 128; ++k) { const float w = w_ada[(size_t)k * 6144 + col]; a0 += cs[k] * w; a1 += cs[1024 + k] * w; }
        part[(F.wave * 2 + 0) * 64 + F.lane] = a0; part[(F.wave * 2 + 1) * 64 + F.lane] = a1;
        __syncthreads();
        if (F.wave < 2) { float s = 0.f;
#pragma unroll
            for (int w = 0; w < 8; ++w) s += part[(w * 2 + F.wave) * 64 + F.lane];
            mod[F.wave * 6144 + col] = s + b_ada[col]; }
        __syncthreads();
    }
    if (blockIdx.x == F.G - 1) {
        const float* rb = INP(kp, 15); float* bg = (float*)(F.ws + WS_BIASG);
        for (int i = F.tid; i < 12 * 128; i += NWAVES * 64) { const int h = i >> 7, d = i & 127; bg[i] = (rb[rel_bucket(d) * 12 + h] - rb[31 * 12 + h]) * LOG2E; }
    }
    __syncthreads();
    LAS float* scr = (LAS float*)(F.lds + RING_OFF + F.wave * 16384);
    const int gw = F.vcu * NWAVES + F.wave, NGW = F.G * NWAVES;
    constexpr int I_IN = 16 * 96, I_OUT = 16 * 32;
    for (int it = gw; it < I_IN + I_OUT; it += NGW) {
        if (it < I_IN) { const int kb = it / 96, nb = it % 96; p0_transpose_item(INP(kp, 8), 1024, 3072, (bf16*)(F.ws + WS_WIN), (size_t)(32 * nb), scr, 64 * kb, 32 * nb, F.lane); }
        else { const int r = it - I_IN, kb = r / 32, nb = r % 32; p0_transpose_item(INP(kp, 14), 1024, 1024, (bf16*)(F.ws + WS_WOUT), (size_t)(32 * nb), scr, 64 * kb, 32 * nb, F.lane); }
    }
}
__device__ __forceinline__ void expert_weights(Frame& F) {
    PHASE_BEGIN(F);
    const kptr_t kp = karg();
    LAS float* scr = (LAS float*)(F.lds + RING_OFF + F.wave * 16384);
    const int gw = F.vcu * NWAVES + F.wave, NGW = F.G * NWAVES;
    constexpr int I_G = 32 * 16 * 16, I_D = 32 * 8 * 32;
    for (int it = gw; it < 2 * I_G + I_D; it += NGW) {
        if (it < 2 * I_G) { const int up = it >= I_G ? 1 : 0, r = it - up * I_G, e = r >> 8, kb = (r >> 4) & 15, nb = r & 15, n0 = 32 * nb;
            p0_transpose_item(INP(kp, 20 + up) + (size_t)e * 1024 * 512, 1024, 512, (bf16*)(F.ws + WS_WGU), (size_t)e * 1024 + (n0 >> 7) * 256 + up * 128 + (n0 & 127), scr, 64 * kb, n0, F.lane); }
        else { const int r = it - 2 * I_G, e = r >> 8, kb = (r >> 5) & 7, nb = r & 31;
            p0_transpose_item(INP(kp, 22) + (size_t)e * 512 * 1024, 512, 1024, (bf16*)(F.ws + WS_WD), (size_t)e * 1024 + 32 * nb, scr, 64 * kb, 32 * nb, F.lane); }
    }
}
__device__ __forceinline__ void p1_prenorm(Frame& F) {
    PHASE_BEGIN(F);
    const kptr_t kp = karg();
    const float* x = INP(kp, 0); const float* gain = INP(kp, 4); const float* mod = (const float*)(F.ws + WS_MOD); bf16* XN = (bf16*)(F.ws + WS_XN);
    const int gw = F.vcu * NWAVES + F.wave, NGW = F.G * NWAVES;
    for (int b = 0; b < BATCH; ++b) {
        f32x4 ge[4], sh[4];
#pragma unroll
        for (int j = 0; j < 4; ++j) { const int c = 4 * F.lane + 256 * j; const f32x4 g = *(const f32x4*)(gain + c), sc = *(const f32x4*)(mod + b * 6144 + 1024 + c); ge[j] = g * (sc + 1.f); sh[j] = *(const f32x4*)(mod + b * 6144 + c); }
        for (int m = b * T + gw; m < (b + 1) * T; m += NGW) {
            const GAS f32x4* xr = (const GAS f32x4*)(x + (size_t)m * D) + F.lane;
            f32x4 v[4]; float s = 0.f;
#pragma unroll
            for (int j = 0; j < 4; ++j) { v[j] = xr[64 * j]; s += (v[j].x * v[j].x + v[j].y * v[j].y) + (v[j].z * v[j].z + v[j].w * v[j].w); }
            const float r = 1.f / sqrtf(wave_sum(s) * (1.f / D) + EPS);
            GAS unsigned long long* o8 = (GAS unsigned long long*)(XN + (size_t)m * D) + F.lane;
#pragma unroll
            for (int j = 0; j < 4; ++j) { const f32x4 h = v[j] * r * ge[j] + sh[j]; o8[64 * j] = (unsigned long long)pk2(h.x, h.y) | ((unsigned long long)pk2(h.z, h.w) << 32); }
        }
    }
}
__device__ __forceinline__ void p3_kmean(Frame& F) {
    PHASE_BEGIN(F);
    const bf16* QKV = (const bf16*)(F.ws + WS_QKV); float* km = (float*)(F.ws + WS_KMEAN);
    const int gw = F.vcu * NWAVES + F.wave, NGW = F.G * NWAVES;
    for (int it = gw; it < 1024; it += NGW) {
        const int b = it >> 9, h = (it >> 6) & 7, j = it & 63; const int ch = F.lane & 7, rg = F.lane >> 3;
        const bf16* base = QKV + ((size_t)(b * T + j * 256 + rg)) * NPROJ + 2048 + h * 64 + ch * 8;
        float a[8] = {0.f, 0.f, 0.f, 0.f, 0.f, 0.f, 0.f, 0.f};
#pragma unroll 8
        for (int i = 0; i < 32; ++i) { const v4u v = *(const GAS v4u*)(base + (size_t)(8 * i) * NPROJ);
            a[0] += bf_lo(v.x); a[1] += bf_hi(v.x); a[2] += bf_lo(v.y); a[3] += bf_hi(v.y); a[4] += bf_lo(v.z); a[5] += bf_hi(v.z); a[6] += bf_lo(v.w); a[7] += bf_hi(v.w); }
#pragma unroll
        for (int k = 0; k < 8; ++k) { a[k] += __shfl_xor(a[k], 8); a[k] += __shfl_xor(a[k], 16); a[k] += __shfl_xor(a[k], 32); }
        if (rg == 0) {
#pragma unroll
            for (int k = 0; k < 8; ++k) km[(size_t)it * 64 + ch * 8 + k] = a[k] * (1.f / 256.f); }
    }
}
__device__ __forceinline__ int moba_list_base(int bh, int j) { return bh * MOBA_CAP + 256 * (63 * j - (j * (j - 1)) / 2); }
__device__ __forceinline__ void p4_moba_select(Frame& F) {
    PHASE_BEGIN(F);
    const bf16* QKV = (const bf16*)(F.ws + WS_QKV); const float* km = (const float*)(F.ws + WS_KMEAN); unsigned* mlist = (unsigned*)(F.ws + WS_MLIST);
    LAS float* kml = (LAS float*)(F.lds);
    for (int bi = blockIdx.x; bi < 512; bi += F.G) {
        const int bh = bi >> 5, qg = bi & 31, b = bh >> 3, h = bh & 7;
        for (int i = F.tid; i < 1024; i += NWAVES * 64) ((LAS f32x4*)kml)[i] = ((const f32x4*)(km + (size_t)bh * 4096))[i];
        __syncthreads();
        const int q = qg * 512 + F.wave * 64 + F.lane, own = (qg * 512 + F.wave * 64) >> 8;
        if (own > 0) {
            float qf[64];
            const bf16* qp = QKV + ((size_t)(b * T + q)) * NPROJ + 1536 + h * 64;
#pragma unroll
            for (int c8 = 0; c8 < 8; ++c8) { const v4u v = *(const GAS v4u*)(qp + c8 * 8);
                qf[c8 * 8 + 0] = bf_lo(v.x); qf[c8 * 8 + 1] = bf_hi(v.x); qf[c8 * 8 + 2] = bf_lo(v.y); qf[c8 * 8 + 3] = bf_hi(v.y); qf[c8 * 8 + 4] = bf_lo(v.z); qf[c8 * 8 + 5] = bf_hi(v.z); qf[c8 * 8 + 6] = bf_lo(v.w); qf[c8 * 8 + 7] = bf_hi(v.w); }
            float v0 = -INFINITY, v1 = -INFINITY, v2 = -INFINITY; int i0 = 64, i1 = 64, i2 = 64;
            for (int j = 0; j < own; ++j) {
                float g = 0.f;
#pragma unroll
                for (int d4 = 0; d4 < 16; ++d4) { const f32x4 kv = ((const LAS f32x4*)kml)[j * 16 + d4]; g += qf[d4 * 4] * kv.x + qf[d4 * 4 + 1] * kv.y + qf[d4 * 4 + 2] * kv.z + qf[d4 * 4 + 3] * kv.w; }
                if (g > v0) { v2 = v1; i2 = i1; v1 = v0; i1 = i0; v0 = g; i0 = j; }
                else if (g > v1) { v2 = v1; i2 = i1; v1 = g; i1 = j; }
                else if (g > v2) { v2 = g; i2 = j; }
            }
            for (int j = 0; j < own; ++j) {
                const bool sel = (i0 == j) || (i1 == j) || (i2 == j);
                const unsigned long long mask = __ballot(sel);
                if (mask) {
                    unsigned base = 0;
                    if (F.lane == 0) base = __hip_atomic_fetch_add(F.ctl + CW_MCNT + (bh * 64 + j) * 16, (unsigned)__popcll(mask), RLX_AGENT);
                    base = (unsigned)__builtin_amdgcn_readfirstlane((int)base);
                    if (sel) { const unsigned pos = base + (unsigned)__popcll(mask & ((1ull << F.lane) - 1ull)); const unsigned slot = (i0 == j) ? 0u : ((i1 == j) ? 1u : 2u);
                        mlist[(size_t)moba_list_base(bh, j) + pos] = (unsigned)q | (slot << 14); }
                }
            }
        }
        __syncthreads();
    }
}
__device__ __forceinline__ void p5_moba_gather(Frame& F, char* lds_generic) {
    PHASE_BEGIN(F);
    LAS int* pre = (LAS int*)(F.lds + 106496);
    LAS int* tmp = (LAS int*)(F.lds + 106496 + 4224);
    for (int i = F.tid; i < 1024; i += NWAVES * 64) { const unsigned c = __hip_atomic_load(F.ctl + CW_MCNT + i * 16, RLX_AGENT); tmp[i] = (int)((c + 255u) >> 8); }
    __syncthreads();
    if (F.wave == 0) { int loc[16]; int s = 0;
#pragma unroll
        for (int k = 0; k < 16; ++k) { loc[k] = s; s += tmp[F.lane * 16 + k]; }
        int incl = s;
#pragma unroll
        for (int o = 1; o < 64; o <<= 1) { const int t = __shfl_up(incl, o); if (F.lane >= o) incl += t; }
        const int excl = incl - s;
#pragma unroll
        for (int k = 0; k < 16; ++k) pre[F.lane * 16 + k] = excl + loc[k];
        if (F.lane == 63) pre[1024] = incl; }
    __syncthreads();
    const int U = pre[1024];
    const bf16* QKV = (const bf16*)(F.ws + WS_QKV); const unsigned* mlist = (const unsigned*)(F.ws + WS_MLIST);
    for (int L = blockIdx.x; L < U; L += F.G) {
        int lo = 0, hi = 1024;
        while (hi - lo > 1) { const int mid = (lo + hi) >> 1; if (pre[mid] <= L) lo = mid; else hi = mid; }
        const int x = lo, chunk = L - pre[x], bh = x >> 6, j = x & 63, b = bh >> 3, h = bh & 7;
        const int cnt = (int)__hip_atomic_load(F.ctl + CW_MCNT + x * 16, RLX_AGENT); const int n = (cnt - chunk * 256) < 256 ? (cnt - chunk * 256) : 256;
        attn_body::moba_gather_unit((const attn_body::bf16*)QKV + (size_t)b * T * NPROJ, h, j, mlist + (size_t)moba_list_base(bh, j) + chunk * 256, n, (long)b * T,
                                    (const float*)(F.ws + WS_BIASG) + (4 + h) * 128, (float*)(F.ws + WS_PML), (attn_body::bf16*)(F.ws + WS_PO), lds_generic);
    }
}
__device__ __forceinline__ void p6_attention(Frame& F, char* lds_generic) {
    PHASE_BEGIN(F);
    const attn_body::bf16* QKV = (const attn_body::bf16*)(F.ws + WS_QKV);
    const int c = blockIdx.x, G = F.G;
    for (int i = 0;; ++i) {
        const long L = (long)i * G + ((i & 1) ? (G - 1 - c) : c);
        if (L >= 3072) break;
        if (L < 2048) {
            const int qb = 63 - (int)(L >> 5), st = (int)(L & 31), b = st >> 4, vh = st & 15, hd = vh >> 2, mp = (vh >> 1) & 1, vhalf = vh & 1;
            const attn_body::bf16* base = QKV + (size_t)b * T * NPROJ;
            attn_body::MobaMerge mm{nullptr, nullptr, 0, 0, 0};
            attn_body::attn_unit<8, 0>(base + hd * 128 + mp * 64, base + 512 + hd * 128 + mp * 64, base + 1024 + hd * 128 + vhalf * 64,
                                       (attn_body::bf16*)(F.ws + WS_OD) + (size_t)b * T * 1024 + vh * 64, qb * 256, 0, 4 * (qb + 1),
                                       (const float*)(F.ws + WS_BIASG) + hd * 128, mm, lds_generic);
        } else {
            const int o = (int)(L - 2048), b = o >> 9, h = (o >> 6) & 7, qb = o & 63;
            const attn_body::bf16* base = QKV + (size_t)b * T * NPROJ;
            attn_body::MobaMerge mm{(const float*)(F.ws + WS_PML), (const attn_body::bf16*)(F.ws + WS_PO), (long)b * T + qb * 256, h, qb < 3 ? qb : 3};
            attn_body::attn_unit<8, 1>(base + 1536 + h * 64, base + 2048 + h * 64, base + 2560 + h * 64,
                                       (attn_body::bf16*)(F.ws + WS_XN) + (size_t)b * T * 1024 + 512 + h * 64, qb * 256, qb * 256, 4,
                                       (const float*)(F.ws + WS_BIASG) + (4 + h) * 128, mm, lds_generic);
        }
    }
}
__device__ __forceinline__ void p7_ydiff(Frame& F) {
    PHASE_BEGIN(F);
    const kptr_t kp = karg();
    const float l1 = wave_sum(INP(kp, 9)[F.lane] * INP(kp, 10)[F.lane]), l2 = wave_sum(INP(kp, 11)[F.lane] * INP(kp, 12)[F.lane]);
    const float lam = expf(l1) - expf(l2) + LAMBDA_INIT;
    const bf16* OD = (const bf16*)(F.ws + WS_OD); bf16* Y = (bf16*)(F.ws + WS_XN);
    const int gw = F.vcu * NWAVES + F.wave, NGW = F.G * NWAVES;
    const int hd = F.lane >> 4, i = F.lane & 15;
    float gn[8];
#pragma unroll
    for (int k = 0; k < 8; ++k) gn[k] = INP(kp, 13)[i * 8 + k] * (1.f - LAMBDA_INIT);
    for (int m = gw; m < M; m += NGW) {
        const v4u a = *(const GAS v4u*)(OD + (size_t)m * 1024 + hd * 256 + i * 8), bb = *(const GAS v4u*)(OD + (size_t)m * 1024 + hd * 256 + 128 + i * 8);
        float v[8] = {bf_lo(a.x) - lam * bf_lo(bb.x), bf_hi(a.x) - lam * bf_hi(bb.x), bf_lo(a.y) - lam * bf_lo(bb.y), bf_hi(a.y) - lam * bf_hi(bb.y),
                      bf_lo(a.z) - lam * bf_lo(bb.z), bf_hi(a.z) - lam * bf_hi(bb.z), bf_lo(a.w) - lam * bf_lo(bb.w), bf_hi(a.w) - lam * bf_hi(bb.w)};
        float s = 0.f;
#pragma unroll
        for (int k = 0; k < 8; ++k) s += v[k] * v[k];
        s += __shfl_xor(s, 1); s += __shfl_xor(s, 2); s += __shfl_xor(s, 4); s += __shfl_xor(s, 8);
        const float r = 1.f / sqrtf(s * (1.f / 128.f) + EPS);
        v4u o; o.x = pk2(v[0] * r * gn[0], v[1] * r * gn[1]); o.y = pk2(v[2] * r * gn[2], v[3] * r * gn[3]); o.z = pk2(v[4] * r * gn[4], v[5] * r * gn[5]); o.w = pk2(v[6] * r * gn[6], v[7] * r * gn[7]);
        *(GAS v4u*)(Y + (size_t)m * 1024 + hd * 128 + i * 8) = o;
    }
    expert_weights(F);
}
__device__ __forceinline__ void p9_postmix_route(Frame& F) {
    PHASE_BEGIN(F);
    const kptr_t kp = karg();
    const float* x = INP(kp, 0); const float* yo = (const float*)(F.ws + WS_YO); const float* mod = (const float*)(F.ws + WS_MOD);
    bf16* XN = (bf16*)(F.ws + WS_XN); float* tokw = (float*)(F.ws + WS_TOKW); int* elist = (int*)(F.ws + WS_ELIST);
    LAS float* WE = (LAS float*)(F.lds); LAS float* WG = (LAS float*)(F.lds + 131072);
    for (int f = F.tid; f < 32768; f += NWAVES * 64) { const int k = f >> 5, cc = f & 31; const int l = (k & 255) >> 2, kk = ((k >> 8) << 2) | (k & 3), g = cc >> 3, hf = (cc >> 2) & 1, ii = cc & 3;
        WE[((((g * 16 + kk) * 2 + hf) * 64 + l) << 2) + ii] = INP(kp, 18)[f]; }
    for (int f = F.tid; f < 4096; f += NWAVES * 64) { const int k = f >> 2, ii = f & 3; const int l = (k & 255) >> 2, kk = ((k >> 8) << 2) | (k & 3); WG[((kk * 64 + l) << 2) + ii] = INP(kp, 16)[f]; }
    __syncthreads();
    const int gw = F.vcu * NWAVES + F.wave, NGW = F.G * NWAVES;
    const float bg0 = INP(kp, 17)[0], bg1 = INP(kp, 17)[1], bg2 = INP(kp, 17)[2], bg3 = INP(kp, 17)[3];
    for (int b = 0; b < BATCH; ++b) {
        f32x4 a1[4], ge[4], sh[4];
#pragma unroll
        for (int j = 0; j < 4; ++j) { const int c = 4 * F.lane + 256 * j; a1[j] = *(const f32x4*)(INP(kp, 5) + c) * *(const f32x4*)(mod + b * 6144 + 2048 + c);
            ge[j] = *(const f32x4*)(INP(kp, 6) + c) * (*(const f32x4*)(mod + b * 6144 + 4096 + c) + 1.f); sh[j] = *(const f32x4*)(mod + b * 6144 + 3072 + c); }
        for (int m = b * T + gw; m < (b + 1) * T; m += NGW) {
            const GAS f32x4* yr = (const GAS f32x4*)(yo + (size_t)m * D) + F.lane; const GAS f32x4* xr = (const GAS f32x4*)(x + (size_t)m * D) + F.lane;
            f32x4 xv[4]; float s = 0.f, s2 = 0.f;
            {   f32x4 y[4];
#pragma unroll
                for (int j = 0; j < 4; ++j) { y[j] = yr[64 * j]; xv[j] = xr[64 * j]; s += (y[j].x * y[j].x + y[j].y * y[j].y) + (y[j].z * y[j].z + y[j].w * y[j].w); }
                const float r1 = 1.f / sqrtf(wave_sum(s) * (1.f / D) + EPS);
                GAS f32x4* orow = (GAS f32x4*)(F.out + (size_t)m * D) + F.lane;
#pragma unroll
                for (int j = 0; j < 4; ++j) { xv[j] = xv[j] + a1[j] * (y[j] * r1); orow[64 * j] = xv[j]; s2 += (xv[j].x * xv[j].x + xv[j].y * xv[j].y) + (xv[j].z * xv[j].z + xv[j].w * xv[j].w); }
            }
            const float r2 = 1.f / sqrtf(wave_sum(s2) * (1.f / D) + EPS);
            GAS unsigned long long* o8 = (GAS unsigned long long*)(XN + (size_t)m * D) + F.lane;
            float gl[4] = {0.f, 0.f, 0.f, 0.f};
#pragma unroll
            for (int j = 0; j < 4; ++j) { xv[j] = xv[j] * r2 * ge[j] + sh[j]; o8[64 * j] = (unsigned long long)pk2(xv[j].x, xv[j].y) | ((unsigned long long)pk2(xv[j].z, xv[j].w) << 32);
#pragma unroll
                for (int ii = 0; ii < 4; ++ii) { const f32x4 w = ((const LAS f32x4*)WG)[(j * 4 + ii) * 64 + F.lane]; const float hv = xv[j][ii]; gl[0] += hv * w.x; gl[1] += hv * w.y; gl[2] += hv * w.z; gl[3] += hv * w.w; }
                __builtin_amdgcn_sched_barrier(0); }
            gl[0] = wave_sum(gl[0]) + bg0; gl[1] = wave_sum(gl[1]) + bg1; gl[2] = wave_sum(gl[2]) + bg2; gl[3] = wave_sum(gl[3]) + bg3;
            int g = 0; float gm = gl[0];
            if (gl[1] > gm) { gm = gl[1]; g = 1; } if (gl[2] > gm) { gm = gl[2]; g = 2; } if (gl[3] > gm) { gm = gl[3]; g = 3; }
            const float gw_ = 1.f / (expf(gl[0] - gm) + expf(gl[1] - gm) + expf(gl[2] - gm) + expf(gl[3] - gm));
            g = __builtin_amdgcn_readfirstlane(g);
            float el[8] = {0.f, 0.f, 0.f, 0.f, 0.f, 0.f, 0.f, 0.f};
#pragma unroll
            for (int j = 0; j < 4; ++j) {
#pragma unroll
                for (int ii = 0; ii < 4; ++ii) { const int kk = j * 4 + ii; const f32x4 wa = ((const LAS f32x4*)WE)[((g * 16 + kk) * 2 + 0) * 64 + F.lane], wb = ((const LAS f32x4*)WE)[((g * 16 + kk) * 2 + 1) * 64 + F.lane]; const float hv = xv[j][ii];
                    el[0] += hv * wa.x; el[1] += hv * wa.y; el[2] += hv * wa.z; el[3] += hv * wa.w; el[4] += hv * wb.x; el[5] += hv * wb.y; el[6] += hv * wb.z; el[7] += hv * wb.w; }
                __builtin_amdgcn_sched_barrier(0); }
            float ea = -INFINITY, eb = -INFINITY; int ia = 0, ib = 0;
#pragma unroll
            for (int k = 0; k < 8; ++k) { const float v = wave_sum(el[k]) + INP(kp, 19)[g * 8 + k];
                if (v > ea) { eb = ea; ib = ia; ea = v; ia = k; } else if (v > eb) { eb = v; ib = k; } }
            const float pb = expf(eb - ea), wa_ = gw_ / (1.f + pb), wb_ = gw_ * pb / (1.f + pb);
            if (F.lane == 0) {
                const int e0 = g * 8 + ia, e1 = g * 8 + ib;
                const unsigned p0 = __hip_atomic_fetch_add(F.ctl + CW_ECNT + e0 * 64, 1u, RLX_AGENT), p1 = __hip_atomic_fetch_add(F.ctl + CW_ECNT + e1 * 64, 1u, RLX_AGENT);
                elist[e0 * 32768 + (int)p0] = m * 2; elist[e1 * 32768 + (int)p1] = m * 2 + 1;
                *(f32x2*)(tokw + (size_t)m * 2) = (f32x2){wa_, wb_};
            }
        }
    }
}
struct MoeOrder {
    const LAS int* tp;
    const gu32* ecnt; const int* elist; int G, c;
    __device__ __forceinline__ bool next(int i, pg8::Unit& u) const {
        const long L = (long)i * G + c; const int U = tp[32] * 4; if (L >= U) return false;
        const int rt = (int)(L >> 2), pn = (int)(L & 3); int e = 0;
#pragma unroll 1
        for (int k = 1; k < 32; ++k) e += (tp[k] <= rt) ? 1 : 0;
        const int t = rt - tp[e]; const int cnt = (int)__hip_atomic_load(ecnt + e * 64, RLX_AGENT);
        u.pm = rt; u.pn = e * 4 + pn; u.nvalid = (cnt - t * 256) < 256 ? (cnt - t * 256) : 256; u.rows = elist + e * 32768 + t * 256; return true;
    }
    __device__ __forceinline__ int arow(const pg8::Unit& u, int r) const { return r < u.nvalid ? (u.rows[r] >> 1) : 0; }
};
__device__ __forceinline__ void moe_prefix(Frame& F, LAS int* tp) {
    if (F.tid == 0) { int s = 0; for (int e = 0; e < 32; ++e) { tp[e] = s; s += ((int)__hip_atomic_load(F.ctl + CW_ECNT + e * 64, RLX_AGENT) + 255) >> 8; } tp[32] = s; }
    __syncthreads();
}
__device__ __forceinline__ void p12_final(Frame& F) {
    PHASE_BEGIN(F);
    const kptr_t kp = karg();
    const float* mod = (const float*)(F.ws + WS_MOD); const bf16* SO = (const bf16*)(F.ws + WS_SO); const float* tokw = (const float*)(F.ws + WS_TOKW);
    const int gw = F.vcu * NWAVES + F.wave, NGW = F.G * NWAVES;
    for (int b = 0; b < BATCH; ++b) {
        f32x4 pg[4], g2[4];
#pragma unroll
        for (int j = 0; j < 4; ++j) { const int c = 4 * F.lane + 256 * j; pg[j] = *(const f32x4*)(INP(kp, 7) + c); g2[j] = *(const f32x4*)(mod + b * 6144 + 5120 + c); }
        for (int m = b * T + gw; m < (b + 1) * T; m += NGW) {
            const f32x2 w = *(const f32x2*)(tokw + (size_t)m * 2);
            const GAS v2u* s0 = (const GAS v2u*)(SO + (size_t)m * 2048) + F.lane; const GAS v2u* s1 = (const GAS v2u*)(SO + (size_t)m * 2048 + 1024) + F.lane;
            GAS f32x4* orow = (GAS f32x4*)(F.out + (size_t)m * D) + F.lane;
            f32x4 y[4], xv[4]; float s = 0.f;
#pragma unroll
            for (int j = 0; j < 4; ++j) { const v2u a = s0[64 * j], bq = s1[64 * j]; xv[j] = orow[64 * j];
                y[j] = (f32x4){w.x * bf_lo(a.x) + w.y * bf_lo(bq.x), w.x * bf_hi(a.x) + w.y * bf_hi(bq.x), w.x * bf_lo(a.y) + w.y * bf_lo(bq.y), w.x * bf_hi(a.y) + w.y * bf_hi(bq.y)};
                s += (y[j].x * y[j].x + y[j].y * y[j].y) + (y[j].z * y[j].z + y[j].w * y[j].w); }
            const float r = 1.f / sqrtf(wave_sum(s) * (1.f / D) + EPS);
#pragma unroll
            for (int j = 0; j < 4; ++j) orow[64 * j] = xv[j] + g2[j] * (y[j] * r * pg[j]);
        }
    }
}

struct Args { const float* in[23]; float* out; unsigned char* ws; int ph_lo, ph_hi; };
__global__ void __launch_bounds__(NWAVES * 64, 2) hymba_fwd(Args args) {
    extern __shared__ __attribute__((aligned(16))) unsigned char lds[];
    Frame F;
    F.lds = (LAS unsigned char*)lds;
    F.MISC = (volatile LAS unsigned*)(F.lds + MISC_OFF);
    F.tid = threadIdx.x; F.lane = F.tid & 63; F.wave = __builtin_amdgcn_readfirstlane(F.tid >> 6);
    F.G = gridDim.x; { const int bx = blockIdx.x; F.vcu = (F.G % 8 == 0) ? (bx % 8) * (F.G / 8) + bx / 8 : bx; }
    F.ws = args.ws; F.out = args.out; F.ctl = (gu32*)(args.ws + WS_CTL);
    for (int u = F.tid; u < (LDS_BYTES - LDSCTL_OFF) / 4; u += NWAVES * 64) ((LAS unsigned*)(F.lds + LDSCTL_OFF))[u] = 0u;
    __syncthreads();
    XcdBarrier bar; bar.bar = (unsigned*)(F.ctl + CW_BAR); bar.x = 0; bar.st = nullptr;
    if (N_LAUNCHES == 1) bar = xcd_barrier_post((unsigned*)(F.ctl + CW_BAR), F.MISC + 8);
#define GRID_BAR() do { if (N_LAUNCHES == 1) xcd_barrier(bar); } while (0)
    const int lo = args.ph_lo, hi = args.ph_hi;
#define IN(k) (lo <= (k) && (k) < hi)
#define BOTH(k) (IN(k) && IN((k) + 1))
    bf16* XN = (bf16*)(args.ws + WS_XN);

    if (IN(0)) { p0_prologue(F); if (BOTH(0)) GRID_BAR(); }
    if (IN(1)) { p1_prenorm(F); if (BOTH(1)) GRID_BAR(); }
    if (IN(2)) {
        pg8::Gemm g{XN, (const bf16*)(args.ws + WS_WIN), M, NPROJ, D}; pg8::StaticOrder S; S.init(M, NPROJ, F.G, (int)blockIdx.x);
        pg8::EpiQKV E{(bf16*)(args.ws + WS_QKV), NPROJ, 0xC3u, attn_body::C2};
        pg8::gemm_phase<pg8::EpiQKV, pg8::StaticOrder, false>(F.lds + RING_OFF, g, S, E);
        if (BOTH(2)) GRID_BAR();
    }
    if (IN(3)) { p3_kmean(F); if (BOTH(3)) GRID_BAR(); }
    if (IN(4)) { p4_moba_select(F); if (BOTH(4)) GRID_BAR(); }
    if (IN(5)) { p5_moba_gather(F, (char*)lds + RING_OFF); if (BOTH(5)) GRID_BAR(); }
    if (IN(6)) { p6_attention(F, (char*)lds + RING_OFF); if (BOTH(6)) GRID_BAR(); }
    if (IN(7)) { p7_ydiff(F); if (BOTH(7)) GRID_BAR(); }
    if (IN(8)) {
        pg8::Gemm g{XN, (const bf16*)(args.ws + WS_WOUT), M, D, D}; pg8::StaticOrder S; S.init(M, D, F.G, (int)blockIdx.x);
        pg8::EpiF32 E{(float*)(args.ws + WS_YO), D};
        pg8::gemm_phase<pg8::EpiF32, pg8::StaticOrder, false>(F.lds + RING_OFF, g, S, E);
        if (BOTH(8)) GRID_BAR();
    }
    if (IN(9)) { p9_postmix_route(F); if (BOTH(9)) GRID_BAR(); }
    if (IN(10)) {
        LAS int* tp = (LAS int*)(F.lds + RING_BYTES); moe_prefix(F, tp);
        MoeOrder S{tp, F.ctl + CW_ECNT, (const int*)(args.ws + WS_ELIST), F.G, (int)blockIdx.x};
        pg8::Gemm g{XN, (const bf16*)(args.ws + WS_WGU), M, 1024, D};
        pg8::EpiSwiGLU E{(bf16*)(args.ws + WS_HID)};
        pg8::gemm_phase<pg8::EpiSwiGLU, MoeOrder, true>(F.lds + RING_OFF, g, S, E);
        if (BOTH(10)) GRID_BAR();
    }
    if (IN(11)) {
        LAS int* tp = (LAS int*)(F.lds + RING_BYTES); moe_prefix(F, tp);
        MoeOrder S{tp, F.ctl + CW_ECNT, (const int*)(args.ws + WS_ELIST), F.G, (int)blockIdx.x};
        pg8::Gemm g{(const bf16*)(args.ws + WS_HID), (const bf16*)(args.ws + WS_WD), 73728, 1024, EFF};
        pg8::EpiDown E{(bf16*)(args.ws + WS_SO)};
        pg8::gemm_phase<pg8::EpiDown, MoeOrder, false>(F.lds + RING_OFF, g, S, E);
        if (BOTH(11)) GRID_BAR();
    }
    if (IN(12)) { p12_final(F); }
#undef IN
#undef BOTH
#undef GRID_BAR
}

extern "C" void kernel_launch(void* const* d_in, const int* in_sizes, int n_in, void* d_out, int out_size, void* d_ws, size_t ws_size, hipStream_t stream) {
    static int grid = 0;
    if (grid == 0) {
        if (n_in != 23 || in_sizes[0] != M * D || out_size != M * D || ws_size < WS_END) { fprintf(stderr, "kernel_launch: unexpected shapes (n_in %d, in0 %d, out %d, ws %zu); nothing launched\n", n_in, n_in > 0 ? in_sizes[0] : -1, out_size, ws_size); grid = -1; return; }
        int dev = 0, cus = 0, per_cu = 0;
        if (hipGetDevice(&dev) != hipSuccess || hipDeviceGetAttribute(&cus, hipDeviceAttributeMultiprocessorCount, dev) != hipSuccess) { fprintf(stderr, "kernel_launch: device query failed\n"); grid = -1; return; }
        if (hipFuncSetAttribute((const void*)hymba_fwd, hipFuncAttributeMaxDynamicSharedMemorySize, LDS_BYTES) != hipSuccess) { fprintf(stderr, "kernel_launch: hipFuncSetAttribute failed\n"); grid = -1; return; }
        if (hipOccupancyMaxActiveBlocksPerMultiprocessor(&per_cu, (const void*)hymba_fwd, NWAVES * 64, LDS_BYTES) != hipSuccess || per_cu < 1)
            fprintf(stderr, "kernel_launch: note: occupancy query reports %d workgroups per CU\n", per_cu);
        (void)hipGetLastError();
        grid = cus;
    }
    if (grid < 0) return;
    if (hipMemsetAsync((char*)d_ws + WS_CTL, 0, CTL_ZERO_BYTES, stream) != hipSuccess) { fprintf(stderr, "kernel_launch: hipMemsetAsync failed\n"); return; }
    Args a{};
    for (int i = 0; i < 23; ++i) a.in[i] = (const float*)d_in[i];
    a.out = (float*)d_out; a.ws = (unsigned char*)d_ws;
    for (int li = 0; li < N_LAUNCHES; ++li) {
        a.ph_lo = (N_LAUNCHES == 1) ? 0 : li; a.ph_hi = (N_LAUNCHES == 1) ? N_PHASES : li + 1;
        hipLaunchKernelGGL(hymba_fwd, dim3(grid), dim3(NWAVES * 64), LDS_BYTES, stream, a);
        const hipError_t le = hipPeekAtLastError();
        if (le != hipSuccess) { fprintf(stderr, "kernel_launch: launch %d failed: %s\n", li, hipGetErrorName(le)); break; }
    }
}
```

```cpp
#include <hip/hip_runtime.h>
#include <hip/hip_bf16.h>
#include <cstdio>
#include <cstdint>
#include <cmath>

namespace pg8 {
#define PG8_LAS __attribute__((address_space(3)))
typedef unsigned short bf16_t;
typedef short bf16x8 __attribute__((ext_vector_type(8)));
typedef float f32x4 __attribute__((ext_vector_type(4)));
typedef unsigned u32x4 __attribute__((ext_vector_type(4)));
constexpr int BM = 256, BK = 64, HALF = 128, HTB = HALF * BK * 2  , STAGE_BYTES = 8 * HTB, NXCD = 8, WGM = 8;

__host__ __device__ __forceinline__ int lds_byte(int r, int c) { const int st = (r >> 4) * 2 + (c >> 5), rr = r & 15, cc = c & 31, ob = rr * 64 + cc * 2; return st * 1024 + (ob ^ (((ob >> 9) & 1) << 5)); }
__host__ __device__ __forceinline__ void stage_rc(int b, int& R, int& C) { const int st = b / 1024, sb = b % 1024, swz = sb ^ (((sb >> 9) & 1) << 5); R = (st >> 1) * 16 + swz / 64; C = (st & 1) * 32 + (swz % 64) / 2; }
__host__ __device__ __forceinline__ int perm32(int rho) { const int n = rho >> 4, i = rho & 15; return 8 * (i >> 2) + 4 * n + (i & 3); }

struct Unit { int pm, pn; int nvalid; const int* rows; };
struct Gemm { const bf16_t* A; const bf16_t* Bt; int M, N, K; };

struct StaticOrder {
    int nM, nN, nwg, G, c;
    __host__ __device__ void init(int M, int N, int G_, int c_) { nM = M / BM; nN = N / BM; nwg = nM * nN; G = G_; c = c_; }
    __host__ __device__ bool next(int i, Unit& u) const {
        const long L = (long)i * G + c; if (L >= nwg) return false;
        int wgid = (int)L; { const int q = nwg / NXCD, r = nwg % NXCD, xcd = wgid % NXCD, off = wgid / NXCD; wgid = (xcd < r ? xcd * (q + 1) : r * (q + 1) + (xcd - r) * q) + off; }
        const int nig = WGM * nN, gid = wgid / nig, fm = gid * WGM, gsz = (nM - fm) < WGM ? (nM - fm) : WGM;
        u.pm = fm + ((wgid % nig) % gsz); u.pn = (wgid % nig) / gsz; u.nvalid = 256; u.rows = nullptr; return true;
    }
    __device__ __forceinline__ int arow(const Unit&, int r) const { return r; }
};

__device__ __forceinline__ unsigned cvt_pk_bf16(float lo, float hi) { unsigned r; asm volatile("v_cvt_pk_bf16_f32 %0, %1, %2" : "=v"(r) : "v"(lo), "v"(hi)); return r; }

struct EpiQKV {
    static constexpr bool PERM = true;
    bf16_t* O; int ldc; unsigned qmask; float qscale;
    __device__ __forceinline__ void operator()(const f32x4 (&acc)[2][2][4][2], const Unit& u, int wr, int wc, int fr, int fq) const {
        const int row0 = u.pm * BM + wr * 64 + fr; const int col0 = u.pn * BM + wc * 32 + 8 * fq;
        const float sc = ((qmask >> u.pn) & 1u) ? qscale : 1.f;
#pragma unroll
        for (int ai = 0; ai < 2; ++ai)
#pragma unroll
            for (int m = 0; m < 4; ++m) { bf16_t* rowp = O + (size_t)(row0 + ai * HALF + m * 16) * ldc + col0;
#pragma unroll
                for (int bj = 0; bj < 2; ++bj) { const f32x4 v0 = acc[ai][bj][m][0] * sc, v1 = acc[ai][bj][m][1] * sc;
                    u32x4 w; w.x = cvt_pk_bf16(v0[0], v0[1]); w.y = cvt_pk_bf16(v0[2], v0[3]); w.z = cvt_pk_bf16(v1[0], v1[1]); w.w = cvt_pk_bf16(v1[2], v1[3]);
                    *(u32x4*)(rowp + bj * HALF) = w; } }
    }
};
struct EpiF32 {
    static constexpr bool PERM = false;
    float* O; int ldc;
    __device__ __forceinline__ void operator()(const f32x4 (&acc)[2][2][4][2], const Unit& u, int wr, int wc, int fr, int fq) const {
        const int col0 = u.pn * BM + wc * 32 + 4 * fq;
#pragma unroll
        for (int ai = 0; ai < 2; ++ai)
#pragma unroll
            for (int m = 0; m < 4; ++m) { float* rowp = O + (size_t)(u.pm * BM + ai * HALF + wr * 64 + m * 16 + fr) * ldc + col0;
#pragma unroll
                for (int bj = 0; bj < 2; ++bj)
#pragma unroll
                    for (int n = 0; n < 2; ++n) *(f32x4*)(rowp + bj * HALF + n * 16) = acc[ai][bj][m][n]; }
    }
};
struct EpiSwiGLU {
    static constexpr bool PERM = true;
    bf16_t* H;
    __device__ __forceinline__ void operator()(const f32x4 (&acc)[2][2][4][2], const Unit& u, int wr, int wc, int fr, int fq) const {
        const int col0 = (u.pn & 3) * 128 + wc * 32 + 8 * fq;
#pragma unroll
        for (int ai = 0; ai < 2; ++ai)
#pragma unroll
            for (int m = 0; m < 4; ++m) { bf16_t* rowp = H + (size_t)(u.pm * BM + ai * HALF + wr * 64 + m * 16 + fr) * 512 + col0;
                float h[8];
#pragma unroll
                for (int n = 0; n < 2; ++n)
#pragma unroll
                    for (int k = 0; k < 4; ++k) { const float gt = acc[ai][0][m][n][k], up = acc[ai][1][m][n][k];
                        h[n * 4 + k] = gt * __builtin_amdgcn_rcpf(1.f + __builtin_amdgcn_exp2f(-1.4426950408889634f * gt)) * up; }
                u32x4 w; w.x = cvt_pk_bf16(h[0], h[1]); w.y = cvt_pk_bf16(h[2], h[3]); w.z = cvt_pk_bf16(h[4], h[5]); w.w = cvt_pk_bf16(h[6], h[7]);
                *(u32x4*)rowp = w; }
    }
};
struct EpiDown {
    static constexpr bool PERM = true;
    bf16_t* SO;
    __device__ __forceinline__ void operator()(const f32x4 (&acc)[2][2][4][2], const Unit& u, int wr, int wc, int fr, int fq) const {
        const int col0 = (u.pn & 3) * BM + wc * 32 + 8 * fq;
#pragma unroll
        for (int ai = 0; ai < 2; ++ai)
#pragma unroll
            for (int m = 0; m < 4; ++m) { const int r = ai * HALF + wr * 64 + m * 16 + fr;
                if (r < u.nvalid) { const int ent = u.rows[r]; bf16_t* rowp = SO + (size_t)ent * 1024 + col0;
#pragma unroll
                    for (int bj = 0; bj < 2; ++bj) { const f32x4 v0 = acc[ai][bj][m][0], v1 = acc[ai][bj][m][1];
                        u32x4 w; w.x = cvt_pk_bf16(v0[0], v0[1]); w.y = cvt_pk_bf16(v0[2], v0[3]); w.z = cvt_pk_bf16(v1[0], v1[1]); w.w = cvt_pk_bf16(v1[2], v1[3]);
                        *(u32x4*)(rowp + bj * HALF) = w; } } }
    }
};

template <class Epi, class Sched, bool GATHER>
__device__ __forceinline__ void gemm_phase(PG8_LAS unsigned char* lds, const Gemm g, const Sched& S, const Epi& E) {
    const int tid = threadIdx.x, wid = __builtin_amdgcn_readfirstlane(tid >> 6), lane = tid & 63, wr = wid >> 2, wc = wid & 3, fr = lane & 15, fq = lane >> 4;
    const int K = g.K, nt = K / BK;
    int Rr[2], Cc[2]; unsigned voffB[2];
#pragma unroll
    for (int i = 0; i < 2; ++i) { int R, C; stage_rc(tid * 16 + i * 8192, R, C); Rr[i] = R; Cc[i] = C; const int Rb = Epi::PERM ? ((R & ~31) + perm32(R & 31)) : R; voffB[i] = (unsigned)(Rb * K + C) * 2u; }
    const size_t kstep = (size_t)(BK * 2);
    const size_t hstep = (size_t)HALF * K * 2;
    const size_t tstep = 2 * hstep;
    const unsigned ldsw = (unsigned)wid * 1024u;
    const int aoff = lds_byte(wr * 64 + fr, fq * 8), boff = lds_byte(wc * 32 + fr, fq * 8);
#define PG8_SA(b, h) (((b) * 2 + (h)) * HTB)
#define PG8_SB(b, h) ((4 + (b) * 2 + (h)) * HTB)
#define PG8_STAGE(bufoff, gbase, voff) do { _Pragma("unroll") for (int _i = 0; _i < 2; ++_i) \
        __builtin_amdgcn_global_load_lds((const unsigned*)((const char*)(gbase) + (voff)[_i]), (PG8_LAS unsigned*)(lds + (bufoff) + ldsw + _i * 8192), 16, 0, 0); } while (0)
#define PG8_LDA(dst, b, h) do { _Pragma("unroll") for (int m = 0; m < 4; ++m) _Pragma("unroll") for (int k = 0; k < 2; ++k) dst[m][k] = *(const PG8_LAS bf16x8*)(lds + PG8_SA(b, h) + aoff + m * 2048 + k * 1024); } while (0)
#define PG8_LDB(dst, b, h) do { _Pragma("unroll") for (int n = 0; n < 2; ++n) _Pragma("unroll") for (int k = 0; k < 2; ++k) dst[n][k] = *(const PG8_LAS bf16x8*)(lds + PG8_SB(b, h) + boff + n * 2048 + k * 1024); } while (0)
#define PG8_MMA(ai, bj, At, Bt) do { __builtin_amdgcn_s_setprio(1); _Pragma("unroll") for (int m = 0; m < 4; ++m) _Pragma("unroll") for (int n = 0; n < 2; ++n) _Pragma("unroll") for (int k = 0; k < 2; ++k) \
        acc[ai][bj][m][n] = __builtin_amdgcn_mfma_f32_16x16x32_bf16(Bt[n][k], At[m][k], acc[ai][bj][m][n], 0, 0, 0); __builtin_amdgcn_s_setprio(0); } while (0)
#define PG8_WAIT_V(n) asm volatile("s_waitcnt vmcnt(" #n ")" ::: "memory")
#define PG8_WAIT_L(n) asm volatile("s_waitcnt lgkmcnt(" #n ")" ::: "memory")
#define PG8_BAR __builtin_amdgcn_s_barrier()
#define PG8_SCHED __builtin_amdgcn_sched_barrier(0)
#define PG8_CALC_VOFF(u, vo) do { _Pragma("unroll") for (int h_ = 0; h_ < 2; ++h_) _Pragma("unroll") for (int i_ = 0; i_ < 2; ++i_) { \
        if constexpr (GATHER) { const int tok_ = S.arow(u, h_ * HALF + Rr[i_]); vo[h_][i_] = (unsigned)(tok_ * K + Cc[i_]) * 2u; } \
        else vo[h_][i_] = (unsigned)(Rr[i_] * K + Cc[i_]) * 2u + (unsigned)(h_ * hstep); } } while (0)
    Unit cur, nxt; int ui = 0;
    if (!S.next(0, cur)) return;
    unsigned vA[2][2], nvA[2][2];
    PG8_CALC_VOFF(cur, vA);
    if constexpr (GATHER) asm volatile("" : "+v"(vA[0][0]), "+v"(vA[0][1]), "+v"(vA[1][0]), "+v"(vA[1][1]));
    f32x4 acc[2][2][4][2];
#pragma unroll
    for (int a = 0; a < 2; ++a)
#pragma unroll
        for (int b = 0; b < 2; ++b)
#pragma unroll
            for (int m = 0; m < 4; ++m)
#pragma unroll
                for (int n = 0; n < 2; ++n) acc[a][b][m][n] = (f32x4){0.f, 0.f, 0.f, 0.f};
    bf16x8 At[4][2], B0[2][2], B1[2][2];
    const char* cA = GATHER ? (const char*)g.A : (const char*)g.A + (size_t)cur.pm * tstep; const char* cB = (const char*)g.Bt + (size_t)cur.pn * tstep;
    PG8_STAGE(PG8_SB(0, 0), cB, voffB); PG8_STAGE(PG8_SB(0, 1), cB + hstep, voffB); PG8_STAGE(PG8_SA(0, 0), cA, vA[0]); PG8_STAGE(PG8_SA(0, 1), cA, vA[1]);
    if (wr == 1) PG8_BAR;
    PG8_WAIT_V(2); PG8_BAR;
    PG8_STAGE(PG8_SB(1, 0), cB + kstep, voffB); PG8_STAGE(PG8_SA(1, 0), cA + kstep, vA[0]); PG8_STAGE(PG8_SB(1, 1), cB + hstep + kstep, voffB);
    PG8_WAIT_V(6); PG8_BAR;
    for (;;) {
        const bool has_next = S.next(ui + 1, nxt);
        const char* nA = has_next ? (GATHER ? (const char*)g.A : (const char*)g.A + (size_t)nxt.pm * tstep) : cA; const char* nB = has_next ? (const char*)g.Bt + (size_t)nxt.pn * tstep : cB;
        if constexpr (GATHER) {
            if (has_next) { PG8_CALC_VOFF(nxt, nvA); }
            else {
#pragma unroll
                for (int h_ = 0; h_ < 2; ++h_)
#pragma unroll
                    for (int i_ = 0; i_ < 2; ++i_) nvA[h_][i_] = vA[h_][i_]; }
            asm volatile("" : "+v"(nvA[0][0]), "+v"(nvA[0][1]), "+v"(nvA[1][0]), "+v"(nvA[1][1]));
        }
        for (int t = 0; t < nt; t += 2) {
            const bool last = (t == nt - 2);
            const char* a1 = cA + (size_t)(t + 1) * kstep;
            const char* a2 = last ? nA : cA + (size_t)(t + 2) * kstep; const char* b2 = last ? nB : cB + (size_t)(t + 2) * kstep;
            const char* a3 = a2 + kstep; const char* b3 = b2 + kstep;
            unsigned w0[2], w1[2];
#pragma unroll
            for (int i_ = 0; i_ < 2; ++i_) { w0[i_] = (GATHER && last) ? nvA[0][i_] : vA[0][i_]; w1[i_] = (GATHER && last) ? nvA[1][i_] : vA[1][i_]; }
            PG8_LDB(B0, 0, 0); PG8_LDB(B1, 0, 1); PG8_SCHED; PG8_LDA(At, 0, 0); PG8_STAGE(PG8_SA(1, 1), a1, vA[1]);
            PG8_WAIT_V(8); PG8_WAIT_L(0); PG8_BAR; PG8_MMA(0, 0, At, B0); PG8_MMA(0, 1, At, B1); PG8_BAR; PG8_SCHED;
            PG8_LDA(At, 0, 1); PG8_STAGE(PG8_SB(0, 0), b2, voffB); PG8_STAGE(PG8_SB(0, 1), b2 + hstep, voffB); PG8_STAGE(PG8_SA(0, 0), a2, w0);
            PG8_WAIT_V(8); PG8_WAIT_L(0); PG8_BAR; PG8_MMA(1, 0, At, B0); PG8_MMA(1, 1, At, B1); PG8_BAR; PG8_SCHED;
            PG8_LDB(B0, 1, 0); PG8_LDB(B1, 1, 1); PG8_SCHED; PG8_LDA(At, 1, 0); PG8_STAGE(PG8_SA(0, 1), a2, w1);
            PG8_WAIT_V(8); PG8_WAIT_L(0); PG8_BAR; PG8_MMA(0, 0, At, B0); PG8_MMA(0, 1, At, B1); PG8_BAR; PG8_SCHED;
            PG8_LDA(At, 1, 1); PG8_STAGE(PG8_SB(1, 0), b3, voffB); PG8_STAGE(PG8_SB(1, 1), b3 + hstep, voffB); PG8_STAGE(PG8_SA(1, 0), a3, w0);
            PG8_WAIT_V(8); PG8_WAIT_L(0); PG8_BAR; PG8_MMA(1, 0, At, B0); PG8_MMA(1, 1, At, B1); PG8_BAR; PG8_SCHED;
        }
        if (wr == 0) PG8_BAR;
        E(acc, cur, wr, wc, fr, fq);
        if (!has_next) break;
#pragma unroll
        for (int a = 0; a < 2; ++a)
#pragma unroll
            for (int b = 0; b < 2; ++b)
#pragma unroll
                for (int m = 0; m < 4; ++m)
#pragma unroll
                    for (int n = 0; n < 2; ++n) acc[a][b][m][n] = (f32x4){0.f, 0.f, 0.f, 0.f};
        cur = nxt; cA = nA; cB = nB; ++ui;
        if constexpr (GATHER) {
#pragma unroll
            for (int h_ = 0; h_ < 2; ++h_)
#pragma unroll
                for (int i_ = 0; i_ < 2; ++i_) vA[h_][i_] = nvA[h_][i_]; }
        if (wr == 1) PG8_BAR;
    }
    PG8_WAIT_V(0);
    PG8_BAR;
#undef PG8_SA
#undef PG8_SB
#undef PG8_STAGE
#undef PG8_LDA
#undef PG8_LDB
#undef PG8_MMA
#undef PG8_WAIT_V
#undef PG8_WAIT_L
#undef PG8_BAR
#undef PG8_SCHED
#undef PG8_CALC_VOFF
}
}

namespace attn_body {
using bf16=__hip_bfloat16;
using bf16x8=__attribute__((ext_vector_type(8)))short;
using s16x4=__attribute__((ext_vector_type(4)))short;
using f32x16=__attribute__((ext_vector_type(16)))float;
using u32x4=__attribute__((ext_vector_type(4)))unsigned;
constexpr int SEQ=16384,D=64;
constexpr int LDQ=3072;
constexpr int LDO=1024;
constexpr int NW=8,QBLK=32,QB=QBLK*NW,KVBLK=64,NQB=SEQ/QB;
__device__ __forceinline__ int crow(int r,int hi){return (r&3)+8*(r>>2)+4*hi;}
#define SBAR() __builtin_amdgcn_sched_barrier(0)
typedef __attribute__((address_space(3))) const float* lds_cfptr;
__device__ __forceinline__ void biasmask(f32x16&p0,f32x16&p1,int jb,int qrel,int hi,lds_cfptr bl){
  const float NEG=-INFINITY; const int kb=64*jb+4*hi;
  #pragma unroll
  for(int g=0;g<4;++g){
    #pragma unroll
    for(int rr=0;rr<4;++rr){const int r=4*g+rr; const int kv=kb+(r&3)+8*(r>>2); const int d0=qrel-kv,d1=d0-32;
      const int i0=d0<0?0:(d0>127?127:d0), i1=d1<0?0:(d1>127?127:d1);
      const float b0=bl[i0],b1=bl[i1];
      p0[r]=d0<0?NEG:p0[r]+b0; p1[r]=d1<0?NEG:p1[r]+b1;}
    __builtin_amdgcn_sched_barrier(0); }
}

constexpr int NSLOT=3, SLOTB=8192;
constexpr int LDS_K=0, LDS_V=NSLOT*SLOTB, LDS_WS=2*NSLOT*SLOTB, LDS_OST=LDS_WS+NW*128*4, LDS_BIAS=LDS_OST+NW*4096, LDS_BYTES=LDS_BIAS+512;
constexpr float C2=0.125f*1.4426950408889634f;
__device__ __forceinline__ void glds16(const void*gsrc,unsigned lds_dst){unsigned keep;
  asm volatile("s_mov_b32 %0, m0\n\ts_mov_b32 m0, %2\n\ts_nop 0\n\tglobal_load_lds_dwordx4 %1, off\n\ts_mov_b32 m0, %0":"=&s"(keep):"v"(gsrc),"s"(lds_dst):"memory");}
__device__ __forceinline__ float max3f(float a,float b,float c){float r;asm("v_max3_f32 %0, %1, %2, %3":"=v"(r):"v"(a),"v"(b),"v"(c));return r;}
__device__ __forceinline__ float max2f(float a,float b){float r;asm("v_max_f32_e32 %0, %1, %2":"=v"(r):"v"(a),"v"(b));return r;}
__device__ __forceinline__ float fadd_s(float a,float b){float r;asm("v_add_f32_e32 %0, %1, %2":"=v"(r):"v"(a),"v"(b));return r;}
__device__ __forceinline__ float fsub_s(float a,float b){float r;asm("v_sub_f32_e32 %0, %1, %2":"=v"(r):"v"(a),"v"(b));return r;}
typedef float f32x2_t __attribute__((ext_vector_type(2))); typedef __bf16 bf16x2_t __attribute__((ext_vector_type(2)));
__device__ __forceinline__ unsigned cvtpk_s(float lo,float hi){f32x2_t v={lo,hi};bf16x2_t b=__builtin_convertvector(v,bf16x2_t);return __builtin_bit_cast(unsigned,b);}
#define WAIT_BAR(N) asm volatile("s_waitcnt vmcnt(" #N ") lgkmcnt(0)\n\ts_barrier":::"memory")

__device__ __forceinline__ void qkt(f32x16&p0,f32x16&p1,const char*Kslot,const bf16x8*qr,const f32x16&negm,int r32,int hi){
  const char*kb=Kslot+hi*1024+r32*16;
  #pragma unroll
  for(int d0=0;d0<4;++d0){
    const bf16x8 b0=*reinterpret_cast<const bf16x8*>(kb+d0*2048);
    const bf16x8 b1=*reinterpret_cast<const bf16x8*>(kb+d0*2048+512);
    if(d0==0){p0=__builtin_amdgcn_mfma_f32_32x32x16_bf16(b0,qr[0],negm,0,0,0);p1=__builtin_amdgcn_mfma_f32_32x32x16_bf16(b1,qr[0],negm,0,0,0);}
    else{p0=__builtin_amdgcn_mfma_f32_32x32x16_bf16(b0,qr[d0],p0,0,0,0);p1=__builtin_amdgcn_mfma_f32_32x32x16_bf16(b1,qr[d0],p1,0,0,0);}}
}
typedef __attribute__((address_space(3))) const char* lds_cptr;
typedef short v4i16_t __attribute__((ext_vector_type(4)));
__device__ __forceinline__ void kload8(bf16x8*kf,lds_cptr kp){
  kf[0]=*(const __attribute__((address_space(3))) bf16x8*)(kp);      kf[1]=*(const __attribute__((address_space(3))) bf16x8*)(kp+512);
  kf[2]=*(const __attribute__((address_space(3))) bf16x8*)(kp+2048); kf[3]=*(const __attribute__((address_space(3))) bf16x8*)(kp+2560);
  kf[4]=*(const __attribute__((address_space(3))) bf16x8*)(kp+4096); kf[5]=*(const __attribute__((address_space(3))) bf16x8*)(kp+4608);
  kf[6]=*(const __attribute__((address_space(3))) bf16x8*)(kp+6144); kf[7]=*(const __attribute__((address_space(3))) bf16x8*)(kp+6656);
}
__device__ __forceinline__ void kload2(bf16x8*kf,lds_cptr kp,int j){ kf[2*j]=*(const __attribute__((address_space(3))) bf16x8*)(kp+j*2048); kf[2*j+1]=*(const __attribute__((address_space(3))) bf16x8*)(kp+j*2048+512); }
__device__ __forceinline__ s16x4 vtr(lds_cptr p){ return __builtin_bit_cast(s16x4,__builtin_amdgcn_ds_read_tr16_b64_v4i16((__attribute__((address_space(3))) v4i16_t*)p)); }
__device__ __forceinline__ float rowmax(const f32x16&p0,const f32x16&p1){
  float a=max3f(p0[0],p0[1],p1[0]),b=max3f(p0[2],p0[3],p1[1]);a=max3f(a,p1[2],p1[3]);
  #pragma unroll
  for(int r=4;r<16;r+=4){a=max3f(a,p0[r],p0[r+1]);b=max3f(b,p0[r+2],p0[r+3]);a=max3f(a,p1[r],p1[r+1]);b=max3f(b,p1[r+2],p1[r+3]);}
  const float m=max2f(a,b);
  auto rr=__builtin_amdgcn_permlane32_swap(__float_as_uint(m),__float_as_uint(m),false,false);
  return max2f(__uint_as_float(rr[0]),__uint_as_float(rr[1]));
}
__device__ __forceinline__ float rowmax_c(const f32x16&p0,const f32x16&p1){
  float a=__builtin_fmaxf(p0[0],p1[0]);
  #pragma unroll
  for(int r=1;r<16;++r){a=__builtin_fmaxf(a,__builtin_fmaxf(p0[r],p1[r]));}
  auto rr=__builtin_amdgcn_permlane32_swap(__float_as_uint(a),__float_as_uint(a),false,false);
  return __builtin_fmaxf(__uint_as_float(rr[0]),__uint_as_float(rr[1]));
}
__device__ __forceinline__ void pv(f32x16*o,int vb,bf16x8 pa0,bf16x8 pa1,bf16x8 pa2,bf16x8 pa3){
  #pragma unroll
  for(int d0=0;d0<2;++d0){s16x4 lo[4],hi[4];
    #pragma unroll
    for(int ks=0;ks<4;++ks){
      asm volatile("ds_read_b64_tr_b16 %0,%1 offset:%c2":"=&v"(lo[ks]):"v"(vb),"i"(d0*4096+ks*1024):"memory");
      asm volatile("ds_read_b64_tr_b16 %0,%1 offset:%c2":"=&v"(hi[ks]):"v"(vb),"i"(d0*4096+ks*1024+512):"memory");}
    asm volatile("s_waitcnt lgkmcnt(0)":::"memory");SBAR();
    #define PK(k) (bf16x8){lo[k][0],lo[k][1],lo[k][2],lo[k][3],hi[k][0],hi[k][1],hi[k][2],hi[k][3]}
    o[d0]=__builtin_amdgcn_mfma_f32_32x32x16_bf16(pa0,PK(0),o[d0],0,0,0);
    o[d0]=__builtin_amdgcn_mfma_f32_32x32x16_bf16(pa1,PK(1),o[d0],0,0,0);
    o[d0]=__builtin_amdgcn_mfma_f32_32x32x16_bf16(pa2,PK(2),o[d0],0,0,0);
    o[d0]=__builtin_amdgcn_mfma_f32_32x32x16_bf16(pa3,PK(3),o[d0],0,0,0);
    #undef PK
  }
}
__device__ __forceinline__ float bflo(unsigned u){return __uint_as_float(u<<16);}
__device__ __forceinline__ float bfhi(unsigned u){return __uint_as_float(u&0xffff0000u);}

struct MobaMerge { const float* pml; const bf16* po; long grow0; int h; int ns; };
constexpr long MROWS=2L*SEQ;

template<int THRL,int MODE> __device__ __forceinline__ void attn_unit(const bf16*Qp,const bf16*__restrict__ Kp,const bf16*__restrict__ Vp,bf16*Op,int q0,int kv0,int NT,const float*biasG,const MobaMerge&mm,char*shm){
  int tid=threadIdx.x; asm volatile("":"+v"(tid));
  const int lane=tid&63,r32=lane&31,hi=lane>>5; const int wid=__builtin_amdgcn_readfirstlane(tid>>6);
  const bf16*Qw=Qp+(long)(q0+wid*QBLK)*LDQ;
  const bf16*Kh=Kp+(long)kv0*LDQ,*Vh=Vp+(long)kv0*LDQ;
  const unsigned lds0=(unsigned)(uintptr_t)shm;
  float*wsf=(float*)(shm+LDS_WS)+wid*128;
  const lds_cptr shm3=(lds_cptr)shm;
  asm volatile("":"+s"(biasG));
  { __attribute__((address_space(3))) float* blw=(__attribute__((address_space(3))) float*)(shm3+LDS_BIAS); if(tid<128)blw[tid]=biasG[tid]; }
  const lds_cfptr bl=(lds_cfptr)(shm3+LDS_BIAS);
  const bf16*ksrc=Kh+(long)lane*LDQ+wid*8;
  const bf16*vsrc=Vh+(long)(16*(wid&3)+(lane>>2))*LDQ+(wid>>2)*32+(lane&3)*8;
  const unsigned kdst=lds0+LDS_K+wid*1024, vdst=lds0+LDS_V+wid*1024;
  #define DMA_K(t,slot) glds16(ksrc+(long)(t)*KVBLK*LDQ,(unsigned)__builtin_amdgcn_readfirstlane(kdst+(slot)))
  #define DMA_V(t,slot) glds16(vsrc+(long)(t)*KVBLK*LDQ,(unsigned)__builtin_amdgcn_readfirstlane(vdst+(slot)))
  const int vb0=(int)(lds0+LDS_V)+((lane>>4)&1)*32+(lane&3)*8+(4*hi+((lane&15)>>2))*64;
  const char*Kbase=shm+LDS_K; bf16x8 kf[8];
  const lds_cptr kp0=shm3+LDS_K+hi*1024+r32*16; const lds_cptr vp0=shm3+LDS_V+((lane>>4)&1)*32+(lane&3)*8+(4*hi+((lane&15)>>2))*64;
  asm volatile("s_waitcnt vmcnt(0)":::"memory");
  DMA_K(0,0);DMA_V(0,0);DMA_K(1,SLOTB);
  bf16x8 qr[4];
  #pragma unroll
  for(int d0=0;d0<4;++d0)qr[d0]=*reinterpret_cast<const bf16x8*>(&Qw[(long)r32*LDQ+d0*16+hi*8]);
  float mhat=0.f,l_reg=0.f;f32x16 o[2];o[0]=f32x16{};o[1]=f32x16{};f32x16 negm=f32x16{};asm volatile("":"+v"(negm));
  const int qrel=wid*QBLK+r32;
  #define CMASK(P0,P1,t) do{int jb_=(t)-(NT-4); if(jb_>=-2 && (32*wid-(64*jb_+63))<113)biasmask(P0,P1,jb_,qrel,hi,bl);}while(0)
  bool resc=false;
  #define START(P0,P1) do{ const float rm=rowmax(P0,P1); resc=false; \
    { const float dl=rm; mhat=fadd_s(mhat,dl); \
      _Pragma("unroll") for(int r=0;r<16;++r){P0[r]=fsub_s(P0[r],dl);P1[r]=fsub_s(P1[r],dl);} \
      _Pragma("unroll") for(int r=0;r<16;++r)negm[r]=-mhat; asm volatile("":"+v"(negm)); } \
    _Pragma("unroll") for(int r=0;r<16;++r)P0[r]=__builtin_amdgcn_exp2f(P0[r]); }while(0)
  #define RESC() do{ if(resc){ asm volatile("s_waitcnt lgkmcnt(0)":::"memory"); \
      _Pragma("unroll") for(int d_=0;d_<2;++d_) _Pragma("unroll") for(int r=0;r<16;++r)o[d_][r]*=wsf[crow(r,hi)]; } }while(0)
  f32x16 pA0,pA1,pB0,pB1;
  int sl_prev=0,sl_cur=0,sl_next=SLOTB;
  #define ROT() do{sl_prev=sl_cur;sl_cur=sl_next;sl_next=(sl_next==(NSLOT-1)*SLOTB)?0:sl_next+SLOTB;}while(0)
  DMA_K(2,2*SLOTB);
  WAIT_BAR(3);
  qkt(pA0,pA1,Kbase,qr,negm,r32,hi);asm volatile("s_nop 15\n\ts_nop 7":"+v"(pA0),"+v"(pA1));CMASK(pA0,pA1,0);
  START(pA0,pA1);
  _Pragma("unroll") for(int r=0;r<16;++r)pA1[r]=__builtin_amdgcn_exp2f(pA1[r]);
  WAIT_BAR(0);
  DMA_K(3,0);DMA_V(1,SLOTB);
  ROT();
  kload8(kf,kp0+sl_cur);
  WAIT_BAR(2);
  s16x4 vlo[8],vhi[8]; u32x4 pw0,pw1,pw2,pw3;
  #define PKW(P,B) cvtpk_s(P[B],P[B+1])
  #define PAF(k) __builtin_bit_cast(bf16x8,pw##k)
  #define VFR(i) (bf16x8){vlo[i][0],vlo[i][1],vlo[i][2],vlo[i][3],vhi[i][0],vhi[i][1],vhi[i][2],vhi[i][3]}
  #define PIN(x) asm volatile("":"+v"(x))
  #define MX3(a,b,c) __builtin_fmaxf(__builtin_fmaxf((a),(b)),(c))
  #define GAPA(MF,A0,A1,A2,A3,W0,W1,PW) do{ MF; sacc+=A0; sacc+=A1; sacc+=A2; sacc+=A3; PIN(sacc); W0; W1; PIN(PW); SBAR(); }while(0)
  #define EX(v) __builtin_amdgcn_exp2f(v)
  #define GAPB(MF,X,B) do{ MF; { float e0_=EX(X[B]),e1_=EX(X[B+1]),e2_=EX(X[B+2]),e3_=EX(X[B+3]); asm volatile("":"+v"(e0_),"+v"(e1_),"+v"(e2_),"+v"(e3_)); X[B]=e0_;X[B+1]=e1_;X[B+2]=e2_;X[B+3]=e3_; } SBAR(); }while(0)
  #define VRD(i) do{ vlo[i]=vtr(vp_+(((i)>>2)*4096+((i)&3)*1024)); vhi[i]=vtr(vp_+(((i)>>2)*4096+((i)&3)*1024+512)); }while(0)
  #define KRD(G,j) do{ if(G){ kload2(kf,kp0+sl_next,j); SBAR(); } }while(0)
  #define STEP(C0,C1,P0,P1,t,GK,GV,GL) do{ SBAR(); \
    const lds_cptr vp_=vp0+sl_prev; \
    VRD(0); SBAR(); float sacc=(P0[0]+P0[1]); \
    GAPA(C0=__builtin_amdgcn_mfma_f32_32x32x16_bf16(kf[0],qr[0],negm,0,0,0), P0[2],P0[3],P0[4],P0[5],     pw0[0]=PKW(P0,0), pw0[1]=PKW(P0,2), pw0); \
    VRD(4); SBAR(); GAPA(C1=__builtin_amdgcn_mfma_f32_32x32x16_bf16(kf[1],qr[0],negm,0,0,0), P0[6],P0[7],P0[8],P0[9],     pw0[2]=PKW(P0,4), pw0[3]=PKW(P0,6), pw0); \
    VRD(1); SBAR(); GAPA(C0=__builtin_amdgcn_mfma_f32_32x32x16_bf16(kf[2],qr[1],C0,0,0,0),   P0[10],P0[11],P0[12],P0[13], pw1[0]=PKW(P0,8), pw1[1]=PKW(P0,10), pw1); \
    VRD(5); SBAR(); GAPA(C1=__builtin_amdgcn_mfma_f32_32x32x16_bf16(kf[3],qr[1],C1,0,0,0),   P0[14],P0[15],P1[0],P1[1],   pw1[2]=PKW(P0,12),pw1[3]=PKW(P0,14), pw1); \
    VRD(2); SBAR(); GAPA(C0=__builtin_amdgcn_mfma_f32_32x32x16_bf16(kf[4],qr[2],C0,0,0,0),   P1[2],P1[3],P1[4],P1[5],     pw2[0]=PKW(P1,0), pw2[1]=PKW(P1,2), pw2); \
    VRD(6); SBAR(); GAPA(C1=__builtin_amdgcn_mfma_f32_32x32x16_bf16(kf[5],qr[2],C1,0,0,0),   P1[6],P1[7],P1[8],P1[9],     pw2[2]=PKW(P1,4), pw2[3]=PKW(P1,6), pw2); \
    VRD(3); SBAR(); GAPA(C0=__builtin_amdgcn_mfma_f32_32x32x16_bf16(kf[6],qr[3],C0,0,0,0),   P1[10],P1[11],P1[12],P1[13], pw3[0]=PKW(P1,8), pw3[1]=PKW(P1,10), pw3); \
    VRD(7); SBAR(); GAPA(C1=__builtin_amdgcn_mfma_f32_32x32x16_bf16(kf[7],qr[3],C1,0,0,0),   P1[14],P1[15],0.f,0.f,       pw3[2]=PKW(P1,12),pw3[3]=PKW(P1,14), pw3); \
    l_reg+=sacc; \
    if(GK){DMA_K((t)+3,sl_cur);} if(GV){DMA_V((t)+1,sl_next);} \
    CMASK(C0,C1,t); \
    { float a=MX3(C0[0],C0[1],C1[0]),b=MX3(C0[2],C0[3],C1[1]); a=MX3(a,C1[2],C1[3]); \
      _Pragma("unroll") for(int r=4;r<16;r+=4){a=MX3(a,C0[r],C0[r+1]);b=MX3(b,C0[r+2],C0[r+3]);a=MX3(a,C1[r],C1[r+1]);b=MX3(b,C1[r+2],C1[r+3]);} \
      float rm=__builtin_fmaxf(a,b); { auto rr=__builtin_amdgcn_permlane32_swap(__float_as_uint(rm),__float_as_uint(rm),false,false); rm=__builtin_fmaxf(__uint_as_float(rr[0]),__uint_as_float(rr[1])); } \
      resc=false; \
      if(__builtin_expect(__any(rm>(float)THRL),0)){ const float dl=__builtin_fmaxf(rm,0.f); mhat+=dl; \
        _Pragma("unroll") for(int r=0;r<16;++r){C0[r]-=dl;C1[r]-=dl;} \
        _Pragma("unroll") for(int r=0;r<16;++r)negm[r]=-mhat; asm volatile("":"+v"(negm)); \
        const float f=__builtin_amdgcn_exp2f(-dl); l_reg*=f; if(hi==0)wsf[r32]=f; resc=true; } } \
    SBAR(); \
    GAPB(o[0]=__builtin_amdgcn_mfma_f32_32x32x16_bf16(PAF(0),VFR(0),o[0],0,0,0), C0,0); \
    GAPB(o[1]=__builtin_amdgcn_mfma_f32_32x32x16_bf16(PAF(0),VFR(4),o[1],0,0,0), C0,4); \
    KRD(GL,0); GAPB(o[0]=__builtin_amdgcn_mfma_f32_32x32x16_bf16(PAF(1),VFR(1),o[0],0,0,0), C0,8); \
    KRD(GL,1); GAPB(o[1]=__builtin_amdgcn_mfma_f32_32x32x16_bf16(PAF(1),VFR(5),o[1],0,0,0), C0,12); \
    KRD(GL,2); GAPB(o[0]=__builtin_amdgcn_mfma_f32_32x32x16_bf16(PAF(2),VFR(2),o[0],0,0,0), C1,0); \
    KRD(GL,3); GAPB(o[1]=__builtin_amdgcn_mfma_f32_32x32x16_bf16(PAF(2),VFR(6),o[1],0,0,0), C1,4); \
    GAPB(o[0]=__builtin_amdgcn_mfma_f32_32x32x16_bf16(PAF(3),VFR(3),o[0],0,0,0), C1,8); \
    GAPB(o[1]=__builtin_amdgcn_mfma_f32_32x32x16_bf16(PAF(3),VFR(7),o[1],0,0,0), C1,12); \
    }while(0)
  int t=1;
  #undef CMASK
  #define CMASK(P0,P1,t) do{}while(0)
  for(;t+7<NT;t+=2){
    STEP(pB0,pB1,pA0,pA1,t,true,true,true);     WAIT_BAR(2); RESC(); ROT();
    STEP(pA0,pA1,pB0,pB1,t+1,true,true,true);   WAIT_BAR(2); RESC(); ROT();
  }
  #undef CMASK
  #define CMASK(P0,P1,t) do{int jb_=(t)-(NT-4); if(jb_>=-2 && (32*wid-(64*jb_+63))<113)biasmask(P0,P1,jb_,qrel,hi,bl);}while(0)
  #define ENDW(tt) do{ if((tt)+3<NT){WAIT_BAR(2);} else if((tt)+2<NT){WAIT_BAR(1);} else {WAIT_BAR(0);} }while(0)
  for(;t+1<NT;t+=2){
    STEP(pB0,pB1,pA0,pA1,t,(t+3<NT),(t+1<NT),(t+1<NT));       ENDW(t);   RESC(); ROT();
    STEP(pA0,pA1,pB0,pB1,t+1,(t+4<NT),(t+2<NT),(t+2<NT));     ENDW(t+1); RESC(); ROT();
  }
  STEP(pB0,pB1,pA0,pA1,NT-1,false,false,false); RESC();
  { float sacc=pB0[0]+pB0[1]; _Pragma("unroll") for(int r=2;r<16;++r)sacc+=pB0[r]; _Pragma("unroll") for(int r=0;r<16;++r)sacc+=pB1[r]; l_reg+=sacc;
    pw0=(u32x4){PKW(pB0,0),PKW(pB0,2),PKW(pB0,4),PKW(pB0,6)};pw1=(u32x4){PKW(pB0,8),PKW(pB0,10),PKW(pB0,12),PKW(pB0,14)};pw2=(u32x4){PKW(pB1,0),PKW(pB1,2),PKW(pB1,4),PKW(pB1,6)};pw3=(u32x4){PKW(pB1,8),PKW(pB1,10),PKW(pB1,12),PKW(pB1,14)};
    SBAR(); pv(o,vb0+sl_cur,PAF(0),PAF(1),PAF(2),PAF(3)); }
  #undef PKW
  #undef PAF
  #undef VFR
  #undef PIN
  #undef MX3
  #undef GAPA
  #undef GAPB
  #undef EX
  #undef VRD
  #undef KRD
  #undef STEP
  #undef ENDW
  {auto rr=__builtin_amdgcn_permlane32_swap(__float_as_uint(l_reg),__float_as_uint(l_reg),false,false);l_reg=__uint_as_float(rr[0])+__uint_as_float(rr[1]);}
  const float*pml_=mm.pml; const bf16*po_=mm.po; if constexpr(MODE==1){ asm volatile("":"+s"(pml_),"+s"(po_)); }
  if constexpr(MODE==1){
    const long gr=mm.grow0+wid*QBLK+r32; float ms[3],ls[3],as[3]; float Mx=mhat;
    #pragma unroll
    for(int s=0;s<3;++s){ ms[s]=-INFINITY; ls[s]=0.f; if(s<mm.ns){ const f32x2_t v=*(const f32x2_t*)(pml_+((long)s*MROWS+gr)*16+mm.h*2); ms[s]=v.x; ls[s]=v.y; Mx=__builtin_fmaxf(Mx,ms[s]); } }
    const float a0=__builtin_amdgcn_exp2f(mhat-Mx); float L=a0*l_reg;
    #pragma unroll
    for(int s=0;s<3;++s){ as[s]=(s<mm.ns)?__builtin_amdgcn_exp2f(ms[s]-Mx):0.f; L+=as[s]*ls[s]; }
    const float inv=1.0f/L;
    if(hi==0){wsf[32+r32]=a0*inv;wsf[64+r32]=as[0]*inv;wsf[96+r32]=as[1]*inv;wsf[r32]=as[2]*inv;}
  } else {
    if(hi==0)wsf[32+r32]=1.0f/l_reg;
  }
  asm volatile("s_waitcnt lgkmcnt(0)":::"memory");
  float rli[16];
  #pragma unroll
  for(int r=0;r<16;++r)rli[r]=wsf[32+crow(r,hi)];
  { asm volatile("":"+s"(Op)); }
  bf16*Ow=Op+(long)(q0+wid*QBLK)*LDO;
  { bf16*stg=(bf16*)(shm+LDS_OST)+wid*2048;
    #pragma unroll
    for(int r=0;r<16;++r){const int orow=crow(r,hi);
      #pragma unroll
      for(int d0=0;d0<2;++d0)stg[orow*64+d0*32+r32]=__float2bfloat16(o[d0][r]*rli[r]);}
    asm volatile("s_waitcnt lgkmcnt(0)":::"memory");
    int lane_e=lane; asm volatile("":"+v"(lane_e));
    #pragma unroll
    for(int i=0;i<4;++i){const int row=i*8+(lane_e>>3),ch=lane_e&7; u32x4 v=*(const u32x4*)(stg+row*64+ch*8);
      if constexpr(MODE==1){
        float a[8]={bflo(v.x),bfhi(v.x),bflo(v.y),bfhi(v.y),bflo(v.z),bfhi(v.z),bflo(v.w),bfhi(v.w)};
        #pragma unroll
        for(int s=0;s<3;++s){ if(s<mm.ns){ const float c=wsf[(s==0?64:(s==1?96:0))+row];
            const u32x4 pp=*(const u32x4*)(po_+(((long)s*MROWS+mm.grow0+wid*QBLK+row)*8+mm.h)*64+ch*8);
            a[0]+=c*bflo(pp.x);a[1]+=c*bfhi(pp.x);a[2]+=c*bflo(pp.y);a[3]+=c*bfhi(pp.y);a[4]+=c*bflo(pp.z);a[5]+=c*bfhi(pp.z);a[6]+=c*bflo(pp.w);a[7]+=c*bfhi(pp.w);} }
        v.x=cvtpk_s(a[0],a[1]);v.y=cvtpk_s(a[2],a[3]);v.z=cvtpk_s(a[4],a[5]);v.w=cvtpk_s(a[6],a[7]);
      }
      *(u32x4*)(Ow+(long)row*LDO+ch*8)=v;} }
  asm volatile("s_waitcnt lgkmcnt(0)\n\ts_barrier":::"memory");
  #undef DMA_K
  #undef DMA_V
  #undef CMASK
  #undef START
  #undef RESC
  #undef ROT
}


constexpr int VSLOTB=16384;
constexpr int W_LDS_K=0, W_LDS_V=NSLOT*SLOTB, W_LDS_WS=W_LDS_V+NSLOT*VSLOTB, W_LDS_OST=W_LDS_WS+NW*128*4, W_LDS_BIAS=W_LDS_OST+NW*4096, W_LDS_BYTES=W_LDS_BIAS+512;
__device__ __forceinline__ void pv128(f32x16*o,int vb,bf16x8 pa0,bf16x8 pa1,bf16x8 pa2,bf16x8 pa3){
  #pragma unroll
  for(int d0=0;d0<4;++d0){s16x4 lo[4],hi[4];
    #pragma unroll
    for(int ks=0;ks<4;++ks){
      asm volatile("ds_read_b64_tr_b16 %0,%1 offset:%c2":"=&v"(lo[ks]):"v"(vb),"i"(d0*4096+ks*1024):"memory");
      asm volatile("ds_read_b64_tr_b16 %0,%1 offset:%c2":"=&v"(hi[ks]):"v"(vb),"i"(d0*4096+ks*1024+512):"memory");}
    asm volatile("s_waitcnt lgkmcnt(0)":::"memory");SBAR();
    #define PK(k) (bf16x8){lo[k][0],lo[k][1],lo[k][2],lo[k][3],hi[k][0],hi[k][1],hi[k][2],hi[k][3]}
    o[d0]=__builtin_amdgcn_mfma_f32_32x32x16_bf16(pa0,PK(0),o[d0],0,0,0);
    o[d0]=__builtin_amdgcn_mfma_f32_32x32x16_bf16(pa1,PK(1),o[d0],0,0,0);
    o[d0]=__builtin_amdgcn_mfma_f32_32x32x16_bf16(pa2,PK(2),o[d0],0,0,0);
    o[d0]=__builtin_amdgcn_mfma_f32_32x32x16_bf16(pa3,PK(3),o[d0],0,0,0);
    #undef PK
  }
}
template<int THRL> __device__ __forceinline__ void attn_unit128(const bf16*Qp,const bf16*__restrict__ Kp,const bf16*__restrict__ Vp,bf16*Op,int q0,int NT,const float*biasG,char*shm){
  int tid=threadIdx.x; asm volatile("":"+v"(tid));
  const int lane=tid&63,r32=lane&31,hi=lane>>5; const int wid=__builtin_amdgcn_readfirstlane(tid>>6);
  const bf16*Qw=Qp+(long)(q0+wid*QBLK)*LDQ;
  const bf16*Kh=Kp,*Vh=Vp;
  const unsigned lds0=(unsigned)(uintptr_t)shm;
  float*wsf=(float*)(shm+W_LDS_WS)+wid*128;
  const lds_cptr shm3=(lds_cptr)shm;
  asm volatile("":"+s"(biasG));
  { __attribute__((address_space(3))) float* blw=(__attribute__((address_space(3))) float*)(shm3+W_LDS_BIAS); if(tid<128)blw[tid]=biasG[tid]; }
  const lds_cfptr bl=(lds_cfptr)(shm3+W_LDS_BIAS);
  const bf16*ksrc=Kh+(long)lane*LDQ+wid*8;
  const bf16*vsrc=Vh+(long)(16*(wid&3)+(lane>>2))*LDQ+(wid>>2)*32+(lane&3)*8;
  const unsigned kdst=lds0+W_LDS_K+wid*1024, vdst=lds0+W_LDS_V+wid*1024;
  #define DMA_K(t,slot) glds16(ksrc+(long)(t)*KVBLK*LDQ,(unsigned)__builtin_amdgcn_readfirstlane(kdst+(slot)))
  #define DMA_V(t,slot) do{ glds16(vsrc+(long)(t)*KVBLK*LDQ,(unsigned)__builtin_amdgcn_readfirstlane(vdst+2*(slot))); glds16(vsrc+(long)(t)*KVBLK*LDQ+64,(unsigned)__builtin_amdgcn_readfirstlane(vdst+2*(slot)+8192)); }while(0)
  const int vb0=(int)(lds0+W_LDS_V)+((lane>>4)&1)*32+(lane&3)*8+(4*hi+((lane&15)>>2))*64;
  const char*Kbase=shm+W_LDS_K; bf16x8 kf[8];
  const lds_cptr kp0=shm3+W_LDS_K+hi*1024+r32*16; const lds_cptr vp0=shm3+W_LDS_V+((lane>>4)&1)*32+(lane&3)*8+(4*hi+((lane&15)>>2))*64;
  asm volatile("s_waitcnt vmcnt(0)":::"memory");
  DMA_K(0,0);DMA_V(0,0);DMA_K(1,SLOTB);
  bf16x8 qr[4];
  #pragma unroll
  for(int d0=0;d0<4;++d0)qr[d0]=*reinterpret_cast<const bf16x8*>(&Qw[(long)r32*LDQ+d0*16+hi*8]);
  float mhat=0.f,l_reg=0.f;f32x16 o[4];o[0]=f32x16{};o[1]=f32x16{};o[2]=f32x16{};o[3]=f32x16{};f32x16 negm=f32x16{};asm volatile("":"+v"(negm));
  const int qrel=wid*QBLK+r32;
  #define CMASK(P0,P1,t) do{int jb_=(t)-(NT-4); if(jb_>=-2 && (32*wid-(64*jb_+63))<113)biasmask(P0,P1,jb_,qrel,hi,bl);}while(0)
  bool resc=false;
  #define RESC() do{ if(resc){ asm volatile("s_waitcnt lgkmcnt(0)":::"memory"); \
      _Pragma("unroll") for(int d_=0;d_<4;++d_) _Pragma("unroll") for(int r=0;r<16;++r)o[d_][r]*=wsf[crow(r,hi)]; } }while(0)
  f32x16 C0,C1; u32x4 pw0,pw1,pw2,pw3;
  int sl_prev=0,sl_cur=0,sl_next=SLOTB;
  #define ROT() do{sl_prev=sl_cur;sl_cur=sl_next;sl_next=(sl_next==(NSLOT-1)*SLOTB)?0:sl_next+SLOTB;}while(0)
  #define PKW(P,B) cvtpk_s(P[B],P[B+1])
  DMA_K(2,2*SLOTB);
  WAIT_BAR(3);
  qkt(C0,C1,Kbase,qr,negm,r32,hi);asm volatile("s_nop 15\n\ts_nop 7":"+v"(C0),"+v"(C1));CMASK(C0,C1,0);
  { const float rm=rowmax(C0,C1); mhat=rm;
    _Pragma("unroll") for(int r=0;r<16;++r)negm[r]=-mhat; asm volatile("":"+v"(negm));
    _Pragma("unroll") for(int r=0;r<16;++r){C0[r]=__builtin_amdgcn_exp2f(C0[r]-mhat);C1[r]=__builtin_amdgcn_exp2f(C1[r]-mhat);}
    float sacc=0.f; _Pragma("unroll") for(int r=0;r<16;++r)sacc+=C0[r]+C1[r]; l_reg+=sacc;
    pw0=(u32x4){PKW(C0,0),PKW(C0,2),PKW(C0,4),PKW(C0,6)};pw1=(u32x4){PKW(C0,8),PKW(C0,10),PKW(C0,12),PKW(C0,14)};pw2=(u32x4){PKW(C1,0),PKW(C1,2),PKW(C1,4),PKW(C1,6)};pw3=(u32x4){PKW(C1,8),PKW(C1,10),PKW(C1,12),PKW(C1,14)}; }
  const __attribute__((address_space(3))) char* qlds=(const __attribute__((address_space(3))) char*)(shm3+W_LDS_OST+wid*4096+lane*16);
  { __attribute__((address_space(3))) char* qw=(__attribute__((address_space(3))) char*)(shm3+W_LDS_OST+wid*4096+lane*16);
    #pragma unroll
    for(int d0=0;d0<4;++d0)*(__attribute__((address_space(3))) bf16x8*)(qw+d0*1024)=qr[d0]; }
  WAIT_BAR(0);
  DMA_K(3,0);DMA_V(1,SLOTB);
  ROT();
  kload8(kf,kp0+sl_cur);
  WAIT_BAR(3);
  s16x4 vlo[8],vhi[8];
  #define PAF(k) __builtin_bit_cast(bf16x8,pw##k)
  #define VFR(i) (bf16x8){vlo[i][0],vlo[i][1],vlo[i][2],vlo[i][3],vhi[i][0],vhi[i][1],vhi[i][2],vhi[i][3]}
  #define PIN(x) asm volatile("":"+v"(x))
  #define MX3(a,b,c) __builtin_fmaxf(__builtin_fmaxf((a),(b)),(c))
  #define EX(v) __builtin_amdgcn_exp2f(v)
  #define GA(MF) do{ MF; SBAR(); }while(0)
  #define EX2(X,B) do{ float e0_=EX(X[B]), e1_=EX(X[B+1]); asm volatile("":"+v"(e0_),"+v"(e1_)); X[B]=e0_; X[B+1]=e1_; }while(0)
  #define GB0(MF,X,B) do{ MF; EX2(X,B); SBAR(); }while(0)
  #define GB1(MF,X,B,PWD,Y,YB) do{ MF; EX2(X,B); sacc+=Y[YB]; sacc+=Y[YB+1]; PIN(sacc); { unsigned pk_=PKW(Y,YB); PIN(pk_); PWD=pk_; } SBAR(); }while(0)
  #define VRS(s,i) do{ vlo[s]=vtr(vp_+(((i)>>2)*4096+((i)&3)*1024)); vhi[s]=vtr(vp_+(((i)>>2)*4096+((i)&3)*1024+512)); SBAR(); }while(0)
  #define KRD(G,j) do{ if(G){ kload2(kf,kp0+sl_next,j); SBAR(); } }while(0)
  #define MF(a,b,c) __builtin_amdgcn_mfma_f32_32x32x16_bf16(a,b,c,0,0,0)
  #define QL(d) (*(const __attribute__((address_space(3))) bf16x8*)(qlds+(d)*1024))
  #define STEP(t,GK,GV,GL) do{ SBAR(); \
    const lds_cptr vp_=vp0+2*sl_prev; \
    bf16x8 qa_=QL(0),qb_=QL(1); SBAR(); \
    VRS(0,0);  GA(C0=MF(kf[0],qa_,negm)); \
    VRS(1,4);  GA(C1=MF(kf[1],qa_,negm)); qa_=QL(2); SBAR(); \
    VRS(2,8);  GA(C0=MF(kf[2],qb_,C0)); \
    VRS(3,12); GA(C1=MF(kf[3],qb_,C1)); qb_=QL(3); SBAR(); \
    VRS(4,1);  GA(C0=MF(kf[4],qa_,C0)); \
    VRS(5,5);  GA(C1=MF(kf[5],qa_,C1)); \
    VRS(6,9);  GA(C0=MF(kf[6],qb_,C0)); \
    VRS(7,13); GA(C1=MF(kf[7],qb_,C1)); \
    if(GK){DMA_K((t)+3,sl_cur);} if(GV){DMA_V((t)+1,sl_next);} \
    CMASK(C0,C1,t); \
    { float a=MX3(C0[0],C0[1],C1[0]),b=MX3(C0[2],C0[3],C1[1]); a=MX3(a,C1[2],C1[3]); \
      _Pragma("unroll") for(int r=4;r<16;r+=4){a=MX3(a,C0[r],C0[r+1]);b=MX3(b,C0[r+2],C0[r+3]);a=MX3(a,C1[r],C1[r+1]);b=MX3(b,C1[r+2],C1[r+3]);} \
      float rm=__builtin_fmaxf(a,b); { auto rr=__builtin_amdgcn_permlane32_swap(__float_as_uint(rm),__float_as_uint(rm),false,false); rm=__builtin_fmaxf(__uint_as_float(rr[0]),__uint_as_float(rr[1])); } \
      resc=false; \
      if(__builtin_expect(__any(rm>(float)THRL),0)){ const float dl=__builtin_fmaxf(rm,0.f); mhat+=dl; \
        _Pragma("unroll") for(int r=0;r<16;++r){C0[r]-=dl;C1[r]-=dl;} \
        _Pragma("unroll") for(int r=0;r<16;++r)negm[r]=-mhat; asm volatile("":"+v"(negm)); \
        const float f=__builtin_amdgcn_exp2f(-dl); l_reg*=f; if(hi==0)wsf[r32]=f; resc=true; } } \
    SBAR(); float sacc=0.f; \
    GB0(o[0]=MF(PAF(0),VFR(0),o[0]), C0,0); \
    GB0(o[1]=MF(PAF(0),VFR(1),o[1]), C0,2); \
    GB0(o[2]=MF(PAF(0),VFR(2),o[2]), C0,4); \
    GB0(o[3]=MF(PAF(0),VFR(3),o[3]), C0,6); \
    VRS(0,2);  GB1(o[0]=MF(PAF(1),VFR(4),o[0]), C0,8,  pw0[0],C0,0); \
    VRS(1,6);  GB1(o[1]=MF(PAF(1),VFR(5),o[1]), C0,10, pw0[1],C0,2); \
    VRS(2,10); GB1(o[2]=MF(PAF(1),VFR(6),o[2]), C0,12, pw0[2],C0,4); \
    VRS(3,14); GB1(o[3]=MF(PAF(1),VFR(7),o[3]), C0,14, pw0[3],C0,6); \
    VRS(4,3);  KRD(GL,0); GB1(o[0]=MF(PAF(2),VFR(0),o[0]), C1,0, pw1[0],C0,8); \
    VRS(5,7);  KRD(GL,1); GB1(o[1]=MF(PAF(2),VFR(1),o[1]), C1,2, pw1[1],C0,10); \
    VRS(6,11); GB1(o[2]=MF(PAF(2),VFR(2),o[2]), C1,4, pw1[2],C0,12); \
    VRS(7,15); GB1(o[3]=MF(PAF(2),VFR(3),o[3]), C1,6, pw1[3],C0,14); \
    KRD(GL,2); GB1(o[0]=MF(PAF(3),VFR(4),o[0]), C1,8,  pw2[0],C1,0); \
    KRD(GL,3); GB1(o[1]=MF(PAF(3),VFR(5),o[1]), C1,10, pw2[1],C1,2); \
    GB1(o[2]=MF(PAF(3),VFR(6),o[2]), C1,12, pw2[2],C1,4); \
    GB1(o[3]=MF(PAF(3),VFR(7),o[3]), C1,14, pw2[3],C1,6); \
    sacc+=C1[8];sacc+=C1[9];pw3[0]=PKW(C1,8); sacc+=C1[10];sacc+=C1[11];pw3[1]=PKW(C1,10); sacc+=C1[12];sacc+=C1[13];pw3[2]=PKW(C1,12); sacc+=C1[14];sacc+=C1[15];pw3[3]=PKW(C1,14); \
    l_reg+=sacc; \
    }while(0)
  int t=1;
  #undef CMASK
  #define CMASK(P0,P1,t) do{}while(0)
  for(;t+7<NT;t+=2){
    STEP(t,true,true,true);     WAIT_BAR(3); RESC(); ROT();
    STEP(t+1,true,true,true);   WAIT_BAR(3); RESC(); ROT();
  }
  #undef CMASK
  #define CMASK(P0,P1,t) do{int jb_=(t)-(NT-4); if(jb_>=-2 && (32*wid-(64*jb_+63))<113)biasmask(P0,P1,jb_,qrel,hi,bl);}while(0)
  #define ENDW(tt) do{ if((tt)+3<NT){WAIT_BAR(3);} else if((tt)+2<NT){WAIT_BAR(2);} else {WAIT_BAR(0);} }while(0)
  for(;t+1<NT;t+=2){
    STEP(t,(t+3<NT),(t+1<NT),(t+1<NT));       ENDW(t);   RESC(); ROT();
    STEP(t+1,(t+4<NT),(t+2<NT),(t+2<NT));     ENDW(t+1); RESC(); ROT();
  }
  STEP(NT-1,false,false,false); RESC();
  SBAR(); pv128(o,vb0+2*sl_cur,PAF(0),PAF(1),PAF(2),PAF(3));
  #undef PKW
  #undef PAF
  #undef VFR
  #undef PIN
  #undef MX3
  #undef EX
  #undef EX2
  #undef GA
  #undef GB0
  #undef GB1
  #undef VRS
  #undef KRD
  #undef MF
  #undef QL
  #undef STEP
  #undef ENDW
  {auto rr=__builtin_amdgcn_permlane32_swap(__float_as_uint(l_reg),__float_as_uint(l_reg),false,false);l_reg=__uint_as_float(rr[0])+__uint_as_float(rr[1]);}
  if(hi==0)wsf[32+r32]=1.0f/l_reg;
  asm volatile("s_waitcnt lgkmcnt(0)":::"memory");
  float rli[16];
  #pragma unroll
  for(int r=0;r<16;++r)rli[r]=wsf[32+crow(r,hi)];
  { asm volatile("":"+s"(Op)); }
  bf16*Ow=Op+(long)(q0+wid*QBLK)*LDO;
  { bf16*stg=(bf16*)(shm+W_LDS_OST)+wid*2048;
    int lane_e=lane; asm volatile("":"+v"(lane_e));
    #pragma unroll
    for(int ph=0;ph<2;++ph){
      #pragma unroll
      for(int r=0;r<16;++r){const int orow=crow(r,hi);
        #pragma unroll
        for(int d0=0;d0<2;++d0)stg[orow*64+d0*32+r32]=__float2bfloat16(o[2*ph+d0][r]*rli[r]);}
      asm volatile("s_waitcnt lgkmcnt(0)":::"memory");
      #pragma unroll
      for(int i=0;i<4;++i){const int row=i*8+(lane_e>>3),ch=lane_e&7; const u32x4 v=*(const u32x4*)(stg+row*64+ch*8); *(u32x4*)(Ow+(long)row*LDO+ph*64+ch*8)=v;}
      asm volatile("s_waitcnt lgkmcnt(0)":::"memory"); } }
  asm volatile("s_waitcnt lgkmcnt(0)\n\ts_barrier":::"memory");
  #undef DMA_K
  #undef DMA_V
  #undef CMASK
  #undef RESC
  #undef ROT
}

constexpr int LDS_GK=0, LDS_GV=4*SLOTB, LDS_GWS=8*SLOTB, LDS_GOST=LDS_GWS+NW*128*4, LDS_GBIAS=LDS_GOST+NW*4096, LDS_GBYTES=LDS_GBIAS+512;
__device__ __forceinline__ void moba_gather_unit(const bf16*QKVb  ,int h,int j,const unsigned*ent,int n,long growb  ,const float*biasG,float*pml,bf16*po,char*shm){
  int tid=threadIdx.x; asm volatile("":"+v"(tid));
  const int lane=tid&63,r32=lane&31,hi=lane>>5; const int wid=__builtin_amdgcn_readfirstlane(tid>>6);
  const unsigned lds0=(unsigned)(uintptr_t)shm; const lds_cptr shm3=(lds_cptr)shm;
  float*wsf=(float*)(shm+LDS_GWS)+wid*128;
  { __attribute__((address_space(3))) float* blw=(__attribute__((address_space(3))) float*)(shm3+LDS_GBIAS); if(tid<128)blw[tid]=biasG[tid]; }
  const lds_cfptr bl=(lds_cfptr)(shm3+LDS_GBIAS);
  const int ei=wid*QBLK+r32; const unsigned e=ent[ei<n?ei:n-1];
  const int qloc=(int)(e&0x3FFFu), slot=(int)(e>>14);
  const bf16*Qrow=QKVb+(long)qloc*LDQ+1536+h*64;
  bf16x8 qr[4];
  #pragma unroll
  for(int d0=0;d0<4;++d0)qr[d0]=*reinterpret_cast<const bf16x8*>(Qrow+d0*16+hi*8);
  const bf16*Kh=QKVb+(long)(j*256)*LDQ+2048+h*64,*Vh=QKVb+(long)(j*256)*LDQ+2560+h*64;
  const bf16*ksrc=Kh+(long)lane*LDQ+wid*8;
  const bf16*vsrc=Vh+(long)(16*(wid&3)+(lane>>2))*LDQ+(wid>>2)*32+(lane&3)*8;
  #pragma unroll
  for(int t=0;t<4;++t){ glds16(ksrc+(long)t*KVBLK*LDQ,(unsigned)__builtin_amdgcn_readfirstlane(lds0+LDS_GK+t*SLOTB+wid*1024)); glds16(vsrc+(long)t*KVBLK*LDQ,(unsigned)__builtin_amdgcn_readfirstlane(lds0+LDS_GV+t*SLOTB+wid*1024)); }
  asm volatile("s_waitcnt vmcnt(0) lgkmcnt(0)\n\ts_barrier":::"memory");
  const int vb0=(int)(lds0+LDS_GV)+((lane>>4)&1)*32+(lane&3)*8+(4*hi+((lane&15)>>2))*64;
  float mhat=0.f,l_reg=0.f; f32x16 o[2]; o[0]=f32x16{}; o[1]=f32x16{}; f32x16 negm=f32x16{};
  const bool nearq=__any(qloc-(j*256+128)<128+113);
  #pragma unroll
  for(int t=0;t<4;++t){
    f32x16 p0,p1; qkt(p0,p1,shm+LDS_GK+t*SLOTB,qr,negm,r32,hi);
    if(t>=2 && nearq){ const int kb=j*256+t*64+4*hi;
      #pragma unroll
      for(int r=0;r<16;++r){ const int kv=kb+(r&3)+8*(r>>2); const int d0=qloc-kv,d1=d0-32; const int i0=d0>127?127:(d0<0?0:d0), i1=d1>127?127:(d1<0?0:d1); p0[r]+=bl[i0]; p1[r]+=bl[i1]; } }
    const float rm=rowmax_c(p0,p1);
    const float dl=(t==0)?rm:__builtin_fmaxf(rm,0.f);
    mhat+=dl;
    #pragma unroll
    for(int r=0;r<16;++r){p0[r]-=dl;p1[r]-=dl;}
    #pragma unroll
    for(int r=0;r<16;++r)negm[r]=-mhat;
    if(t>0){ const float f=__builtin_amdgcn_exp2f(-dl); l_reg*=f; if(hi==0)wsf[r32]=f; asm volatile("s_waitcnt lgkmcnt(0)":::"memory");
      #pragma unroll
      for(int d_=0;d_<2;++d_)
        #pragma unroll
        for(int r=0;r<16;++r)o[d_][r]*=wsf[crow(r,hi)]; }
    float sacc=0.f;
    #pragma unroll
    for(int r=0;r<16;++r){p0[r]=__builtin_amdgcn_exp2f(p0[r]);p1[r]=__builtin_amdgcn_exp2f(p1[r]);sacc+=p0[r]+p1[r];}
    l_reg+=sacc;
    u32x4 pw0,pw1,pw2,pw3;
    pw0=(u32x4){cvtpk_s(p0[0],p0[1]),cvtpk_s(p0[2],p0[3]),cvtpk_s(p0[4],p0[5]),cvtpk_s(p0[6],p0[7])};
    pw1=(u32x4){cvtpk_s(p0[8],p0[9]),cvtpk_s(p0[10],p0[11]),cvtpk_s(p0[12],p0[13]),cvtpk_s(p0[14],p0[15])};
    pw2=(u32x4){cvtpk_s(p1[0],p1[1]),cvtpk_s(p1[2],p1[3]),cvtpk_s(p1[4],p1[5]),cvtpk_s(p1[6],p1[7])};
    pw3=(u32x4){cvtpk_s(p1[8],p1[9]),cvtpk_s(p1[10],p1[11]),cvtpk_s(p1[12],p1[13]),cvtpk_s(p1[14],p1[15])};
    pv(o,vb0+t*SLOTB,__builtin_bit_cast(bf16x8,pw0),__builtin_bit_cast(bf16x8,pw1),__builtin_bit_cast(bf16x8,pw2),__builtin_bit_cast(bf16x8,pw3));
  }
  {auto rr=__builtin_amdgcn_permlane32_swap(__float_as_uint(l_reg),__float_as_uint(l_reg),false,false);l_reg=__uint_as_float(rr[0])+__uint_as_float(rr[1]);}
  if(hi==0 && ei<n){ f32x2_t v={mhat,l_reg}; *(f32x2_t*)(pml+((long)slot*MROWS+growb+qloc)*16+h*2)=v; }
  { bf16*stg=(bf16*)(shm+LDS_GOST)+wid*2048;
    #pragma unroll
    for(int r=0;r<16;++r){const int orow=crow(r,hi);
      #pragma unroll
      for(int d0=0;d0<2;++d0)stg[orow*64+d0*32+r32]=__float2bfloat16(o[d0][r]);}
    asm volatile("s_waitcnt lgkmcnt(0)":::"memory");
    #pragma unroll
    for(int i=0;i<4;++i){const int row=i*8+(lane>>3),ch=lane&7; const u32x4 v=*(const u32x4*)(stg+row*64+ch*8);
      const unsigned er=(unsigned)__shfl((int)e,row); const int ql=(int)(er&0x3FFFu), sl=(int)(er>>14);
      if(wid*QBLK+row<n) *(u32x4*)(po+(((long)sl*MROWS+growb+ql)*8+h)*64+ch*8)=v; } }
  asm volatile("s_waitcnt lgkmcnt(0)\n\ts_barrier":::"memory");
}
#undef SBAR
#undef WAIT_BAR
}

constexpr int NWAVES = 8;
#ifndef MK_N_LAUNCHES
#define MK_N_LAUNCHES 1
#endif
constexpr int N_PHASES = 13;
constexpr int N_LAUNCHES = MK_N_LAUNCHES;

constexpr int BATCH = 2, T = 16384, D = 1024, M = BATCH * T;
constexpr int NPROJ = 3072;
constexpr int NEXP = 32, EFF = 512;
constexpr float EPS = 1e-6f, LOG2E = 1.4426950408889634f;
constexpr float LAMBDA_INIT = 0.2f;
constexpr int MOBA_CAP = 256 * 2016;

constexpr size_t MiB = 1u << 20;
constexpr size_t WS_CTL = 0, CTL_ZERO_BYTES = 1 * MiB;
constexpr size_t WS_MOD = 1 * MiB;
constexpr size_t WS_BIASG = 1 * MiB + 64 * 1024;
constexpr size_t WS_KMEAN = 1 * MiB + 256 * 1024;
constexpr size_t WS_TOKW = 2 * MiB;
constexpr size_t WS_ELIST = 3 * MiB;
constexpr size_t WS_WIN = 8 * MiB, WS_WOUT = 14 * MiB;
constexpr size_t WS_XN = 16 * MiB;
constexpr size_t WS_QKV = 80 * MiB;
constexpr size_t WS_OD = 272 * MiB;
constexpr size_t WS_PO = 336 * MiB;
constexpr size_t WS_PML = 432 * MiB;
constexpr size_t WS_MLIST = 438 * MiB;
constexpr size_t WS_WGU = 336 * MiB, WS_WD = 400 * MiB;
constexpr size_t WS_YO = 80 * MiB;
constexpr size_t WS_HID = 208 * MiB;
constexpr size_t WS_SO = 80 * MiB;
constexpr size_t WS_END = 472 * MiB;
static_assert(WS_MLIST + (size_t)16 * MOBA_CAP * 4 <= WS_END && WS_PML + (size_t)3 * M * 16 * 4 <= WS_MLIST && WS_PO + (size_t)3 * M * 512 * 2 <= WS_PML, "d_ws map");
static_assert(WS_HID + (size_t)73728 * 512 * 2 <= WS_WGU && WS_SO + (size_t)M * 2 * 1024 * 2 <= WS_HID && WS_WD + (size_t)32 * 1024 * 512 * 2 <= WS_PML, "d_ws map");
constexpr int CW_BAR = 4096;
constexpr int CW_MCNT = 16384;
constexpr int CW_ECNT = 16384 + 1024 * 16;
static_assert((CW_ECNT + 32 * 64) * 4 <= (int)CTL_ZERO_BYTES, "CTL words inside the memset region");

constexpr int RING_OFF = 0, RING_BYTES = 131072;
constexpr int LDSCTL_OFF = 147456, MISC_OFF = LDSCTL_OFF + 320;
constexpr int LDS_BYTES = 148480;
static_assert(MISC_OFF + 128 <= LDS_BYTES, "LDS map");

#define GAS __attribute__((address_space(1)))
#define LAS __attribute__((address_space(3)))
typedef unsigned short bf16;
typedef unsigned v4u __attribute__((ext_vector_type(4)));
typedef unsigned v2u __attribute__((ext_vector_type(2)));
typedef float f32x4 __attribute__((ext_vector_type(4)));
typedef float f32x2 __attribute__((ext_vector_type(2)));
typedef GAS unsigned gu32;
#define RLX_AGENT __ATOMIC_RELAXED, __HIP_MEMORY_SCOPE_AGENT
#define LDS_WAIT() asm volatile("s_waitcnt lgkmcnt(0)" ::: "memory")
#define VM_WAIT() asm volatile("s_waitcnt vmcnt(0)" ::: "memory")
__device__ __forceinline__ unsigned f2bf(float f) { unsigned u = __builtin_bit_cast(unsigned, f); return (u + 0x7fffu + ((u >> 16) & 1u)) >> 16; }
__device__ __forceinline__ unsigned pk2(float lo, float hi) { return f2bf(lo) | (f2bf(hi) << 16); }
__device__ __forceinline__ float bf_lo(unsigned u) { return __uint_as_float(u << 16); }
__device__ __forceinline__ float bf_hi(unsigned u) { return __uint_as_float(u & 0xffff0000u); }

#define XB_TMO      128
#define XB_XCNT(j)  (256  + 64 * (j))
#define XB_XSUB(j)  (1280 + 64 * (j))
#define XB_XGEN(j)  (2304 + 64 * (j))
#define XB_TOP      3328
#define XB_TOPGEN   3392
#define XCD_BAR_WORDS 3456
#define XB_SPIN_CAP (1u << 18)

__device__ __forceinline__ unsigned xb_ld(unsigned* p)              { return __hip_atomic_load(p, __ATOMIC_RELAXED, __HIP_MEMORY_SCOPE_AGENT); }
__device__ __forceinline__ unsigned xb_add(unsigned* p, unsigned v) { return __hip_atomic_fetch_add(p, v, __ATOMIC_RELAXED, __HIP_MEMORY_SCOPE_AGENT); }
__device__ __forceinline__ unsigned xb_xcc_id() { return (unsigned)__builtin_amdgcn_s_getreg((3 << 11) | 20) & 0xFu; }
#define XB_SPIN(cond, bar) do { unsigned _sp = 0; while (cond) { __builtin_amdgcn_s_sleep(1); \
    if ((++_sp & 255u) == 0u) { if (xb_ld(&(bar)[XB_TMO])) break; if (_sp > XB_SPIN_CAP) { atomicAdd(&(bar)[XB_TMO], 1u); break; } } } } while (0)

struct XcdBarrier {
    unsigned* bar; unsigned x;
    volatile LAS unsigned* st;
};
__device__ __forceinline__ XcdBarrier xcd_barrier_post(unsigned* bar, volatile LAS unsigned* st) {
    XcdBarrier b; b.bar = bar; b.x = xb_xcc_id(); b.st = st;
    if (threadIdx.x == 0) (void)xb_add(&bar[XB_XCNT(b.x)], 1u);
    return b;
}
__device__ __forceinline__ void xcd_barrier_complete(unsigned* bar, unsigned x, unsigned& nloc, unsigned& nx) {
    const unsigned G = gridDim.x * gridDim.y * gridDim.z;
    unsigned sum, cnt, mine, sp = 0u;
    for (;;) {
        sum = 0u; cnt = 0u; mine = 0u;
#pragma unroll
        for (unsigned j = 0; j < 16; ++j) { const unsigned c = xb_ld(&bar[XB_XCNT(j)]); sum += c; cnt += (c > 0u) ? 1u : 0u; mine = (j == x) ? c : mine; }
        if (sum == G) break;
        __builtin_amdgcn_s_sleep(1);
        if ((++sp & 255u) == 0u) { if (xb_ld(&bar[XB_TMO])) break; if (sp > XB_SPIN_CAP) { atomicAdd(&bar[XB_TMO], 1u); break; } }
    }
    nloc = mine > 0u ? mine : 1u; nx = cnt > 0u ? cnt : 1u;
}
__device__ __forceinline__ void xcd_barrier(const XcdBarrier& b) {
    asm volatile("s_waitcnt vmcnt(0)" ::: "memory");
    __syncthreads();
    if (threadIdx.x == 0) {
        unsigned* bar = b.bar;
        __builtin_amdgcn_s_waitcnt(0);
        unsigned nloc = b.st[0], nx = b.st[1];
        if (nloc == 0u) { xcd_barrier_complete(bar, b.x, nloc, nx); b.st[0] = nloc; b.st[1] = nx; }
        const unsigned old = xb_add(&bar[XB_XSUB(b.x)], 1u);
        const unsigned gen = old / nloc;
        if (old + 1u == (gen + 1u) * nloc) {
            __builtin_amdgcn_fence(__ATOMIC_RELEASE, "agent");
            asm volatile("s_waitcnt vmcnt(0)" ::: "memory");
            const unsigned og = xb_add(&bar[XB_TOP], 1u);
            const unsigned tg = og / nx;
            if (og + 1u == (tg + 1u) * nx) xb_add(&bar[XB_TOPGEN], 1u);
            else XB_SPIN(xb_ld(&bar[XB_TOPGEN]) == tg, bar);
            __builtin_amdgcn_fence(__ATOMIC_ACQUIRE, "agent");
            xb_add(&bar[XB_XGEN(b.x)], 1u);
            asm volatile("s_waitcnt vmcnt(0)" ::: "memory");
        } else {
            XB_SPIN(xb_ld(&bar[XB_XGEN(b.x)]) == gen, bar);
            __builtin_amdgcn_fence(__ATOMIC_ACQUIRE, "agent");
            asm volatile("s_waitcnt vmcnt(0)" ::: "memory");
        }
    }
    __syncthreads();
}

struct Frame {
    LAS unsigned char* lds;
    volatile LAS unsigned* MISC;
    gu32* ctl;
    int tid, lane, wave;
    int vcu, G;
    float* out; unsigned char* ws;
};
typedef __attribute__((address_space(4))) const unsigned char* kptr_t;
__device__ __forceinline__ kptr_t karg() { kptr_t p = (kptr_t)__builtin_amdgcn_kernarg_segment_ptr(); asm volatile("" : "+s"(p)); return p; }
#define INP(kp, i) (*(const float* const __attribute__((address_space(4)))*)((kp) + 8 * (i)))
__device__ __forceinline__ float wave_sum(float v) {
#pragma unroll
    for (int o = 1; o < 64; o <<= 1) v += __shfl_xor(v, o);
    return v;
}
#define PHASE_BEGIN(F) do { asm volatile("" : "+v"((F).tid)); (F).lane = (F).tid & 63; } while (0)
__device__ __forceinline__ float silu_f(float v) { return v / (1.f + __expf(-v)); }
__device__ __forceinline__ int rel_bucket(int d) {
    if (d < 16) return d;
    const int thr[15] = {19, 21, 24, 27, 31, 35, 40, 46, 52, 59, 67, 77, 87, 99, 113};
    int b = 16;
#pragma unroll
    for (int i = 0; i < 15; ++i) b += (d >= thr[i]) ? 1 : 0;
    return b;
}
__device__ __forceinline__ void p0_transpose_item(const float* W, int K, int N, bf16* WT, size_t dst_row0, LAS float* scr, int k0, int n0, int lane) {
#pragma unroll 8
    for (int i = 0; i < 32; ++i) { const int kk = 2 * i + (lane >> 5); scr[kk * 33 + (lane & 31)] = W[(size_t)(k0 + kk) * N + n0 + (lane & 31)]; }
    LDS_WAIT(); asm volatile("" ::: "memory");
    const int c = lane & 7;
#pragma unroll
    for (int j = 0; j < 4; ++j) { const int n = (lane >> 3) + 8 * j; const LAS float* s = scr + (8 * c) * 33 + n;
        v4u o; o.x = pk2(s[0 * 33], s[1 * 33]); o.y = pk2(s[2 * 33], s[3 * 33]); o.z = pk2(s[4 * 33], s[5 * 33]); o.w = pk2(s[6 * 33], s[7 * 33]);
        *(GAS v4u*)(WT + (dst_row0 + n) * K + k0 + 8 * c) = o; }
    LDS_WAIT(); asm volatile("" ::: "memory");
}

__device__ __forceinline__ void p0_prologue(Frame& F) {
    PHASE_BEGIN(F);
    const kptr_t kp = karg();
    const float* c = INP(kp, 1); const float* w_ada = INP(kp, 2); const float* b_ada = INP(kp, 3);
    float* mod = (float*)(F.ws + WS_MOD);
    LAS float* cs = (LAS float*)(F.lds);
    LAS float* part = (LAS float*)(F.lds + 8192);
    for (int cg = blockIdx.x; cg < 96; cg += F.G) {
        for (int i = F.tid; i < 2048; i += NWAVES * 64) cs[i] = silu_f(c[i]);
        __syncthreads();
        const int col = cg * 64 + F.lane; float a0 = 0.f, a1 = 0.f;
#pragma unroll 8
        for (int k = F.wave * 128; k < F.wave * 128 + 128; ++k) { const float w = w_ada[(size_t)k * 6144 + col]; a0 += cs[k] * w; a1 += cs[1024 + k] * w; }
        part[(F.wave * 2 + 0) * 64 + F.lane] = a0; part[(F.wave * 2 + 1) * 64 + F.lane] = a1;
        __syncthreads();
        if (F.wave < 2) { float s = 0.f;
#pragma unroll
            for (int w = 0; w < 8; ++w) s += part[(w * 2 + F.wave) * 64 + F.lane];
            mod[F.wave * 6144 + col] = s + b_ada[col]; }
        __syncthreads();
    }
    if (blockIdx.x == F.G - 1) {
        const float* rb = INP(kp, 15); float* bg = (float*)(F.ws + WS_BIASG);
        for (int i = F.tid; i < 12 * 128; i += NWAVES * 64) { const int h = i >> 7, d = i & 127; bg[i] = (rb[rel_bucket(d) * 12 + h] - rb[31 * 12 + h]) * LOG2E; }
    }
    __syncthreads();
    LAS float* scr = (LAS float*)(F.lds + RING_OFF + F.wave * 16384);
    const int gw = F.vcu * NWAVES + F.wave, NGW = F.G * NWAVES;
    constexpr int I_IN = 16 * 96, I_OUT = 16 * 32;
    for (int it = gw; it < I_IN + I_OUT; it += NGW) {
        if (it < I_IN) { const int kb = it / 96, nb = it % 96; p0_transpose_item(INP(kp, 8), 1024, 3072, (bf16*)(F.ws + WS_WIN), (size_t)(32 * nb), scr, 64 * kb, 32 * nb, F.lane); }
        else { const int r = it - I_IN, kb = r / 32, nb = r % 32; p0_transpose_item(INP(kp, 14), 1024, 1024, (bf16*)(F.ws + WS_WOUT), (size_t)(32 * nb), scr, 64 * kb, 32 * nb, F.lane); }
    }
}
__device__ __forceinline__ void expert_weights(Frame& F) {
    PHASE_BEGIN(F);
    const kptr_t kp = karg();
    LAS float* scr = (LAS float*)(F.lds + RING_OFF + F.wave * 16384);
    const int gw = F.vcu * NWAVES + F.wave, NGW = F.G * NWAVES;
    constexpr int I_G = 32 * 16 * 16, I_D = 32 * 8 * 32;
    for (int it = gw; it < 2 * I_G + I_D; it += NGW) {
        if (it < 2 * I_G) { const int up = it >= I_G ? 1 : 0, r = it - up * I_G, e = r >> 8, kb = (r >> 4) & 15, nb = r & 15, n0 = 32 * nb;
            p0_transpose_item(INP(kp, 20 + up) + (size_t)e * 1024 * 512, 1024, 512, (bf16*)(F.ws + WS_WGU), (size_t)e * 1024 + (n0 >> 7) * 256 + up * 128 + (n0 & 127), scr, 64 * kb, n0, F.lane); }
        else { const int r = it - 2 * I_G, e = r >> 8, kb = (r >> 5) & 7, nb = r & 31;
            p0_transpose_item(INP(kp, 22) + (size_t)e * 512 * 1024, 512, 1024, (bf16*)(F.ws + WS_WD), (size_t)e * 1024 + 32 * nb, scr, 64 * kb, 32 * nb, F.lane); }
    }
}
__device__ __forceinline__ void p1_prenorm(Frame& F) {
    PHASE_BEGIN(F);
    const kptr_t kp = karg();
    const float* x = INP(kp, 0); const float* gain = INP(kp, 4); const float* mod = (const float*)(F.ws + WS_MOD); bf16* XN = (bf16*)(F.ws + WS_XN);
    const int gw = F.vcu * NWAVES + F.wave, NGW = F.G * NWAVES;
    for (int b = 0; b < BATCH; ++b) {
        f32x4 ge[4], sh[4];
#pragma unroll
        for (int j = 0; j < 4; ++j) { const int c = 4 * F.lane + 256 * j; const f32x4 g = *(const f32x4*)(gain + c), sc = *(const f32x4*)(mod + b * 6144 + 1024 + c); ge[j] = g * (sc + 1.f); sh[j] = *(const f32x4*)(mod + b * 6144 + c); }
        for (int m = b * T + gw; m < (b + 1) * T; m += NGW) {
            const GAS f32x4* xr = (const GAS f32x4*)(x + (size_t)m * D) + F.lane;
            f32x4 v[4]; float s = 0.f;
#pragma unroll
            for (int j = 0; j < 4; ++j) { v[j] = xr[64 * j]; s += (v[j].x * v[j].x + v[j].y * v[j].y) + (v[j].z * v[j].z + v[j].w * v[j].w); }
            const float r = 1.f / sqrtf(wave_sum(s) * (1.f / D) + EPS);
            GAS unsigned long long* o8 = (GAS unsigned long long*)(XN + (size_t)m * D) + F.lane;
#pragma unroll
            for (int j = 0; j < 4; ++j) { const f32x4 h = v[j] * r * ge[j] + sh[j]; o8[64 * j] = (unsigned long long)pk2(h.x, h.y) | ((unsigned long long)pk2(h.z, h.w) << 32); }
        }
    }
}
__device__ __forceinline__ void p3_kmean(Frame& F) {
    PHASE_BEGIN(F);
    const bf16* QKV = (const bf16*)(F.ws + WS_QKV); float* km = (float*)(F.ws + WS_KMEAN);
    const int gw = F.vcu * NWAVES + F.wave, NGW = F.G * NWAVES;
    for (int it = gw; it < 1024; it += NGW) {
        const int b = it >> 9, h = (it >> 6) & 7, j = it & 63; const int ch = F.lane & 7, rg = F.lane >> 3;
        const bf16* base = QKV + ((size_t)(b * T + j * 256 + rg)) * NPROJ + 2048 + h * 64 + ch * 8;
        float a[8] = {0.f, 0.f, 0.f, 0.f, 0.f, 0.f, 0.f, 0.f};
#pragma unroll 8
        for (int i = 0; i < 32; ++i) { const v4u v = *(const GAS v4u*)(base + (size_t)(8 * i) * NPROJ);
            a[0] += bf_lo(v.x); a[1] += bf_hi(v.x); a[2] += bf_lo(v.y); a[3] += bf_hi(v.y); a[4] += bf_lo(v.z); a[5] += bf_hi(v.z); a[6] += bf_lo(v.w); a[7] += bf_hi(v.w); }
#pragma unroll
        for (int k = 0; k < 8; ++k) { a[k] += __shfl_xor(a[k], 8); a[k] += __shfl_xor(a[k], 16); a[k] += __shfl_xor(a[k], 32); }
        if (rg == 0) {
#pragma unroll
            for (int k = 0; k < 8; ++k) km[(size_t)it * 64 + ch * 8 + k] = a[k] * (1.f / 256.f); }
    }
}
__device__ __forceinline__ int moba_list_base(int bh, int j) { return bh * MOBA_CAP + 256 * (63 * j - (j * (j - 1)) / 2); }
__device__ __forceinline__ void p4_moba_select(Frame& F) {
    PHASE_BEGIN(F);
    const bf16* QKV = (const bf16*)(F.ws + WS_QKV); const float* km = (const float*)(F.ws + WS_KMEAN); unsigned* mlist = (unsigned*)(F.ws + WS_MLIST);
    LAS float* kml = (LAS float*)(F.lds);
    for (int bi = blockIdx.x; bi < 512; bi += F.G) {
        const int bh = bi >> 5, qg = bi & 31, b = bh >> 3, h = bh & 7;
        for (int i = F.tid; i < 1024; i += NWAVES * 64) ((LAS f32x4*)kml)[i] = ((const f32x4*)(km + (size_t)bh * 4096))[i];
        __syncthreads();
        const int q = qg * 512 + F.wave * 64 + F.lane, own = (qg * 512 + F.wave * 64) >> 8;
        if (own > 0) {
            float qf[64];
            const bf16* qp = QKV + ((size_t)(b * T + q)) * NPROJ + 1536 + h * 64;
#pragma unroll
            for (int c8 = 0; c8 < 8; ++c8) { const v4u v = *(const GAS v4u*)(qp + c8 * 8);
                qf[c8 * 8 + 0] = bf_lo(v.x); qf[c8 * 8 + 1] = bf_hi(v.x); qf[c8 * 8 + 2] = bf_lo(v.y); qf[c8 * 8 + 3] = bf_hi(v.y); qf[c8 * 8 + 4] = bf_lo(v.z); qf[c8 * 8 + 5] = bf_hi(v.z); qf[c8 * 8 + 6] = bf_lo(v.w); qf[c8 * 8 + 7] = bf_hi(v.w); }
            float v0 = -INFINITY, v1 = -INFINITY, v2 = -INFINITY; int i0 = 64, i1 = 64, i2 = 64;
            for (int j = 0; j < own; ++j) {
                float g = 0.f;
#pragma unroll
                for (int d4 = 0; d4 < 16; ++d4) { const f32x4 kv = ((const LAS f32x4*)kml)[j * 16 + d4]; g += qf[d4 * 4] * kv.x + qf[d4 * 4 + 1] * kv.y + qf[d4 * 4 + 2] * kv.z + qf[d4 * 4 + 3] * kv.w; }
                if (g > v0) { v2 = v1; i2 = i1; v1 = v0; i1 = i0; v0 = g; i0 = j; }
                else if (g > v1) { v2 = v1; i2 = i1; v1 = g; i1 = j; }
                else if (g > v2) { v2 = g; i2 = j; }
            }
            for (int j = 0; j < own; ++j) {
                const bool sel = (i0 == j) || (i1 == j) || (i2 == j);
                const unsigned long long mask = __ballot(sel);
                if (mask) {
                    unsigned base = 0;
                    if (F.lane == 0) base = __hip_atomic_fetch_add(F.ctl + CW_MCNT + (bh * 64 + j) * 16, (unsigned)__popcll(mask), RLX_AGENT);
                    base = (unsigned)__builtin_amdgcn_readfirstlane((int)base);
                    if (sel) { const unsigned pos = base + (unsigned)__popcll(mask & ((1ull << F.lane) - 1ull)); const unsigned slot = (i0 == j) ? 0u : ((i1 == j) ? 1u : 2u);
                        mlist[(size_t)moba_list_base(bh, j) + pos] = (unsigned)q | (slot << 14); }
                }
            }
        }
        __syncthreads();
    }
}
__device__ __forceinline__ void p5_moba_gather(Frame& F, char* lds_generic) {
    PHASE_BEGIN(F);
    LAS int* pre = (LAS int*)(F.lds + 106496);
    LAS int* tmp = (LAS int*)(F.lds + 106496 + 4224);
    for (int i = F.tid; i < 1024; i += NWAVES * 64) { const unsigned c = __hip_atomic_load(F.ctl + CW_MCNT + i * 16, RLX_AGENT); tmp[i] = (int)((c + 255u) >> 8); }
    __syncthreads();
    if (F.wave == 0) { int loc[16]; int s = 0;
#pragma unroll
        for (int k = 0; k < 16; ++k) { loc[k] = s; s += tmp[F.lane * 16 + k]; }
        int incl = s;
#pragma unroll
        for (int o = 1; o < 64; o <<= 1) { const int t = __shfl_up(incl, o); if (F.lane >= o) incl += t; }
        const int excl = incl - s;
#pragma unroll
        for (int k = 0; k < 16; ++k) pre[F.lane * 16 + k] = excl + loc[k];
        if (F.lane == 63) pre[1024] = incl; }
    __syncthreads();
    const int U = pre[1024];
    const bf16* QKV = (const bf16*)(F.ws + WS_QKV); const unsigned* mlist = (const unsigned*)(F.ws + WS_MLIST);
    for (int L = blockIdx.x; L < U; L += F.G) {
        int lo = 0, hi = 1024;
        while (hi - lo > 1) { const int mid = (lo + hi) >> 1; if (pre[mid] <= L) lo = mid; else hi = mid; }
        const int x = lo, chunk = L - pre[x], bh = x >> 6, j = x & 63, b = bh >> 3, h = bh & 7;
        const int cnt = (int)__hip_atomic_load(F.ctl + CW_MCNT + x * 16, RLX_AGENT); const int n = (cnt - chunk * 256) < 256 ? (cnt - chunk * 256) : 256;
        attn_body::moba_gather_unit((const attn_body::bf16*)QKV + (size_t)b * T * NPROJ, h, j, mlist + (size_t)moba_list_base(bh, j) + chunk * 256, n, (long)b * T,
                                    (const float*)(F.ws + WS_BIASG) + (4 + h) * 128, (float*)(F.ws + WS_PML), (attn_body::bf16*)(F.ws + WS_PO), lds_generic);
    }
}
__device__ __forceinline__ void p6_attention(Frame& F, char* lds_generic) {
    PHASE_BEGIN(F);
    const attn_body::bf16* QKV = (const attn_body::bf16*)(F.ws + WS_QKV);
    const int c = blockIdx.x, G = F.G;
    for (int i = 0;; ++i) {
        const long L = (long)i * G + ((i & 1) ? (G - 1 - c) : c);
        if (L >= 1024) break;
        const int qb = 63 - (int)(L >> 4), st = (int)(L & 15), b = st >> 3, hd = (st >> 1) & 3, mp = st & 1;
        const attn_body::bf16* base = QKV + (size_t)b * T * NPROJ;
        attn_body::attn_unit128<8>(base + hd * 128 + mp * 64, base + 512 + hd * 128 + mp * 64, base + 1024 + hd * 128,
                                   (attn_body::bf16*)(F.ws + WS_OD) + (size_t)b * T * 1024 + (hd * 2 + mp) * 128, qb * 256, 4 * (qb + 1),
                                   (const float*)(F.ws + WS_BIASG) + hd * 128, lds_generic);
    }
    for (int i = 0;; ++i) {
        const long L = (long)i * G + ((i & 1) ? (G - 1 - c) : c);
        if (L >= 1024) break;
        const int o = (int)L, b = o >> 9, h = (o >> 6) & 7, qb = o & 63;
        const attn_body::bf16* base = QKV + (size_t)b * T * NPROJ;
        attn_body::MobaMerge mm{(const float*)(F.ws + WS_PML), (const attn_body::bf16*)(F.ws + WS_PO), (long)b * T + qb * 256, h, qb < 3 ? qb : 3};
        attn_body::attn_unit<8, 1>(base + 1536 + h * 64, base + 2048 + h * 64, base + 2560 + h * 64,
                                   (attn_body::bf16*)(F.ws + WS_XN) + (size_t)b * T * 1024 + 512 + h * 64, qb * 256, qb * 256, 4,
                                   (const float*)(F.ws + WS_BIASG) + (4 + h) * 128, mm, lds_generic);
    }
}
__device__ __forceinline__ void p7_ydiff(Frame& F) {
    PHASE_BEGIN(F);
    const kptr_t kp = karg();
    const float l1 = wave_sum(INP(kp, 9)[F.lane] * INP(kp, 10)[F.lane]), l2 = wave_sum(INP(kp, 11)[F.lane] * INP(kp, 12)[F.lane]);
    const float lam = expf(l1) - expf(l2) + LAMBDA_INIT;
    const bf16* OD = (const bf16*)(F.ws + WS_OD); bf16* Y = (bf16*)(F.ws + WS_XN);
    const int gw = F.vcu * NWAVES + F.wave, NGW = F.G * NWAVES;
    const int hd = F.lane >> 4, i = F.lane & 15;
    float gn[8];
#pragma unroll
    for (int k = 0; k < 8; ++k) gn[k] = INP(kp, 13)[i * 8 + k] * (1.f - LAMBDA_INIT);
    for (int m = gw; m < M; m += NGW) {
        const v4u a = *(const GAS v4u*)(OD + (size_t)m * 1024 + hd * 256 + i * 8), bb = *(const GAS v4u*)(OD + (size_t)m * 1024 + hd * 256 + 128 + i * 8);
        float v[8] = {bf_lo(a.x) - lam * bf_lo(bb.x), bf_hi(a.x) - lam * bf_hi(bb.x), bf_lo(a.y) - lam * bf_lo(bb.y), bf_hi(a.y) - lam * bf_hi(bb.y),
                      bf_lo(a.z) - lam * bf_lo(bb.z), bf_hi(a.z) - lam * bf_hi(bb.z), bf_lo(a.w) - lam * bf_lo(bb.w), bf_hi(a.w) - lam * bf_hi(bb.w)};
        float s = 0.f;
#pragma unroll
        for (int k = 0; k < 8; ++k) s += v[k] * v[k];
        s += __shfl_xor(s, 1); s += __shfl_xor(s, 2); s += __shfl_xor(s, 4); s += __shfl_xor(s, 8);
        const float r = 1.f / sqrtf(s * (1.f / 128.f) + EPS);
        v4u o; o.x = pk2(v[0] * r * gn[0], v[1] * r * gn[1]); o.y = pk2(v[2] * r * gn[2], v[3] * r * gn[3]); o.z = pk2(v[4] * r * gn[4], v[5] * r * gn[5]); o.w = pk2(v[6] * r * gn[6], v[7] * r * gn[7]);
        *(GAS v4u*)(Y + (size_t)m * 1024 + hd * 128 + i * 8) = o;
    }
    expert_weights(F);
}
__device__ __forceinline__ void p9_postmix_route(Frame& F) {
    PHASE_BEGIN(F);
    const kptr_t kp = karg();
    const float* x = INP(kp, 0); const float* yo = (const float*)(F.ws + WS_YO); const float* mod = (const float*)(F.ws + WS_MOD);
    bf16* XN = (bf16*)(F.ws + WS_XN); float* tokw = (float*)(F.ws + WS_TOKW); int* elist = (int*)(F.ws + WS_ELIST);
    LAS float* WE = (LAS float*)(F.lds); LAS float* WG = (LAS float*)(F.lds + 131072);
    for (int f = F.tid; f < 32768; f += NWAVES * 64) { const int k = f >> 5, cc = f & 31; const int l = (k & 255) >> 2, kk = ((k >> 8) << 2) | (k & 3), g = cc >> 3, hf = (cc >> 2) & 1, ii = cc & 3;
        WE[((((g * 16 + kk) * 2 + hf) * 64 + l) << 2) + ii] = INP(kp, 18)[f]; }
    for (int f = F.tid; f < 4096; f += NWAVES * 64) { const int k = f >> 2, ii = f & 3; const int l = (k & 255) >> 2, kk = ((k >> 8) << 2) | (k & 3); WG[((kk * 64 + l) << 2) + ii] = INP(kp, 16)[f]; }
    __syncthreads();
    const int gw = F.vcu * NWAVES + F.wave, NGW = F.G * NWAVES;
    const float bg0 = INP(kp, 17)[0], bg1 = INP(kp, 17)[1], bg2 = INP(kp, 17)[2], bg3 = INP(kp, 17)[3];
    for (int b = 0; b < BATCH; ++b) {
        f32x4 a1[4], ge[4], sh[4];
#pragma unroll
        for (int j = 0; j < 4; ++j) { const int c = 4 * F.lane + 256 * j; a1[j] = *(const f32x4*)(INP(kp, 5) + c) * *(const f32x4*)(mod + b * 6144 + 2048 + c);
            ge[j] = *(const f32x4*)(INP(kp, 6) + c) * (*(const f32x4*)(mod + b * 6144 + 4096 + c) + 1.f); sh[j] = *(const f32x4*)(mod + b * 6144 + 3072 + c); }
        for (int m = b * T + gw; m < (b + 1) * T; m += NGW) {
            const GAS f32x4* yr = (const GAS f32x4*)(yo + (size_t)m * D) + F.lane; const GAS f32x4* xr = (const GAS f32x4*)(x + (size_t)m * D) + F.lane;
            f32x4 xv[4]; float s = 0.f, s2 = 0.f;
            {   f32x4 y[4];
#pragma unroll
                for (int j = 0; j < 4; ++j) { y[j] = yr[64 * j]; xv[j] = xr[64 * j]; s += (y[j].x * y[j].x + y[j].y * y[j].y) + (y[j].z * y[j].z + y[j].w * y[j].w); }
                const float r1 = 1.f / sqrtf(wave_sum(s) * (1.f / D) + EPS);
                GAS f32x4* orow = (GAS f32x4*)(F.out + (size_t)m * D) + F.lane;
#pragma unroll
                for (int j = 0; j < 4; ++j) { xv[j] = xv[j] + a1[j] * (y[j] * r1); orow[64 * j] = xv[j]; s2 += (xv[j].x * xv[j].x + xv[j].y * xv[j].y) + (xv[j].z * xv[j].z + xv[j].w * xv[j].w); }
            }
            const float r2 = 1.f / sqrtf(wave_sum(s2) * (1.f / D) + EPS);
            GAS unsigned long long* o8 = (GAS unsigned long long*)(XN + (size_t)m * D) + F.lane;
            float gl[4] = {0.f, 0.f, 0.f, 0.f};
#pragma unroll
            for (int j = 0; j < 4; ++j) { xv[j] = xv[j] * r2 * ge[j] + sh[j]; o8[64 * j] = (unsigned long long)pk2(xv[j].x, xv[j].y) | ((unsigned long long)pk2(xv[j].z, xv[j].w) << 32);
#pragma unroll
                for (int ii = 0; ii < 4; ++ii) { const f32x4 w = ((const LAS f32x4*)WG)[(j * 4 + ii) * 64 + F.lane]; const float hv = xv[j][ii]; gl[0] += hv * w.x; gl[1] += hv * w.y; gl[2] += hv * w.z; gl[3] += hv * w.w; }
                __builtin_amdgcn_sched_barrier(0); }
            gl[0] = wave_sum(gl[0]) + bg0; gl[1] = wave_sum(gl[1]) + bg1; gl[2] = wave_sum(gl[2]) + bg2; gl[3] = wave_sum(gl[3]) + bg3;
            int g = 0; float gm = gl[0];
            if (gl[1] > gm) { gm = gl[1]; g = 1; } if (gl[2] > gm) { gm = gl[2]; g = 2; } if (gl[3] > gm) { gm = gl[3]; g = 3; }
            const float gw_ = 1.f / (expf(gl[0] - gm) + expf(gl[1] - gm) + expf(gl[2] - gm) + expf(gl[3] - gm));
            g = __builtin_amdgcn_readfirstlane(g);
            float el[8] = {0.f, 0.f, 0.f, 0.f, 0.f, 0.f, 0.f, 0.f};
#pragma unroll
            for (int j = 0; j < 4; ++j) {
#pragma unroll
                for (int ii = 0; ii < 4; ++ii) { const int kk = j * 4 + ii; const f32x4 wa = ((const LAS f32x4*)WE)[((g * 16 + kk) * 2 + 0) * 64 + F.lane], wb = ((const LAS f32x4*)WE)[((g * 16 + kk) * 2 + 1) * 64 + F.lane]; const float hv = xv[j][ii];
                    el[0] += hv * wa.x; el[1] += hv * wa.y; el[2] += hv * wa.z; el[3] += hv * wa.w; el[4] += hv * wb.x; el[5] += hv * wb.y; el[6] += hv * wb.z; el[7] += hv * wb.w; }
                __builtin_amdgcn_sched_barrier(0); }
            float ea = -INFINITY, eb = -INFINITY; int ia = 0, ib = 0;
#pragma unroll
            for (int k = 0; k < 8; ++k) { const float v = wave_sum(el[k]) + INP(kp, 19)[g * 8 + k];
                if (v > ea) { eb = ea; ib = ia; ea = v; ia = k; } else if (v > eb) { eb = v; ib = k; } }
            const float pb = expf(eb - ea), wa_ = gw_ / (1.f + pb), wb_ = gw_ * pb / (1.f + pb);
            if (F.lane == 0) {
                const int e0 = g * 8 + ia, e1 = g * 8 + ib;
                const unsigned p0 = __hip_atomic_fetch_add(F.ctl + CW_ECNT + e0 * 64, 1u, RLX_AGENT), p1 = __hip_atomic_fetch_add(F.ctl + CW_ECNT + e1 * 64, 1u, RLX_AGENT);
                elist[e0 * 32768 + (int)p0] = m * 2; elist[e1 * 32768 + (int)p1] = m * 2 + 1;
                *(f32x2*)(tokw + (size_t)m * 2) = (f32x2){wa_, wb_};
            }
        }
    }
}
struct MoeOrder {
    const LAS int* tp;
    const gu32* ecnt; const int* elist; int G, c;
    __device__ __forceinline__ bool next(int i, pg8::Unit& u) const {
        const long L = (long)i * G + c; const int U = tp[32] * 4; if (L >= U) return false;
        const int rt = (int)(L >> 2), pn = (int)(L & 3); int e = 0;
#pragma unroll 1
        for (int k = 1; k < 32; ++k) e += (tp[k] <= rt) ? 1 : 0;
        const int t = rt - tp[e]; const int cnt = (int)__hip_atomic_load(ecnt + e * 64, RLX_AGENT);
        u.pm = rt; u.pn = e * 4 + pn; u.nvalid = (cnt - t * 256) < 256 ? (cnt - t * 256) : 256; u.rows = elist + e * 32768 + t * 256; return true;
    }
    __device__ __forceinline__ int arow(const pg8::Unit& u, int r) const { return r < u.nvalid ? (u.rows[r] >> 1) : 0; }
};
__device__ __forceinline__ void moe_prefix(Frame& F, LAS int* tp) {
    if (F.tid == 0) { int s = 0; for (int e = 0; e < 32; ++e) { tp[e] = s; s += ((int)__hip_atomic_load(F.ctl + CW_ECNT + e * 64, RLX_AGENT) + 255) >> 8; } tp[32] = s; }
    __syncthreads();
}

__device__ __forceinline__ void p2_qkv(Frame& F) {
    pg8::Gemm g{(const bf16*)(F.ws + WS_XN), (const bf16*)(F.ws + WS_WIN), M, NPROJ, D}; pg8::StaticOrder S; S.init(M, NPROJ, F.G, (int)blockIdx.x);
    pg8::EpiQKV E{(bf16*)(F.ws + WS_QKV), NPROJ, 0xC3u, attn_body::C2};
    pg8::gemm_phase<pg8::EpiQKV, pg8::StaticOrder, false>(F.lds + RING_OFF, g, S, E);
}
__device__ __forceinline__ void p8_wo(Frame& F) {
    pg8::Gemm g{(const bf16*)(F.ws + WS_XN), (const bf16*)(F.ws + WS_WOUT), M, D, D}; pg8::StaticOrder S; S.init(M, D, F.G, (int)blockIdx.x);
    pg8::EpiF32 E{(float*)(F.ws + WS_YO), D};
    pg8::gemm_phase<pg8::EpiF32, pg8::StaticOrder, false>(F.lds + RING_OFF, g, S, E);
}
__device__ __forceinline__ void p10_gateup(Frame& F) {
    LAS int* tp = (LAS int*)(F.lds + RING_BYTES); moe_prefix(F, tp);
    MoeOrder S{tp, F.ctl + CW_ECNT, (const int*)(F.ws + WS_ELIST), F.G, (int)blockIdx.x};
    pg8::Gemm g{(const bf16*)(F.ws + WS_XN), (const bf16*)(F.ws + WS_WGU), M, 1024, D};
    pg8::EpiSwiGLU E{(bf16*)(F.ws + WS_HID)};
    pg8::gemm_phase<pg8::EpiSwiGLU, MoeOrder, true>(F.lds + RING_OFF, g, S, E);
}
__device__ __forceinline__ void p11_down(Frame& F) {
    LAS int* tp = (LAS int*)(F.lds + RING_BYTES); moe_prefix(F, tp);
    MoeOrder S{tp, F.ctl + CW_ECNT, (const int*)(F.ws + WS_ELIST), F.G, (int)blockIdx.x};
    pg8::Gemm g{(const bf16*)(F.ws + WS_HID), (const bf16*)(F.ws + WS_WD), 73728, 1024, EFF};
    pg8::EpiDown E{(bf16*)(F.ws + WS_SO)};
    pg8::gemm_phase<pg8::EpiDown, MoeOrder, false>(F.lds + RING_OFF, g, S, E);
}
__device__ __forceinline__ void p12_final(Frame& F) {
    PHASE_BEGIN(F);
    const kptr_t kp = karg();
    const float* mod = (const float*)(F.ws + WS_MOD); const bf16* SO = (const bf16*)(F.ws + WS_SO); const float* tokw = (const float*)(F.ws + WS_TOKW);
    const int gw = F.vcu * NWAVES + F.wave, NGW = F.G * NWAVES;
    for (int b = 0; b < BATCH; ++b) {
        f32x4 pg[4], g2[4];
#pragma unroll
        for (int j = 0; j < 4; ++j) { const int c = 4 * F.lane + 256 * j; pg[j] = *(const f32x4*)(INP(kp, 7) + c); g2[j] = *(const f32x4*)(mod + b * 6144 + 5120 + c); }
        for (int m = b * T + gw; m < (b + 1) * T; m += NGW) {
            const f32x2 w = *(const f32x2*)(tokw + (size_t)m * 2);
            const GAS v2u* s0 = (const GAS v2u*)(SO + (size_t)m * 2048) + F.lane; const GAS v2u* s1 = (const GAS v2u*)(SO + (size_t)m * 2048 + 1024) + F.lane;
            GAS f32x4* orow = (GAS f32x4*)(F.out + (size_t)m * D) + F.lane;
            f32x4 y[4], xv[4]; float s = 0.f;
#pragma unroll
            for (int j = 0; j < 4; ++j) { const v2u a = s0[64 * j], bq = s1[64 * j]; xv[j] = orow[64 * j];
                y[j] = (f32x4){w.x * bf_lo(a.x) + w.y * bf_lo(bq.x), w.x * bf_hi(a.x) + w.y * bf_hi(bq.x), w.x * bf_lo(a.y) + w.y * bf_lo(bq.y), w.x * bf_hi(a.y) + w.y * bf_hi(bq.y)};
                s += (y[j].x * y[j].x + y[j].y * y[j].y) + (y[j].z * y[j].z + y[j].w * y[j].w); }
            const float r = 1.f / sqrtf(wave_sum(s) * (1.f / D) + EPS);
#pragma unroll
            for (int j = 0; j < 4; ++j) orow[64 * j] = xv[j] + g2[j] * (y[j] * r * pg[j]);
        }
    }
}

struct Args { const float* in[23]; float* out; unsigned char* ws; int ph_lo, ph_hi; };
__global__ void __launch_bounds__(NWAVES * 64, 2) hymba_fwd(Args args) {
    extern __shared__ __attribute__((aligned(16))) unsigned char lds[];
    Frame F;
    F.lds = (LAS unsigned char*)lds;
    F.MISC = (volatile LAS unsigned*)(F.lds + MISC_OFF);
    F.tid = threadIdx.x; F.lane = F.tid & 63; F.wave = __builtin_amdgcn_readfirstlane(F.tid >> 6);
    F.G = gridDim.x; { const int bx = blockIdx.x; F.vcu = (F.G % 8 == 0) ? (bx % 8) * (F.G / 8) + bx / 8 : bx; }
    F.ws = args.ws; F.out = args.out; F.ctl = (gu32*)(args.ws + WS_CTL);
    for (int u = F.tid; u < (LDS_BYTES - LDSCTL_OFF) / 4; u += NWAVES * 64) ((LAS unsigned*)(F.lds + LDSCTL_OFF))[u] = 0u;
    __syncthreads();
    XcdBarrier bar; bar.bar = (unsigned*)(F.ctl + CW_BAR); bar.x = 0; bar.st = nullptr;
    if (N_LAUNCHES == 1) bar = xcd_barrier_post((unsigned*)(F.ctl + CW_BAR), F.MISC + 8);
#define GRID_BAR() do { if (N_LAUNCHES == 1) xcd_barrier(bar); } while (0)
    const int lo = args.ph_lo, hi = args.ph_hi;
#define IN(k) (lo <= (k) && (k) < hi)
#ifndef PROBE_MASK
#define PROBE_MASK 0
#endif
#define TWICE(k) ((PROBE_MASK >> (k)) & 1)
#define BOTH(k) (IN(k) && IN((k) + 1))

    if (IN(0)) { p0_prologue(F); if (BOTH(0)) GRID_BAR(); }
    if (TWICE(0) && IN(0)) { p0_prologue(F); if (BOTH(0)) GRID_BAR(); }
    if (IN(1)) { p1_prenorm(F); if (BOTH(1)) GRID_BAR(); }
    if (TWICE(1) && IN(1)) { p1_prenorm(F); if (BOTH(1)) GRID_BAR(); }
    if (IN(2)) { p2_qkv(F); if (BOTH(2)) GRID_BAR(); }
    if (TWICE(2) && IN(2)) { p2_qkv(F); if (BOTH(2)) GRID_BAR(); }
    if (IN(3)) { p3_kmean(F); if (BOTH(3)) GRID_BAR(); }
    if (TWICE(3) && IN(3)) { p3_kmean(F); if (BOTH(3)) GRID_BAR(); }
    if (IN(4)) { p4_moba_select(F); if (BOTH(4)) GRID_BAR(); }
    if (IN(5)) { p5_moba_gather(F, (char*)lds + RING_OFF); if (BOTH(5)) GRID_BAR(); }
    if (TWICE(5) && IN(5)) { p5_moba_gather(F, (char*)lds + RING_OFF); if (BOTH(5)) GRID_BAR(); }
    if (IN(6)) { p6_attention(F, (char*)lds + RING_OFF); if (BOTH(6)) GRID_BAR(); }
    if (TWICE(6) && IN(6)) { p6_attention(F, (char*)lds + RING_OFF); if (BOTH(6)) GRID_BAR(); }
    if (IN(7)) { p7_ydiff(F); if (BOTH(7)) GRID_BAR(); }
    if (TWICE(7) && IN(7)) { p7_ydiff(F); if (BOTH(7)) GRID_BAR(); }
    if (IN(8)) { p8_wo(F); if (BOTH(8)) GRID_BAR(); }
    if (TWICE(8) && IN(8)) { p8_wo(F); if (BOTH(8)) GRID_BAR(); }
    if (IN(9)) { p9_postmix_route(F); if (BOTH(9)) GRID_BAR(); }
    if (IN(10)) { p10_gateup(F); if (BOTH(10)) GRID_BAR(); }
    if (TWICE(10) && IN(10)) { p10_gateup(F); if (BOTH(10)) GRID_BAR(); }
    if (IN(11)) { p11_down(F); if (BOTH(11)) GRID_BAR(); }
    if (TWICE(11) && IN(11)) { p11_down(F); if (BOTH(11)) GRID_BAR(); }
    if (IN(12)) { p12_final(F); }
#undef IN
#undef BOTH
#undef GRID_BAR
}

extern "C" void kernel_launch(void* const* d_in, const int* in_sizes, int n_in, void* d_out, int out_size, void* d_ws, size_t ws_size, hipStream_t stream) {
    static int grid = 0;
    if (grid == 0) {
        if (n_in != 23 || in_sizes[0] != M * D || out_size != M * D || ws_size < WS_END) { fprintf(stderr, "kernel_launch: unexpected shapes (n_in %d, in0 %d, out %d, ws %zu); nothing launched\n", n_in, n_in > 0 ? in_sizes[0] : -1, out_size, ws_size); grid = -1; return; }
        int dev = 0, cus = 0, per_cu = 0;
        if (hipGetDevice(&dev) != hipSuccess || hipDeviceGetAttribute(&cus, hipDeviceAttributeMultiprocessorCount, dev) != hipSuccess) { fprintf(stderr, "kernel_launch: device query failed\n"); grid = -1; return; }
        if (hipFuncSetAttribute((const void*)hymba_fwd, hipFuncAttributeMaxDynamicSharedMemorySize, LDS_BYTES) != hipSuccess) { fprintf(stderr, "kernel_launch: hipFuncSetAttribute failed\n"); grid = -1; return; }
        if (hipOccupancyMaxActiveBlocksPerMultiprocessor(&per_cu, (const void*)hymba_fwd, NWAVES * 64, LDS_BYTES) != hipSuccess || per_cu < 1)
            fprintf(stderr, "kernel_launch: note: occupancy query reports %d workgroups per CU\n", per_cu);
        (void)hipGetLastError();
        grid = cus;
    }
    if (grid < 0) return;
    if (hipMemsetAsync((char*)d_ws + WS_CTL, 0, CTL_ZERO_BYTES, stream) != hipSuccess) { fprintf(stderr, "kernel_launch: hipMemsetAsync failed\n"); return; }
    Args a{};
    for (int i = 0; i < 23; ++i) a.in[i] = (const float*)d_in[i];
    a.out = (float*)d_out; a.ws = (unsigned char*)d_ws;
    for (int li = 0; li < N_LAUNCHES; ++li) {
        a.ph_lo = (N_LAUNCHES == 1) ? 0 : li; a.ph_hi = (N_LAUNCHES == 1) ? N_PHASES : li + 1;
        hipLaunchKernelGGL(hymba_fwd, dim3(grid), dim3(NWAVES * 64), LDS_BYTES, stream, a);
        const hipError_t le = hipPeekAtLastError();
        if (le != hipSuccess) { fprintf(stderr, "kernel_launch: launch %d failed: %s\n", li, hipGetErrorName(le)); break; }
    }
}
```

```cpp
#include <hip/hip_runtime.h>
#include <hip/hip_bf16.h>
#include <cstdio>
#include <cstdint>
#include <cmath>

namespace pg8 {
#define PG8_LAS __attribute__((address_space(3)))
typedef unsigned short bf16_t;
typedef short bf16x8 __attribute__((ext_vector_type(8)));
typedef float f32x4 __attribute__((ext_vector_type(4)));
typedef unsigned u32x4 __attribute__((ext_vector_type(4)));
constexpr int BM = 256, BK = 64, HALF = 128, HTB = HALF * BK * 2  , STAGE_BYTES = 8 * HTB, NXCD = 8, WGM = 8;

__host__ __device__ __forceinline__ int lds_byte(int r, int c) { const int st = (r >> 4) * 2 + (c >> 5), rr = r & 15, cc = c & 31, ob = rr * 64 + cc * 2; return st * 1024 + (ob ^ (((ob >> 9) & 1) << 5)); }
__host__ __device__ __forceinline__ void stage_rc(int b, int& R, int& C) { const int st = b / 1024, sb = b % 1024, swz = sb ^ (((sb >> 9) & 1) << 5); R = (st >> 1) * 16 + swz / 64; C = (st & 1) * 32 + (swz % 64) / 2; }
__host__ __device__ __forceinline__ int perm32(int rho) { const int n = rho >> 4, i = rho & 15; return 8 * (i >> 2) + 4 * n + (i & 3); }

struct Unit { int pm, pn; int nvalid; const int* rows; };
struct Gemm { const bf16_t* A; const bf16_t* Bt; int M, N, K; };

struct StaticOrder {
    int nM, nN, nwg, G, c;
    __host__ __device__ void init(int M, int N, int G_, int c_) { nM = M / BM; nN = N / BM; nwg = nM * nN; G = G_; c = c_; }
    __host__ __device__ bool next(int i, Unit& u) const {
        const long L = (long)i * G + c; if (L >= nwg) return false;
        int wgid = (int)L; { const int q = nwg / NXCD, r = nwg % NXCD, xcd = wgid % NXCD, off = wgid / NXCD; wgid = (xcd < r ? xcd * (q + 1) : r * (q + 1) + (xcd - r) * q) + off; }
        const int nig = WGM * nN, gid = wgid / nig, fm = gid * WGM, gsz = (nM - fm) < WGM ? (nM - fm) : WGM;
        u.pm = fm + ((wgid % nig) % gsz); u.pn = (wgid % nig) / gsz; u.nvalid = 256; u.rows = nullptr; return true;
    }
    __device__ __forceinline__ int arow(const Unit&, int r) const { return r; }
};

__device__ __forceinline__ unsigned cvt_pk_bf16(float lo, float hi) { unsigned r; asm volatile("v_cvt_pk_bf16_f32 %0, %1, %2" : "=v"(r) : "v"(lo), "v"(hi)); return r; }

struct EpiQKV {
    static constexpr bool PERM = true;
    bf16_t* O; int ldc; unsigned qmask; float qscale;
    __device__ __forceinline__ void operator()(const f32x4 (&acc)[2][2][4][2], const Unit& u, int wr, int wc, int fr, int fq) const {
        const int row0 = u.pm * BM + wr * 64 + fr; const int col0 = u.pn * BM + wc * 32 + 8 * fq;
        const float sc = ((qmask >> u.pn) & 1u) ? qscale : 1.f;
#pragma unroll
        for (int ai = 0; ai < 2; ++ai)
#pragma unroll
            for (int m = 0; m < 4; ++m) { bf16_t* rowp = O + (size_t)(row0 + ai * HALF + m * 16) * ldc + col0;
#pragma unroll
                for (int bj = 0; bj < 2; ++bj) { const f32x4 v0 = acc[ai][bj][m][0] * sc, v1 = acc[ai][bj][m][1] * sc;
                    u32x4 w; w.x = cvt_pk_bf16(v0[0], v0[1]); w.y = cvt_pk_bf16(v0[2], v0[3]); w.z = cvt_pk_bf16(v1[0], v1[1]); w.w = cvt_pk_bf16(v1[2], v1[3]);
                    *(u32x4*)(rowp + bj * HALF) = w; } }
    }
};
struct EpiF32 {
    static constexpr bool PERM = false;
    float* O; int ldc;
    __device__ __forceinline__ void operator()(const f32x4 (&acc)[2][2][4][2], const Unit& u, int wr, int wc, int fr, int fq) const {
        const int col0 = u.pn * BM + wc * 32 + 4 * fq;
#pragma unroll
        for (int ai = 0; ai < 2; ++ai)
#pragma unroll
            for (int m = 0; m < 4; ++m) { float* rowp = O + (size_t)(u.pm * BM + ai * HALF + wr * 64 + m * 16 + fr) * ldc + col0;
#pragma unroll
                for (int bj = 0; bj < 2; ++bj)
#pragma unroll
                    for (int n = 0; n < 2; ++n) *(f32x4*)(rowp + bj * HALF + n * 16) = acc[ai][bj][m][n]; }
    }
};
struct EpiSwiGLU {
    static constexpr bool PERM = true;
    bf16_t* H;
    __device__ __forceinline__ void operator()(const f32x4 (&acc)[2][2][4][2], const Unit& u, int wr, int wc, int fr, int fq) const {
        const int col0 = (u.pn & 3) * 128 + wc * 32 + 8 * fq;
#pragma unroll
        for (int ai = 0; ai < 2; ++ai)
#pragma unroll
            for (int m = 0; m < 4; ++m) { bf16_t* rowp = H + (size_t)(u.pm * BM + ai * HALF + wr * 64 + m * 16 + fr) * 512 + col0;
                float h[8];
#pragma unroll
                for (int n = 0; n < 2; ++n)
#pragma unroll
                    for (int k = 0; k < 4; ++k) { const float gt = acc[ai][0][m][n][k], up = acc[ai][1][m][n][k];
                        h[n * 4 + k] = gt * __builtin_amdgcn_rcpf(1.f + __builtin_amdgcn_exp2f(-1.4426950408889634f * gt)) * up; }
                u32x4 w; w.x = cvt_pk_bf16(h[0], h[1]); w.y = cvt_pk_bf16(h[2], h[3]); w.z = cvt_pk_bf16(h[4], h[5]); w.w = cvt_pk_bf16(h[6], h[7]);
                *(u32x4*)rowp = w; }
    }
};
struct EpiDown {
    static constexpr bool PERM = true;
    bf16_t* SO;
    __device__ __forceinline__ void operator()(const f32x4 (&acc)[2][2][4][2], const Unit& u, int wr, int wc, int fr, int fq) const {
        const int col0 = (u.pn & 3) * BM + wc * 32 + 8 * fq;
#pragma unroll
        for (int ai = 0; ai < 2; ++ai)
#pragma unroll
            for (int m = 0; m < 4; ++m) { const int r = ai * HALF + wr * 64 + m * 16 + fr;
                if (r < u.nvalid) { const int ent = u.rows[r]; bf16_t* rowp = SO + (size_t)ent * 1024 + col0;
#pragma unroll
                    for (int bj = 0; bj < 2; ++bj) { const f32x4 v0 = acc[ai][bj][m][0], v1 = acc[ai][bj][m][1];
                        u32x4 w; w.x = cvt_pk_bf16(v0[0], v0[1]); w.y = cvt_pk_bf16(v0[2], v0[3]); w.z = cvt_pk_bf16(v1[0], v1[1]); w.w = cvt_pk_bf16(v1[2], v1[3]);
                        *(u32x4*)(rowp + bj * HALF) = w; } } }
    }
};

template <class Epi, class Sched, bool GATHER>
__device__ __forceinline__ void gemm_phase(PG8_LAS unsigned char* lds, const Gemm g, const Sched& S, const Epi& E) {
    const int tid = threadIdx.x, wid = __builtin_amdgcn_readfirstlane(tid >> 6), lane = tid & 63, wr = wid >> 2, wc = wid & 3, fr = lane & 15, fq = lane >> 4;
    const int K = g.K, nt = K / BK;
    int Rr[2], Cc[2]; unsigned voffB[2];
#pragma unroll
    for (int i = 0; i < 2; ++i) { int R, C; stage_rc(tid * 16 + i * 8192, R, C); Rr[i] = R; Cc[i] = C; const int Rb = Epi::PERM ? ((R & ~31) + perm32(R & 31)) : R; voffB[i] = (unsigned)(Rb * K + C) * 2u; }
    const size_t kstep = (size_t)(BK * 2);
    const size_t hstep = (size_t)HALF * K * 2;
    const size_t tstep = 2 * hstep;
    const unsigned ldsw = (unsigned)wid * 1024u;
    const int aoff = lds_byte(wr * 64 + fr, fq * 8), boff = lds_byte(wc * 32 + fr, fq * 8);
#define PG8_SA(b, h) (((b) * 2 + (h)) * HTB)
#define PG8_SB(b, h) ((4 + (b) * 2 + (h)) * HTB)
#define PG8_STAGE(bufoff, gbase, voff) do { _Pragma("unroll") for (int _i = 0; _i < 2; ++_i) \
        __builtin_amdgcn_global_load_lds((const unsigned*)((const char*)(gbase) + (voff)[_i]), (PG8_LAS unsigned*)(lds + (bufoff) + ldsw + _i * 8192), 16, 0, 0); } while (0)
#define PG8_LDA(dst, b, h) do { _Pragma("unroll") for (int m = 0; m < 4; ++m) _Pragma("unroll") for (int k = 0; k < 2; ++k) dst[m][k] = *(const PG8_LAS bf16x8*)(lds + PG8_SA(b, h) + aoff + m * 2048 + k * 1024); } while (0)
#define PG8_LDB(dst, b, h) do { _Pragma("unroll") for (int n = 0; n < 2; ++n) _Pragma("unroll") for (int k = 0; k < 2; ++k) dst[n][k] = *(const PG8_LAS bf16x8*)(lds + PG8_SB(b, h) + boff + n * 2048 + k * 1024); } while (0)
#define PG8_MMA(ai, bj, At, Bt) do { __builtin_amdgcn_s_setprio(1); _Pragma("unroll") for (int m = 0; m < 4; ++m) _Pragma("unroll") for (int n = 0; n < 2; ++n) _Pragma("unroll") for (int k = 0; k < 2; ++k) \
        acc[ai][bj][m][n] = __builtin_amdgcn_mfma_f32_16x16x32_bf16(Bt[n][k], At[m][k], acc[ai][bj][m][n], 0, 0, 0); __builtin_amdgcn_s_setprio(0); } while (0)
#define PG8_WAIT_V(n) asm volatile("s_waitcnt vmcnt(" #n ")" ::: "memory")
#define PG8_WAIT_L(n) asm volatile("s_waitcnt lgkmcnt(" #n ")" ::: "memory")
#define PG8_BAR __builtin_amdgcn_s_barrier()
#define PG8_SCHED __builtin_amdgcn_sched_barrier(0)
#define PG8_CALC_VOFF(u, vo) do { _Pragma("unroll") for (int h_ = 0; h_ < 2; ++h_) _Pragma("unroll") for (int i_ = 0; i_ < 2; ++i_) { \
        if constexpr (GATHER) { const int tok_ = S.arow(u, h_ * HALF + Rr[i_]); vo[h_][i_] = (unsigned)(tok_ * K + Cc[i_]) * 2u; } \
        else vo[h_][i_] = (unsigned)(Rr[i_] * K + Cc[i_]) * 2u + (unsigned)(h_ * hstep); } } while (0)
    Unit cur, nxt; int ui = 0;
    if (!S.next(0, cur)) return;
    unsigned vA[2][2], nvA[2][2];
    PG8_CALC_VOFF(cur, vA);
    if constexpr (GATHER) asm volatile("" : "+v"(vA[0][0]), "+v"(vA[0][1]), "+v"(vA[1][0]), "+v"(vA[1][1]));
    f32x4 acc[2][2][4][2];
#pragma unroll
    for (int a = 0; a < 2; ++a)
#pragma unroll
        for (int b = 0; b < 2; ++b)
#pragma unroll
            for (int m = 0; m < 4; ++m)
#pragma unroll
                for (int n = 0; n < 2; ++n) acc[a][b][m][n] = (f32x4){0.f, 0.f, 0.f, 0.f};
    bf16x8 At[4][2], B0[2][2], B1[2][2];
    const char* cA = GATHER ? (const char*)g.A : (const char*)g.A + (size_t)cur.pm * tstep; const char* cB = (const char*)g.Bt + (size_t)cur.pn * tstep;
    PG8_STAGE(PG8_SB(0, 0), cB, voffB); PG8_STAGE(PG8_SB(0, 1), cB + hstep, voffB); PG8_STAGE(PG8_SA(0, 0), cA, vA[0]); PG8_STAGE(PG8_SA(0, 1), cA, vA[1]);
    if (wr == 1) PG8_BAR;
    PG8_WAIT_V(2); PG8_BAR;
    PG8_STAGE(PG8_SB(1, 0), cB + kstep, voffB); PG8_STAGE(PG8_SA(1, 0), cA + kstep, vA[0]); PG8_STAGE(PG8_SB(1, 1), cB + hstep + kstep, voffB);
    PG8_WAIT_V(6); PG8_BAR;
    for (;;) {
        const bool has_next = S.next(ui + 1, nxt);
        const char* nA = has_next ? (GATHER ? (const char*)g.A : (const char*)g.A + (size_t)nxt.pm * tstep) : cA; const char* nB = has_next ? (const char*)g.Bt + (size_t)nxt.pn * tstep : cB;
        if constexpr (GATHER) {
            if (has_next) { PG8_CALC_VOFF(nxt, nvA); }
            else {
#pragma unroll
                for (int h_ = 0; h_ < 2; ++h_)
#pragma unroll
                    for (int i_ = 0; i_ < 2; ++i_) nvA[h_][i_] = vA[h_][i_]; }
            asm volatile("" : "+v"(nvA[0][0]), "+v"(nvA[0][1]), "+v"(nvA[1][0]), "+v"(nvA[1][1]));
        }
        for (int t = 0; t < nt; t += 2) {
            const bool last = (t == nt - 2);
            const char* a1 = cA + (size_t)(t + 1) * kstep;
            const char* a2 = last ? nA : cA + (size_t)(t + 2) * kstep; const char* b2 = last ? nB : cB + (size_t)(t + 2) * kstep;
            const char* a3 = a2 + kstep; const char* b3 = b2 + kstep;
            unsigned w0[2], w1[2];
#pragma unroll
            for (int i_ = 0; i_ < 2; ++i_) { w0[i_] = (GATHER && last) ? nvA[0][i_] : vA[0][i_]; w1[i_] = (GATHER && last) ? nvA[1][i_] : vA[1][i_]; }
            PG8_LDB(B0, 0, 0); PG8_LDB(B1, 0, 1); PG8_SCHED; PG8_LDA(At, 0, 0); PG8_STAGE(PG8_SA(1, 1), a1, vA[1]);
            PG8_WAIT_V(8); PG8_WAIT_L(0); PG8_BAR; PG8_MMA(0, 0, At, B0); PG8_MMA(0, 1, At, B1); PG8_BAR; PG8_SCHED;
            PG8_LDA(At, 0, 1); PG8_STAGE(PG8_SB(0, 0), b2, voffB); PG8_STAGE(PG8_SB(0, 1), b2 + hstep, voffB); PG8_STAGE(PG8_SA(0, 0), a2, w0);
            PG8_WAIT_V(8); PG8_WAIT_L(0); PG8_BAR; PG8_MMA(1, 0, At, B0); PG8_MMA(1, 1, At, B1); PG8_BAR; PG8_SCHED;
            PG8_LDB(B0, 1, 0); PG8_LDB(B1, 1, 1); PG8_SCHED; PG8_LDA(At, 1, 0); PG8_STAGE(PG8_SA(0, 1), a2, w1);
            PG8_WAIT_V(8); PG8_WAIT_L(0); PG8_BAR; PG8_MMA(0, 0, At, B0); PG8_MMA(0, 1, At, B1); PG8_BAR; PG8_SCHED;
            PG8_LDA(At, 1, 1); PG8_STAGE(PG8_SB(1, 0), b3, voffB); PG8_STAGE(PG8_SB(1, 1), b3 + hstep, voffB); PG8_STAGE(PG8_SA(1, 0), a3, w0);
            PG8_WAIT_V(8); PG8_WAIT_L(0); PG8_BAR; PG8_MMA(1, 0, At, B0); PG8_MMA(1, 1, At, B1); PG8_BAR; PG8_SCHED;
        }
        if (wr == 0) PG8_BAR;
        E(acc, cur, wr, wc, fr, fq);
        if (!has_next) break;
#pragma unroll
        for (int a = 0; a < 2; ++a)
#pragma unroll
            for (int b = 0; b < 2; ++b)
#pragma unroll
                for (int m = 0; m < 4; ++m)
#pragma unroll
                    for (int n = 0; n < 2; ++n) acc[a][b][m][n] = (f32x4){0.f, 0.f, 0.f, 0.f};
        cur = nxt; cA = nA; cB = nB; ++ui;
        if constexpr (GATHER) {
#pragma unroll
            for (int h_ = 0; h_ < 2; ++h_)
#pragma unroll
                for (int i_ = 0; i_ < 2; ++i_) vA[h_][i_] = nvA[h_][i_]; }
        if (wr == 1) PG8_BAR;
    }
    PG8_WAIT_V(0);
    PG8_BAR;
#undef PG8_SA
#undef PG8_SB
#undef PG8_STAGE
#undef PG8_LDA
#undef PG8_LDB
#undef PG8_MMA
#undef PG8_WAIT_V
#undef PG8_WAIT_L
#undef PG8_BAR
#undef PG8_SCHED
#undef PG8_CALC_VOFF
}
}

namespace attn_body {
using bf16=__hip_bfloat16;
using bf16x8=__attribute__((ext_vector_type(8)))short;
using s16x4=__attribute__((ext_vector_type(4)))short;
using f32x16=__attribute__((ext_vector_type(16)))float;
using u32x4=__attribute__((ext_vector_type(4)))unsigned;
constexpr int SEQ=16384,D=64;
constexpr int LDQ=3072;
constexpr int LDO=1024;
constexpr int NW=8,QBLK=32,QB=QBLK*NW,KVBLK=64,NQB=SEQ/QB;
__device__ __forceinline__ int crow(int r,int hi){return (r&3)+8*(r>>2)+4*hi;}
#define SBAR() __builtin_amdgcn_sched_barrier(0)
typedef __attribute__((address_space(3))) const float* lds_cfptr;
__device__ __forceinline__ void biasmask(f32x16&p0,f32x16&p1,int jb,int qrel,int hi,lds_cfptr bl){
  const float NEG=-INFINITY; const int kb=64*jb+4*hi;
  #pragma unroll
  for(int g=0;g<4;++g){
    #pragma unroll
    for(int rr=0;rr<4;++rr){const int r=4*g+rr; const int kv=kb+(r&3)+8*(r>>2); const int d0=qrel-kv,d1=d0-32;
      const int i0=d0<0?0:(d0>127?127:d0), i1=d1<0?0:(d1>127?127:d1);
      const float b0=bl[i0],b1=bl[i1];
      p0[r]=d0<0?NEG:p0[r]+b0; p1[r]=d1<0?NEG:p1[r]+b1;}
    __builtin_amdgcn_sched_barrier(0); }
}

constexpr int NSLOT=3, SLOTB=8192;
constexpr int LDS_K=0, LDS_V=NSLOT*SLOTB, LDS_WS=2*NSLOT*SLOTB, LDS_OST=LDS_WS+NW*128*4, LDS_BIAS=LDS_OST+NW*4096, LDS_BYTES=LDS_BIAS+512;
constexpr float C2=0.125f*1.4426950408889634f;
__device__ __forceinline__ void glds16(const void*gsrc,unsigned lds_dst){unsigned keep;
  asm volatile("s_mov_b32 %0, m0\n\ts_mov_b32 m0, %2\n\ts_nop 0\n\tglobal_load_lds_dwordx4 %1, off\n\ts_mov_b32 m0, %0":"=&s"(keep):"v"(gsrc),"s"(lds_dst):"memory");}
__device__ __forceinline__ float max3f(float a,float b,float c){float r;asm("v_max3_f32 %0, %1, %2, %3":"=v"(r):"v"(a),"v"(b),"v"(c));return r;}
__device__ __forceinline__ float max2f(float a,float b){float r;asm("v_max_f32_e32 %0, %1, %2":"=v"(r):"v"(a),"v"(b));return r;}
__device__ __forceinline__ float fadd_s(float a,float b){float r;asm("v_add_f32_e32 %0, %1, %2":"=v"(r):"v"(a),"v"(b));return r;}
__device__ __forceinline__ float fsub_s(float a,float b){float r;asm("v_sub_f32_e32 %0, %1, %2":"=v"(r):"v"(a),"v"(b));return r;}
typedef float f32x2_t __attribute__((ext_vector_type(2))); typedef __bf16 bf16x2_t __attribute__((ext_vector_type(2)));
__device__ __forceinline__ unsigned cvtpk_s(float lo,float hi){f32x2_t v={lo,hi};bf16x2_t b=__builtin_convertvector(v,bf16x2_t);return __builtin_bit_cast(unsigned,b);}
#define WAIT_BAR(N) asm volatile("s_waitcnt vmcnt(" #N ") lgkmcnt(0)\n\ts_barrier":::"memory")

__device__ __forceinline__ void qkt(f32x16&p0,f32x16&p1,const char*Kslot,const bf16x8*qr,const f32x16&negm,int r32,int hi){
  const char*kb=Kslot+hi*1024+r32*16;
  #pragma unroll
  for(int d0=0;d0<4;++d0){
    const bf16x8 b0=*reinterpret_cast<const bf16x8*>(kb+d0*2048);
    const bf16x8 b1=*reinterpret_cast<const bf16x8*>(kb+d0*2048+512);
    if(d0==0){p0=__builtin_amdgcn_mfma_f32_32x32x16_bf16(b0,qr[0],negm,0,0,0);p1=__builtin_amdgcn_mfma_f32_32x32x16_bf16(b1,qr[0],negm,0,0,0);}
    else{p0=__builtin_amdgcn_mfma_f32_32x32x16_bf16(b0,qr[d0],p0,0,0,0);p1=__builtin_amdgcn_mfma_f32_32x32x16_bf16(b1,qr[d0],p1,0,0,0);}}
}
typedef __attribute__((address_space(3))) const char* lds_cptr;
typedef short v4i16_t __attribute__((ext_vector_type(4)));
__device__ __forceinline__ void kload8(bf16x8*kf,lds_cptr kp){
  kf[0]=*(const __attribute__((address_space(3))) bf16x8*)(kp);      kf[1]=*(const __attribute__((address_space(3))) bf16x8*)(kp+512);
  kf[2]=*(const __attribute__((address_space(3))) bf16x8*)(kp+2048); kf[3]=*(const __attribute__((address_space(3))) bf16x8*)(kp+2560);
  kf[4]=*(const __attribute__((address_space(3))) bf16x8*)(kp+4096); kf[5]=*(const __attribute__((address_space(3))) bf16x8*)(kp+4608);
  kf[6]=*(const __attribute__((address_space(3))) bf16x8*)(kp+6144); kf[7]=*(const __attribute__((address_space(3))) bf16x8*)(kp+6656);
}
__device__ __forceinline__ void kload2(bf16x8*kf,lds_cptr kp,int j){ kf[2*j]=*(const __attribute__((address_space(3))) bf16x8*)(kp+j*2048); kf[2*j+1]=*(const __attribute__((address_space(3))) bf16x8*)(kp+j*2048+512); }
__device__ __forceinline__ s16x4 vtr(lds_cptr p){ return __builtin_bit_cast(s16x4,__builtin_amdgcn_ds_read_tr16_b64_v4i16((__attribute__((address_space(3))) v4i16_t*)p)); }
__device__ __forceinline__ float rowmax(const f32x16&p0,const f32x16&p1){
  float a=max3f(p0[0],p0[1],p1[0]),b=max3f(p0[2],p0[3],p1[1]);a=max3f(a,p1[2],p1[3]);
  #pragma unroll
  for(int r=4;r<16;r+=4){a=max3f(a,p0[r],p0[r+1]);b=max3f(b,p0[r+2],p0[r+3]);a=max3f(a,p1[r],p1[r+1]);b=max3f(b,p1[r+2],p1[r+3]);}
  const float m=max2f(a,b);
  auto rr=__builtin_amdgcn_permlane32_swap(__float_as_uint(m),__float_as_uint(m),false,false);
  return max2f(__uint_as_float(rr[0]),__uint_as_float(rr[1]));
}
__device__ __forceinline__ float rowmax_c(const f32x16&p0,const f32x16&p1){
  float a=__builtin_fmaxf(p0[0],p1[0]);
  #pragma unroll
  for(int r=1;r<16;++r){a=__builtin_fmaxf(a,__builtin_fmaxf(p0[r],p1[r]));}
  auto rr=__builtin_amdgcn_permlane32_swap(__float_as_uint(a),__float_as_uint(a),false,false);
  return __builtin_fmaxf(__uint_as_float(rr[0]),__uint_as_float(rr[1]));
}
__device__ __forceinline__ void pv(f32x16*o,int vb,bf16x8 pa0,bf16x8 pa1,bf16x8 pa2,bf16x8 pa3){
  #pragma unroll
  for(int d0=0;d0<2;++d0){s16x4 lo[4],hi[4];
    #pragma unroll
    for(int ks=0;ks<4;++ks){
      asm volatile("ds_read_b64_tr_b16 %0,%1 offset:%c2":"=&v"(lo[ks]):"v"(vb),"i"(d0*4096+ks*1024):"memory");
      asm volatile("ds_read_b64_tr_b16 %0,%1 offset:%c2":"=&v"(hi[ks]):"v"(vb),"i"(d0*4096+ks*1024+512):"memory");}
    asm volatile("s_waitcnt lgkmcnt(0)":::"memory");SBAR();
    #define PK(k) (bf16x8){lo[k][0],lo[k][1],lo[k][2],lo[k][3],hi[k][0],hi[k][1],hi[k][2],hi[k][3]}
    o[d0]=__builtin_amdgcn_mfma_f32_32x32x16_bf16(pa0,PK(0),o[d0],0,0,0);
    o[d0]=__builtin_amdgcn_mfma_f32_32x32x16_bf16(pa1,PK(1),o[d0],0,0,0);
    o[d0]=__builtin_amdgcn_mfma_f32_32x32x16_bf16(pa2,PK(2),o[d0],0,0,0);
    o[d0]=__builtin_amdgcn_mfma_f32_32x32x16_bf16(pa3,PK(3),o[d0],0,0,0);
    #undef PK
  }
}
__device__ __forceinline__ float bflo(unsigned u){return __uint_as_float(u<<16);}
__device__ __forceinline__ float bfhi(unsigned u){return __uint_as_float(u&0xffff0000u);}

struct MobaMerge { const float* pml; const bf16* po; long grow0; int h; int ns; };
constexpr long MROWS=2L*SEQ;
struct GatherArgs { const unsigned* ent; int n; float* pml; bf16* po; long growb; int h; };
__device__ __forceinline__ void gbias(f32x16&p0,f32x16&p1,int dq,int hi,lds_cfptr bl){
  #pragma unroll
  for(int g=0;g<4;++g){
    #pragma unroll
    for(int rr=0;rr<4;++rr){const int r=4*g+rr; const int d0=dq-(4*hi+(r&3)+8*(r>>2)),d1=d0-32;
      const int i0=d0<0?0:(d0>127?127:d0), i1=d1<0?0:(d1>127?127:d1);
      p0[r]+=bl[i0]; p1[r]+=bl[i1];}
    __builtin_amdgcn_sched_barrier(0); }
}

template<int THRL,int MODE> __device__ __forceinline__ void attn_unit(const bf16*Qp,const bf16*__restrict__ Kp,const bf16*__restrict__ Vp,bf16*Op,int q0,int kv0,int NT,const float*biasG,const MobaMerge&mm,const GatherArgs&ga,char*shm){
  int tid=threadIdx.x; asm volatile("":"+v"(tid));
  const int lane=tid&63,r32=lane&31,hi=lane>>5; const int wid=__builtin_amdgcn_readfirstlane(tid>>6);
  unsigned gent=0u; int qloc=0;
  if constexpr(MODE==2){ const int ei=wid*QBLK+r32; gent=ga.ent[ei<ga.n?ei:ga.n-1]; qloc=(int)(gent&0x3FFFu); }
  const bf16*Qw=(MODE==2)?(Qp+(long)(qloc-r32)*LDQ):(Qp+(long)(q0+wid*QBLK)*LDQ);
  const bf16*Kh=Kp+(long)kv0*LDQ,*Vh=Vp+(long)kv0*LDQ;
  const unsigned lds0=(unsigned)(uintptr_t)shm;
  float*wsf=(float*)(shm+LDS_WS)+wid*128;
  const lds_cptr shm3=(lds_cptr)shm;
  asm volatile("":"+s"(biasG));
  { __attribute__((address_space(3))) float* blw=(__attribute__((address_space(3))) float*)(shm3+LDS_BIAS); if(tid<128)blw[tid]=biasG[tid]; }
  const lds_cfptr bl=(lds_cfptr)(shm3+LDS_BIAS);
  const bf16*ksrc=Kh+(long)lane*LDQ+wid*8;
  const bf16*vsrc=Vh+(long)(16*(wid&3)+(lane>>2))*LDQ+(wid>>2)*32+(lane&3)*8;
  const unsigned kdst=lds0+LDS_K+wid*1024, vdst=lds0+LDS_V+wid*1024;
  #define DMA_K(t,slot) glds16(ksrc+(long)(t)*KVBLK*LDQ,(unsigned)__builtin_amdgcn_readfirstlane(kdst+(slot)))
  #define DMA_V(t,slot) glds16(vsrc+(long)(t)*KVBLK*LDQ,(unsigned)__builtin_amdgcn_readfirstlane(vdst+(slot)))
  const int vb0=(int)(lds0+LDS_V)+((lane>>4)&1)*32+(lane&3)*8+(4*hi+((lane&15)>>2))*64;
  const char*Kbase=shm+LDS_K; bf16x8 kf[8];
  const lds_cptr kp0=shm3+LDS_K+hi*1024+r32*16; const lds_cptr vp0=shm3+LDS_V+((lane>>4)&1)*32+(lane&3)*8+(4*hi+((lane&15)>>2))*64;
  asm volatile("s_waitcnt vmcnt(0)":::"memory");
  DMA_K(0,0);DMA_V(0,0);DMA_K(1,SLOTB);
  bf16x8 qr[4];
  #pragma unroll
  for(int d0=0;d0<4;++d0)qr[d0]=*reinterpret_cast<const bf16x8*>(&Qw[(long)r32*LDQ+d0*16+hi*8]);
  float mhat=0.f,l_reg=0.f;f32x16 o[2];o[0]=f32x16{};o[1]=f32x16{};f32x16 negm=f32x16{};asm volatile("":"+v"(negm));
  const int qrel=wid*QBLK+r32;
  const bool nearq=(MODE==2)?(bool)__any(qloc-(kv0+128)<128+113):false;
  #define CMASK(P0,P1,t) do{ if constexpr(MODE==2){ if((t)>=2 && nearq)gbias(P0,P1,qloc-(kv0+64*(t)),hi,bl); } else { int jb_=(t)-(NT-4); if(jb_>=-2 && (32*wid-(64*jb_+63))<113)biasmask(P0,P1,jb_,qrel,hi,bl); } }while(0)
  bool resc=false;
  #define START(P0,P1) do{ const float rm=rowmax(P0,P1); resc=false; \
    { const float dl=rm; mhat=fadd_s(mhat,dl); \
      _Pragma("unroll") for(int r=0;r<16;++r){P0[r]=fsub_s(P0[r],dl);P1[r]=fsub_s(P1[r],dl);} \
      _Pragma("unroll") for(int r=0;r<16;++r)negm[r]=-mhat; asm volatile("":"+v"(negm)); } \
    _Pragma("unroll") for(int r=0;r<16;++r)P0[r]=__builtin_amdgcn_exp2f(P0[r]); }while(0)
  #define RESC() do{ if(resc){ asm volatile("s_waitcnt lgkmcnt(0)":::"memory"); \
      _Pragma("unroll") for(int d_=0;d_<2;++d_) _Pragma("unroll") for(int r=0;r<16;++r)o[d_][r]*=wsf[crow(r,hi)]; } }while(0)
  f32x16 pA0,pA1,pB0,pB1;
  int sl_prev=0,sl_cur=0,sl_next=SLOTB;
  #define ROT() do{sl_prev=sl_cur;sl_cur=sl_next;sl_next=(sl_next==(NSLOT-1)*SLOTB)?0:sl_next+SLOTB;}while(0)
  DMA_K(2,2*SLOTB);
  WAIT_BAR(3);
  qkt(pA0,pA1,Kbase,qr,negm,r32,hi);asm volatile("s_nop 15\n\ts_nop 7":"+v"(pA0),"+v"(pA1));CMASK(pA0,pA1,0);
  START(pA0,pA1);
  _Pragma("unroll") for(int r=0;r<16;++r)pA1[r]=__builtin_amdgcn_exp2f(pA1[r]);
  WAIT_BAR(0);
  DMA_K(3,0);DMA_V(1,SLOTB);
  ROT();
  kload8(kf,kp0+sl_cur);
  WAIT_BAR(2);
  s16x4 vlo[8],vhi[8]; u32x4 pw0,pw1,pw2,pw3;
  #define PKW(P,B) cvtpk_s(P[B],P[B+1])
  #define PAF(k) __builtin_bit_cast(bf16x8,pw##k)
  #define VFR(i) (bf16x8){vlo[i][0],vlo[i][1],vlo[i][2],vlo[i][3],vhi[i][0],vhi[i][1],vhi[i][2],vhi[i][3]}
  #define PIN(x) asm volatile("":"+v"(x))
  #define MX3(a,b,c) __builtin_fmaxf(__builtin_fmaxf((a),(b)),(c))
  #define GAPA(MF,A0,A1,A2,A3,W0,W1,PW) do{ MF; sacc+=A0; sacc+=A1; sacc+=A2; sacc+=A3; PIN(sacc); W0; W1; PIN(PW); SBAR(); }while(0)
  #define EX(v) __builtin_amdgcn_exp2f(v)
  #define GAPB(MF,X,B) do{ MF; { float e0_=EX(X[B]),e1_=EX(X[B+1]),e2_=EX(X[B+2]),e3_=EX(X[B+3]); asm volatile("":"+v"(e0_),"+v"(e1_),"+v"(e2_),"+v"(e3_)); X[B]=e0_;X[B+1]=e1_;X[B+2]=e2_;X[B+3]=e3_; } SBAR(); }while(0)
  #define VRD(i) do{ vlo[i]=vtr(vp_+(((i)>>2)*4096+((i)&3)*1024)); vhi[i]=vtr(vp_+(((i)>>2)*4096+((i)&3)*1024+512)); }while(0)
  #define KRD(G,j) do{ if(G){ kload2(kf,kp0+sl_next,j); SBAR(); } }while(0)
  #define STEP(C0,C1,P0,P1,t,GK,GV,GL) do{ SBAR(); \
    const lds_cptr vp_=vp0+sl_prev; \
    VRD(0); SBAR(); float sacc=(P0[0]+P0[1]); \
    GAPA(C0=__builtin_amdgcn_mfma_f32_32x32x16_bf16(kf[0],qr[0],negm,0,0,0), P0[2],P0[3],P0[4],P0[5],     pw0[0]=PKW(P0,0), pw0[1]=PKW(P0,2), pw0); \
    VRD(4); SBAR(); GAPA(C1=__builtin_amdgcn_mfma_f32_32x32x16_bf16(kf[1],qr[0],negm,0,0,0), P0[6],P0[7],P0[8],P0[9],     pw0[2]=PKW(P0,4), pw0[3]=PKW(P0,6), pw0); \
    VRD(1); SBAR(); GAPA(C0=__builtin_amdgcn_mfma_f32_32x32x16_bf16(kf[2],qr[1],C0,0,0,0),   P0[10],P0[11],P0[12],P0[13], pw1[0]=PKW(P0,8), pw1[1]=PKW(P0,10), pw1); \
    VRD(5); SBAR(); GAPA(C1=__builtin_amdgcn_mfma_f32_32x32x16_bf16(kf[3],qr[1],C1,0,0,0),   P0[14],P0[15],P1[0],P1[1],   pw1[2]=PKW(P0,12),pw1[3]=PKW(P0,14), pw1); \
    VRD(2); SBAR(); GAPA(C0=__builtin_amdgcn_mfma_f32_32x32x16_bf16(kf[4],qr[2],C0,0,0,0),   P1[2],P1[3],P1[4],P1[5],     pw2[0]=PKW(P1,0), pw2[1]=PKW(P1,2), pw2); \
    VRD(6); SBAR(); GAPA(C1=__builtin_amdgcn_mfma_f32_32x32x16_bf16(kf[5],qr[2],C1,0,0,0),   P1[6],P1[7],P1[8],P1[9],     pw2[2]=PKW(P1,4), pw2[3]=PKW(P1,6), pw2); \
    VRD(3); SBAR(); GAPA(C0=__builtin_amdgcn_mfma_f32_32x32x16_bf16(kf[6],qr[3],C0,0,0,0),   P1[10],P1[11],P1[12],P1[13], pw3[0]=PKW(P1,8), pw3[1]=PKW(P1,10), pw3); \
    VRD(7); SBAR(); GAPA(C1=__builtin_amdgcn_mfma_f32_32x32x16_bf16(kf[7],qr[3],C1,0,0,0),   P1[14],P1[15],0.f,0.f,       pw3[2]=PKW(P1,12),pw3[3]=PKW(P1,14), pw3); \
    l_reg+=sacc; \
    if(GK){DMA_K((t)+3,sl_cur);} if(GV){DMA_V((t)+1,sl_next);} \
    CMASK(C0,C1,t); \
    { float a=MX3(C0[0],C0[1],C1[0]),b=MX3(C0[2],C0[3],C1[1]); a=MX3(a,C1[2],C1[3]); \
      _Pragma("unroll") for(int r=4;r<16;r+=4){a=MX3(a,C0[r],C0[r+1]);b=MX3(b,C0[r+2],C0[r+3]);a=MX3(a,C1[r],C1[r+1]);b=MX3(b,C1[r+2],C1[r+3]);} \
      float rm=__builtin_fmaxf(a,b); { auto rr=__builtin_amdgcn_permlane32_swap(__float_as_uint(rm),__float_as_uint(rm),false,false); rm=__builtin_fmaxf(__uint_as_float(rr[0]),__uint_as_float(rr[1])); } \
      resc=false; \
      if(__builtin_expect(__any(rm>(float)THRL),0)){ const float dl=__builtin_fmaxf(rm,0.f); mhat+=dl; \
        _Pragma("unroll") for(int r=0;r<16;++r){C0[r]-=dl;C1[r]-=dl;} \
        _Pragma("unroll") for(int r=0;r<16;++r)negm[r]=-mhat; asm volatile("":"+v"(negm)); \
        const float f=__builtin_amdgcn_exp2f(-dl); l_reg*=f; if(hi==0)wsf[r32]=f; resc=true; } } \
    SBAR(); \
    GAPB(o[0]=__builtin_amdgcn_mfma_f32_32x32x16_bf16(PAF(0),VFR(0),o[0],0,0,0), C0,0); \
    GAPB(o[1]=__builtin_amdgcn_mfma_f32_32x32x16_bf16(PAF(0),VFR(4),o[1],0,0,0), C0,4); \
    KRD(GL,0); GAPB(o[0]=__builtin_amdgcn_mfma_f32_32x32x16_bf16(PAF(1),VFR(1),o[0],0,0,0), C0,8); \
    KRD(GL,1); GAPB(o[1]=__builtin_amdgcn_mfma_f32_32x32x16_bf16(PAF(1),VFR(5),o[1],0,0,0), C0,12); \
    KRD(GL,2); GAPB(o[0]=__builtin_amdgcn_mfma_f32_32x32x16_bf16(PAF(2),VFR(2),o[0],0,0,0), C1,0); \
    KRD(GL,3); GAPB(o[1]=__builtin_amdgcn_mfma_f32_32x32x16_bf16(PAF(2),VFR(6),o[1],0,0,0), C1,4); \
    GAPB(o[0]=__builtin_amdgcn_mfma_f32_32x32x16_bf16(PAF(3),VFR(3),o[0],0,0,0), C1,8); \
    GAPB(o[1]=__builtin_amdgcn_mfma_f32_32x32x16_bf16(PAF(3),VFR(7),o[1],0,0,0), C1,12); \
    }while(0)
  int t=1;
  #undef CMASK
  #define CMASK(P0,P1,t) do{}while(0)
  for(;t+7<NT;t+=2){
    STEP(pB0,pB1,pA0,pA1,t,true,true,true);     WAIT_BAR(2); RESC(); ROT();
    STEP(pA0,pA1,pB0,pB1,t+1,true,true,true);   WAIT_BAR(2); RESC(); ROT();
  }
  #undef CMASK
  #define CMASK(P0,P1,t) do{ if constexpr(MODE==2){ if((t)>=2 && nearq)gbias(P0,P1,qloc-(kv0+64*(t)),hi,bl); } else { int jb_=(t)-(NT-4); if(jb_>=-2 && (32*wid-(64*jb_+63))<113)biasmask(P0,P1,jb_,qrel,hi,bl); } }while(0)
  #define ENDW(tt) do{ if((tt)+3<NT){WAIT_BAR(2);} else if((tt)+2<NT){WAIT_BAR(1);} else {WAIT_BAR(0);} }while(0)
  for(;t+1<NT;t+=2){
    STEP(pB0,pB1,pA0,pA1,t,(t+3<NT),(t+1<NT),(t+1<NT));       ENDW(t);   RESC(); ROT();
    STEP(pA0,pA1,pB0,pB1,t+1,(t+4<NT),(t+2<NT),(t+2<NT));     ENDW(t+1); RESC(); ROT();
  }
  STEP(pB0,pB1,pA0,pA1,NT-1,false,false,false); RESC();
  { float sacc=pB0[0]+pB0[1]; _Pragma("unroll") for(int r=2;r<16;++r)sacc+=pB0[r]; _Pragma("unroll") for(int r=0;r<16;++r)sacc+=pB1[r]; l_reg+=sacc;
    pw0=(u32x4){PKW(pB0,0),PKW(pB0,2),PKW(pB0,4),PKW(pB0,6)};pw1=(u32x4){PKW(pB0,8),PKW(pB0,10),PKW(pB0,12),PKW(pB0,14)};pw2=(u32x4){PKW(pB1,0),PKW(pB1,2),PKW(pB1,4),PKW(pB1,6)};pw3=(u32x4){PKW(pB1,8),PKW(pB1,10),PKW(pB1,12),PKW(pB1,14)};
    SBAR(); pv(o,vb0+sl_cur,PAF(0),PAF(1),PAF(2),PAF(3)); }
  #undef PKW
  #undef PAF
  #undef VFR
  #undef PIN
  #undef MX3
  #undef GAPA
  #undef GAPB
  #undef EX
  #undef VRD
  #undef KRD
  #undef STEP
  #undef ENDW
  {auto rr=__builtin_amdgcn_permlane32_swap(__float_as_uint(l_reg),__float_as_uint(l_reg),false,false);l_reg=__uint_as_float(rr[0])+__uint_as_float(rr[1]);}
  const float*pml_=mm.pml; const bf16*po_=mm.po; if constexpr(MODE==1){ asm volatile("":"+s"(pml_),"+s"(po_)); }
  if constexpr(MODE==1){
    const long gr=mm.grow0+wid*QBLK+r32; float ms[3],ls[3],as[3]; float Mx=mhat;
    #pragma unroll
    for(int s=0;s<3;++s){ ms[s]=-INFINITY; ls[s]=0.f; if(s<mm.ns){ const f32x2_t v=*(const f32x2_t*)(pml_+((long)s*MROWS+gr)*16+mm.h*2); ms[s]=v.x; ls[s]=v.y; Mx=__builtin_fmaxf(Mx,ms[s]); } }
    const float a0=__builtin_amdgcn_exp2f(mhat-Mx); float L=a0*l_reg;
    #pragma unroll
    for(int s=0;s<3;++s){ as[s]=(s<mm.ns)?__builtin_amdgcn_exp2f(ms[s]-Mx):0.f; L+=as[s]*ls[s]; }
    const float inv=1.0f/L;
    if(hi==0){wsf[32+r32]=a0*inv;wsf[64+r32]=as[0]*inv;wsf[96+r32]=as[1]*inv;wsf[r32]=as[2]*inv;}
  } else if constexpr(MODE==2){
    if(hi==0){ wsf[32+r32]=1.0f; if(wid*QBLK+r32<ga.n){ f32x2_t v={mhat,l_reg}; *(f32x2_t*)(ga.pml+((long)(gent>>14)*MROWS+ga.growb+qloc)*16+ga.h*2)=v; } }
  } else {
    if(hi==0)wsf[32+r32]=1.0f/l_reg;
  }
  asm volatile("s_waitcnt lgkmcnt(0)":::"memory");
  float rli[16];
  #pragma unroll
  for(int r=0;r<16;++r)rli[r]=wsf[32+crow(r,hi)];
  { asm volatile("":"+s"(Op)); }
  bf16*Ow=Op+(long)(q0+wid*QBLK)*LDO;
  { bf16*stg=(bf16*)(shm+LDS_OST)+wid*2048;
    #pragma unroll
    for(int r=0;r<16;++r){const int orow=crow(r,hi);
      #pragma unroll
      for(int d0=0;d0<2;++d0)stg[orow*64+d0*32+r32]=__float2bfloat16(o[d0][r]*rli[r]);}
    asm volatile("s_waitcnt lgkmcnt(0)":::"memory");
    int lane_e=lane; asm volatile("":"+v"(lane_e));
    #pragma unroll
    for(int i=0;i<4;++i){const int row=i*8+(lane_e>>3),ch=lane_e&7; u32x4 v=*(const u32x4*)(stg+row*64+ch*8);
      if constexpr(MODE==1){
        float a[8]={bflo(v.x),bfhi(v.x),bflo(v.y),bfhi(v.y),bflo(v.z),bfhi(v.z),bflo(v.w),bfhi(v.w)};
        #pragma unroll
        for(int s=0;s<3;++s){ if(s<mm.ns){ const float c=wsf[(s==0?64:(s==1?96:0))+row];
            const u32x4 pp=*(const u32x4*)(po_+(((long)s*MROWS+mm.grow0+wid*QBLK+row)*8+mm.h)*64+ch*8);
            a[0]+=c*bflo(pp.x);a[1]+=c*bfhi(pp.x);a[2]+=c*bflo(pp.y);a[3]+=c*bfhi(pp.y);a[4]+=c*bflo(pp.z);a[5]+=c*bfhi(pp.z);a[6]+=c*bflo(pp.w);a[7]+=c*bfhi(pp.w);} }
        v.x=cvtpk_s(a[0],a[1]);v.y=cvtpk_s(a[2],a[3]);v.z=cvtpk_s(a[4],a[5]);v.w=cvtpk_s(a[6],a[7]);
      }
      if constexpr(MODE==2){ const unsigned er=(unsigned)__shfl((int)gent,row); if(wid*QBLK+row<ga.n) *(u32x4*)(ga.po+(((long)(er>>14)*MROWS+ga.growb+(long)(er&0x3FFFu))*8+ga.h)*64+ch*8)=v; }
      else *(u32x4*)(Ow+(long)row*LDO+ch*8)=v;} }
  asm volatile("s_waitcnt lgkmcnt(0)\n\ts_barrier":::"memory");
  #undef DMA_K
  #undef DMA_V
  #undef CMASK
  #undef START
  #undef RESC
  #undef ROT
}


constexpr int VSLOTB=16384;
constexpr int W_LDS_K=0, W_LDS_V=NSLOT*SLOTB, W_LDS_WS=W_LDS_V+NSLOT*VSLOTB, W_LDS_OST=W_LDS_WS+NW*128*4, W_LDS_BIAS=W_LDS_OST+NW*4096, W_LDS_BYTES=W_LDS_BIAS+512;
__device__ __forceinline__ void pv128(f32x16*o,int vb,bf16x8 pa0,bf16x8 pa1,bf16x8 pa2,bf16x8 pa3){
  #pragma unroll
  for(int d0=0;d0<4;++d0){s16x4 lo[4],hi[4];
    #pragma unroll
    for(int ks=0;ks<4;++ks){
      asm volatile("ds_read_b64_tr_b16 %0,%1 offset:%c2":"=&v"(lo[ks]):"v"(vb),"i"(d0*4096+ks*1024):"memory");
      asm volatile("ds_read_b64_tr_b16 %0,%1 offset:%c2":"=&v"(hi[ks]):"v"(vb),"i"(d0*4096+ks*1024+512):"memory");}
    asm volatile("s_waitcnt lgkmcnt(0)":::"memory");SBAR();
    #define PK(k) (bf16x8){lo[k][0],lo[k][1],lo[k][2],lo[k][3],hi[k][0],hi[k][1],hi[k][2],hi[k][3]}
    o[d0]=__builtin_amdgcn_mfma_f32_32x32x16_bf16(pa0,PK(0),o[d0],0,0,0);
    o[d0]=__builtin_amdgcn_mfma_f32_32x32x16_bf16(pa1,PK(1),o[d0],0,0,0);
    o[d0]=__builtin_amdgcn_mfma_f32_32x32x16_bf16(pa2,PK(2),o[d0],0,0,0);
    o[d0]=__builtin_amdgcn_mfma_f32_32x32x16_bf16(pa3,PK(3),o[d0],0,0,0);
    #undef PK
  }
}
template<int THRL> __device__ __forceinline__ void attn_unit128(const bf16*Qp,const bf16*__restrict__ Kp,const bf16*__restrict__ Vp,bf16*Op,int q0,int NT,const float*biasG,char*shm){
  int tid=threadIdx.x; asm volatile("":"+v"(tid));
  const int lane=tid&63,r32=lane&31,hi=lane>>5; const int wid=__builtin_amdgcn_readfirstlane(tid>>6);
  const bf16*Qw=Qp+(long)(q0+wid*QBLK)*LDQ;
  const bf16*Kh=Kp,*Vh=Vp;
  const unsigned lds0=(unsigned)(uintptr_t)shm;
  float*wsf=(float*)(shm+W_LDS_WS)+wid*128;
  const lds_cptr shm3=(lds_cptr)shm;
  asm volatile("":"+s"(biasG));
  { __attribute__((address_space(3))) float* blw=(__attribute__((address_space(3))) float*)(shm3+W_LDS_BIAS); if(tid<128)blw[tid]=biasG[tid]; }
  const lds_cfptr bl=(lds_cfptr)(shm3+W_LDS_BIAS);
  const bf16*ksrc=Kh+(long)lane*LDQ+wid*8;
  const bf16*vsrc=Vh+(long)(16*(wid&3)+(lane>>2))*LDQ+(wid>>2)*32+(lane&3)*8;
  const unsigned kdst=lds0+W_LDS_K+wid*1024, vdst=lds0+W_LDS_V+wid*1024;
  #define DMA_K(t,slot) glds16(ksrc+(long)(t)*KVBLK*LDQ,(unsigned)__builtin_amdgcn_readfirstlane(kdst+(slot)))
  #define DMA_V(t,slot) do{ glds16(vsrc+(long)(t)*KVBLK*LDQ,(unsigned)__builtin_amdgcn_readfirstlane(vdst+2*(slot))); glds16(vsrc+(long)(t)*KVBLK*LDQ+64,(unsigned)__builtin_amdgcn_readfirstlane(vdst+2*(slot)+8192)); }while(0)
  const int vb0=(int)(lds0+W_LDS_V)+((lane>>4)&1)*32+(lane&3)*8+(4*hi+((lane&15)>>2))*64;
  const char*Kbase=shm+W_LDS_K; bf16x8 kf[8];
  const lds_cptr kp0=shm3+W_LDS_K+hi*1024+r32*16; const lds_cptr vp0=shm3+W_LDS_V+((lane>>4)&1)*32+(lane&3)*8+(4*hi+((lane&15)>>2))*64;
  asm volatile("s_waitcnt vmcnt(0)":::"memory");
  DMA_K(0,0);DMA_V(0,0);DMA_K(1,SLOTB);
  bf16x8 qr[4];
  #pragma unroll
  for(int d0=0;d0<4;++d0)qr[d0]=*reinterpret_cast<const bf16x8*>(&Qw[(long)r32*LDQ+d0*16+hi*8]);
  float mhat=0.f,l_reg=0.f;f32x16 o[4];o[0]=f32x16{};o[1]=f32x16{};o[2]=f32x16{};o[3]=f32x16{};f32x16 negm=f32x16{};asm volatile("":"+v"(negm));
  const int qrel=wid*QBLK+r32;
  #define CMASK(P0,P1,t) do{int jb_=(t)-(NT-4); if(jb_>=-2 && (32*wid-(64*jb_+63))<113)biasmask(P0,P1,jb_,qrel,hi,bl);}while(0)
  bool resc=false;
  #define RESC() do{ if(resc){ asm volatile("s_waitcnt lgkmcnt(0)":::"memory"); \
      _Pragma("unroll") for(int d_=0;d_<4;++d_) _Pragma("unroll") for(int r=0;r<16;++r)o[d_][r]*=wsf[crow(r,hi)]; } }while(0)
  f32x16 C0,C1; u32x4 pw0,pw1,pw2,pw3;
  int sl_prev=0,sl_cur=0,sl_next=SLOTB;
  #define ROT() do{sl_prev=sl_cur;sl_cur=sl_next;sl_next=(sl_next==(NSLOT-1)*SLOTB)?0:sl_next+SLOTB;}while(0)
  #define PKW(P,B) cvtpk_s(P[B],P[B+1])
  DMA_K(2,2*SLOTB);
  WAIT_BAR(3);
  qkt(C0,C1,Kbase,qr,negm,r32,hi);asm volatile("s_nop 15\n\ts_nop 7":"+v"(C0),"+v"(C1));CMASK(C0,C1,0);
  { const float rm=rowmax(C0,C1); mhat=rm;
    _Pragma("unroll") for(int r=0;r<16;++r)negm[r]=-mhat; asm volatile("":"+v"(negm));
    _Pragma("unroll") for(int r=0;r<16;++r){C0[r]=__builtin_amdgcn_exp2f(C0[r]-mhat);C1[r]=__builtin_amdgcn_exp2f(C1[r]-mhat);}
    float sacc=0.f; _Pragma("unroll") for(int r=0;r<16;++r)sacc+=C0[r]+C1[r]; l_reg+=sacc;
    pw0=(u32x4){PKW(C0,0),PKW(C0,2),PKW(C0,4),PKW(C0,6)};pw1=(u32x4){PKW(C0,8),PKW(C0,10),PKW(C0,12),PKW(C0,14)};pw2=(u32x4){PKW(C1,0),PKW(C1,2),PKW(C1,4),PKW(C1,6)};pw3=(u32x4){PKW(C1,8),PKW(C1,10),PKW(C1,12),PKW(C1,14)}; }
  const __attribute__((address_space(3))) char* qlds=(const __attribute__((address_space(3))) char*)(shm3+W_LDS_OST+wid*4096+lane*16);
  { __attribute__((address_space(3))) char* qw=(__attribute__((address_space(3))) char*)(shm3+W_LDS_OST+wid*4096+lane*16);
    #pragma unroll
    for(int d0=0;d0<4;++d0)*(__attribute__((address_space(3))) bf16x8*)(qw+d0*1024)=qr[d0]; }
  WAIT_BAR(0);
  DMA_K(3,0);DMA_V(1,SLOTB);
  ROT();
  kload8(kf,kp0+sl_cur);
  WAIT_BAR(3);
  s16x4 vlo[8],vhi[8];
  #define PAF(k) __builtin_bit_cast(bf16x8,pw##k)
  #define VFR(i) (bf16x8){vlo[i][0],vlo[i][1],vlo[i][2],vlo[i][3],vhi[i][0],vhi[i][1],vhi[i][2],vhi[i][3]}
  #define PIN(x) asm volatile("":"+v"(x))
  #define MX3(a,b,c) __builtin_fmaxf(__builtin_fmaxf((a),(b)),(c))
  #define EX(v) __builtin_amdgcn_exp2f(v)
  #define GA(MF) do{ MF; SBAR(); }while(0)
  #define EX2(X,B) do{ float e0_=EX(X[B]), e1_=EX(X[B+1]); asm volatile("":"+v"(e0_),"+v"(e1_)); X[B]=e0_; X[B+1]=e1_; }while(0)
  #define GB0(MF,X,B) do{ MF; EX2(X,B); SBAR(); }while(0)
  #define GB1(MF,X,B,PWD,Y,YB) do{ MF; EX2(X,B); sacc+=Y[YB]; sacc+=Y[YB+1]; PIN(sacc); { unsigned pk_=PKW(Y,YB); PIN(pk_); PWD=pk_; } SBAR(); }while(0)
  #define VRS(s,i) do{ vlo[s]=vtr(vp_+(((i)>>2)*4096+((i)&3)*1024)); vhi[s]=vtr(vp_+(((i)>>2)*4096+((i)&3)*1024+512)); SBAR(); }while(0)
  #define KRD(G,j) do{ if(G){ kload2(kf,kp0+sl_next,j); SBAR(); } }while(0)
  #define MF(a,b,c) __builtin_amdgcn_mfma_f32_32x32x16_bf16(a,b,c,0,0,0)
  #define QL(d) (*(const __attribute__((address_space(3))) bf16x8*)(qlds+(d)*1024))
  #define STEP(t,GK,GV,GL) do{ SBAR(); \
    const lds_cptr vp_=vp0+2*sl_prev; \
    bf16x8 qa_=QL(0),qb_=QL(1); SBAR(); \
    VRS(0,0);  GA(C0=MF(kf[0],qa_,negm)); \
    VRS(1,4);  GA(C1=MF(kf[1],qa_,negm)); qa_=QL(2); SBAR(); \
    VRS(2,8);  GA(C0=MF(kf[2],qb_,C0)); \
    VRS(3,12); GA(C1=MF(kf[3],qb_,C1)); qb_=QL(3); SBAR(); \
    VRS(4,1);  GA(C0=MF(kf[4],qa_,C0)); \
    VRS(5,5);  GA(C1=MF(kf[5],qa_,C1)); \
    VRS(6,9);  GA(C0=MF(kf[6],qb_,C0)); \
    VRS(7,13); GA(C1=MF(kf[7],qb_,C1)); \
    if(GK){DMA_K((t)+3,sl_cur);} if(GV){DMA_V((t)+1,sl_next);} \
    CMASK(C0,C1,t); \
    { float a=MX3(C0[0],C0[1],C1[0]),b=MX3(C0[2],C0[3],C1[1]); a=MX3(a,C1[2],C1[3]); \
      _Pragma("unroll") for(int r=4;r<16;r+=4){a=MX3(a,C0[r],C0[r+1]);b=MX3(b,C0[r+2],C0[r+3]);a=MX3(a,C1[r],C1[r+1]);b=MX3(b,C1[r+2],C1[r+3]);} \
      float rm=__builtin_fmaxf(a,b); { auto rr=__builtin_amdgcn_permlane32_swap(__float_as_uint(rm),__float_as_uint(rm),false,false); rm=__builtin_fmaxf(__uint_as_float(rr[0]),__uint_as_float(rr[1])); } \
      resc=false; \
      if(__builtin_expect(__any(rm>(float)THRL),0)){ const float dl=__builtin_fmaxf(rm,0.f); mhat+=dl; \
        _Pragma("unroll") for(int r=0;r<16;++r){C0[r]-=dl;C1[r]-=dl;} \
        _Pragma("unroll") for(int r=0;r<16;++r)negm[r]=-mhat; asm volatile("":"+v"(negm)); \
        const float f=__builtin_amdgcn_exp2f(-dl); l_reg*=f; if(hi==0)wsf[r32]=f; resc=true; } } \
    SBAR(); float sacc=0.f; \
    GB0(o[0]=MF(PAF(0),VFR(0),o[0]), C0,0); \
    GB0(o[1]=MF(PAF(0),VFR(1),o[1]), C0,2); \
    GB0(o[2]=MF(PAF(0),VFR(2),o[2]), C0,4); \
    GB0(o[3]=MF(PAF(0),VFR(3),o[3]), C0,6); \
    VRS(0,2);  GB1(o[0]=MF(PAF(1),VFR(4),o[0]), C0,8,  pw0[0],C0,0); \
    VRS(1,6);  GB1(o[1]=MF(PAF(1),VFR(5),o[1]), C0,10, pw0[1],C0,2); \
    VRS(2,10); GB1(o[2]=MF(PAF(1),VFR(6),o[2]), C0,12, pw0[2],C0,4); \
    VRS(3,14); GB1(o[3]=MF(PAF(1),VFR(7),o[3]), C0,14, pw0[3],C0,6); \
    VRS(4,3);  KRD(GL,0); GB1(o[0]=MF(PAF(2),VFR(0),o[0]), C1,0, pw1[0],C0,8); \
    VRS(5,7);  KRD(GL,1); GB1(o[1]=MF(PAF(2),VFR(1),o[1]), C1,2, pw1[1],C0,10); \
    VRS(6,11); GB1(o[2]=MF(PAF(2),VFR(2),o[2]), C1,4, pw1[2],C0,12); \
    VRS(7,15); GB1(o[3]=MF(PAF(2),VFR(3),o[3]), C1,6, pw1[3],C0,14); \
    KRD(GL,2); GB1(o[0]=MF(PAF(3),VFR(4),o[0]), C1,8,  pw2[0],C1,0); \
    KRD(GL,3); GB1(o[1]=MF(PAF(3),VFR(5),o[1]), C1,10, pw2[1],C1,2); \
    GB1(o[2]=MF(PAF(3),VFR(6),o[2]), C1,12, pw2[2],C1,4); \
    GB1(o[3]=MF(PAF(3),VFR(7),o[3]), C1,14, pw2[3],C1,6); \
    sacc+=C1[8];sacc+=C1[9];pw3[0]=PKW(C1,8); sacc+=C1[10];sacc+=C1[11];pw3[1]=PKW(C1,10); sacc+=C1[12];sacc+=C1[13];pw3[2]=PKW(C1,12); sacc+=C1[14];sacc+=C1[15];pw3[3]=PKW(C1,14); \
    l_reg+=sacc; \
    }while(0)
  int t=1;
  #undef CMASK
  #define CMASK(P0,P1,t) do{}while(0)
  for(;t+7<NT;t+=2){
    STEP(t,true,true,true);     WAIT_BAR(3); RESC(); ROT();
    STEP(t+1,true,true,true);   WAIT_BAR(3); RESC(); ROT();
  }
  #undef CMASK
  #define CMASK(P0,P1,t) do{int jb_=(t)-(NT-4); if(jb_>=-2 && (32*wid-(64*jb_+63))<113)biasmask(P0,P1,jb_,qrel,hi,bl);}while(0)
  #define ENDW(tt) do{ if((tt)+3<NT){WAIT_BAR(3);} else if((tt)+2<NT){WAIT_BAR(2);} else {WAIT_BAR(0);} }while(0)
  for(;t+1<NT;t+=2){
    STEP(t,(t+3<NT),(t+1<NT),(t+1<NT));       ENDW(t);   RESC(); ROT();
    STEP(t+1,(t+4<NT),(t+2<NT),(t+2<NT));     ENDW(t+1); RESC(); ROT();
  }
  STEP(NT-1,false,false,false); RESC();
  SBAR(); pv128(o,vb0+2*sl_cur,PAF(0),PAF(1),PAF(2),PAF(3));
  #undef PKW
  #undef PAF
  #undef VFR
  #undef PIN
  #undef MX3
  #undef EX
  #undef EX2
  #undef GA
  #undef GB0
  #undef GB1
  #undef VRS
  #undef KRD
  #undef MF
  #undef QL
  #undef STEP
  #undef ENDW
  {auto rr=__builtin_amdgcn_permlane32_swap(__float_as_uint(l_reg),__float_as_uint(l_reg),false,false);l_reg=__uint_as_float(rr[0])+__uint_as_float(rr[1]);}
  if(hi==0)wsf[32+r32]=1.0f/l_reg;
  asm volatile("s_waitcnt lgkmcnt(0)":::"memory");
  float rli[16];
  #pragma unroll
  for(int r=0;r<16;++r)rli[r]=wsf[32+crow(r,hi)];
  { asm volatile("":"+s"(Op)); }
  bf16*Ow=Op+(long)(q0+wid*QBLK)*LDO;
  { bf16*stg=(bf16*)(shm+W_LDS_OST)+wid*2048;
    int lane_e=lane; asm volatile("":"+v"(lane_e));
    #pragma unroll
    for(int ph=0;ph<2;++ph){
      #pragma unroll
      for(int r=0;r<16;++r){const int orow=crow(r,hi);
        #pragma unroll
        for(int d0=0;d0<2;++d0)stg[orow*64+d0*32+r32]=__float2bfloat16(o[2*ph+d0][r]*rli[r]);}
      asm volatile("s_waitcnt lgkmcnt(0)":::"memory");
      #pragma unroll
      for(int i=0;i<4;++i){const int row=i*8+(lane_e>>3),ch=lane_e&7; const u32x4 v=*(const u32x4*)(stg+row*64+ch*8); *(u32x4*)(Ow+(long)row*LDO+ph*64+ch*8)=v;}
      asm volatile("s_waitcnt lgkmcnt(0)":::"memory"); } }
  asm volatile("s_waitcnt lgkmcnt(0)\n\ts_barrier":::"memory");
  #undef DMA_K
  #undef DMA_V
  #undef CMASK
  #undef RESC
  #undef ROT
}

constexpr int LDS_GK=0, LDS_GV=4*SLOTB, LDS_GWS=8*SLOTB, LDS_GOST=LDS_GWS+NW*128*4, LDS_GBIAS=LDS_GOST+NW*4096, LDS_GBYTES=LDS_GBIAS+512;
__device__ __forceinline__ void moba_gather_unit(const bf16*QKVb  ,int h,int j,const unsigned*ent,int n,long growb  ,const float*biasG,float*pml,bf16*po,char*shm){
  int tid=threadIdx.x; asm volatile("":"+v"(tid));
  const int lane=tid&63,r32=lane&31,hi=lane>>5; const int wid=__builtin_amdgcn_readfirstlane(tid>>6);
  const unsigned lds0=(unsigned)(uintptr_t)shm; const lds_cptr shm3=(lds_cptr)shm;
  float*wsf=(float*)(shm+LDS_GWS)+wid*128;
  { __attribute__((address_space(3))) float* blw=(__attribute__((address_space(3))) float*)(shm3+LDS_GBIAS); if(tid<128)blw[tid]=biasG[tid]; }
  const lds_cfptr bl=(lds_cfptr)(shm3+LDS_GBIAS);
  const int ei=wid*QBLK+r32; const unsigned e=ent[ei<n?ei:n-1];
  const int qloc=(int)(e&0x3FFFu), slot=(int)(e>>14);
  const bf16*Qrow=QKVb+(long)qloc*LDQ+1536+h*64;
  bf16x8 qr[4];
  #pragma unroll
  for(int d0=0;d0<4;++d0)qr[d0]=*reinterpret_cast<const bf16x8*>(Qrow+d0*16+hi*8);
  const bf16*Kh=QKVb+(long)(j*256)*LDQ+2048+h*64,*Vh=QKVb+(long)(j*256)*LDQ+2560+h*64;
  const bf16*ksrc=Kh+(long)lane*LDQ+wid*8;
  const bf16*vsrc=Vh+(long)(16*(wid&3)+(lane>>2))*LDQ+(wid>>2)*32+(lane&3)*8;
  #pragma unroll
  for(int t=0;t<4;++t){ glds16(ksrc+(long)t*KVBLK*LDQ,(unsigned)__builtin_amdgcn_readfirstlane(lds0+LDS_GK+t*SLOTB+wid*1024)); glds16(vsrc+(long)t*KVBLK*LDQ,(unsigned)__builtin_amdgcn_readfirstlane(lds0+LDS_GV+t*SLOTB+wid*1024)); }
  asm volatile("s_waitcnt vmcnt(0) lgkmcnt(0)\n\ts_barrier":::"memory");
  const int vb0=(int)(lds0+LDS_GV)+((lane>>4)&1)*32+(lane&3)*8+(4*hi+((lane&15)>>2))*64;
  float mhat=0.f,l_reg=0.f; f32x16 o[2]; o[0]=f32x16{}; o[1]=f32x16{}; f32x16 negm=f32x16{};
  const bool nearq=__any(qloc-(j*256+128)<128+113);
  #pragma unroll
  for(int t=0;t<4;++t){
    f32x16 p0,p1; qkt(p0,p1,shm+LDS_GK+t*SLOTB,qr,negm,r32,hi);
    if(t>=2 && nearq){ const int kb=j*256+t*64+4*hi;
      #pragma unroll
      for(int r=0;r<16;++r){ const int kv=kb+(r&3)+8*(r>>2); const int d0=qloc-kv,d1=d0-32; const int i0=d0>127?127:(d0<0?0:d0), i1=d1>127?127:(d1<0?0:d1); p0[r]+=bl[i0]; p1[r]+=bl[i1]; } }
    const float rm=rowmax_c(p0,p1);
    const float dl=(t==0)?rm:__builtin_fmaxf(rm,0.f);
    mhat+=dl;
    #pragma unroll
    for(int r=0;r<16;++r){p0[r]-=dl;p1[r]-=dl;}
    #pragma unroll
    for(int r=0;r<16;++r)negm[r]=-mhat;
    if(t>0){ const float f=__builtin_amdgcn_exp2f(-dl); l_reg*=f; if(hi==0)wsf[r32]=f; asm volatile("s_waitcnt lgkmcnt(0)":::"memory");
      #pragma unroll
      for(int d_=0;d_<2;++d_)
        #pragma unroll
        for(int r=0;r<16;++r)o[d_][r]*=wsf[crow(r,hi)]; }
    float sacc=0.f;
    #pragma unroll
    for(int r=0;r<16;++r){p0[r]=__builtin_amdgcn_exp2f(p0[r]);p1[r]=__builtin_amdgcn_exp2f(p1[r]);sacc+=p0[r]+p1[r];}
    l_reg+=sacc;
    u32x4 pw0,pw1,pw2,pw3;
    pw0=(u32x4){cvtpk_s(p0[0],p0[1]),cvtpk_s(p0[2],p0[3]),cvtpk_s(p0[4],p0[5]),cvtpk_s(p0[6],p0[7])};
    pw1=(u32x4){cvtpk_s(p0[8],p0[9]),cvtpk_s(p0[10],p0[11]),cvtpk_s(p0[12],p0[13]),cvtpk_s(p0[14],p0[15])};
    pw2=(u32x4){cvtpk_s(p1[0],p1[1]),cvtpk_s(p1[2],p1[3]),cvtpk_s(p1[4],p1[5]),cvtpk_s(p1[6],p1[7])};
    pw3=(u32x4){cvtpk_s(p1[8],p1[9]),cvtpk_s(p1[10],p1[11]),cvtpk_s(p1[12],p1[13]),cvtpk_s(p1[14],p1[15])};
    pv(o,vb0+t*SLOTB,__builtin_bit_cast(bf16x8,pw0),__builtin_bit_cast(bf16x8,pw1),__builtin_bit_cast(bf16x8,pw2),__builtin_bit_cast(bf16x8,pw3));
  }
  {auto rr=__builtin_amdgcn_permlane32_swap(__float_as_uint(l_reg),__float_as_uint(l_reg),false,false);l_reg=__uint_as_float(rr[0])+__uint_as_float(rr[1]);}
  if(hi==0 && ei<n){ f32x2_t v={mhat,l_reg}; *(f32x2_t*)(pml+((long)slot*MROWS+growb+qloc)*16+h*2)=v; }
  { bf16*stg=(bf16*)(shm+LDS_GOST)+wid*2048;
    #pragma unroll
    for(int r=0;r<16;++r){const int orow=crow(r,hi);
      #pragma unroll
      for(int d0=0;d0<2;++d0)stg[orow*64+d0*32+r32]=__float2bfloat16(o[d0][r]);}
    asm volatile("s_waitcnt lgkmcnt(0)":::"memory");
    #pragma unroll
    for(int i=0;i<4;++i){const int row=i*8+(lane>>3),ch=lane&7; const u32x4 v=*(const u32x4*)(stg+row*64+ch*8);
      const unsigned er=(unsigned)__shfl((int)e,row); const int ql=(int)(er&0x3FFFu), sl=(int)(er>>14);
      if(wid*QBLK+row<n) *(u32x4*)(po+(((long)sl*MROWS+growb+ql)*8+h)*64+ch*8)=v; } }
  asm volatile("s_waitcnt lgkmcnt(0)\n\ts_barrier":::"memory");
}
#undef SBAR
#undef WAIT_BAR
}

constexpr int NWAVES = 8;
#ifndef MK_N_LAUNCHES
#define MK_N_LAUNCHES 1
#endif
constexpr int N_PHASES = 13;
constexpr int N_LAUNCHES = MK_N_LAUNCHES;

constexpr int BATCH = 2, T = 16384, D = 1024, M = BATCH * T;
constexpr int NPROJ = 3072;
constexpr int NEXP = 32, EFF = 512;
constexpr float EPS = 1e-6f, LOG2E = 1.4426950408889634f;
constexpr float LAMBDA_INIT = 0.2f;
constexpr int MOBA_CAP = 256 * 2016;

constexpr size_t MiB = 1u << 20;
constexpr size_t WS_CTL = 0, CTL_ZERO_BYTES = 1 * MiB;
constexpr size_t WS_MOD = 1 * MiB;
constexpr size_t WS_BIASG = 1 * MiB + 64 * 1024;
constexpr size_t WS_KMEAN = 1 * MiB + 256 * 1024;
constexpr size_t WS_TOKW = 2 * MiB;
constexpr size_t WS_ELIST = 3 * MiB;
constexpr size_t WS_WIN = 8 * MiB, WS_WOUT = 14 * MiB;
constexpr size_t WS_XN = 16 * MiB;
constexpr size_t WS_QKV = 80 * MiB;
constexpr size_t WS_OD = 272 * MiB;
constexpr size_t WS_PO = 336 * MiB;
constexpr size_t WS_PML = 432 * MiB;
constexpr size_t WS_MLIST = 438 * MiB;
constexpr size_t WS_WGU = 336 * MiB, WS_WD = 400 * MiB;
constexpr size_t WS_YO = 80 * MiB;
constexpr size_t WS_HID = 208 * MiB;
constexpr size_t WS_SO = 80 * MiB;
constexpr size_t WS_END = 472 * MiB;
static_assert(WS_MLIST + (size_t)16 * MOBA_CAP * 4 <= WS_END && WS_PML + (size_t)3 * M * 16 * 4 <= WS_MLIST && WS_PO + (size_t)3 * M * 512 * 2 <= WS_PML, "d_ws map");
static_assert(WS_HID + (size_t)73728 * 512 * 2 <= WS_WGU && WS_SO + (size_t)M * 2 * 1024 * 2 <= WS_HID && WS_WD + (size_t)32 * 1024 * 512 * 2 <= WS_PML, "d_ws map");
constexpr int CW_BAR = 4096;
constexpr int CW_MCNT = 16384;
constexpr int CW_ECNT = 16384 + 1024 * 16;
static_assert((CW_ECNT + 32 * 64) * 4 <= (int)CTL_ZERO_BYTES, "CTL words inside the memset region");

constexpr int RING_OFF = 0, RING_BYTES = 131072;
constexpr int LDSCTL_OFF = 147456, MISC_OFF = LDSCTL_OFF + 320;
constexpr int LDS_BYTES = 148480;
static_assert(MISC_OFF + 128 <= LDS_BYTES, "LDS map");

#define GAS __attribute__((address_space(1)))
#define LAS __attribute__((address_space(3)))
typedef unsigned short bf16;
typedef unsigned v4u __attribute__((ext_vector_type(4)));
typedef unsigned v2u __attribute__((ext_vector_type(2)));
typedef float f32x4 __attribute__((ext_vector_type(4)));
typedef float f32x2 __attribute__((ext_vector_type(2)));
typedef GAS unsigned gu32;
#define RLX_AGENT __ATOMIC_RELAXED, __HIP_MEMORY_SCOPE_AGENT
#define LDS_WAIT() asm volatile("s_waitcnt lgkmcnt(0)" ::: "memory")
#define VM_WAIT() asm volatile("s_waitcnt vmcnt(0)" ::: "memory")
__device__ __forceinline__ unsigned f2bf(float f) { unsigned u = __builtin_bit_cast(unsigned, f); return (u + 0x7fffu + ((u >> 16) & 1u)) >> 16; }
__device__ __forceinline__ unsigned pk2(float lo, float hi) { return f2bf(lo) | (f2bf(hi) << 16); }
__device__ __forceinline__ float bf_lo(unsigned u) { return __uint_as_float(u << 16); }
__device__ __forceinline__ float bf_hi(unsigned u) { return __uint_as_float(u & 0xffff0000u); }

#define XB_TMO      128
#define XB_XCNT(j)  (256  + 64 * (j))
#define XB_XSUB(j)  (1280 + 64 * (j))
#define XB_XGEN(j)  (2304 + 64 * (j))
#define XB_TOP      3328
#define XB_TOPGEN   3392
#define XCD_BAR_WORDS 3456
#define XB_SPIN_CAP (1u << 18)

__device__ __forceinline__ unsigned xb_ld(unsigned* p)              { return __hip_atomic_load(p, __ATOMIC_RELAXED, __HIP_MEMORY_SCOPE_AGENT); }
__device__ __forceinline__ unsigned xb_add(unsigned* p, unsigned v) { return __hip_atomic_fetch_add(p, v, __ATOMIC_RELAXED, __HIP_MEMORY_SCOPE_AGENT); }
__device__ __forceinline__ unsigned xb_xcc_id() { return (unsigned)__builtin_amdgcn_s_getreg((3 << 11) | 20) & 0xFu; }
#define XB_SPIN(cond, bar) do { unsigned _sp = 0; while (cond) { __builtin_amdgcn_s_sleep(1); \
    if ((++_sp & 255u) == 0u) { if (xb_ld(&(bar)[XB_TMO])) break; if (_sp > XB_SPIN_CAP) { atomicAdd(&(bar)[XB_TMO], 1u); break; } } } } while (0)

struct XcdBarrier {
    unsigned* bar; unsigned x;
    volatile LAS unsigned* st;
};
__device__ __forceinline__ XcdBarrier xcd_barrier_post(unsigned* bar, volatile LAS unsigned* st) {
    XcdBarrier b; b.bar = bar; b.x = xb_xcc_id(); b.st = st;
    if (threadIdx.x == 0) (void)xb_add(&bar[XB_XCNT(b.x)], 1u);
    return b;
}
__device__ __forceinline__ void xcd_barrier_complete(unsigned* bar, unsigned x, unsigned& nloc, unsigned& nx) {
    const unsigned G = gridDim.x * gridDim.y * gridDim.z;
    unsigned sum, cnt, mine, sp = 0u;
    for (;;) {
        sum = 0u; cnt = 0u; mine = 0u;
#pragma unroll
        for (unsigned j = 0; j < 16; ++j) { const unsigned c = xb_ld(&bar[XB_XCNT(j)]); sum += c; cnt += (c > 0u) ? 1u : 0u; mine = (j == x) ? c : mine; }
        if (sum == G) break;
        __builtin_amdgcn_s_sleep(1);
        if ((++sp & 255u) == 0u) { if (xb_ld(&bar[XB_TMO])) break; if (sp > XB_SPIN_CAP) { atomicAdd(&bar[XB_TMO], 1u); break; } }
    }
    nloc = mine > 0u ? mine : 1u; nx = cnt > 0u ? cnt : 1u;
}
__device__ __forceinline__ void xcd_barrier(const XcdBarrier& b) {
    asm volatile("s_waitcnt vmcnt(0)" ::: "memory");
    __syncthreads();
    if (threadIdx.x == 0) {
        unsigned* bar = b.bar;
        __builtin_amdgcn_s_waitcnt(0);
        unsigned nloc = b.st[0], nx = b.st[1];
        if (nloc == 0u) { xcd_barrier_complete(bar, b.x, nloc, nx); b.st[0] = nloc; b.st[1] = nx; }
        const unsigned old = xb_add(&bar[XB_XSUB(b.x)], 1u);
        const unsigned gen = old / nloc;
        if (old + 1u == (gen + 1u) * nloc) {
            __builtin_amdgcn_fence(__ATOMIC_RELEASE, "agent");
            asm volatile("s_waitcnt vmcnt(0)" ::: "memory");
            const unsigned og = xb_add(&bar[XB_TOP], 1u);
            const unsigned tg = og / nx;
            if (og + 1u == (tg + 1u) * nx) xb_add(&bar[XB_TOPGEN], 1u);
            else XB_SPIN(xb_ld(&bar[XB_TOPGEN]) == tg, bar);
            __builtin_amdgcn_fence(__ATOMIC_ACQUIRE, "agent");
            xb_add(&bar[XB_XGEN(b.x)], 1u);
            asm volatile("s_waitcnt vmcnt(0)" ::: "memory");
        } else {
            XB_SPIN(xb_ld(&bar[XB_XGEN(b.x)]) == gen, bar);
            __builtin_amdgcn_fence(__ATOMIC_ACQUIRE, "agent");
            asm volatile("s_waitcnt vmcnt(0)" ::: "memory");
        }
    }
    __syncthreads();
}

struct Frame {
    LAS unsigned char* lds;
    volatile LAS unsigned* MISC;
    gu32* ctl;
    int tid, lane, wave;
    int vcu, G;
    float* out; unsigned char* ws;
};
typedef __attribute__((address_space(4))) const unsigned char* kptr_t;
__device__ __forceinline__ kptr_t karg() { kptr_t p = (kptr_t)__builtin_amdgcn_kernarg_segment_ptr(); asm volatile("" : "+s"(p)); return p; }
#define INP(kp, i) (*(const float* const __attribute__((address_space(4)))*)((kp) + 8 * (i)))
__device__ __forceinline__ float wave_sum(float v) {
#pragma unroll
    for (int o = 1; o < 64; o <<= 1) v += __shfl_xor(v, o);
    return v;
}
#define PHASE_BEGIN(F) do { asm volatile("" : "+v"((F).tid)); (F).lane = (F).tid & 63; } while (0)
__device__ __forceinline__ float silu_f(float v) { return v / (1.f + __expf(-v)); }
__device__ __forceinline__ int rel_bucket(int d) {
    if (d < 16) return d;
    const int thr[15] = {19, 21, 24, 27, 31, 35, 40, 46, 52, 59, 67, 77, 87, 99, 113};
    int b = 16;
#pragma unroll
    for (int i = 0; i < 15; ++i) b += (d >= thr[i]) ? 1 : 0;
    return b;
}
__device__ __forceinline__ void p0_transpose_item(const float* W, int K, int N, bf16* WT, size_t dst_row0, LAS float* scr, int k0, int n0, int lane) {
#pragma unroll 8
    for (int i = 0; i < 32; ++i) { const int kk = 2 * i + (lane >> 5); scr[kk * 33 + (lane & 31)] = W[(size_t)(k0 + kk) * N + n0 + (lane & 31)]; }
    LDS_WAIT(); asm volatile("" ::: "memory");
    const int c = lane & 7;
#pragma unroll
    for (int j = 0; j < 4; ++j) { const int n = (lane >> 3) + 8 * j; const LAS float* s = scr + (8 * c) * 33 + n;
        v4u o; o.x = pk2(s[0 * 33], s[1 * 33]); o.y = pk2(s[2 * 33], s[3 * 33]); o.z = pk2(s[4 * 33], s[5 * 33]); o.w = pk2(s[6 * 33], s[7 * 33]);
        *(GAS v4u*)(WT + (dst_row0 + n) * K + k0 + 8 * c) = o; }
    LDS_WAIT(); asm volatile("" ::: "memory");
}

__device__ __forceinline__ void p0_prologue(Frame& F) {
    PHASE_BEGIN(F);
    const kptr_t kp = karg();
    const float* c = INP(kp, 1); const float* w_ada = INP(kp, 2); const float* b_ada = INP(kp, 3);
    float* mod = (float*)(F.ws + WS_MOD);
    LAS float* cs = (LAS float*)(F.lds);
    LAS float* part = (LAS float*)(F.lds + 8192);
    for (int cg = blockIdx.x; cg < 96; cg += F.G) {
        for (int i = F.tid; i < 2048; i += NWAVES * 64) cs[i] = silu_f(c[i]);
        __syncthreads();
        const int col = cg * 64 + F.lane; float a0 = 0.f, a1 = 0.f;
#pragma unroll 8
        for (int k = F.wave * 128; k < F.wave * 128 + 128; ++k) { const float w = w_ada[(size_t)k * 6144 + col]; a0 += cs[k] * w; a1 += cs[1024 + k] * w; }
        part[(F.wave * 2 + 0) * 64 + F.lane] = a0; part[(F.wave * 2 + 1) * 64 + F.lane] = a1;
        __syncthreads();
        if (F.wave < 2) { float s = 0.f;
#pragma unroll
            for (int w = 0; w < 8; ++w) s += part[(w * 2 + F.wave) * 64 + F.lane];
            mod[F.wave * 6144 + col] = s + b_ada[col]; }
        __syncthreads();
    }
    if (blockIdx.x == F.G - 1) {
        const float* rb = INP(kp, 15); float* bg = (float*)(F.ws + WS_BIASG);
        for (int i = F.tid; i < 12 * 128; i += NWAVES * 64) { const int h = i >> 7, d = i & 127; bg[i] = (rb[rel_bucket(d) * 12 + h] - rb[31 * 12 + h]) * LOG2E; }
    }
    __syncthreads();
    LAS float* scr = (LAS float*)(F.lds + RING_OFF + F.wave * 16384);
    const int gw = F.vcu * NWAVES + F.wave, NGW = F.G * NWAVES;
    constexpr int I_IN = 16 * 96, I_OUT = 16 * 32;
    for (int it = gw; it < I_IN + I_OUT; it += NGW) {
        if (it < I_IN) { const int kb = it / 96, nb = it % 96; p0_transpose_item(INP(kp, 8), 1024, 3072, (bf16*)(F.ws + WS_WIN), (size_t)(32 * nb), scr, 64 * kb, 32 * nb, F.lane); }
        else { const int r = it - I_IN, kb = r / 32, nb = r % 32; p0_transpose_item(INP(kp, 14), 1024, 1024, (bf16*)(F.ws + WS_WOUT), (size_t)(32 * nb), scr, 64 * kb, 32 * nb, F.lane); }
    }
}
__device__ __forceinline__ void expert_weights(Frame& F) {
    PHASE_BEGIN(F);
    const kptr_t kp = karg();
    LAS float* scr = (LAS float*)(F.lds + RING_OFF + F.wave * 16384);
    const int gw = F.vcu * NWAVES + F.wave, NGW = F.G * NWAVES;
    constexpr int I_G = 32 * 16 * 16, I_D = 32 * 8 * 32;
    for (int it = gw; it < 2 * I_G + I_D; it += NGW) {
        if (it < 2 * I_G) { const int up = it >= I_G ? 1 : 0, r = it - up * I_G, e = r >> 8, kb = (r >> 4) & 15, nb = r & 15, n0 = 32 * nb;
            p0_transpose_item(INP(kp, 20 + up) + (size_t)e * 1024 * 512, 1024, 512, (bf16*)(F.ws + WS_WGU), (size_t)e * 1024 + (n0 >> 7) * 256 + up * 128 + (n0 & 127), scr, 64 * kb, n0, F.lane); }
        else { const int r = it - 2 * I_G, e = r >> 8, kb = (r >> 5) & 7, nb = r & 31;
            p0_transpose_item(INP(kp, 22) + (size_t)e * 512 * 1024, 512, 1024, (bf16*)(F.ws + WS_WD), (size_t)e * 1024 + 32 * nb, scr, 64 * kb, 32 * nb, F.lane); }
    }
}
__device__ __forceinline__ void p1_prenorm(Frame& F) {
    PHASE_BEGIN(F);
    const kptr_t kp = karg();
    const float* x = INP(kp, 0); const float* gain = INP(kp, 4); const float* mod = (const float*)(F.ws + WS_MOD); bf16* XN = (bf16*)(F.ws + WS_XN);
    const int gw = F.vcu * NWAVES + F.wave, NGW = F.G * NWAVES;
    for (int b = 0; b < BATCH; ++b) {
        f32x4 ge[4], sh[4];
#pragma unroll
        for (int j = 0; j < 4; ++j) { const int c = 4 * F.lane + 256 * j; const f32x4 g = *(const f32x4*)(gain + c), sc = *(const f32x4*)(mod + b * 6144 + 1024 + c); ge[j] = g * (sc + 1.f); sh[j] = *(const f32x4*)(mod + b * 6144 + c); }
        for (int m = b * T + gw; m < (b + 1) * T; m += NGW) {
            const GAS f32x4* xr = (const GAS f32x4*)(x + (size_t)m * D) + F.lane;
            f32x4 v[4]; float s = 0.f;
#pragma unroll
            for (int j = 0; j < 4; ++j) { v[j] = xr[64 * j]; s += (v[j].x * v[j].x + v[j].y * v[j].y) + (v[j].z * v[j].z + v[j].w * v[j].w); }
            const float r = 1.f / sqrtf(wave_sum(s) * (1.f / D) + EPS);
            GAS unsigned long long* o8 = (GAS unsigned long long*)(XN + (size_t)m * D) + F.lane;
#pragma unroll
            for (int j = 0; j < 4; ++j) { const f32x4 h = v[j] * r * ge[j] + sh[j]; o8[64 * j] = (unsigned long long)pk2(h.x, h.y) | ((unsigned long long)pk2(h.z, h.w) << 32); }
        }
    }
}
__device__ __forceinline__ void p3_kmean(Frame& F) {
    PHASE_BEGIN(F);
    const bf16* QKV = (const bf16*)(F.ws + WS_QKV); float* km = (float*)(F.ws + WS_KMEAN);
    const int gw = F.vcu * NWAVES + F.wave, NGW = F.G * NWAVES;
    for (int it = gw; it < 1024; it += NGW) {
        const int b = it >> 9, h = (it >> 6) & 7, j = it & 63; const int ch = F.lane & 7, rg = F.lane >> 3;
        const bf16* base = QKV + ((size_t)(b * T + j * 256 + rg)) * NPROJ + 2048 + h * 64 + ch * 8;
        float a[8] = {0.f, 0.f, 0.f, 0.f, 0.f, 0.f, 0.f, 0.f};
#pragma unroll 8
        for (int i = 0; i < 32; ++i) { const v4u v = *(const GAS v4u*)(base + (size_t)(8 * i) * NPROJ);
            a[0] += bf_lo(v.x); a[1] += bf_hi(v.x); a[2] += bf_lo(v.y); a[3] += bf_hi(v.y); a[4] += bf_lo(v.z); a[5] += bf_hi(v.z); a[6] += bf_lo(v.w); a[7] += bf_hi(v.w); }
#pragma unroll
        for (int k = 0; k < 8; ++k) { a[k] += __shfl_xor(a[k], 8); a[k] += __shfl_xor(a[k], 16); a[k] += __shfl_xor(a[k], 32); }
        if (rg == 0) {
#pragma unroll
            for (int k = 0; k < 8; ++k) km[(size_t)it * 64 + ch * 8 + k] = a[k] * (1.f / 256.f); }
    }
}
__device__ __forceinline__ int moba_list_base(int bh, int j) { return bh * MOBA_CAP + 256 * (63 * j - (j * (j - 1)) / 2); }
__device__ __forceinline__ void p4_moba_select(Frame& F) {
    PHASE_BEGIN(F);
    const bf16* QKV = (const bf16*)(F.ws + WS_QKV); const float* km = (const float*)(F.ws + WS_KMEAN); unsigned* mlist = (unsigned*)(F.ws + WS_MLIST);
    LAS float* kml = (LAS float*)(F.lds);
    for (int bi = blockIdx.x; bi < 512; bi += F.G) {
        const int bh = bi >> 5, qg = bi & 31, b = bh >> 3, h = bh & 7;
        for (int i = F.tid; i < 1024; i += NWAVES * 64) ((LAS f32x4*)kml)[i] = ((const f32x4*)(km + (size_t)bh * 4096))[i];
        __syncthreads();
        const int q = qg * 512 + F.wave * 64 + F.lane, own = (qg * 512 + F.wave * 64) >> 8;
        if (own > 0) {
            float qf[64];
            const bf16* qp = QKV + ((size_t)(b * T + q)) * NPROJ + 1536 + h * 64;
#pragma unroll
            for (int c8 = 0; c8 < 8; ++c8) { const v4u v = *(const GAS v4u*)(qp + c8 * 8);
                qf[c8 * 8 + 0] = bf_lo(v.x); qf[c8 * 8 + 1] = bf_hi(v.x); qf[c8 * 8 + 2] = bf_lo(v.y); qf[c8 * 8 + 3] = bf_hi(v.y); qf[c8 * 8 + 4] = bf_lo(v.z); qf[c8 * 8 + 5] = bf_hi(v.z); qf[c8 * 8 + 6] = bf_lo(v.w); qf[c8 * 8 + 7] = bf_hi(v.w); }
            float v0 = -INFINITY, v1 = -INFINITY, v2 = -INFINITY; int i0 = 64, i1 = 64, i2 = 64;
            for (int j = 0; j < own; ++j) {
                float g = 0.f;
#pragma unroll
                for (int d4 = 0; d4 < 16; ++d4) { const f32x4 kv = ((const LAS f32x4*)kml)[j * 16 + d4]; g += qf[d4 * 4] * kv.x + qf[d4 * 4 + 1] * kv.y + qf[d4 * 4 + 2] * kv.z + qf[d4 * 4 + 3] * kv.w; }
                if (g > v0) { v2 = v1; i2 = i1; v1 = v0; i1 = i0; v0 = g; i0 = j; }
                else if (g > v1) { v2 = v1; i2 = i1; v1 = g; i1 = j; }
                else if (g > v2) { v2 = g; i2 = j; }
            }
            for (int j = 0; j < own; ++j) {
                const bool sel = (i0 == j) || (i1 == j) || (i2 == j);
                const unsigned long long mask = __ballot(sel);
                if (mask) {
                    unsigned base = 0;
                    if (F.lane == 0) base = __hip_atomic_fetch_add(F.ctl + CW_MCNT + (bh * 64 + j) * 16, (unsigned)__popcll(mask), RLX_AGENT);
                    base = (unsigned)__builtin_amdgcn_readfirstlane((int)base);
                    if (sel) { const unsigned pos = base + (unsigned)__popcll(mask & ((1ull << F.lane) - 1ull)); const unsigned slot = (i0 == j) ? 0u : ((i1 == j) ? 1u : 2u);
                        mlist[(size_t)moba_list_base(bh, j) + pos] = (unsigned)q | (slot << 14); }
                }
            }
        }
        __syncthreads();
    }
}
__device__ __forceinline__ void p5_moba_gather(Frame& F, char* lds_generic) {
    PHASE_BEGIN(F);
    LAS int* pre = (LAS int*)(F.lds + 106496);
    LAS int* tmp = (LAS int*)(F.lds + 106496 + 4224);
    for (int i = F.tid; i < 1024; i += NWAVES * 64) { const unsigned c = __hip_atomic_load(F.ctl + CW_MCNT + i * 16, RLX_AGENT); tmp[i] = (int)((c + 255u) >> 8); }
    __syncthreads();
    if (F.wave == 0) { int loc[16]; int s = 0;
#pragma unroll
        for (int k = 0; k < 16; ++k) { loc[k] = s; s += tmp[F.lane * 16 + k]; }
        int incl = s;
#pragma unroll
        for (int o = 1; o < 64; o <<= 1) { const int t = __shfl_up(incl, o); if (F.lane >= o) incl += t; }
        const int excl = incl - s;
#pragma unroll
        for (int k = 0; k < 16; ++k) pre[F.lane * 16 + k] = excl + loc[k];
        if (F.lane == 63) pre[1024] = incl; }
    __syncthreads();
    const int U = pre[1024];
    const bf16* QKV = (const bf16*)(F.ws + WS_QKV); const unsigned* mlist = (const unsigned*)(F.ws + WS_MLIST);
    for (int L = blockIdx.x; L < U; L += F.G) {
        int lo = 0, hi = 1024;
        while (hi - lo > 1) { const int mid = (lo + hi) >> 1; if (pre[mid] <= L) lo = mid; else hi = mid; }
        const int x = lo, chunk = L - pre[x], bh = x >> 6, j = x & 63, b = bh >> 3, h = bh & 7;
        const int cnt = (int)__hip_atomic_load(F.ctl + CW_MCNT + x * 16, RLX_AGENT); const int n = (cnt - chunk * 256) < 256 ? (cnt - chunk * 256) : 256;
        const attn_body::bf16* base = (const attn_body::bf16*)QKV + (size_t)b * T * NPROJ;
        attn_body::MobaMerge mm{nullptr, nullptr, 0, 0, 0};
        attn_body::GatherArgs ga{mlist + (size_t)moba_list_base(bh, j) + chunk * 256, n, (float*)(F.ws + WS_PML), (attn_body::bf16*)(F.ws + WS_PO), (long)b * T, h};
        attn_body::attn_unit<8, 2>(base + 1536 + h * 64, base + 2048 + h * 64, base + 2560 + h * 64, nullptr, 0, j * 256, 4,
                                   (const float*)(F.ws + WS_BIASG) + (4 + h) * 128, mm, ga, lds_generic);
    }
}
__device__ __forceinline__ void p6_attention(Frame& F, char* lds_generic) {
    PHASE_BEGIN(F);
    const attn_body::bf16* QKV = (const attn_body::bf16*)(F.ws + WS_QKV);
    const int c = blockIdx.x, G = F.G;
    for (int i = 0;; ++i) {
        const long L = (long)i * G + ((i & 1) ? (G - 1 - c) : c);
        if (L >= 1024) break;
        const int qb = 63 - (int)(L >> 4), st = (int)(L & 15), b = st >> 3, hd = (st >> 1) & 3, mp = st & 1;
        const attn_body::bf16* base = QKV + (size_t)b * T * NPROJ;
        attn_body::attn_unit128<8>(base + hd * 128 + mp * 64, base + 512 + hd * 128 + mp * 64, base + 1024 + hd * 128,
                                   (attn_body::bf16*)(F.ws + WS_OD) + (size_t)b * T * 1024 + (hd * 2 + mp) * 128, qb * 256, 4 * (qb + 1),
                                   (const float*)(F.ws + WS_BIASG) + hd * 128, lds_generic);
    }
    for (int i = 0;; ++i) {
        const long L = (long)i * G + ((i & 1) ? (G - 1 - c) : c);
        if (L >= 1024) break;
        const int o = (int)L, b = o >> 9, h = (o >> 6) & 7, qb = o & 63;
        const attn_body::bf16* base = QKV + (size_t)b * T * NPROJ;
        attn_body::MobaMerge mm{(const float*)(F.ws + WS_PML), (const attn_body::bf16*)(F.ws + WS_PO), (long)b * T + qb * 256, h, qb < 3 ? qb : 3};
        attn_body::attn_unit<8, 1>(base + 1536 + h * 64, base + 2048 + h * 64, base + 2560 + h * 64,
                                   (attn_body::bf16*)(F.ws + WS_XN) + (size_t)b * T * 1024 + 512 + h * 64, qb * 256, qb * 256, 4,
                                   (const float*)(F.ws + WS_BIASG) + (4 + h) * 128, mm, attn_body::GatherArgs{nullptr, 0, nullptr, nullptr, 0, 0}, lds_generic);
    }
}
__device__ __forceinline__ void p7_ydiff(Frame& F) {
    PHASE_BEGIN(F);
    const kptr_t kp = karg();
    const float l1 = wave_sum(INP(kp, 9)[F.lane] * INP(kp, 10)[F.lane]), l2 = wave_sum(INP(kp, 11)[F.lane] * INP(kp, 12)[F.lane]);
    const float lam = expf(l1) - expf(l2) + LAMBDA_INIT;
    const bf16* OD = (const bf16*)(F.ws + WS_OD); bf16* Y = (bf16*)(F.ws + WS_XN);
    const int gw = F.vcu * NWAVES + F.wave, NGW = F.G * NWAVES;
    const int hd = F.lane >> 4, i = F.lane & 15;
    float gn[8];
#pragma unroll
    for (int k = 0; k < 8; ++k) gn[k] = INP(kp, 13)[i * 8 + k] * (1.f - LAMBDA_INIT);
    for (int m = gw; m < M; m += NGW) {
        const v4u a = *(const GAS v4u*)(OD + (size_t)m * 1024 + hd * 256 + i * 8), bb = *(const GAS v4u*)(OD + (size_t)m * 1024 + hd * 256 + 128 + i * 8);
        float v[8] = {bf_lo(a.x) - lam * bf_lo(bb.x), bf_hi(a.x) - lam * bf_hi(bb.x), bf_lo(a.y) - lam * bf_lo(bb.y), bf_hi(a.y) - lam * bf_hi(bb.y),
                      bf_lo(a.z) - lam * bf_lo(bb.z), bf_hi(a.z) - lam * bf_hi(bb.z), bf_lo(a.w) - lam * bf_lo(bb.w), bf_hi(a.w) - lam * bf_hi(bb.w)};
        float s = 0.f;
#pragma unroll
        for (int k = 0; k < 8; ++k) s += v[k] * v[k];
        s += __shfl_xor(s, 1); s += __shfl_xor(s, 2); s += __shfl_xor(s, 4); s += __shfl_xor(s, 8);
        const float r = 1.f / sqrtf(s * (1.f / 128.f) + EPS);
        v4u o; o.x = pk2(v[0] * r * gn[0], v[1] * r * gn[1]); o.y = pk2(v[2] * r * gn[2], v[3] * r * gn[3]); o.z = pk2(v[4] * r * gn[4], v[5] * r * gn[5]); o.w = pk2(v[6] * r * gn[6], v[7] * r * gn[7]);
        *(GAS v4u*)(Y + (size_t)m * 1024 + hd * 128 + i * 8) = o;
    }
    expert_weights(F);
}
__device__ __forceinline__ void p9_postmix_route(Frame& F) {
    PHASE_BEGIN(F);
    const kptr_t kp = karg();
    const float* x = INP(kp, 0); const float* yo = (const float*)(F.ws + WS_YO); const float* mod = (const float*)(F.ws + WS_MOD);
    bf16* XN = (bf16*)(F.ws + WS_XN); float* tokw = (float*)(F.ws + WS_TOKW); int* elist = (int*)(F.ws + WS_ELIST);
    LAS float* WE = (LAS float*)(F.lds); LAS float* WG = (LAS float*)(F.lds + 131072);
    for (int f = F.tid; f < 32768; f += NWAVES * 64) { const int k = f >> 5, cc = f & 31; const int l = (k & 255) >> 2, kk = ((k >> 8) << 2) | (k & 3), g = cc >> 3, hf = (cc >> 2) & 1, ii = cc & 3;
        WE[((((g * 16 + kk) * 2 + hf) * 64 + l) << 2) + ii] = INP(kp, 18)[f]; }
    for (int f = F.tid; f < 4096; f += NWAVES * 64) { const int k = f >> 2, ii = f & 3; const int l = (k & 255) >> 2, kk = ((k >> 8) << 2) | (k & 3); WG[((kk * 64 + l) << 2) + ii] = INP(kp, 16)[f]; }
    __syncthreads();
    const int gw = F.vcu * NWAVES + F.wave, NGW = F.G * NWAVES;
    const float bg0 = INP(kp, 17)[0], bg1 = INP(kp, 17)[1], bg2 = INP(kp, 17)[2], bg3 = INP(kp, 17)[3];
    for (int b = 0; b < BATCH; ++b) {
        f32x4 a1[4], ge[4], sh[4];
#pragma unroll
        for (int j = 0; j < 4; ++j) { const int c = 4 * F.lane + 256 * j; a1[j] = *(const f32x4*)(INP(kp, 5) + c) * *(const f32x4*)(mod + b * 6144 + 2048 + c);
            ge[j] = *(const f32x4*)(INP(kp, 6) + c) * (*(const f32x4*)(mod + b * 6144 + 4096 + c) + 1.f); sh[j] = *(const f32x4*)(mod + b * 6144 + 3072 + c); }
        for (int m = b * T + gw; m < (b + 1) * T; m += NGW) {
            const GAS f32x4* yr = (const GAS f32x4*)(yo + (size_t)m * D) + F.lane; const GAS f32x4* xr = (const GAS f32x4*)(x + (size_t)m * D) + F.lane;
            f32x4 xv[4]; float s = 0.f, s2 = 0.f;
            {   f32x4 y[4];
#pragma unroll
                for (int j = 0; j < 4; ++j) { y[j] = yr[64 * j]; xv[j] = xr[64 * j]; s += (y[j].x * y[j].x + y[j].y * y[j].y) + (y[j].z * y[j].z + y[j].w * y[j].w); }
                const float r1 = 1.f / sqrtf(wave_sum(s) * (1.f / D) + EPS);
                GAS f32x4* orow = (GAS f32x4*)(F.out + (size_t)m * D) + F.lane;
#pragma unroll
                for (int j = 0; j < 4; ++j) { xv[j] = xv[j] + a1[j] * (y[j] * r1); orow[64 * j] = xv[j]; s2 += (xv[j].x * xv[j].x + xv[j].y * xv[j].y) + (xv[j].z * xv[j].z + xv[j].w * xv[j].w); }
            }
            const float r2 = 1.f / sqrtf(wave_sum(s2) * (1.f / D) + EPS);
            GAS unsigned long long* o8 = (GAS unsigned long long*)(XN + (size_t)m * D) + F.lane;
            float gl[4] = {0.f, 0.f, 0.f, 0.f};
#pragma unroll
            for (int j = 0; j < 4; ++j) { xv[j] = xv[j] * r2 * ge[j] + sh[j]; o8[64 * j] = (unsigned long long)pk2(xv[j].x, xv[j].y) | ((unsigned long long)pk2(xv[j].z, xv[j].w) << 32);
#pragma unroll
                for (int ii = 0; ii < 4; ++ii) { const f32x4 w = ((const LAS f32x4*)WG)[(j * 4 + ii) * 64 + F.lane]; const float hv = xv[j][ii]; gl[0] += hv * w.x; gl[1] += hv * w.y; gl[2] += hv * w.z; gl[3] += hv * w.w; }
                __builtin_amdgcn_sched_barrier(0); }
            gl[0] = wave_sum(gl[0]) + bg0; gl[1] = wave_sum(gl[1]) + bg1; gl[2] = wave_sum(gl[2]) + bg2; gl[3] = wave_sum(gl[3]) + bg3;
            int g = 0; float gm = gl[0];
            if (gl[1] > gm) { gm = gl[1]; g = 1; } if (gl[2] > gm) { gm = gl[2]; g = 2; } if (gl[3] > gm) { gm = gl[3]; g = 3; }
            const float gw_ = 1.f / (expf(gl[0] - gm) + expf(gl[1] - gm) + expf(gl[2] - gm) + expf(gl[3] - gm));
            g = __builtin_amdgcn_readfirstlane(g);
            float el[8] = {0.f, 0.f, 0.f, 0.f, 0.f, 0.f, 0.f, 0.f};
#pragma unroll
            for (int j = 0; j < 4; ++j) {
#pragma unroll
                for (int ii = 0; ii < 4; ++ii) { const int kk = j * 4 + ii; const f32x4 wa = ((const LAS f32x4*)WE)[((g * 16 + kk) * 2 + 0) * 64 + F.lane], wb = ((const LAS f32x4*)WE)[((g * 16 + kk) * 2 + 1) * 64 + F.lane]; const float hv = xv[j][ii];
                    el[0] += hv * wa.x; el[1] += hv * wa.y; el[2] += hv * wa.z; el[3] += hv * wa.w; el[4] += hv * wb.x; el[5] += hv * wb.y; el[6] += hv * wb.z; el[7] += hv * wb.w; }
                __builtin_amdgcn_sched_barrier(0); }
            float ea = -INFINITY, eb = -INFINITY; int ia = 0, ib = 0;
#pragma unroll
            for (int k = 0; k < 8; ++k) { const float v = wave_sum(el[k]) + INP(kp, 19)[g * 8 + k];
                if (v > ea) { eb = ea; ib = ia; ea = v; ia = k; } else if (v > eb) { eb = v; ib = k; } }
            const float pb = expf(eb - ea), wa_ = gw_ / (1.f + pb), wb_ = gw_ * pb / (1.f + pb);
            if (F.lane == 0) {
                const int e0 = g * 8 + ia, e1 = g * 8 + ib;
                const unsigned p0 = __hip_atomic_fetch_add(F.ctl + CW_ECNT + e0 * 64, 1u, RLX_AGENT), p1 = __hip_atomic_fetch_add(F.ctl + CW_ECNT + e1 * 64, 1u, RLX_AGENT);
                elist[e0 * 32768 + (int)p0] = m * 2; elist[e1 * 32768 + (int)p1] = m * 2 + 1;
                *(f32x2*)(tokw + (size_t)m * 2) = (f32x2){wa_, wb_};
            }
        }
    }
}
struct MoeOrder {
    const LAS int* tp;
    const gu32* ecnt; const int* elist; int G, c;
    __device__ __forceinline__ bool next(int i, pg8::Unit& u) const {
        const long L = (long)i * G + c; const int U = tp[32] * 4; if (L >= U) return false;
        const int rt = (int)(L >> 2), pn = (int)(L & 3); int e = 0;
#pragma unroll 1
        for (int k = 1; k < 32; ++k) e += (tp[k] <= rt) ? 1 : 0;
        const int t = rt - tp[e]; const int cnt = (int)__hip_atomic_load(ecnt + e * 64, RLX_AGENT);
        u.pm = rt; u.pn = e * 4 + pn; u.nvalid = (cnt - t * 256) < 256 ? (cnt - t * 256) : 256; u.rows = elist + e * 32768 + t * 256; return true;
    }
    __device__ __forceinline__ int arow(const pg8::Unit& u, int r) const { return r < u.nvalid ? (u.rows[r] >> 1) : 0; }
};
__device__ __forceinline__ void moe_prefix(Frame& F, LAS int* tp) {
    if (F.tid == 0) { int s = 0; for (int e = 0; e < 32; ++e) { tp[e] = s; s += ((int)__hip_atomic_load(F.ctl + CW_ECNT + e * 64, RLX_AGENT) + 255) >> 8; } tp[32] = s; }
    __syncthreads();
}

__device__ __forceinline__ void p2_qkv(Frame& F) {
    pg8::Gemm g{(const bf16*)(F.ws + WS_XN), (const bf16*)(F.ws + WS_WIN), M, NPROJ, D}; pg8::StaticOrder S; S.init(M, NPROJ, F.G, (int)blockIdx.x);
    pg8::EpiQKV E{(bf16*)(F.ws + WS_QKV), NPROJ, 0xC3u, attn_body::C2};
    pg8::gemm_phase<pg8::EpiQKV, pg8::StaticOrder, false>(F.lds + RING_OFF, g, S, E);
}
__device__ __forceinline__ void p8_wo(Frame& F) {
    pg8::Gemm g{(const bf16*)(F.ws + WS_XN), (const bf16*)(F.ws + WS_WOUT), M, D, D}; pg8::StaticOrder S; S.init(M, D, F.G, (int)blockIdx.x);
    pg8::EpiF32 E{(float*)(F.ws + WS_YO), D};
    pg8::gemm_phase<pg8::EpiF32, pg8::StaticOrder, false>(F.lds + RING_OFF, g, S, E);
}
__device__ __forceinline__ void p10_gateup(Frame& F) {
    LAS int* tp = (LAS int*)(F.lds + RING_BYTES); moe_prefix(F, tp);
    MoeOrder S{tp, F.ctl + CW_ECNT, (const int*)(F.ws + WS_ELIST), F.G, (int)blockIdx.x};
    pg8::Gemm g{(const bf16*)(F.ws + WS_XN), (const bf16*)(F.ws + WS_WGU), M, 1024, D};
    pg8::EpiSwiGLU E{(bf16*)(F.ws + WS_HID)};
    pg8::gemm_phase<pg8::EpiSwiGLU, MoeOrder, true>(F.lds + RING_OFF, g, S, E);
}
__device__ __forceinline__ void p11_down(Frame& F) {
    LAS int* tp = (LAS int*)(F.lds + RING_BYTES); moe_prefix(F, tp);
    MoeOrder S{tp, F.ctl + CW_ECNT, (const int*)(F.ws + WS_ELIST), F.G, (int)blockIdx.x};
    pg8::Gemm g{(const bf16*)(F.ws + WS_HID), (const bf16*)(F.ws + WS_WD), 73728, 1024, EFF};
    pg8::EpiDown E{(bf16*)(F.ws + WS_SO)};
    pg8::gemm_phase<pg8::EpiDown, MoeOrder, false>(F.lds + RING_OFF, g, S, E);
}
__device__ __forceinline__ void p12_final(Frame& F) {
    PHASE_BEGIN(F);
    const kptr_t kp = karg();
    const float* mod = (const float*)(F.ws + WS_MOD); const bf16* SO = (const bf16*)(F.ws + WS_SO); const float* tokw = (const float*)(F.ws + WS_TOKW);
    const int gw = F.vcu * NWAVES + F.wave, NGW = F.G * NWAVES;
    for (int b = 0; b < BATCH; ++b) {
        f32x4 pg[4], g2[4];
#pragma unroll
        for (int j = 0; j < 4; ++j) { const int c = 4 * F.lane + 256 * j; pg[j] = *(const f32x4*)(INP(kp, 7) + c); g2[j] = *(const f32x4*)(mod + b * 6144 + 5120 + c); }
        for (int m = b * T + gw; m < (b + 1) * T; m += NGW) {
            const f32x2 w = *(const f32x2*)(tokw + (size_t)m * 2);
            const GAS v2u* s0 = (const GAS v2u*)(SO + (size_t)m * 2048) + F.lane; const GAS v2u* s1 = (const GAS v2u*)(SO + (size_t)m * 2048 + 1024) + F.lane;
            GAS f32x4* orow = (GAS f32x4*)(F.out + (size_t)m * D) + F.lane;
            f32x4 y[4], xv[4]; float s = 0.f;
#pragma unroll
            for (int j = 0; j < 4; ++j) { const v2u a = s0[64 * j], bq = s1[64 * j]; xv[j] = orow[64 * j];
                y[j] = (f32x4){w.x * bf_lo(a.x) + w.y * bf_lo(bq.x), w.x * bf_hi(a.x) + w.y * bf_hi(bq.x), w.x * bf_lo(a.y) + w.y * bf_lo(bq.y), w.x * bf_hi(a.y) + w.y * bf_hi(bq.y)};
                s += (y[j].x * y[j].x + y[j].y * y[j].y) + (y[j].z * y[j].z + y[j].w * y[j].w); }
            const float r = 1.f / sqrtf(wave_sum(s) * (1.f / D) + EPS);
#pragma unroll
            for (int j = 0; j < 4; ++j) orow[64 * j] = xv[j] + g2[j] * (y[j] * r * pg[j]);
        }
    }
}

struct Args { const float* in[23]; float* out; unsigned char* ws; int ph_lo, ph_hi; };
__global__ void __launch_bounds__(NWAVES * 64, 2) hymba_fwd(Args args) {
    extern __shared__ __attribute__((aligned(16))) unsigned char lds[];
    Frame F;
    F.lds = (LAS unsigned char*)lds;
    F.MISC = (volatile LAS unsigned*)(F.lds + MISC_OFF);
    F.tid = threadIdx.x; F.lane = F.tid & 63; F.wave = __builtin_amdgcn_readfirstlane(F.tid >> 6);
    F.G = gridDim.x; { const int bx = blockIdx.x; F.vcu = (F.G % 8 == 0) ? (bx % 8) * (F.G / 8) + bx / 8 : bx; }
    F.ws = args.ws; F.out = args.out; F.ctl = (gu32*)(args.ws + WS_CTL);
    for (int u = F.tid; u < (LDS_BYTES - LDSCTL_OFF) / 4; u += NWAVES * 64) ((LAS unsigned*)(F.lds + LDSCTL_OFF))[u] = 0u;
    __syncthreads();
    XcdBarrier bar; bar.bar = (unsigned*)(F.ctl + CW_BAR); bar.x = 0; bar.st = nullptr;
    if (N_LAUNCHES == 1) bar = xcd_barrier_post((unsigned*)(F.ctl + CW_BAR), F.MISC + 8);
#define GRID_BAR() do { if (N_LAUNCHES == 1) xcd_barrier(bar); } while (0)
    const int lo = args.ph_lo, hi = args.ph_hi;
#define IN(k) (lo <= (k) && (k) < hi)
#ifndef PROBE_MASK
#define PROBE_MASK 0
#endif
#define TWICE(k) ((PROBE_MASK >> (k)) & 1)
#define BOTH(k) (IN(k) && IN((k) + 1))

    if (IN(0)) { p0_prologue(F); if (BOTH(0)) GRID_BAR(); }
    if (TWICE(0) && IN(0)) { p0_prologue(F); if (BOTH(0)) GRID_BAR(); }
    if (IN(1)) { p1_prenorm(F); if (BOTH(1)) GRID_BAR(); }
    if (TWICE(1) && IN(1)) { p1_prenorm(F); if (BOTH(1)) GRID_BAR(); }
    if (IN(2)) { p2_qkv(F); if (BOTH(2)) GRID_BAR(); }
    if (TWICE(2) && IN(2)) { p2_qkv(F); if (BOTH(2)) GRID_BAR(); }
    if (IN(3)) { p3_kmean(F); if (BOTH(3)) GRID_BAR(); }
    if (TWICE(3) && IN(3)) { p3_kmean(F); if (BOTH(3)) GRID_BAR(); }
    if (IN(4)) { p4_moba_select(F); if (BOTH(4)) GRID_BAR(); }
    if (IN(5)) { p5_moba_gather(F, (char*)lds + RING_OFF); if (BOTH(5)) GRID_BAR(); }
    if (TWICE(5) && IN(5)) { p5_moba_gather(F, (char*)lds + RING_OFF); if (BOTH(5)) GRID_BAR(); }
    if (IN(6)) { p6_attention(F, (char*)lds + RING_OFF); if (BOTH(6)) GRID_BAR(); }
    if (TWICE(6) && IN(6)) { p6_attention(F, (char*)lds + RING_OFF); if (BOTH(6)) GRID_BAR(); }
    if (IN(7)) { p7_ydiff(F); if (BOTH(7)) GRID_BAR(); }
    if (TWICE(7) && IN(7)) { p7_ydiff(F); if (BOTH(7)) GRID_BAR(); }
    if (IN(8)) { p8_wo(F); if (BOTH(8)) GRID_BAR(); }
    if (TWICE(8) && IN(8)) { p8_wo(F); if (BOTH(8)) GRID_BAR(); }
    if (IN(9)) { p9_postmix_route(F); if (BOTH(9)) GRID_BAR(); }
    if (IN(10)) { p10_gateup(F); if (BOTH(10)) GRID_BAR(); }
    if (TWICE(10) && IN(10)) { p10_gateup(F); if (BOTH(10)) GRID_BAR(); }
    if (IN(11)) { p11_down(F); if (BOTH(11)) GRID_BAR(); }
    if (TWICE(11) && IN(11)) { p11_down(F); if (BOTH(11)) GRID_BAR(); }
    if (IN(12)) { p12_final(F); }
#undef IN
#undef BOTH
#undef GRID_BAR
}

extern "C" void kernel_launch(void* const* d_in, const int* in_sizes, int n_in, void* d_out, int out_size, void* d_ws, size_t ws_size, hipStream_t stream) {
    static int grid = 0;
    if (grid == 0) {
        if (n_in != 23 || in_sizes[0] != M * D || out_size != M * D || ws_size < WS_END) { fprintf(stderr, "kernel_launch: unexpected shapes (n_in %d, in0 %d, out %d, ws %zu); nothing launched\n", n_in, n_in > 0 ? in_sizes[0] : -1, out_size, ws_size); grid = -1; return; }
        int dev = 0, cus = 0, per_cu = 0;
        if (hipGetDevice(&dev) != hipSuccess || hipDeviceGetAttribute(&cus, hipDeviceAttributeMultiprocessorCount, dev) != hipSuccess) { fprintf(stderr, "kernel_launch: device query failed\n"); grid = -1; return; }
        if (hipFuncSetAttribute((const void*)hymba_fwd, hipFuncAttributeMaxDynamicSharedMemorySize, LDS_BYTES) != hipSuccess) { fprintf(stderr, "kernel_launch: hipFuncSetAttribute failed\n"); grid = -1; return; }
        if (hipOccupancyMaxActiveBlocksPerMultiprocessor(&per_cu, (const void*)hymba_fwd, NWAVES * 64, LDS_BYTES) != hipSuccess || per_cu < 1)
            fprintf(stderr, "kernel_launch: note: occupancy query reports %d workgroups per CU\n", per_cu);
        (void)hipGetLastError();
        grid = cus;
    }
    if (grid < 0) return;
    if (hipMemsetAsync((char*)d_ws + WS_CTL, 0, CTL_ZERO_BYTES, stream) != hipSuccess) { fprintf(stderr, "kernel_launch: hipMemsetAsync failed\n"); return; }
    Args a{};
    for (int i = 0; i < 23; ++i) a.in[i] = (const float*)d_in[i];
    a.out = (float*)d_out; a.ws = (unsigned char*)d_ws;
    for (int li = 0; li < N_LAUNCHES; ++li) {
        a.ph_lo = (N_LAUNCHES == 1) ? 0 : li; a.ph_hi = (N_LAUNCHES == 1) ? N_PHASES : li + 1;
        hipLaunchKernelGGL(hymba_fwd, dim3(grid), dim3(NWAVES * 64), LDS_BYTES, stream, a);
        const hipError_t le = hipPeekAtLastError();
        if (le != hipSuccess) { fprintf(stderr, "kernel_launch: launch %d failed: %s\n", li, hipGetErrorName(le)); break; }
    }
}
```

```cpp
#include <hip/hip_runtime.h>
#include <hip/hip_bf16.h>
#include <cstdio>
#include <cstdint>
#include <cmath>

__device__ __forceinline__ int lane_now() { unsigned m_ = ~0u; asm volatile("" : "+s"(m_)); return (int)__builtin_amdgcn_mbcnt_hi(m_, __builtin_amdgcn_mbcnt_lo(m_, 0u)); }
namespace pg8 {
#define PG8_LAS __attribute__((address_space(3)))
typedef unsigned short bf16_t;
typedef short bf16x8 __attribute__((ext_vector_type(8)));
typedef float f32x4 __attribute__((ext_vector_type(4)));
typedef unsigned u32x4 __attribute__((ext_vector_type(4)));
constexpr int BM = 256, BK = 64, HALF = 128, HTB = HALF * BK * 2  , STAGE_BYTES = 8 * HTB, NXCD = 8, WGM = 8;

__host__ __device__ __forceinline__ int lds_byte(int r, int c) { const int st = (r >> 4) * 2 + (c >> 5), rr = r & 15, cc = c & 31, ob = rr * 64 + cc * 2; return st * 1024 + (ob ^ (((ob >> 9) & 1) << 5)); }
__host__ __device__ __forceinline__ void stage_rc(int b, int& R, int& C) { const int st = b / 1024, sb = b % 1024, swz = sb ^ (((sb >> 9) & 1) << 5); R = (st >> 1) * 16 + swz / 64; C = (st & 1) * 32 + (swz % 64) / 2; }
__host__ __device__ __forceinline__ int perm32(int rho) { const int n = rho >> 4, i = rho & 15; return 8 * (i >> 2) + 4 * n + (i & 3); }

struct Unit { int pm, pn; int nvalid; const int* rows; };
struct Gemm { const unsigned char* base; unsigned offA, offB; int K; int sA; };
typedef int v8i_t __attribute__((ext_vector_type(8)));
typedef int v4i_t __attribute__((ext_vector_type(4)));

struct StaticOrder {
    int nM, nN, nwg, G, c;
    __host__ __device__ void init(int M, int N, int G_, int c_) { nM = M / BM; nN = N / BM; nwg = nM * nN; G = G_; c = c_; }
    __host__ __device__ bool next(int i, Unit& u) const {
        const long L = (long)i * G + c; if (L >= nwg) return false;
        int wgid = (int)L; { const int q = nwg / NXCD, r = nwg % NXCD, xcd = wgid % NXCD, off = wgid / NXCD; wgid = (xcd < r ? xcd * (q + 1) : r * (q + 1) + (xcd - r) * q) + off; }
        const int nig = WGM * nN, gid = wgid / nig, fm = gid * WGM, gsz = (nM - fm) < WGM ? (nM - fm) : WGM;
        u.pm = fm + ((wgid % nig) % gsz); u.pn = (wgid % nig) / gsz; u.nvalid = 256; u.rows = nullptr; return true;
    }
    __device__ __forceinline__ int arow(const Unit&, int r) const { return r; }
};

__device__ __forceinline__ unsigned cvt_pk_bf16(float lo, float hi) { unsigned r; asm volatile("v_cvt_pk_bf16_f32 %0, %1, %2" : "=v"(r) : "v"(lo), "v"(hi)); return r; }

struct EpiQKV {
    static constexpr bool PERM = true;
    bf16_t* O; int ldc; unsigned qmask; float qscale; float* kmean; int kt0; bool f8tiles;
    __device__ __forceinline__ void operator()(const f32x4 (&acc)[2][2][4][2], const Unit& u, int wr, int wc, int fr, int fq) const {
        bf16_t* O = this->O; asm volatile("" : "+s"(O));
        const int row0 = u.pm * BM + wr * 64 + fr; const int col0 = u.pn * BM + wc * 32 + 8 * fq;
        const float sc = ((qmask >> u.pn) & 1u) ? qscale : 1.f;
#pragma unroll
        for (int ai = 0; ai < 2; ++ai)
#pragma unroll
            for (int m = 0; m < 4; ++m) { bf16_t* rowp = O + (size_t)(row0 + ai * HALF + m * 16) * ldc + col0;
#pragma unroll
                for (int bj = 0; bj < 2; ++bj) { const f32x4 v0 = acc[ai][bj][m][0] * sc, v1 = acc[ai][bj][m][1] * sc;
                    if (f8tiles && u.pn < 4) {
                        const float es = (u.pn < 2) ? 32.f : 4.f; int w0 = 0, w1 = 0;
                        w0 = __builtin_amdgcn_cvt_pk_fp8_f32(v0[0] * es, v0[1] * es, w0, false); w0 = __builtin_amdgcn_cvt_pk_fp8_f32(v0[2] * es, v0[3] * es, w0, true);
                        w1 = __builtin_amdgcn_cvt_pk_fp8_f32(v1[0] * es, v1[1] * es, w1, false); w1 = __builtin_amdgcn_cvt_pk_fp8_f32(v1[2] * es, v1[3] * es, w1, true);
                        typedef int v2i_t __attribute__((ext_vector_type(2)));
                        *(v2i_t*)((unsigned char*)(O + (size_t)(row0 + ai * HALF + m * 16) * ldc) + col0 + bj * HALF) = (v2i_t){w0, w1}; continue; }
                    u32x4 w; w.x = cvt_pk_bf16(v0[0], v0[1]); w.y = cvt_pk_bf16(v0[2], v0[3]); w.z = cvt_pk_bf16(v1[0], v1[1]); w.w = cvt_pk_bf16(v1[2], v1[3]);
                    *(u32x4*)(rowp + bj * HALF) = w; } }
        if (kmean != nullptr && (u.pn == kt0 || u.pn == kt0 + 1)) {
            float* km = kmean; asm volatile("" : "+s"(km));
#pragma unroll
            for (int bj = 0; bj < 2; ++bj)
#pragma unroll
                for (int n = 0; n < 2; ++n) { f32x4 cs = {0.f, 0.f, 0.f, 0.f};
#pragma unroll
                    for (int ai = 0; ai < 2; ++ai)
#pragma unroll
                        for (int m = 0; m < 4; ++m) cs += acc[ai][bj][m][n];
#pragma unroll
                    for (int i = 0; i < 4; ++i) { float v = cs[i];
                        v += __builtin_bit_cast(float, __builtin_amdgcn_update_dpp(0, __builtin_bit_cast(int, v), 0xB1, 0xf, 0xf, true)); v += __builtin_bit_cast(float, __builtin_amdgcn_update_dpp(0, __builtin_bit_cast(int, v), 0x4E, 0xf, 0xf, true));
                        v += __builtin_bit_cast(float, __builtin_amdgcn_update_dpp(0, __builtin_bit_cast(int, v), 0x141, 0xf, 0xf, true)); v += __builtin_bit_cast(float, __builtin_amdgcn_update_dpp(0, __builtin_bit_cast(int, v), 0x140, 0xf, 0xf, true));
                        if (fr == 0) { const int c = (u.pn - kt0) * BM + bj * HALF + wc * 32 + 8 * fq + 4 * n + i;
                            __hip_atomic_fetch_add(km + ((size_t)((u.pm >> 6) * 8 + (c >> 6)) * 64 + (u.pm & 63)) * 64 + (c & 63), v * (1.f / 256.f), __ATOMIC_RELAXED, __HIP_MEMORY_SCOPE_AGENT); } } }
        }
    }
};
struct EpiF32 {
    static constexpr bool PERM = false;
    float* O; int ldc;
    __device__ __forceinline__ void operator()(const f32x4 (&acc)[2][2][4][2], const Unit& u, int wr, int wc, int fr, int fq) const {
        const int col0 = u.pn * BM + wc * 32 + 4 * fq;
#pragma unroll
        for (int ai = 0; ai < 2; ++ai)
#pragma unroll
            for (int m = 0; m < 4; ++m) { float* rowp = O + (size_t)(u.pm * BM + ai * HALF + wr * 64 + m * 16 + fr) * ldc + col0;
#pragma unroll
                for (int bj = 0; bj < 2; ++bj)
#pragma unroll
                    for (int n = 0; n < 2; ++n) *(f32x4*)(rowp + bj * HALF + n * 16) = acc[ai][bj][m][n]; }
    }
};
struct EpiSwiGLU {
    static constexpr bool PERM = true;
    bf16_t* H;
    __device__ __forceinline__ void operator()(const f32x4 (&acc)[2][2][4][2], const Unit& u, int wr, int wc, int fr, int fq) const {
        const int col0 = (u.pn & 3) * 128 + wc * 32 + 8 * fq;
#pragma unroll
        for (int ai = 0; ai < 2; ++ai)
#pragma unroll
            for (int m = 0; m < 4; ++m) { bf16_t* rowp = H + (size_t)(u.pm * BM + ai * HALF + wr * 64 + m * 16 + fr) * 512 + col0;
                float h[8];
#pragma unroll
                for (int n = 0; n < 2; ++n)
#pragma unroll
                    for (int k = 0; k < 4; ++k) { const float gt = acc[ai][0][m][n][k], up = acc[ai][1][m][n][k];
                        h[n * 4 + k] = gt * __builtin_amdgcn_rcpf(1.f + __builtin_amdgcn_exp2f(-1.4426950408889634f * gt)) * up; }
                u32x4 w; w.x = cvt_pk_bf16(h[0], h[1]); w.y = cvt_pk_bf16(h[2], h[3]); w.z = cvt_pk_bf16(h[4], h[5]); w.w = cvt_pk_bf16(h[6], h[7]);
                *(u32x4*)rowp = w; }
    }
};
struct EpiSwiGLU8 {
    static constexpr bool PERM = true;
    unsigned char* H; float osc;
    __device__ __forceinline__ void operator()(const f32x4 (&acc)[2][2][4][2], const Unit& u, int wr, int wc, int fr, int fq) const {
        unsigned char* H = this->H; asm volatile("" : "+s"(H));
        const int col0 = (u.pn & 3) * 128 + wc * 32 + 8 * fq;
#pragma unroll
        for (int ai = 0; ai < 2; ++ai)
#pragma unroll
            for (int m = 0; m < 4; ++m) { unsigned char* rowp = H + (size_t)(u.pm * BM + ai * HALF + wr * 64 + m * 16 + fr) * 512 + col0;
                float h[8];
#pragma unroll
                for (int n = 0; n < 2; ++n)
#pragma unroll
                    for (int k = 0; k < 4; ++k) { const float gt = acc[ai][0][m][n][k], up = acc[ai][1][m][n][k];
                        h[n * 4 + k] = gt * __builtin_amdgcn_rcpf(1.f + __builtin_amdgcn_exp2f(-1.4426950408889634f * gt)) * up * osc; }
                int w0 = 0, w1 = 0;
                w0 = __builtin_amdgcn_cvt_pk_fp8_f32(h[0], h[1], w0, false); w0 = __builtin_amdgcn_cvt_pk_fp8_f32(h[2], h[3], w0, true);
                w1 = __builtin_amdgcn_cvt_pk_fp8_f32(h[4], h[5], w1, false); w1 = __builtin_amdgcn_cvt_pk_fp8_f32(h[6], h[7], w1, true);
                typedef int v2i_t __attribute__((ext_vector_type(2)));
                *(v2i_t*)rowp = (v2i_t){w0, w1}; }
    }
};
struct EpiDown {
    static constexpr bool PERM = true;
    bf16_t* SO;
    __device__ __forceinline__ void operator()(const f32x4 (&acc)[2][2][4][2], const Unit& u, int wr, int wc, int fr, int fq) const {
        bf16_t* SO = this->SO; asm volatile("" : "+s"(SO)); const int* rows_ = u.rows; asm volatile("" : "+v"(fr), "+v"(fq));
        const int col0 = (u.pn & 3) * BM + wc * 32 + 8 * fq;
#pragma unroll
        for (int ai = 0; ai < 2; ++ai)
#pragma unroll
            for (int m = 0; m < 4; ++m) { const int r = ai * HALF + wr * 64 + m * 16 + fr;
                if (r < u.nvalid) { const int ent = rows_[r]; unsigned char* rowp8 = (unsigned char*)SO + (size_t)ent * 1024 + col0;
#pragma unroll
                    for (int bj = 0; bj < 2; ++bj) { const f32x4 v0 = acc[ai][bj][m][0] * 16.f, v1 = acc[ai][bj][m][1] * 16.f;
                        int w0 = 0, w1 = 0; w0 = __builtin_amdgcn_cvt_pk_fp8_f32(v0[0], v0[1], w0, false); w0 = __builtin_amdgcn_cvt_pk_fp8_f32(v0[2], v0[3], w0, true);
                        w1 = __builtin_amdgcn_cvt_pk_fp8_f32(v1[0], v1[1], w1, false); w1 = __builtin_amdgcn_cvt_pk_fp8_f32(v1[2], v1[3], w1, true);
                        typedef int v2i_t __attribute__((ext_vector_type(2))); *(v2i_t*)((unsigned char*)rowp8 + bj * HALF) = (v2i_t){w0, w1}; } }
                __builtin_amdgcn_sched_barrier(0); }
    }
};

template <class Epi, class Sched, bool GATHER, bool FP8 = false>
__device__ __forceinline__ void gemm_phase(PG8_LAS unsigned char* lds, const Gemm g, const Sched& S, const Epi& E, int wv  ) {
    asm volatile("" : "+s"(wv));
    const int lane = lane_now(), wid = __builtin_amdgcn_readfirstlane(wv), tid = wid * 64 + lane,
               wr = wid >> 2, wc = wid & 3, fr = lane & 15, fq = lane >> 4;
    const int K = g.K, nt = K / BK;
    unsigned voffB[2];
#pragma unroll
    for (int i = 0; i < 2; ++i) { int R, C; stage_rc(tid * 16 + i * 8192, R, C); const int Rb = Epi::PERM ? ((R & ~31) + perm32(R & 31)) : R; voffB[i] = (unsigned)(Rb * K + C) * 2u; }
    const unsigned kstep = (unsigned)(BK * 2);
    const unsigned hstep = (unsigned)HALF * (unsigned)K * 2u;
    const unsigned tstep = 2u * hstep;
    const __amdgpu_buffer_rsrc_t rsA = __builtin_amdgcn_make_buffer_rsrc((void*)g.base, 0, 0x7ffffff0, 0x00020000);
#define rsB rsA
    const unsigned ldsw = (unsigned)wid * 1024u;
    const int aoff = lds_byte(wr * 64 + fr, fq * 8), boff = lds_byte(wc * 32 + fr, fq * 8);
    const PG8_LAS unsigned char* ldsB = lds + 4 * HTB + boff; asm volatile("" : "+v"(ldsB));
#define PG8_SA(b, h) (((b) * 2 + (h)) * HTB)
#define PG8_SB(b, h) ((4 + (b) * 2 + (h)) * HTB)
#define PG8_STAGE_A(bufoff, soff, voff) do { _Pragma("unroll") for (int _i = 0; _i < 2; ++_i) \
        __builtin_amdgcn_raw_ptr_buffer_load_lds(rsA, (PG8_LAS unsigned*)(lds + (bufoff) + ldsw + _i * 8192), 16, (int)(voff)[_i], (int)(soff), 0, 0); } while (0)
#define PG8_STAGE_B(bufoff, soff, voff) do { _Pragma("unroll") for (int _i = 0; _i < 2; ++_i) \
        __builtin_amdgcn_raw_ptr_buffer_load_lds(rsB, (PG8_LAS unsigned*)(lds + (bufoff) + ldsw + _i * 8192), 16, (int)(voff)[_i], (int)(soff), 0, 0); } while (0)
#define PG8_LDA(dst, b, h) do { _Pragma("unroll") for (int m = 0; m < 4; ++m) _Pragma("unroll") for (int k = 0; k < 2; ++k) dst[m][k] = *(const PG8_LAS bf16x8*)(lds + PG8_SA(b, h) + aoff + m * 2048 + k * 1024); } while (0)
#define PG8_LDB(dst, b, h) do { _Pragma("unroll") for (int n = 0; n < 2; ++n) _Pragma("unroll") for (int k = 0; k < 2; ++k) dst[n][k] = *(const PG8_LAS bf16x8*)(ldsB + ((b) * 2 + (h)) * HTB + n * 2048 + k * 1024); } while (0)
#define PG8_MMA(ai, bj, At, Bt) do { __builtin_amdgcn_s_setprio(1); _Pragma("unroll") for (int m = 0; m < 4; ++m) _Pragma("unroll") for (int n = 0; n < 2; ++n) _Pragma("unroll") for (int k = 0; k < 2; ++k) \
        acc[ai][bj][m][n] = __builtin_amdgcn_mfma_f32_16x16x32_bf16(Bt[n][k], At[m][k], acc[ai][bj][m][n], 0, 0, 0); __builtin_amdgcn_s_setprio(0); } while (0)
#define PG8_RD16(off) (*(const PG8_LAS v4i_t*)(lds + (off)))
#define PG8_CAT(x0, x1) __builtin_shufflevector(x0, x1, 0, 1, 2, 3, 4, 5, 6, 7)
#define PG8_LDA8(dst, b, h) do { _Pragma("unroll") for (int m = 0; m < 4; ++m) dst[m] = PG8_CAT(PG8_RD16(PG8_SA(b, h) + aoff + m * 2048), PG8_RD16(PG8_SA(b, h) + aoff + m * 2048 + 1024)); } while (0)
#define PG8_LDB8(dst, b, h) do { _Pragma("unroll") for (int n = 0; n < 2; ++n) dst[n] = PG8_CAT(*(const PG8_LAS v4i_t*)(ldsB + ((b) * 2 + (h)) * HTB + n * 2048), *(const PG8_LAS v4i_t*)(ldsB + ((b) * 2 + (h)) * HTB + n * 2048 + 1024)); } while (0)
#define PG8_MMA8(ai, bj, At, Bt) do { __builtin_amdgcn_s_setprio(1); _Pragma("unroll") for (int m = 0; m < 4; ++m) _Pragma("unroll") for (int n = 0; n < 2; ++n) \
        acc[ai][bj][m][n] = __builtin_amdgcn_mfma_scale_f32_16x16x128_f8f6f4(Bt[n], At[m], acc[ai][bj][m][n], 0, 0, 1, g.sA, 0, g.sA);     __builtin_amdgcn_s_setprio(0); } while (0)
#define PG8_LA(b, h) do { if constexpr (FP8) PG8_LDA8(At8, b, h); else PG8_LDA(At, b, h); } while (0)
#define PG8_LB0(b, h) do { if constexpr (FP8) PG8_LDB8(B08, b, h); else PG8_LDB(B0, b, h); } while (0)
#define PG8_LB1(b, h) do { if constexpr (FP8) PG8_LDB8(B18, b, h); else PG8_LDB(B1, b, h); } while (0)
#define PG8_MM0(ai, bj) do { if constexpr (FP8) PG8_MMA8(ai, bj, At8, B08); else PG8_MMA(ai, bj, At, B0); } while (0)
#define PG8_MM1(ai, bj) do { if constexpr (FP8) PG8_MMA8(ai, bj, At8, B18); else PG8_MMA(ai, bj, At, B1); } while (0)
#define PG8_WAIT_V(n) asm volatile("s_waitcnt vmcnt(" #n ")" ::: "memory")
#define PG8_WAIT_L(n) asm volatile("s_waitcnt lgkmcnt(" #n ")" ::: "memory")
#define PG8_BAR __builtin_amdgcn_s_barrier()
#define PG8_SCHED __builtin_amdgcn_sched_barrier(0)
#define PG8_CALC_VOFF(u, vo) do { _Pragma("unroll") for (int h_ = 0; h_ < 2; ++h_) _Pragma("unroll") for (int i_ = 0; i_ < 2; ++i_) { int R_, C_; stage_rc(tid * 16 + i_ * 8192, R_, C_); \
        if constexpr (GATHER) { const int tok_ = S.arow(u, h_ * HALF + R_); vo[h_][i_] = (unsigned)(tok_ * K + C_) * 2u; } \
        else vo[h_][i_] = (unsigned)(R_ * K + C_) * 2u + (unsigned)(h_ * hstep); } } while (0)
    Unit cur, nxt; int ui = 0;
    if (!S.next(0, cur)) return;
    unsigned vA[2][2], nvA[2][2];
    PG8_CALC_VOFF(cur, vA);
    if constexpr (GATHER) asm volatile("" : "+v"(vA[0][0]), "+v"(vA[0][1]), "+v"(vA[1][0]), "+v"(vA[1][1]));
    f32x4 acc[2][2][4][2];
#pragma unroll
    for (int a = 0; a < 2; ++a)
#pragma unroll
        for (int b = 0; b < 2; ++b)
#pragma unroll
            for (int m = 0; m < 4; ++m)
#pragma unroll
                for (int n = 0; n < 2; ++n) acc[a][b][m][n] = (f32x4){0.f, 0.f, 0.f, 0.f};
    bf16x8 At[4][2], B0[2][2], B1[2][2]; v8i_t At8[4], B08[2], B18[2];
    unsigned cA = g.offA + (GATHER ? 0u : (unsigned)cur.pm * tstep), cB = g.offB + (unsigned)cur.pn * tstep;
    PG8_STAGE_B(PG8_SB(0, 0), cB, voffB); PG8_STAGE_B(PG8_SB(0, 1), cB + hstep, voffB); PG8_STAGE_A(PG8_SA(0, 0), cA, vA[0]); PG8_STAGE_A(PG8_SA(0, 1), cA, vA[1]);
    if (wr == 1) PG8_BAR;
    PG8_WAIT_V(2); PG8_BAR;
    PG8_STAGE_B(PG8_SB(1, 0), cB + kstep, voffB); PG8_STAGE_A(PG8_SA(1, 0), cA + kstep, vA[0]); PG8_STAGE_B(PG8_SB(1, 1), cB + hstep + kstep, voffB);
    PG8_WAIT_V(6); PG8_BAR;
    for (;;) {
        const bool has_next = S.next(ui + 1, nxt);
        const unsigned nA = has_next ? g.offA + (GATHER ? 0u : (unsigned)nxt.pm * tstep) : cA, nB = has_next ? g.offB + (unsigned)nxt.pn * tstep : cB;
        if constexpr (GATHER) {
            if (has_next) { PG8_CALC_VOFF(nxt, nvA); }
            else {
#pragma unroll
                for (int h_ = 0; h_ < 2; ++h_)
#pragma unroll
                    for (int i_ = 0; i_ < 2; ++i_) nvA[h_][i_] = vA[h_][i_]; }
            asm volatile("" : "+v"(nvA[0][0]), "+v"(nvA[0][1]), "+v"(nvA[1][0]), "+v"(nvA[1][1]));
        }
#pragma clang loop unroll(disable)
        for (int t = 0; t < nt; t += 2) {
            const bool last = (t == nt - 2);
            const unsigned a1 = cA + (unsigned)(t + 1) * kstep;
            const unsigned a2 = last ? nA : cA + (unsigned)(t + 2) * kstep, b2 = last ? nB : cB + (unsigned)(t + 2) * kstep;
            const unsigned a3 = a2 + kstep, b3 = b2 + kstep;
            PG8_LB0(0, 0); PG8_LB1(0, 1); PG8_SCHED; PG8_LA(0, 0); PG8_STAGE_A(PG8_SA(1, 1), a1, vA[1]);
            if constexpr (GATHER) { if (last) { _Pragma("unroll") for (int h_ = 0; h_ < 2; ++h_) _Pragma("unroll") for (int i_ = 0; i_ < 2; ++i_) vA[h_][i_] = nvA[h_][i_]; } }
            PG8_WAIT_V(8); PG8_WAIT_L(0); PG8_BAR; PG8_MM0(0, 0); PG8_MM1(0, 1); PG8_BAR; PG8_SCHED;
            PG8_LA(0, 1); PG8_STAGE_B(PG8_SB(0, 0), b2, voffB); PG8_STAGE_B(PG8_SB(0, 1), b2 + hstep, voffB); PG8_STAGE_A(PG8_SA(0, 0), a2, vA[0]);
            PG8_WAIT_V(8); PG8_WAIT_L(0); PG8_BAR; PG8_MM0(1, 0); PG8_MM1(1, 1); PG8_BAR; PG8_SCHED;
            PG8_LB0(1, 0); PG8_LB1(1, 1); PG8_SCHED; PG8_LA(1, 0); PG8_STAGE_A(PG8_SA(0, 1), a2, vA[1]);
            PG8_WAIT_V(8); PG8_WAIT_L(0); PG8_BAR; PG8_MM0(0, 0); PG8_MM1(0, 1); PG8_BAR; PG8_SCHED;
            PG8_LA(1, 1); PG8_STAGE_B(PG8_SB(1, 0), b3, voffB); PG8_STAGE_B(PG8_SB(1, 1), b3 + hstep, voffB); PG8_STAGE_A(PG8_SA(1, 0), a3, vA[0]);
            PG8_WAIT_V(8); PG8_WAIT_L(0); PG8_BAR; PG8_MM0(1, 0); PG8_MM1(1, 1); PG8_BAR; PG8_SCHED;
        }
        if (wr == 0) PG8_BAR;
        { const int ln_ = lane_now(); E(acc, cur, wr, wc, ln_ & 15, ln_ >> 4); }
        if (!has_next) break;
#pragma unroll
        for (int a = 0; a < 2; ++a)
#pragma unroll
            for (int b = 0; b < 2; ++b)
#pragma unroll
                for (int m = 0; m < 4; ++m)
#pragma unroll
                    for (int n = 0; n < 2; ++n) acc[a][b][m][n] = (f32x4){0.f, 0.f, 0.f, 0.f};
        cur = nxt; cA = nA; cB = nB; ++ui;
        if (wr == 1) PG8_BAR;
    }
    PG8_WAIT_V(0);
    PG8_BAR;
#undef PG8_SA
#undef PG8_SB
#undef PG8_STAGE_A
#undef rsB
#undef PG8_STAGE_B
#undef PG8_LDA
#undef PG8_LDB
#undef PG8_MMA
#undef PG8_MMA8
#undef PG8_CAT
#undef PG8_RD16
#undef PG8_LDA8
#undef PG8_LDB8
#undef PG8_LA
#undef PG8_LB0
#undef PG8_LB1
#undef PG8_MM0
#undef PG8_MM1
#undef PG8_WAIT_V
#undef PG8_WAIT_L
#undef PG8_BAR
#undef PG8_SCHED
#undef PG8_CALC_VOFF
}
}

namespace attn_body {
using bf16=__hip_bfloat16;
using bf16x8=__attribute__((ext_vector_type(8)))short;
using s16x4=__attribute__((ext_vector_type(4)))short;
using f32x16=__attribute__((ext_vector_type(16)))float;
using u32x4=__attribute__((ext_vector_type(4)))unsigned;
constexpr int SEQ=16384,D=64;
constexpr int LDQ=3072;
constexpr int LDO=1024;
constexpr int NW=8,QBLK=32,QB=QBLK*NW,KVBLK=64,NQB=SEQ/QB;
__device__ __forceinline__ int crow(int r,int hi){return (r&3)+8*(r>>2)+4*hi;}
#define SBAR() __builtin_amdgcn_sched_barrier(0)
#ifndef PRIO_G1A1
#define PRIO_G1A1 2
#define PRIO_G1B1 0
#define PRIO_G1A2 2
#define PRIO_G1B2 0
#define PRIO_G2A1 2
#define PRIO_G2B1 1
#define PRIO_G2A2 2
#define PRIO_G2B2 1
#endif
#if defined(STAMP_PROBE)
#ifndef STAMP_WAVE
#define STAMP_WAVE 0
#endif
#define STAMP_PARAM ,float*dbg
#define STAMP_NOW() ((unsigned)__builtin_amdgcn_s_memtime())
#if STAMP_PROBE == 2
#define STAMP_DECL unsigned st_pre_=0u,st_acc_=0u,st_n_=0u;
#define STAMP_PRE  { st_pre_=STAMP_NOW(); }
#define STAMP_POST { st_acc_+=STAMP_NOW()-st_pre_; ++st_n_; }
#define STAMP_FINI { if(dbg&&wid==STAMP_WAVE&&lane_now()==0&&st_n_>0u){ dbg[2]=(float)st_acc_/(float)st_n_; } }
#elif STAMP_PROBE == 1
#define STAMP_DECL const unsigned st_t0_=STAMP_NOW(); const unsigned st_r0_=(unsigned)__builtin_amdgcn_s_memrealtime();
#define STAMP_PRE
#define STAMP_POST
#define STAMP_FINI { const unsigned t1_=STAMP_NOW(),r1_=(unsigned)__builtin_amdgcn_s_memrealtime(); if(dbg&&wid==STAMP_WAVE&&lane_now()==0){ dbg[1]=(float)(t1_-st_t0_)/(float)(r1_-st_r0_)*100.0f; } }
#else
#define STAMP_DECL const unsigned st_t0_=STAMP_NOW(); const int st_ts_=t;
#define STAMP_PRE
#define STAMP_POST
#define STAMP_FINI { const unsigned t1_=STAMP_NOW(); if(dbg&&wid==STAMP_WAVE&&lane_now()==0&&t>st_ts_){ dbg[0]=(float)(t1_-st_t0_)/(float)(t-st_ts_); dbg[4]=5000.0f; } }
#endif
#else
#define STAMP_PARAM
#define STAMP_DECL
#define STAMP_PRE
#define STAMP_POST
#define STAMP_FINI
#endif
#ifndef STAMP_PLACE
#define STAMP_PLACE 0
#endif
#if STAMP_PLACE == 0
#define SP_W0 STAMP_PRE
#define SP_W1 STAMP_POST
#else
#define SP_W0
#define SP_W1
#endif
#if STAMP_PLACE == 1
#define SP_A0 STAMP_PRE
#define SP_A1 STAMP_POST
#else
#define SP_A0
#define SP_A1
#endif
#if STAMP_PLACE == 2
#define SP_B0 STAMP_PRE
#define SP_B1 STAMP_POST
#else
#define SP_B0
#define SP_B1
#endif
#if STAMP_PLACE == 3
#define SP_D0 STAMP_PRE
#define SP_D1 STAMP_POST
#else
#define SP_D0
#define SP_D1
#endif
typedef __attribute__((address_space(3))) const float* lds_cfptr;
__device__ __forceinline__ void biasmask(f32x16&p0,f32x16&p1,int jb,int qrel,int hi,lds_cfptr bl){
  const float NEG=-INFINITY; const int kb=64*jb+4*hi;
  #pragma unroll
  for(int g=0;g<4;++g){
    float b0[4],b1[4]; int d0v[4];
    #pragma unroll
    for(int rr=0;rr<4;++rr){const int r=4*g+rr; const int kv=kb+(r&3)+8*(r>>2); const int d0=qrel-kv,d1=d0-32; d0v[rr]=d0;
      const int i0=d0<0?0:(d0>127?127:d0), i1=d1<0?0:(d1>127?127:d1);
      b0[rr]=bl[i0]; b1[rr]=bl[i1];}
    asm volatile("":"+v"(b0[0]),"+v"(b0[1]),"+v"(b0[2]),"+v"(b0[3]),"+v"(b1[0]),"+v"(b1[1]),"+v"(b1[2]),"+v"(b1[3]));
    #pragma unroll
    for(int rr=0;rr<4;++rr){const int r=4*g+rr; const int d0=d0v[rr],d1=d0-32;
      p0[r]=d0<0?NEG:p0[r]+b0[rr]; p1[r]=d1<0?NEG:p1[r]+b1[rr];}
    __builtin_amdgcn_sched_barrier(0); }
}

constexpr int LDS_BT4=49152+4096;
__device__ __forceinline__ void biasmask4(f32x16&p0,f32x16&p1,int jb,int qrel,int hi,__attribute__((address_space(3))) const char* shm3){
  const int j=qrel-64*jb-4*hi+197;
  const __attribute__((address_space(3))) char* a=shm3+LDS_BT4+(j&3)*2048+(j&~3)*4;
  #pragma unroll
  for(int g=0;g<4;++g){ const pg8::f32x4 v0=*(const __attribute__((address_space(3))) pg8::f32x4*)(a+128+32*(3-g)), v1=*(const __attribute__((address_space(3))) pg8::f32x4*)(a+32*(3-g));
    #pragma unroll
    for(int rr=0;rr<4;++rr){ p0[4*g+rr]=(v0[3-rr]==-INFINITY)?-INFINITY:p0[4*g+rr]+v0[3-rr]; p1[4*g+rr]=(v1[3-rr]==-INFINITY)?-INFINITY:p1[4*g+rr]+v1[3-rr]; } }
}

#define BMM(P0,P1,jb,q,h) biasmask(P0,P1,jb,q,h,bl)
#define BMF(P0,P1,jb,q,h) biasmask4(P0,P1,jb,q,h,shm3)
constexpr int NSLOT=3, SLOTB=8192;
constexpr int LDS_K=0, LDS_V=NSLOT*SLOTB, LDS_WS=2*NSLOT*SLOTB, LDS_OST=LDS_WS+NW*128*4+8192, LDS_BIAS=LDS_OST+NW*4096, LDS_BYTES=LDS_BIAS+512;
constexpr float C2=0.125f*1.4426950408889634f;
__device__ __forceinline__ void glds16(const void*gsrc,unsigned lds_dst){unsigned keep;
  asm volatile("s_mov_b32 %0, m0\n\ts_mov_b32 m0, %2\n\ts_nop 0\n\tglobal_load_lds_dwordx4 %1, off\n\ts_mov_b32 m0, %0\n\ts_nop 0":"=&s"(keep):"v"(gsrc),"s"(lds_dst):"memory");}
__device__ __forceinline__ float max3f(float a,float b,float c){float r;asm("v_max3_f32 %0, %1, %2, %3":"=v"(r):"v"(a),"v"(b),"v"(c));return r;}
__device__ __forceinline__ float max2f(float a,float b){float r;asm("v_max_f32_e32 %0, %1, %2":"=v"(r):"v"(a),"v"(b));return r;}
__device__ __forceinline__ float fadd_s(float a,float b){float r;asm("v_add_f32_e32 %0, %1, %2":"=v"(r):"v"(a),"v"(b));return r;}
__device__ __forceinline__ float fsub_s(float a,float b){float r;asm("v_sub_f32_e32 %0, %1, %2":"=v"(r):"v"(a),"v"(b));return r;}
typedef float f32x2_t __attribute__((ext_vector_type(2))); typedef __bf16 bf16x2_t __attribute__((ext_vector_type(2)));
__device__ __forceinline__ unsigned cvtpk_s(float lo,float hi){f32x2_t v={lo,hi};bf16x2_t b=__builtin_convertvector(v,bf16x2_t);return __builtin_bit_cast(unsigned,b);}
#define WAIT_BAR(N) asm volatile("s_waitcnt vmcnt(" #N ") lgkmcnt(0)\n\ts_barrier":::"memory")

__device__ __forceinline__ void qkt(f32x16&p0,f32x16&p1,const char*Kslot,const bf16x8*qr,const f32x16&negm,int r32,int hi){
  const char*kb=Kslot+hi*1024+r32*16;
  #pragma unroll
  for(int d0=0;d0<4;++d0){
    const bf16x8 b0=*reinterpret_cast<const bf16x8*>(kb+d0*2048);
    const bf16x8 b1=*reinterpret_cast<const bf16x8*>(kb+d0*2048+512);
    if(d0==0){p0=__builtin_amdgcn_mfma_f32_32x32x16_bf16(b0,qr[0],negm,0,0,0);p1=__builtin_amdgcn_mfma_f32_32x32x16_bf16(b1,qr[0],negm,0,0,0);}
    else{p0=__builtin_amdgcn_mfma_f32_32x32x16_bf16(b0,qr[d0],p0,0,0,0);p1=__builtin_amdgcn_mfma_f32_32x32x16_bf16(b1,qr[d0],p1,0,0,0);}}
}
typedef __attribute__((address_space(3))) const char* lds_cptr;
typedef short v4i16_t __attribute__((ext_vector_type(4)));
__device__ __forceinline__ void kload8(bf16x8*kf,lds_cptr kp){
  kf[0]=*(const __attribute__((address_space(3))) bf16x8*)(kp);      kf[1]=*(const __attribute__((address_space(3))) bf16x8*)(kp+512);
  kf[2]=*(const __attribute__((address_space(3))) bf16x8*)(kp+2048); kf[3]=*(const __attribute__((address_space(3))) bf16x8*)(kp+2560);
  kf[4]=*(const __attribute__((address_space(3))) bf16x8*)(kp+4096); kf[5]=*(const __attribute__((address_space(3))) bf16x8*)(kp+4608);
  kf[6]=*(const __attribute__((address_space(3))) bf16x8*)(kp+6144); kf[7]=*(const __attribute__((address_space(3))) bf16x8*)(kp+6656);
}
__device__ __forceinline__ void kload2(bf16x8*kf,lds_cptr kp,int j){ kf[2*j]=*(const __attribute__((address_space(3))) bf16x8*)(kp+j*2048); kf[2*j+1]=*(const __attribute__((address_space(3))) bf16x8*)(kp+j*2048+512); }
__device__ __forceinline__ s16x4 vtr(lds_cptr p){ return __builtin_bit_cast(s16x4,__builtin_amdgcn_ds_read_tr16_b64_v4i16((__attribute__((address_space(3))) v4i16_t*)p)); }
__device__ __forceinline__ float rowmax(const f32x16&p0,const f32x16&p1){
  float a=max3f(p0[0],p0[1],p1[0]),b=max3f(p0[2],p0[3],p1[1]);a=max3f(a,p1[2],p1[3]);
  #pragma unroll
  for(int r=4;r<16;r+=4){a=max3f(a,p0[r],p0[r+1]);b=max3f(b,p0[r+2],p0[r+3]);a=max3f(a,p1[r],p1[r+1]);b=max3f(b,p1[r+2],p1[r+3]);}
  const float m=max2f(a,b);
  auto rr=__builtin_amdgcn_permlane32_swap(__float_as_uint(m),__float_as_uint(m),false,false);
  return max2f(__uint_as_float(rr[0]),__uint_as_float(rr[1]));
}
__device__ __forceinline__ float rowmax_c(const f32x16&p0,const f32x16&p1){
  float a=__builtin_fmaxf(p0[0],p1[0]);
  #pragma unroll
  for(int r=1;r<16;++r){a=__builtin_fmaxf(a,__builtin_fmaxf(p0[r],p1[r]));}
  auto rr=__builtin_amdgcn_permlane32_swap(__float_as_uint(a),__float_as_uint(a),false,false);
  return __builtin_fmaxf(__uint_as_float(rr[0]),__uint_as_float(rr[1]));
}
__device__ __forceinline__ void pv(f32x16*o,int vb,bf16x8 pa0,bf16x8 pa1,bf16x8 pa2,bf16x8 pa3){
  #pragma unroll
  for(int d0=0;d0<2;++d0){s16x4 lo[4],hi[4];
    #pragma unroll
    for(int ks=0;ks<4;++ks){
      asm volatile("ds_read_b64_tr_b16 %0,%1 offset:%c2":"=&v"(lo[ks]):"v"(vb),"i"(d0*4096+ks*1024):"memory");
      asm volatile("ds_read_b64_tr_b16 %0,%1 offset:%c2":"=&v"(hi[ks]):"v"(vb),"i"(d0*4096+ks*1024+512):"memory");}
    asm volatile("s_waitcnt lgkmcnt(0)":::"memory");SBAR();
    #define PK(k) (bf16x8){lo[k][0],lo[k][1],lo[k][2],lo[k][3],hi[k][0],hi[k][1],hi[k][2],hi[k][3]}
    o[d0]=__builtin_amdgcn_mfma_f32_32x32x16_bf16(pa0,PK(0),o[d0],0,0,0);
    o[d0]=__builtin_amdgcn_mfma_f32_32x32x16_bf16(pa1,PK(1),o[d0],0,0,0);
    o[d0]=__builtin_amdgcn_mfma_f32_32x32x16_bf16(pa2,PK(2),o[d0],0,0,0);
    o[d0]=__builtin_amdgcn_mfma_f32_32x32x16_bf16(pa3,PK(3),o[d0],0,0,0);
    #undef PK
  }
}
__device__ __forceinline__ float bflo(unsigned u){return __uint_as_float(u<<16);}
__device__ __forceinline__ float bfhi(unsigned u){return __uint_as_float(u&0xffff0000u);}

struct MobaMerge { const float* pml; const bf16* po; long grow0; int h; int ns; };
constexpr long MROWS=2L*SEQ;
struct GatherArgs { unsigned gent; int n; float* pml; bf16* po; long growb; int h; };
__device__ __forceinline__ void gbias(f32x16&p0,f32x16&p1,int dq,int hi,lds_cfptr bl){
  #pragma unroll
  for(int g=0;g<4;++g){
    #pragma unroll
    for(int rr=0;rr<4;++rr){const int r=4*g+rr; const int d0=dq-(4*hi+(r&3)+8*(r>>2)),d1=d0-32;
      const int i0=d0<0?0:(d0>127?127:d0), i1=d1<0?0:(d1>127?127:d1);
      p0[r]+=bl[i0]; p1[r]+=bl[i1];}
    __builtin_amdgcn_sched_barrier(0); }
}

template<int THRL,int MODE> __device__ __forceinline__ void attn_unit(const bf16*Qp,const bf16*__restrict__ Kp,const bf16*__restrict__ Vp,bf16*Op,int q0,int kv0,int NT,const float*biasG,const MobaMerge&mm,const GatherArgs&ga,char*shm,int wv,bool newtab=true){
  const int lane=lane_now();
  asm volatile("":"+s"(wv)); const int wid=__builtin_amdgcn_readfirstlane(wv), tid=wid*64+lane, r32=lane&31, hi=lane>>5;
  unsigned gent=0u; int qloc=0;
  if constexpr(MODE==2){ gent=ga.gent; qloc=(int)(gent&0x3FFFu); }
  const bf16*Qw=(MODE==2)?(Qp+(long)(qloc-r32)*LDQ):(Qp+(long)(q0+wid*QBLK)*LDQ);
  const bf16*Kh=Kp+(long)kv0*LDQ,*Vh=Vp+(long)kv0*LDQ;
  const unsigned lds0=(unsigned)(uintptr_t)shm;
  float*wsf=(float*)(shm+LDS_WS)+wid*128;
  const lds_cptr shm3=(lds_cptr)shm;
  asm volatile("":"+s"(biasG));
  if(newtab && wid==0){ glds16((const char*)biasG+lane*16,(unsigned)__builtin_amdgcn_readfirstlane(lds0+LDS_BIAS)); }
  const lds_cfptr bl=(lds_cfptr)(shm3+LDS_BIAS);
  const bf16*ksrc=Kh+(long)lane*LDQ+wid*8;
  const bf16*vsrc=Vh+(long)(16*(wid&3)+(lane>>2))*LDQ+(wid>>2)*32+(lane&3)*8;
  const unsigned kdst=lds0+LDS_K+wid*1024, vdst=lds0+LDS_V+wid*1024;
  #define DMA_K(t,slot) glds16(ksrc+(long)(t)*KVBLK*LDQ,(unsigned)__builtin_amdgcn_readfirstlane(kdst+(slot)))
  #define DMA_V(t,slot) glds16(vsrc+(long)(t)*KVBLK*LDQ,(unsigned)__builtin_amdgcn_readfirstlane(vdst+(slot)))
  const int vb0=(int)(lds0+LDS_V)+((lane>>4)&1)*32+(lane&3)*8+(4*hi+((lane&15)>>2))*64;
  const char*Kbase=shm+LDS_K; bf16x8 kf[8];
  const lds_cptr kp0=shm3+LDS_K+hi*1024+r32*16; const lds_cptr vp0=shm3+LDS_V+((lane>>4)&1)*32+(lane&3)*8+(4*hi+((lane&15)>>2))*64;
  DMA_K(0,0);DMA_V(0,0);DMA_K(1,SLOTB);
  bf16x8 qr[4];
  #pragma unroll
  for(int d0=0;d0<4;++d0)qr[d0]=*reinterpret_cast<const bf16x8*>(&Qw[(long)r32*LDQ+d0*16+hi*8]);
  float mhat=0.f,l_reg=0.f;f32x16 o[2];o[0]=f32x16{};o[1]=f32x16{};f32x16 negm=f32x16{};asm volatile("":"+v"(negm));
  const int qrel=wid*QBLK+r32;
  const bool nearq=(MODE==2)?(bool)__any(qloc-(kv0+128)<128+113):false;
  #define CMASK(P0,P1,t) do{ if constexpr(MODE==2){ if((t)>=2 && nearq)gbias(P0,P1,qloc-(kv0+64*(t)),hi,bl); } else { int jb_=(t)-(NT-4); if(jb_>=-2 && (32*wid-(64*jb_+63))<113)BMM(P0,P1,jb_,qrel,hi); } }while(0)
  bool resc=false;
  #define START(P0,P1) do{ const float rm=rowmax(P0,P1); resc=false; \
    { const float dl=rm; mhat=fadd_s(mhat,dl); \
      _Pragma("unroll") for(int r=0;r<16;++r){P0[r]=fsub_s(P0[r],dl);P1[r]=fsub_s(P1[r],dl);} \
      _Pragma("unroll") for(int r=0;r<16;++r)negm[r]=-mhat; asm volatile("":"+v"(negm)); } \
    _Pragma("unroll") for(int r=0;r<16;++r)P0[r]=__builtin_amdgcn_exp2f(P0[r]); }while(0)
  #define RESC() do{ if(resc){ asm volatile("s_waitcnt lgkmcnt(0)":::"memory"); \
      _Pragma("unroll") for(int d_=0;d_<2;++d_) _Pragma("unroll") for(int r=0;r<16;++r)o[d_][r]*=wsf[crow(r,hi)]; } }while(0)
  f32x16 pA0,pA1,pB0,pB1;
  int sl_prev=0,sl_cur=0,sl_next=SLOTB;
  #define ROT() do{sl_prev=sl_cur;sl_cur=sl_next;sl_next=(sl_next==(NSLOT-1)*SLOTB)?0:sl_next+SLOTB;}while(0)
  DMA_K(2,2*SLOTB);
  WAIT_BAR(3);
  qkt(pA0,pA1,Kbase,qr,negm,r32,hi);asm volatile("s_nop 15\n\ts_nop 7":"+v"(pA0),"+v"(pA1));CMASK(pA0,pA1,0);
  START(pA0,pA1);
  _Pragma("unroll") for(int r=0;r<16;++r)pA1[r]=__builtin_amdgcn_exp2f(pA1[r]);
  WAIT_BAR(0);
  DMA_K(3,0);DMA_V(1,SLOTB);
  ROT();
  kload8(kf,kp0+sl_cur);
  WAIT_BAR(2);
  s16x4 vlo[8],vhi[8]; u32x4 pw0,pw1,pw2,pw3;
  #define PKW(P,B) cvtpk_s(P[B],P[B+1])
  #define PAF(k) __builtin_bit_cast(bf16x8,pw##k)
  #define VFR(i) (bf16x8){vlo[i][0],vlo[i][1],vlo[i][2],vlo[i][3],vhi[i][0],vhi[i][1],vhi[i][2],vhi[i][3]}
  #define PIN(x) asm volatile("":"+v"(x))
  #define MX3(a,b,c) __builtin_fmaxf(__builtin_fmaxf((a),(b)),(c))
  #define GAPA(MF,A0,A1,A2,A3,W0,W1,PW) do{ MF; sacc+=A0; sacc+=A1; sacc+=A2; sacc+=A3; PIN(sacc); W0; W1; PIN(PW); SBAR(); }while(0)
  #define EX(v) __builtin_amdgcn_exp2f(v)
  #define GAPB(MF,X,B) do{ MF; { float e0_=EX(X[B]),e1_=EX(X[B+1]),e2_=EX(X[B+2]),e3_=EX(X[B+3]); asm volatile("":"+v"(e0_),"+v"(e1_),"+v"(e2_),"+v"(e3_)); X[B]=e0_;X[B+1]=e1_;X[B+2]=e2_;X[B+3]=e3_; } SBAR(); }while(0)
  #define VRD(i) do{ vlo[i]=vtr(vp_+(((i)>>2)*4096+((i)&3)*1024)); vhi[i]=vtr(vp_+(((i)>>2)*4096+((i)&3)*1024+512)); }while(0)
  #define KRD(G,j) do{ if(G){ kload2(kf,kp0+sl_next,j); SBAR(); } }while(0)
  #define STEP(C0,C1,P0,P1,t,GK,GV,GL) do{ SBAR(); \
    const lds_cptr vp_=vp0+sl_prev; \
    VRD(0); SBAR(); float sacc=(P0[0]+P0[1]); \
    GAPA(C0=__builtin_amdgcn_mfma_f32_32x32x16_bf16(kf[0],qr[0],negm,0,0,0), P0[2],P0[3],P0[4],P0[5],     pw0[0]=PKW(P0,0), pw0[1]=PKW(P0,2), pw0); \
    VRD(4); SBAR(); GAPA(C1=__builtin_amdgcn_mfma_f32_32x32x16_bf16(kf[1],qr[0],negm,0,0,0), P0[6],P0[7],P0[8],P0[9],     pw0[2]=PKW(P0,4), pw0[3]=PKW(P0,6), pw0); \
    VRD(1); SBAR(); GAPA(C0=__builtin_amdgcn_mfma_f32_32x32x16_bf16(kf[2],qr[1],C0,0,0,0),   P0[10],P0[11],P0[12],P0[13], pw1[0]=PKW(P0,8), pw1[1]=PKW(P0,10), pw1); \
    VRD(5); SBAR(); GAPA(C1=__builtin_amdgcn_mfma_f32_32x32x16_bf16(kf[3],qr[1],C1,0,0,0),   P0[14],P0[15],P1[0],P1[1],   pw1[2]=PKW(P0,12),pw1[3]=PKW(P0,14), pw1); \
    VRD(2); SBAR(); GAPA(C0=__builtin_amdgcn_mfma_f32_32x32x16_bf16(kf[4],qr[2],C0,0,0,0),   P1[2],P1[3],P1[4],P1[5],     pw2[0]=PKW(P1,0), pw2[1]=PKW(P1,2), pw2); \
    VRD(6); SBAR(); GAPA(C1=__builtin_amdgcn_mfma_f32_32x32x16_bf16(kf[5],qr[2],C1,0,0,0),   P1[6],P1[7],P1[8],P1[9],     pw2[2]=PKW(P1,4), pw2[3]=PKW(P1,6), pw2); \
    VRD(3); SBAR(); GAPA(C0=__builtin_amdgcn_mfma_f32_32x32x16_bf16(kf[6],qr[3],C0,0,0,0),   P1[10],P1[11],P1[12],P1[13], pw3[0]=PKW(P1,8), pw3[1]=PKW(P1,10), pw3); \
    VRD(7); SBAR(); GAPA(C1=__builtin_amdgcn_mfma_f32_32x32x16_bf16(kf[7],qr[3],C1,0,0,0),   P1[14],P1[15],0.f,0.f,       pw3[2]=PKW(P1,12),pw3[3]=PKW(P1,14), pw3); \
    l_reg+=sacc; \
    CMASK(C0,C1,t); \
    { float a=MX3(C0[0],C0[1],C1[0]),b=MX3(C0[2],C0[3],C1[1]); a=MX3(a,C1[2],C1[3]); \
      _Pragma("unroll") for(int r=4;r<16;r+=4){a=MX3(a,C0[r],C0[r+1]);b=MX3(b,C0[r+2],C0[r+3]);a=MX3(a,C1[r],C1[r+1]);b=MX3(b,C1[r+2],C1[r+3]);} \
      float rm=__builtin_fmaxf(a,b); { auto rr=__builtin_amdgcn_permlane32_swap(__float_as_uint(rm),__float_as_uint(rm),false,false); rm=__builtin_fmaxf(__uint_as_float(rr[0]),__uint_as_float(rr[1])); } \
      resc=false; \
      if(__builtin_expect(__any(rm>(float)THRL),0)){ const float dl=__builtin_fmaxf(rm,0.f); mhat+=dl; \
        _Pragma("unroll") for(int r=0;r<16;++r){C0[r]-=dl;C1[r]-=dl;} \
        _Pragma("unroll") for(int r=0;r<16;++r)negm[r]=-mhat; asm volatile("":"+v"(negm)); \
        const float f=__builtin_amdgcn_exp2f(-dl); l_reg*=f; if(hi==0)wsf[r32]=f; resc=true; } } \
    SBAR(); \
    GAPB(o[0]=__builtin_amdgcn_mfma_f32_32x32x16_bf16(PAF(0),VFR(0),o[0],0,0,0), C0,0); \
    GAPB(o[1]=__builtin_amdgcn_mfma_f32_32x32x16_bf16(PAF(0),VFR(4),o[1],0,0,0), C0,4); \
    KRD(GL,0); GAPB(o[0]=__builtin_amdgcn_mfma_f32_32x32x16_bf16(PAF(1),VFR(1),o[0],0,0,0), C0,8); \
    KRD(GL,1); GAPB(o[1]=__builtin_amdgcn_mfma_f32_32x32x16_bf16(PAF(1),VFR(5),o[1],0,0,0), C0,12); \
    KRD(GL,2); GAPB(o[0]=__builtin_amdgcn_mfma_f32_32x32x16_bf16(PAF(2),VFR(2),o[0],0,0,0), C1,0); \
    KRD(GL,3); GAPB(o[1]=__builtin_amdgcn_mfma_f32_32x32x16_bf16(PAF(2),VFR(6),o[1],0,0,0), C1,4); \
    GAPB(o[0]=__builtin_amdgcn_mfma_f32_32x32x16_bf16(PAF(3),VFR(3),o[0],0,0,0), C1,8); \
    GAPB(o[1]=__builtin_amdgcn_mfma_f32_32x32x16_bf16(PAF(3),VFR(7),o[1],0,0,0), C1,12); \
    if(GK){DMA_K((t)+3,sl_cur);} if(GV){DMA_V((t)+1,sl_next);}   \
    }while(0)
  int t=1;
  #undef CMASK
  #define CMASK(P0,P1,t) do{}while(0)
  for(;t+7<NT;t+=2){
    STEP(pB0,pB1,pA0,pA1,t,true,true,true);     WAIT_BAR(2); RESC(); ROT();
    STEP(pA0,pA1,pB0,pB1,t+1,true,true,true);   WAIT_BAR(2); RESC(); ROT();
  }
  #undef CMASK
  #define CMASK(P0,P1,t) do{ if constexpr(MODE==2){ if((t)>=2 && nearq)gbias(P0,P1,qloc-(kv0+64*(t)),hi,bl); } else { int jb_=(t)-(NT-4); if(jb_>=-2 && (32*wid-(64*jb_+63))<113)BMM(P0,P1,jb_,qrel,hi); } }while(0)
  #define ENDW(tt) do{ if((tt)+3<NT){WAIT_BAR(2);} else if((tt)+2<NT){WAIT_BAR(1);} else {WAIT_BAR(0);} }while(0)
  for(;t+1<NT;t+=2){
    STEP(pB0,pB1,pA0,pA1,t,(t+3<NT),(t+1<NT),(t+1<NT));       ENDW(t);   RESC(); ROT();
    STEP(pA0,pA1,pB0,pB1,t+1,(t+4<NT),(t+2<NT),(t+2<NT));     ENDW(t+1); RESC(); ROT();
  }
  u32x4 mpp[4][3]; f32x2_t mmv[3];
  if constexpr(MODE==1){
    const float*pml_=mm.pml; const bf16*po_=mm.po; asm volatile("":"+s"(pml_),"+s"(po_));
    const int lane_p=lane_now(); const long gr=mm.grow0+wid*QBLK+(lane_p&31);
    #pragma unroll
    for(int s_=0;s_<3;++s_){ mmv[s_]=(f32x2_t){-INFINITY,0.f}; if(s_<mm.ns) mmv[s_]=*(const f32x2_t*)(pml_+((long)s_*MROWS+gr)*16+mm.h*2); }
    #pragma unroll
    for(int i=0;i<4;++i){ const int row=i*8+(lane_p>>3),ch=lane_p&7;
      #pragma unroll
      for(int s_=0;s_<3;++s_){ mpp[i][s_]=(u32x4){0u,0u,0u,0u}; if(s_<mm.ns) mpp[i][s_]=*(const u32x4*)(po_+(((long)s_*MROWS+mm.grow0+wid*QBLK+row)*8+mm.h)*64+ch*8); } }
    SBAR();
  }
  STEP(pB0,pB1,pA0,pA1,NT-1,false,false,false); RESC();
  { float sacc=pB0[0]+pB0[1]; _Pragma("unroll") for(int r=2;r<16;++r)sacc+=pB0[r]; _Pragma("unroll") for(int r=0;r<16;++r)sacc+=pB1[r]; l_reg+=sacc;
    pw0=(u32x4){PKW(pB0,0),PKW(pB0,2),PKW(pB0,4),PKW(pB0,6)};pw1=(u32x4){PKW(pB0,8),PKW(pB0,10),PKW(pB0,12),PKW(pB0,14)};pw2=(u32x4){PKW(pB1,0),PKW(pB1,2),PKW(pB1,4),PKW(pB1,6)};pw3=(u32x4){PKW(pB1,8),PKW(pB1,10),PKW(pB1,12),PKW(pB1,14)};
    SBAR(); pv(o,vb0+sl_cur,PAF(0),PAF(1),PAF(2),PAF(3)); }
  #undef PKW
  #undef PAF
  #undef VFR
  #undef PIN
  #undef MX3
  #undef GAPA
  #undef GAPB
  #undef EX
  #undef VRD
  #undef KRD
  #undef STEP
  #undef ENDW
  {auto rr=__builtin_amdgcn_permlane32_swap(__float_as_uint(l_reg),__float_as_uint(l_reg),false,false);l_reg=__uint_as_float(rr[0])+__uint_as_float(rr[1]);}
  const float*pml_=mm.pml; const bf16*po_=mm.po; if constexpr(MODE==1){ asm volatile("":"+s"(pml_),"+s"(po_)); }
  if constexpr(MODE==1){
    const long gr=mm.grow0+wid*QBLK+r32; float ms[3],ls[3],as[3]; float Mx=mhat;
    #pragma unroll
    for(int s=0;s<3;++s){ ms[s]=mmv[s].x; ls[s]=mmv[s].y; if(s<mm.ns){ Mx=__builtin_fmaxf(Mx,ms[s]); } }
    const float a0=__builtin_amdgcn_exp2f(mhat-Mx); float L=a0*l_reg;
    #pragma unroll
    for(int s=0;s<3;++s){ as[s]=(s<mm.ns)?__builtin_amdgcn_exp2f(ms[s]-Mx):0.f; L+=as[s]*ls[s]; }
    const float inv=1.0f/L;
    if(hi==0){wsf[32+r32]=a0*inv;wsf[64+r32]=as[0]*inv;wsf[96+r32]=as[1]*inv;wsf[r32]=as[2]*inv;}
  } else if constexpr(MODE==2){
    float*gpml_=ga.pml; asm volatile("":"+s"(gpml_));
    if(hi==0){ wsf[32+r32]=1.0f; if(wid*QBLK+r32<ga.n){ f32x2_t v={mhat,l_reg}; *(f32x2_t*)(gpml_+((long)(gent>>14)*MROWS+ga.growb+qloc)*16+ga.h*2)=v; } }
  } else {
    if(hi==0)wsf[32+r32]=1.0f/l_reg;
  }
  asm volatile("s_waitcnt lgkmcnt(0)":::"memory");
  float rli[16];
  #pragma unroll
  for(int r=0;r<16;++r)rli[r]=wsf[32+crow(r,hi)];
  { asm volatile("":"+s"(Op)); }
  bf16*Ow=Op+(long)(q0+wid*QBLK)*LDO;
  { bf16*stg=(bf16*)(shm+LDS_OST)+wid*2048;
    #pragma unroll
    for(int r=0;r<16;++r){const int orow=crow(r,hi);
      #pragma unroll
      for(int d0=0;d0<2;++d0)stg[orow*64+d0*32+r32]=__float2bfloat16(o[d0][r]*rli[r]);}
    asm volatile("s_waitcnt lgkmcnt(0)":::"memory");
    int lane_e=lane; asm volatile("":"+v"(lane_e));
    #pragma unroll
    for(int i=0;i<4;++i){const int row=i*8+(lane_e>>3),ch=lane_e&7; u32x4 v=*(const u32x4*)(stg+row*64+ch*8);
      if constexpr(MODE==1){
        float a[8]={bflo(v.x),bfhi(v.x),bflo(v.y),bfhi(v.y),bflo(v.z),bfhi(v.z),bflo(v.w),bfhi(v.w)};
        #pragma unroll
        for(int s=0;s<3;++s){ if(s<mm.ns){ const float c=wsf[(s==0?64:(s==1?96:0))+row];
            const u32x4 pp=mpp[i][s];
            a[0]+=c*bflo(pp.x);a[1]+=c*bfhi(pp.x);a[2]+=c*bflo(pp.y);a[3]+=c*bfhi(pp.y);a[4]+=c*bflo(pp.z);a[5]+=c*bfhi(pp.z);a[6]+=c*bflo(pp.w);a[7]+=c*bfhi(pp.w);} }
        v.x=cvtpk_s(a[0],a[1]);v.y=cvtpk_s(a[2],a[3]);v.z=cvtpk_s(a[4],a[5]);v.w=cvtpk_s(a[6],a[7]);
      }
      if constexpr(MODE==2){ bf16*gpo_=ga.po; asm volatile("":"+s"(gpo_)); const unsigned er=(unsigned)__builtin_amdgcn_ds_bpermute(row<<2,(int)gent); if(wid*QBLK+row<ga.n) *(u32x4*)(gpo_+(((long)(er>>14)*MROWS+ga.growb+(long)(er&0x3FFFu))*8+ga.h)*64+ch*8)=v; }
      else *(u32x4*)(Ow+(long)row*LDO+ch*8)=v;} }
  asm volatile("s_waitcnt lgkmcnt(0)\n\ts_barrier":::"memory");
  #undef DMA_K
  #undef DMA_V
  #undef CMASK
  #undef START
  #undef RESC
  #undef ROT
}


constexpr int VSLOTB=16384;
constexpr int W_LDS_K=0, W_LDS_V=NSLOT*SLOTB, W_LDS_WS=W_LDS_V+NSLOT*VSLOTB, W_LDS_OST=W_LDS_WS+NW*128*4, W_LDS_BIAS=W_LDS_OST+NW*4096, W_LDS_BYTES=W_LDS_BIAS+512;
__device__ __forceinline__ void pv128(f32x16*o,int vb,bf16x8 pa0,bf16x8 pa1,bf16x8 pa2,bf16x8 pa3){
  #pragma unroll
  for(int d0=0;d0<4;++d0){s16x4 lo[4],hi[4];
    #pragma unroll
    for(int ks=0;ks<4;++ks){
      asm volatile("ds_read_b64_tr_b16 %0,%1 offset:%c2":"=&v"(lo[ks]):"v"(vb),"i"(d0*4096+ks*1024):"memory");
      asm volatile("ds_read_b64_tr_b16 %0,%1 offset:%c2":"=&v"(hi[ks]):"v"(vb),"i"(d0*4096+ks*1024+512):"memory");}
    asm volatile("s_waitcnt lgkmcnt(0)":::"memory");SBAR();
    #define PK(k) (bf16x8){lo[k][0],lo[k][1],lo[k][2],lo[k][3],hi[k][0],hi[k][1],hi[k][2],hi[k][3]}
    o[d0]=__builtin_amdgcn_mfma_f32_32x32x16_bf16(pa0,PK(0),o[d0],0,0,0);
    o[d0]=__builtin_amdgcn_mfma_f32_32x32x16_bf16(pa1,PK(1),o[d0],0,0,0);
    o[d0]=__builtin_amdgcn_mfma_f32_32x32x16_bf16(pa2,PK(2),o[d0],0,0,0);
    o[d0]=__builtin_amdgcn_mfma_f32_32x32x16_bf16(pa3,PK(3),o[d0],0,0,0);
    #undef PK
  }
}
template<int THRL> __device__ __forceinline__ void attn_unit128(const bf16*Qp,const bf16*__restrict__ Kp,const bf16*__restrict__ Vp,bf16*Op,int q0,int NT,const float*biasG,char*shm,int wv STAMP_PARAM){
  const int lane=lane_now();
  asm volatile("":"+s"(wv)); const int wid=__builtin_amdgcn_readfirstlane(wv), tid=wid*64+lane, r32=lane&31, hi=lane>>5;
  const bf16*Qw=Qp+(long)(q0+wid*QBLK)*LDQ;
  const bf16*Kh=Kp,*Vh=Vp;
  const unsigned lds0=(unsigned)(uintptr_t)shm;
  float*wsf=(float*)(shm+W_LDS_WS)+wid*128;
  const lds_cptr shm3=(lds_cptr)shm;
  asm volatile("":"+s"(biasG));
  { __attribute__((address_space(3))) float* blw=(__attribute__((address_space(3))) float*)(shm3+W_LDS_BIAS); if(tid<128)blw[tid]=biasG[tid]; }
  const lds_cfptr bl=(lds_cfptr)(shm3+W_LDS_BIAS);
  const bf16*ksrc=Kh+(long)lane*LDQ+wid*8;
  const bf16*vsrc=Vh+(long)(16*(wid&3)+(lane>>2))*LDQ+(wid>>2)*32+(lane&3)*8;
  const unsigned kdst=lds0+W_LDS_K+wid*1024, vdst=lds0+W_LDS_V+wid*1024;
  #define DMA_K(t,slot) glds16(ksrc+(long)(t)*KVBLK*LDQ,(unsigned)__builtin_amdgcn_readfirstlane(kdst+(slot)))
  #define DMA_V(t,slot) do{ glds16(vsrc+(long)(t)*KVBLK*LDQ,(unsigned)__builtin_amdgcn_readfirstlane(vdst+2*(slot))); glds16(vsrc+(long)(t)*KVBLK*LDQ+64,(unsigned)__builtin_amdgcn_readfirstlane(vdst+2*(slot)+8192)); }while(0)
  const int vb0=(int)(lds0+W_LDS_V)+((lane>>4)&1)*32+(lane&3)*8+(4*hi+((lane&15)>>2))*64;
  const char*Kbase=shm+W_LDS_K; bf16x8 kf[8];
  const lds_cptr kp0=shm3+W_LDS_K+hi*1024+r32*16; const lds_cptr vp0=shm3+W_LDS_V+((lane>>4)&1)*32+(lane&3)*8+(4*hi+((lane&15)>>2))*64;
  asm volatile("s_waitcnt vmcnt(0)":::"memory");
  DMA_K(0,0);DMA_V(0,0);DMA_K(1,SLOTB);
  bf16x8 qr[4];
  #pragma unroll
  for(int d0=0;d0<4;++d0)qr[d0]=*reinterpret_cast<const bf16x8*>(&Qw[(long)r32*LDQ+d0*16+hi*8]);
  float mhat=0.f,l_reg=0.f;f32x16 o[4];o[0]=f32x16{};o[1]=f32x16{};o[2]=f32x16{};o[3]=f32x16{};f32x16 negm=f32x16{};asm volatile("":"+v"(negm));
  const int qrel=wid*QBLK+r32;
  #define CMASK(P0,P1,t) do{int jb_=(t)-(NT-4); if(jb_>=-2 && (32*wid-(64*jb_+63))<113)biasmask(P0,P1,jb_,qrel,hi,bl);}while(0)
  bool resc=false;
  #define RESC() do{ if(resc){ asm volatile("s_waitcnt lgkmcnt(0)":::"memory"); \
      _Pragma("unroll") for(int d_=0;d_<4;++d_) _Pragma("unroll") for(int r=0;r<16;++r)o[d_][r]*=wsf[crow(r,hi)]; } }while(0)
  f32x16 C0,C1; u32x4 pw0,pw1,pw2,pw3;
  int sl_prev=0,sl_cur=0,sl_next=SLOTB;
  #define ROT() do{sl_prev=sl_cur;sl_cur=sl_next;sl_next=(sl_next==(NSLOT-1)*SLOTB)?0:sl_next+SLOTB;}while(0)
  #define PKW(P,B) cvtpk_s(P[B],P[B+1])
  DMA_K(2,2*SLOTB);
  WAIT_BAR(3);
  qkt(C0,C1,Kbase,qr,negm,r32,hi);asm volatile("s_nop 15\n\ts_nop 7":"+v"(C0),"+v"(C1));CMASK(C0,C1,0);
  { const float rm=rowmax(C0,C1); mhat=rm;
    _Pragma("unroll") for(int r=0;r<16;++r)negm[r]=-mhat; asm volatile("":"+v"(negm));
    _Pragma("unroll") for(int r=0;r<16;++r){C0[r]=__builtin_amdgcn_exp2f(C0[r]-mhat);C1[r]=__builtin_amdgcn_exp2f(C1[r]-mhat);}
    float sacc=0.f; _Pragma("unroll") for(int r=0;r<16;++r)sacc+=C0[r]+C1[r]; l_reg+=sacc;
    pw0=(u32x4){PKW(C0,0),PKW(C0,2),PKW(C0,4),PKW(C0,6)};pw1=(u32x4){PKW(C0,8),PKW(C0,10),PKW(C0,12),PKW(C0,14)};pw2=(u32x4){PKW(C1,0),PKW(C1,2),PKW(C1,4),PKW(C1,6)};pw3=(u32x4){PKW(C1,8),PKW(C1,10),PKW(C1,12),PKW(C1,14)}; }
  const __attribute__((address_space(3))) char* qlds=(const __attribute__((address_space(3))) char*)(shm3+W_LDS_OST+wid*4096+lane*16);
  { __attribute__((address_space(3))) char* qw=(__attribute__((address_space(3))) char*)(shm3+W_LDS_OST+wid*4096+lane*16);
    #pragma unroll
    for(int d0=0;d0<4;++d0)*(__attribute__((address_space(3))) bf16x8*)(qw+d0*1024)=qr[d0]; }
  WAIT_BAR(0);
  DMA_K(3,0);DMA_V(1,SLOTB);
  ROT();
  kload8(kf,kp0+sl_cur);
  WAIT_BAR(3);
  s16x4 vlo[8],vhi[8];
  #define PAF(k) __builtin_bit_cast(bf16x8,pw##k)
  #define VFR(i) (bf16x8){vlo[i][0],vlo[i][1],vlo[i][2],vlo[i][3],vhi[i][0],vhi[i][1],vhi[i][2],vhi[i][3]}
  #define PIN(x) asm volatile("":"+v"(x))
  #define MX3(a,b,c) __builtin_fmaxf(__builtin_fmaxf((a),(b)),(c))
  #define EX(v) __builtin_amdgcn_exp2f(v)
  #define GA(MF) do{ MF; SBAR(); }while(0)
  #define EX2(X,B) do{ float e0_=EX(X[B]), e1_=EX(X[B+1]); asm volatile("":"+v"(e0_),"+v"(e1_)); X[B]=e0_; X[B+1]=e1_; }while(0)
  #define GB0(MF,X,B) do{ MF; EX2(X,B); SBAR(); }while(0)
  #define GB1(MF,X,B,PWD,Y,YB) do{ MF; EX2(X,B); sacc+=Y[YB]; sacc+=Y[YB+1]; PIN(sacc); { unsigned pk_=PKW(Y,YB); PIN(pk_); PWD=pk_; } SBAR(); }while(0)
  #define VRS(s,i) do{ vlo[s]=vtr(vp_+(((i)>>2)*4096+((i)&3)*1024)); vhi[s]=vtr(vp_+(((i)>>2)*4096+((i)&3)*1024+512)); SBAR(); }while(0)
  #define KRD(G,j) do{ if(G){ kload2(kf,kp0+sl_next,j); SBAR(); } }while(0)
  #define MF(a,b,c) __builtin_amdgcn_mfma_f32_32x32x16_bf16(a,b,c,0,0,0)
  #define QL(d) (*(const __attribute__((address_space(3))) bf16x8*)(qlds+(d)*1024))
  #define STEP(t,GK,GV,GL) do{ SBAR(); \
    const lds_cptr vp_=vp0+2*sl_prev; \
    bf16x8 qa_=QL(0),qb_=QL(1); SBAR(); \
    VRS(0,0);  GA(C0=MF(kf[0],qa_,negm)); \
    VRS(1,4);  GA(C1=MF(kf[1],qa_,negm)); qa_=QL(2); SBAR(); \
    VRS(2,8);  GA(C0=MF(kf[2],qb_,C0)); \
    VRS(3,12); GA(C1=MF(kf[3],qb_,C1)); qb_=QL(3); SBAR(); \
    VRS(4,1);  GA(C0=MF(kf[4],qa_,C0)); \
    VRS(5,5);  GA(C1=MF(kf[5],qa_,C1)); \
    VRS(6,9);  GA(C0=MF(kf[6],qb_,C0)); \
    VRS(7,13); GA(C1=MF(kf[7],qb_,C1)); \
    CMASK(C0,C1,t); \
    { float a=MX3(C0[0],C0[1],C1[0]),b=MX3(C0[2],C0[3],C1[1]); a=MX3(a,C1[2],C1[3]); \
      _Pragma("unroll") for(int r=4;r<16;r+=4){a=MX3(a,C0[r],C0[r+1]);b=MX3(b,C0[r+2],C0[r+3]);a=MX3(a,C1[r],C1[r+1]);b=MX3(b,C1[r+2],C1[r+3]);} \
      float rm=__builtin_fmaxf(a,b); { auto rr=__builtin_amdgcn_permlane32_swap(__float_as_uint(rm),__float_as_uint(rm),false,false); rm=__builtin_fmaxf(__uint_as_float(rr[0]),__uint_as_float(rr[1])); } \
      resc=false; \
      if(__builtin_expect(__any(rm>(float)THRL),0)){ const float dl=__builtin_fmaxf(rm,0.f); mhat+=dl; \
        _Pragma("unroll") for(int r=0;r<16;++r){C0[r]-=dl;C1[r]-=dl;} \
        _Pragma("unroll") for(int r=0;r<16;++r)negm[r]=-mhat; asm volatile("":"+v"(negm)); \
        const float f=__builtin_amdgcn_exp2f(-dl); l_reg*=f; if(hi==0)wsf[r32]=f; resc=true; } } \
    SBAR(); float sacc=0.f; \
    GB0(o[0]=MF(PAF(0),VFR(0),o[0]), C0,0); \
    GB0(o[1]=MF(PAF(0),VFR(1),o[1]), C0,2); \
    GB0(o[2]=MF(PAF(0),VFR(2),o[2]), C0,4); \
    GB0(o[3]=MF(PAF(0),VFR(3),o[3]), C0,6); \
    VRS(0,2);  GB1(o[0]=MF(PAF(1),VFR(4),o[0]), C0,8,  pw0[0],C0,0); \
    VRS(1,6);  GB1(o[1]=MF(PAF(1),VFR(5),o[1]), C0,10, pw0[1],C0,2); \
    VRS(2,10); GB1(o[2]=MF(PAF(1),VFR(6),o[2]), C0,12, pw0[2],C0,4); \
    VRS(3,14); GB1(o[3]=MF(PAF(1),VFR(7),o[3]), C0,14, pw0[3],C0,6); \
    VRS(4,3);  KRD(GL,0); GB1(o[0]=MF(PAF(2),VFR(0),o[0]), C1,0, pw1[0],C0,8); \
    VRS(5,7);  KRD(GL,1); GB1(o[1]=MF(PAF(2),VFR(1),o[1]), C1,2, pw1[1],C0,10); \
    VRS(6,11); GB1(o[2]=MF(PAF(2),VFR(2),o[2]), C1,4, pw1[2],C0,12); \
    VRS(7,15); GB1(o[3]=MF(PAF(2),VFR(3),o[3]), C1,6, pw1[3],C0,14); \
    KRD(GL,2); GB1(o[0]=MF(PAF(3),VFR(4),o[0]), C1,8,  pw2[0],C1,0); \
    KRD(GL,3); GB1(o[1]=MF(PAF(3),VFR(5),o[1]), C1,10, pw2[1],C1,2); \
    GB1(o[2]=MF(PAF(3),VFR(6),o[2]), C1,12, pw2[2],C1,4); \
    GB1(o[3]=MF(PAF(3),VFR(7),o[3]), C1,14, pw2[3],C1,6); \
    sacc+=C1[8];sacc+=C1[9];pw3[0]=PKW(C1,8); sacc+=C1[10];sacc+=C1[11];pw3[1]=PKW(C1,10); sacc+=C1[12];sacc+=C1[13];pw3[2]=PKW(C1,12); sacc+=C1[14];sacc+=C1[15];pw3[3]=PKW(C1,14); \
    l_reg+=sacc; \
    if(GK){DMA_K((t)+3,sl_cur);} if(GV){DMA_V((t)+1,sl_next);}   \
    }while(0)
  int t=1;
  #undef CMASK
  #define CMASK(P0,P1,t) do{}while(0)
  STAMP_DECL
  for(;t+7<NT;t+=2){
    STEP(t,true,true,true);     STAMP_PRE WAIT_BAR(3); STAMP_POST RESC(); ROT();
    STEP(t+1,true,true,true);   STAMP_PRE WAIT_BAR(3); STAMP_POST RESC(); ROT();
  }
  STAMP_FINI
  #undef CMASK
  #define CMASK(P0,P1,t) do{int jb_=(t)-(NT-4); if(jb_>=-2 && (32*wid-(64*jb_+63))<113)biasmask(P0,P1,jb_,qrel,hi,bl);}while(0)
  #define ENDW(tt) do{ if((tt)+3<NT){WAIT_BAR(3);} else if((tt)+2<NT){WAIT_BAR(2);} else {WAIT_BAR(0);} }while(0)
  for(;t+1<NT;t+=2){
    STEP(t,(t+3<NT),(t+1<NT),(t+1<NT));       ENDW(t);   RESC(); ROT();
    STEP(t+1,(t+4<NT),(t+2<NT),(t+2<NT));     ENDW(t+1); RESC(); ROT();
  }
  STEP(NT-1,false,false,false); RESC();
  SBAR(); pv128(o,vb0+2*sl_cur,PAF(0),PAF(1),PAF(2),PAF(3));
  #undef PKW
  #undef PAF
  #undef VFR
  #undef PIN
  #undef MX3
  #undef EX
  #undef EX2
  #undef GA
  #undef GB0
  #undef GB1
  #undef VRS
  #undef KRD
  #undef MF
  #undef QL
  #undef STEP
  #undef ENDW
  {auto rr=__builtin_amdgcn_permlane32_swap(__float_as_uint(l_reg),__float_as_uint(l_reg),false,false);l_reg=__uint_as_float(rr[0])+__uint_as_float(rr[1]);}
  if(hi==0)wsf[32+r32]=1.0f/l_reg;
  asm volatile("s_waitcnt lgkmcnt(0)":::"memory");
  float rli[16];
  #pragma unroll
  for(int r=0;r<16;++r)rli[r]=wsf[32+crow(r,hi)];
  { asm volatile("":"+s"(Op)); }
  bf16*Ow=Op+(long)(q0+wid*QBLK)*LDO;
  { bf16*stg=(bf16*)(shm+W_LDS_OST)+wid*2048;
    int lane_e=lane; asm volatile("":"+v"(lane_e));
    #pragma unroll
    for(int ph=0;ph<2;++ph){
      #pragma unroll
      for(int r=0;r<16;++r){const int orow=crow(r,hi);
        #pragma unroll
        for(int d0=0;d0<2;++d0)stg[orow*64+d0*32+r32]=__float2bfloat16(o[2*ph+d0][r]*rli[r]);}
      asm volatile("s_waitcnt lgkmcnt(0)":::"memory");
      #pragma unroll
      for(int i=0;i<4;++i){const int row=i*8+(lane_e>>3),ch=lane_e&7; const u32x4 v=*(const u32x4*)(stg+row*64+ch*8); *(u32x4*)(Ow+(long)row*LDO+ph*64+ch*8)=v;}
      asm volatile("s_waitcnt lgkmcnt(0)":::"memory"); } }
  asm volatile("s_waitcnt lgkmcnt(0)\n\ts_barrier":::"memory");
  #undef DMA_K
  #undef DMA_V
  #undef CMASK
  #undef RESC
  #undef ROT
}


constexpr int F_KSL=4096, F_VSL=8192;
constexpr int F_LDS_K=0, F_LDS_V=4*F_KSL, F_LDS_WS=4*F_KSL+4*F_VSL, F_LDS_OST=F_LDS_WS+NW*128*4+8192, F_LDS_BIAS=F_LDS_OST+NW*4096, F_LDS_BYTES=F_LDS_BIAS+512;
typedef int v8i_t __attribute__((ext_vector_type(8)));
typedef int v4i_t __attribute__((ext_vector_type(4)));
constexpr float PSH=5.f;
template<int THRL> __device__ __forceinline__ void attn_unit128f(const unsigned char*Qp8,const unsigned char*__restrict__ Kp8,const unsigned char*__restrict__ VT,bf16*Op,int q0,int NT,const float*biasG,char*shm,int wv,bf16*Yp,const float*gnp,float lam,float gmul STAMP_PARAM){
  const int lane=lane_now();
  asm volatile("":"+s"(wv)); const int wid=__builtin_amdgcn_readfirstlane(wv), tid=wid*64+lane, r32=lane&31, hi=lane>>5;
  constexpr long LDB=2L*LDQ;
  const unsigned lds0=(unsigned)(uintptr_t)shm;
  float*wsf=(float*)(shm+F_LDS_WS)+wid*128;
  const lds_cptr shm3=(lds_cptr)shm;
  asm volatile("":"+s"(biasG));
  glds16((const char*)biasG+wid*1024+lane*16,(unsigned)__builtin_amdgcn_readfirstlane(lds0+LDS_BT4+wid*1024));
  const __amdgpu_buffer_rsrc_t rs=__builtin_amdgcn_make_buffer_rsrc((void*)Kp8,0,0x7ffffff0,0x00020000);
  const unsigned kvo=(unsigned)(lane*(int)LDB+16*(wid&3));
  const unsigned vvo=(unsigned)(lane*SEQ+16*(wid&3));
  const unsigned vrel=(unsigned)(VT-Kp8);
  typedef __attribute__((address_space(3))) unsigned* lds_uptr;
  #define DK(t,slot) __builtin_amdgcn_raw_ptr_buffer_load_lds(rs,(lds_uptr)(shm3+F_LDS_K+(wid&3)*1024+(slot)),16,(int)kvo,(int)((t)*(KVBLK*(int)LDB)),0,0)
  #define DV(t,slot) do{ __builtin_amdgcn_raw_ptr_buffer_load_lds(rs,(lds_uptr)(shm3+F_LDS_V+(wid&3)*2048+(slot)),16,(int)vvo,(int)(vrel+(unsigned)((t)*KVBLK)),0,0); \
      __builtin_amdgcn_raw_ptr_buffer_load_lds(rs,(lds_uptr)(shm3+F_LDS_V+(wid&3)*2048+1024+(slot)),16,(int)vvo,(int)(vrel+(unsigned)(64*SEQ)+(unsigned)((t)*KVBLK)),0,0); }while(0)
  #define KLD(dst,base) do{ dst=__builtin_shufflevector(*(const __attribute__((address_space(3))) v4i_t*)(base),*(const __attribute__((address_space(3))) v4i_t*)((base)+1024),0,1,2,3,4,5,6,7); }while(0)
  #define MFQ(a,b,c) __builtin_amdgcn_mfma_scale_f32_32x32x64_f8f6f4(a,b,c,0,0,0,0x00007A7D,1,0x00007A7D)
  v8i_t kf[2];
  const lds_cptr kp0=shm3+F_LDS_K+hi*2048+r32*16; const lds_cptr vp0=shm3+F_LDS_V+hi*4096+r32*16;
  if(wid<4){ DK(0,0); DV(0,0); } else { DK(1,F_KSL); DV(1,F_VSL); }
  SBAR();
  v8i_t qf; { const unsigned char*qp=Qp8+(long)(q0+wid*QBLK+r32)*LDB+32*hi; qf=__builtin_shufflevector(*(const v4i_t*)qp,*(const v4i_t*)(qp+16),0,1,2,3,4,5,6,7); }
  f32x16 o[4];o[0]=f32x16{};o[1]=f32x16{};o[2]=f32x16{};o[3]=f32x16{};pg8::f32x4 l4={0.f,0.f,0.f,0.f};f32x16 negm=f32x16{};asm volatile("":"+v"(negm));
  v8i_t ones8; { const int ov_=(((lane>>4)&1)==((lane>>3)&1))?0x50505050:0; ones8=(v8i_t){ov_,ov_,ov_,ov_,ov_,ov_,ov_,ov_}; } asm volatile("":"+v"(ones8));
  #define MFL(a,c) __builtin_amdgcn_mfma_scale_f32_16x16x128_f8f6f4(a,ones8,c,0,0,0,0x00007C7F,1,0x00007C7F)
  #define CMASK(P0,P1,t) do{int jb_=(t)-(NT-4); if(jb_>=-2 && (32*wid-(64*jb_+63))<113){ const int l_=lane_now(); BMF(P0,P1,jb_,wid*QBLK+(l_&31),l_>>5); } }while(0)
  bool resc=false;
  #define RESC() do{ if(resc){ asm volatile("s_waitcnt lgkmcnt(0)":::"memory"); const int l_=lane_now(), h_=l_>>5, lr_=4*(l_>>4)+16*((l_>>3)&1);     \
      _Pragma("unroll") for(int d_=0;d_<4;++d_) _Pragma("unroll") for(int r=0;r<16;++r)o[d_][r]*=wsf[crow(r,h_)]; \
      _Pragma("unroll") for(int i_=0;i_<4;++i_)l4[i_]*=wsf[lr_+i_]; } }while(0)
  f32x16 C0,C1; v8i_t PA,PB;
  #if defined(PROBE_XLDS)
  v4i_t xdummy={0,0,0,0}; asm volatile("":"+v"(xdummy));
  #endif
  #define PK8(X,B) __builtin_amdgcn_cvt_pk_fp8_f32(X[B+2],X[B+3],__builtin_amdgcn_cvt_pk_fp8_f32(X[B],X[B+1],0,false),true)
  SBAR();
  if(wid<4){ DK(2,2*F_KSL); } else { DK(3,3*F_KSL); }
  WAIT_BAR(5);
  { KLD(kf[0],kp0); KLD(kf[1],kp0+512); C0=MFQ(kf[0],qf,negm); C1=MFQ(kf[1],qf,negm); }
  asm volatile("s_nop 15\n\ts_nop 7":"+v"(C0),"+v"(C1));CMASK(C0,C1,0);
  { const float rm=rowmax(C0,C1); const float mhat=rm-PSH;
    _Pragma("unroll") for(int r=0;r<16;++r)negm[r]=-mhat; asm volatile("":"+v"(negm));
    _Pragma("unroll") for(int r=0;r<16;++r){C0[r]=__builtin_amdgcn_exp2f(C0[r]-mhat);C1[r]=__builtin_amdgcn_exp2f(C1[r]-mhat);}
    PA=(v8i_t){PK8(C0,0),PK8(C0,4),PK8(C0,8),PK8(C0,12),PK8(C1,0),PK8(C1,4),PK8(C1,8),PK8(C1,12)}; PB=PA; }
  WAIT_BAR(0);
  KLD(kf[0],kp0+F_KSL); KLD(kf[1],kp0+F_KSL+512);
  v8i_t vf[2];
  #define PIN(x) asm volatile("":"+v"(x))
  #define PK8O(X,B,OLD) __builtin_amdgcn_cvt_pk_fp8_f32(X[B+2],X[B+3],__builtin_amdgcn_cvt_pk_fp8_f32(X[B],X[B+1],OLD,false),true)
  #define MX3(a,b,c) max3f((a),(b),(c))
  #define EX(v) __builtin_amdgcn_exp2f(v)
  #define GA(MF) do{ MF; SBAR(); }while(0)
  #define VRS(sl,q) do{ vf[sl]=__builtin_shufflevector(*(const __attribute__((address_space(3))) v4i_t*)(vp_+(q)*512),*(const __attribute__((address_space(3))) v4i_t*)(vp_+(q)*512+2048),0,1,2,3,4,5,6,7); SBAR(); }while(0)
  #define KRD(G,j) do{ if(G){ KLD(kf[j],kq_+(j)*512); SBAR(); } }while(0)
  #define MF8(a,b,c) __builtin_amdgcn_mfma_scale_f32_32x32x64_f8f6f4(a,b,c,0,0,0,0x00007C7F,1,0x00007C7F)
  #define GB(q,PC,PN,X,B,D0,D1) do{ o[q]=MF8(PC,vf[(q)&1],o[q]); if((q)<2){ VRS((q)&1,(q)+2); } \
      { float e0_=EX(X[B]),e1_=EX(X[B+1]),e2_=EX(X[B+2]),e3_=EX(X[B+3]),e4_=EX(X[B+4]),e5_=EX(X[B+5]),e6_=EX(X[B+6]),e7_=EX(X[B+7]); \
        asm volatile("":"+v"(e0_),"+v"(e1_),"+v"(e2_),"+v"(e3_),"+v"(e4_),"+v"(e5_),"+v"(e6_),"+v"(e7_)); \
        X[B]=e0_;X[B+1]=e1_;X[B+2]=e2_;X[B+3]=e3_;X[B+4]=e4_;X[B+5]=e5_;X[B+6]=e6_;X[B+7]=e7_; \
        { int pk0_=PK8O(X,B,PN[D0]),pk1_=PK8O(X,B+4,PN[D1]); PIN(pk0_); PIN(pk1_); PN[D0]=pk0_; PN[D1]=pk1_; } } XTRA(X,B); SBAR(); }while(0)
  #define PH_A(t,PS,VR,PRA,PR) do{ __builtin_amdgcn_s_setprio(PRA); \
    if(VR){ VRS(0,0); } GA(C0=MFQ(kf[0],qf,negm)); \
    if(VR){ VRS(1,1); } GA(C1=MFQ(kf[1],qf,negm)); \
    l4=MFL(PS,l4); SBAR();     \
    asm volatile("s_nop 15\n\ts_nop 2":"+v"(C0),"+v"(C1));     \
    CMASK(C0,C1,t); \
    { float a,b;     \
      asm("v_max3_f32 %0, %2, %3, %4\n\tv_max3_f32 %1, %5, %6, %7\n\tv_max3_f32 %0, %0, %8, %9\n\tv_max3_f32 %1, %1, %10, %11\n\tv_max3_f32 %0, %0, %12, %13\n\tv_max3_f32 %1, %1, %14, %15\n\tv_max3_f32 %0, %0, %16, %17" \
          :"=&v"(a),"=&v"(b):"v"(C0[0]),"v"(C0[1]),"v"(C0[2]),"v"(C0[3]),"v"(C0[4]),"v"(C0[5]),"v"(C0[6]),"v"(C0[7]),"v"(C0[8]),"v"(C0[9]),"v"(C0[10]),"v"(C0[11]),"v"(C0[12]),"v"(C0[13]),"v"(C0[14]),"v"(C0[15])); \
      asm("v_max3_f32 %1, %1, %2, %3\n\tv_max3_f32 %0, %0, %4, %5\n\tv_max3_f32 %1, %1, %6, %7\n\tv_max3_f32 %0, %0, %8, %9\n\tv_max3_f32 %1, %1, %10, %11\n\tv_max3_f32 %0, %0, %12, %13\n\tv_max3_f32 %1, %1, %14, %15\n\tv_max3_f32 %0, %0, %16, %17\n\tv_max_f32 %0, %0, %1" \
          :"+v"(a),"+v"(b):"v"(C1[0]),"v"(C1[1]),"v"(C1[2]),"v"(C1[3]),"v"(C1[4]),"v"(C1[5]),"v"(C1[6]),"v"(C1[7]),"v"(C1[8]),"v"(C1[9]),"v"(C1[10]),"v"(C1[11]),"v"(C1[12]),"v"(C1[13]),"v"(C1[14]),"v"(C1[15])); \
      float rm=a; \
      resc=false; \
      if(__builtin_expect(__any(rm>(float)THRL),0)){ { auto rr=__builtin_amdgcn_permlane32_swap(__float_as_uint(rm),__float_as_uint(rm),false,false); rm=__builtin_fmaxf(__uint_as_float(rr[0]),__uint_as_float(rr[1])); } \
        const float dl=__builtin_fmaxf(rm-PSH,0.f); const float nm_=negm[0]-dl;     \
        _Pragma("unroll") for(int r=0;r<16;++r){C0[r]-=dl;C1[r]-=dl;} \
        _Pragma("unroll") for(int r=0;r<16;++r)negm[r]=nm_; asm volatile("":"+v"(negm)); \
        const float f=__builtin_amdgcn_exp2f(-dl); { const int l_=lane_now(); if(l_<32)wsf[l_]=f; } resc=true; } } \
    __builtin_amdgcn_s_setprio(PR); SBAR(); }while(0)
  #define PH_B(PC,PN,GL) do{ \
    KRD(GL,0); GB(0,PC,PN,C0,0,0,1); \
    GB(1,PC,PN,C0,8,2,3); \
    KRD(GL,1); GB(2,PC,PN,C1,0,4,5); \
    GB(3,PC,PN,C1,8,6,7); }while(0)
  #if defined(PROBE_XEXP)
  #define XTRA(X,B) do{ float d_; asm volatile("v_exp_f32 %0, %1\n\tv_exp_f32 %0, %2\n\tv_exp_f32 %0, %3\n\tv_exp_f32 %0, %4\n\tv_exp_f32 %0, %1\n\tv_exp_f32 %0, %2\n\tv_exp_f32 %0, %3\n\tv_exp_f32 %0, %4":"=&v"(d_):"v"(X[B]),"v"(X[B+1]),"v"(X[B+2]),"v"(X[B+3])); }while(0)
  #elif defined(PROBE_XCVT)
  #define XTRA(X,B) do{ int d_; asm volatile("v_cvt_pk_fp8_f32 %0, %1, %2\n\tv_cvt_pk_fp8_f32 %0, %3, %4\n\tv_cvt_pk_fp8_f32 %0, %1, %2\n\tv_cvt_pk_fp8_f32 %0, %3, %4\n\tv_cvt_pk_fp8_f32 %0, %1, %2\n\tv_cvt_pk_fp8_f32 %0, %3, %4\n\tv_cvt_pk_fp8_f32 %0, %1, %2\n\tv_cvt_pk_fp8_f32 %0, %3, %4":"=&v"(d_):"v"(X[B]),"v"(X[B+1]),"v"(X[B+2]),"v"(X[B+3])); }while(0)
  #elif defined(PROBE_XMFMA)
  #define XTRA(X,B) do{ pg8::f32x4 d_=__builtin_amdgcn_mfma_scale_f32_16x16x128_f8f6f4(PA,ones8,l4,0,0,0,0x00007C7F,1,0x00007C7F); asm volatile("":"+v"(d_)); }while(0)
  #elif defined(PROBE_XLDS)
  #define XTRA(X,B) do{ asm volatile("ds_read_b128 %0, %1":"+v"(xdummy):"v"((unsigned)(uintptr_t)vp_):"memory"); }while(0)
  #elif defined(PROBE_XNOP)
  #define XTRA(X,B) do{ asm volatile("s_nop 15\n\ts_nop 15"); }while(0)
  #elif defined(PROBE_XADD)
  #define XTRA(X,B) do{ float d_; asm volatile("v_add_f32 %0, %1, %2\n\tv_add_f32 %0, %3, %4\n\tv_add_f32 %0, %1, %2\n\tv_add_f32 %0, %3, %4\n\tv_add_f32 %0, %1, %2\n\tv_add_f32 %0, %3, %4\n\tv_add_f32 %0, %1, %2\n\tv_add_f32 %0, %3, %4":"=&v"(d_):"v"(X[B]),"v"(X[B+1]),"v"(X[B+2]),"v"(X[B+3])); }while(0)
  #else
  #define XTRA(X,B) do{}while(0)
  #endif
  #define ST1(t,PC,PN,VS,KS,GL,PRA_,PRB_) do{ SBAR(); \
    const lds_cptr vp_=vp0+(VS); const lds_cptr kq_=kp0+(KS); \
    SP_A0 PH_A(t,PC,true,PRA_,PRB_); SP_A1 \
    SP_B0 PH_B(PC,PN,GL); SP_B1 \
    RESC(); }while(0)
  #define ST2(t,PC,PN,VS,KS,GL,GA2,PRA_,PRB_) do{ SBAR(); \
    const lds_cptr vp_=vp0+(VS); const lds_cptr kq_=kp0+(KS); \
    SP_B0 VRS(0,0); VRS(1,1); \
    PH_B(PC,PN,GL); SP_B1 \
    RESC(); \
    SP_A0 if(GA2){ PH_A((t)+1,PN,false,PRA_,PRB_); } SP_A1 \
    }while(0)
  if(wid>=4){ const lds_cptr vp_=vp0; PH_A(1,PA,false,PRIO_G2A2,PRIO_G2B1); }
  asm volatile("s_waitcnt lgkmcnt(0)\n\ts_barrier":::"memory");
  int vb=0, kb=2*F_KSL, t=1;
  #define IV1(t,GK3) do{ if(GK3){ DK((t)+3,kb^(2*F_KSL)); } DV((t)+1,vb^(2*F_VSL)); \
      ST1(t,PA,PB,vb,kb,true,PRIO_G1A1,PRIO_G1B1); ST1((t)+1,PB,PA,vb+F_VSL,kb+F_KSL,true,PRIO_G1A2,PRIO_G1B2); \
      SP_W0 WAIT_BAR(0); SP_W1 vb^=2*F_VSL; kb^=2*F_KSL; }while(0)
  #define IV2(t,GK4) do{ if(GK4){ DK((t)+4,(kb^(2*F_KSL))+F_KSL); } DV((t)+2,(vb^(2*F_VSL))+F_VSL); \
      ST2(t,PA,PB,vb,kb,true,true,PRIO_G2A1,PRIO_G2B2); ST2((t)+1,PB,PA,vb+F_VSL,kb+F_KSL,true,true,PRIO_G2A2,PRIO_G2B1); \
      SP_W0 WAIT_BAR(0); SP_W1 vb^=2*F_VSL; kb^=2*F_KSL; }while(0)
  if(wid<4){
    #undef CMASK
    #define CMASK(P0,P1,t) do{}while(0)
    STAMP_DECL
    for(;t+8<NT;t+=2){ IV1(t,true); }
    STAMP_FINI
    #undef CMASK
    #define CMASK(P0,P1,t) do{int jb_=(t)-(NT-4); if(jb_>=-2 && (32*wid-(64*jb_+63))<113){ const int l_=lane_now(); BMF(P0,P1,jb_,wid*QBLK+(l_&31),l_>>5); } }while(0)
    for(;t+1<NT;t+=2){ IV1(t,(t+3<NT)); }
    ST1(NT-1,PA,PB,vb,kb,false,PRIO_G1A1,PRIO_G1B1);
  } else {
    #undef CMASK
    #define CMASK(P0,P1,t) do{}while(0)
    STAMP_DECL
    for(;t+8<NT;t+=2){ IV2(t,true); }
    STAMP_FINI
    #undef CMASK
    #define CMASK(P0,P1,t) do{int jb_=(t)-(NT-4); if(jb_>=-2 && (32*wid-(64*jb_+63))<113){ const int l_=lane_now(); BMF(P0,P1,jb_,wid*QBLK+(l_&31),l_>>5); } }while(0)
    for(;t+1<NT;t+=2){ IV2(t,(t+4<NT)); }
    ST2(NT-1,PA,PB,vb,kb,false,false,0,0);
  }
  #if defined(PROBE_XLDS)
  asm volatile("s_waitcnt lgkmcnt(0)":"+v"(xdummy)::"memory");
  #endif
  __builtin_amdgcn_s_setprio(0);
  { SBAR(); const lds_cptr vp_=vp0+vb+F_VSL; VRS(0,0);VRS(1,1);
    o[0]=MF8(PB,vf[0],o[0]); o[1]=MF8(PB,vf[1],o[1]); VRS(0,2);VRS(1,3); o[2]=MF8(PB,vf[0],o[2]); o[3]=MF8(PB,vf[1],o[3]); l4=MFL(PB,l4); }
  #undef PK8
  #undef PK8O
  #undef PIN
  #undef MX3
  #undef EX
  #undef GA
  #undef GB
  #undef VRS
  #undef KRD
  #undef MFQ
  #undef MF8
  #undef MFL
  #undef KLD
  #undef ST1
  #undef ST2
  #undef IV1
  #undef IV2
  #undef XTRA
  #undef PH_A
  #undef PH_B
  float rli[16];
  const int lane_e=lane_now(), r32e=lane_e&31, hie=lane_e>>5;
  if((lane_e&7)==0){ const int lr_=4*(lane_e>>4)+16*((lane_e>>3)&1); _Pragma("unroll") for(int i_=0;i_<4;++i_)wsf[64+lr_+i_]=l4[i_]; }
  asm volatile("s_waitcnt lgkmcnt(0)":::"memory");
  #pragma unroll
  for(int r=0;r<16;++r)rli[r]=1.0f/wsf[64+crow(r,hie)];
  { asm volatile("":"+s"(Op)); }
  bf16*Ow=Op+(long)(q0+wid*QBLK)*LDO;
  bf16*stg=(bf16*)(shm+F_LDS_OST)+wid*2048;
  if(Yp==nullptr){
    #pragma unroll
    for(int ph=0;ph<2;++ph){
      #pragma unroll
      for(int r=0;r<16;++r){const int orow=crow(r,hie);
        #pragma unroll
        for(int d0=0;d0<2;++d0)stg[orow*64+d0*32+r32e]=__float2bfloat16(o[2*ph+d0][r]*rli[r]);}
      asm volatile("s_waitcnt lgkmcnt(0)":::"memory");
      #pragma unroll
      for(int i=0;i<4;++i){const int row=i*8+(lane_e>>3),ch=lane_e&7; const u32x4 v=*(const u32x4*)(stg+row*64+ch*8); *(u32x4*)(Ow+(long)row*LDO+ph*64+ch*8)=v;}
      asm volatile("s_waitcnt lgkmcnt(0)":::"memory"); }
  } else {
    asm volatile("":"+s"(Yp),"+s"(gnp));
    const int ch=lane_e&7, rw=lane_e>>3;
    u32x4 o1v[2][4], o2v[2][4]; float gnv[2][8];
    #pragma unroll
    for(int ph=0;ph<2;++ph){
      #pragma unroll
      for(int i=0;i<4;++i) o1v[ph][i]=*(const u32x4*)(Ow+(long)(i*8+rw)*LDO+ph*64+ch*8);
      #pragma unroll
      for(int k=0;k<8;++k) gnv[ph][k]=gnp[ph*64+ch*8+k]*gmul; }
    #pragma unroll
    for(int ph=0;ph<2;++ph){
      #pragma unroll
      for(int r=0;r<16;++r){const int orow=crow(r,hie);
        #pragma unroll
        for(int d0=0;d0<2;++d0)stg[orow*64+d0*32+r32e]=__float2bfloat16(o[2*ph+d0][r]*rli[r]);}
      asm volatile("s_waitcnt lgkmcnt(0)":::"memory");
      #pragma unroll
      for(int i=0;i<4;++i) o2v[ph][i]=*(const u32x4*)(stg+(i*8+rw)*64+ch*8);
      asm volatile("s_waitcnt lgkmcnt(0)":::"memory"); }
    bf16*Yw=Yp+(long)(q0+wid*QBLK)*1024;
    #pragma unroll
    for(int i=0;i<4;++i){
      float v[2][8]; float sq=0.f;
      #pragma unroll
      for(int ph=0;ph<2;++ph){ const u32x4 a=o1v[ph][i], b=o2v[ph][i];
        v[ph][0]=bflo(a.x)-lam*bflo(b.x); v[ph][1]=bfhi(a.x)-lam*bfhi(b.x); v[ph][2]=bflo(a.y)-lam*bflo(b.y); v[ph][3]=bfhi(a.y)-lam*bfhi(b.y);
        v[ph][4]=bflo(a.z)-lam*bflo(b.z); v[ph][5]=bfhi(a.z)-lam*bfhi(b.z); v[ph][6]=bflo(a.w)-lam*bflo(b.w); v[ph][7]=bfhi(a.w)-lam*bfhi(b.w);
        #pragma unroll
        for(int k=0;k<8;++k) sq+=v[ph][k]*v[ph][k]; }
      sq+=__builtin_bit_cast(float,__builtin_amdgcn_update_dpp(0,__builtin_bit_cast(int,sq),0xB1,0xf,0xf,true));
      sq+=__builtin_bit_cast(float,__builtin_amdgcn_update_dpp(0,__builtin_bit_cast(int,sq),0x4E,0xf,0xf,true));
      sq+=__builtin_bit_cast(float,__builtin_amdgcn_update_dpp(0,__builtin_bit_cast(int,sq),0x141,0xf,0xf,true));
      const float rn=1.0f/sqrtf(sq*(1.0f/128.0f)+1e-6f);
      #pragma unroll
      for(int ph=0;ph<2;++ph){ u32x4 y;
        y.x=cvtpk_s(v[ph][0]*rn*gnv[ph][0],v[ph][1]*rn*gnv[ph][1]); y.y=cvtpk_s(v[ph][2]*rn*gnv[ph][2],v[ph][3]*rn*gnv[ph][3]);
        y.z=cvtpk_s(v[ph][4]*rn*gnv[ph][4],v[ph][5]*rn*gnv[ph][5]); y.w=cvtpk_s(v[ph][6]*rn*gnv[ph][6],v[ph][7]*rn*gnv[ph][7]);
        *(u32x4*)(Yw+(long)(i*8+rw)*1024+ph*64+ch*8)=y; } }
  }
  asm volatile("s_waitcnt lgkmcnt(0)\n\ts_barrier":::"memory");
  #undef DK
  #undef DV
  #undef CMASK
  #undef RESC
}
#undef SBAR
#undef WAIT_BAR
}

#ifndef STAMP_BLOCK
#define STAMP_BLOCK 0
#endif
#ifndef STAMP_SCALE
#define STAMP_SCALE 10000
#endif
constexpr int NWAVES = 8;
#ifndef MK_N_LAUNCHES
#define MK_N_LAUNCHES 1
#endif
constexpr int N_PHASES = 13;
constexpr int N_LAUNCHES = MK_N_LAUNCHES;

constexpr int BATCH = 2, T = 16384, D = 1024, M = BATCH * T;
constexpr int NPROJ = 3072;
constexpr int NEXP = 32, EFF = 512;
constexpr float EPS = 1e-6f, LOG2E = 1.4426950408889634f;
constexpr float LAMBDA_INIT = 0.2f;
constexpr int MOBA_CAP = 256 * 2016;

constexpr size_t MiB = 1u << 20;
constexpr size_t WS_CTL = 0, CTL_ZERO_BYTES = 1 * MiB;
constexpr size_t WS_MOD = 1 * MiB;
constexpr size_t WS_BIASG = 1 * MiB + 64 * 1024;
constexpr size_t WS_BT4 = 1 * MiB + 128 * 1024;
constexpr size_t WS_KMEAN = 512 * 1024;
constexpr size_t WS_TOKW = 2 * MiB;
constexpr size_t WS_ELIST = 3 * MiB;
constexpr size_t WS_WIN = 8 * MiB, WS_WOUT = 14 * MiB;
constexpr size_t WS_XN = 16 * MiB;
constexpr size_t WS_QKV = 80 * MiB;
constexpr size_t WS_OD = 272 * MiB;
constexpr size_t WS_PO = 336 * MiB;
constexpr size_t WS_PML = 432 * MiB;
constexpr size_t WS_MLIST = 438 * MiB;
constexpr float W8_SCALE = 32.f, HID8_SCALE = 8.f, Y8_SCALE = 16.f;
constexpr size_t WS_WGU = 336 * MiB, WS_WD = 400 * MiB;
constexpr size_t WS_YO = 80 * MiB;
constexpr size_t WS_HID = 208 * MiB;
constexpr size_t WS_SO = 80 * MiB;
constexpr size_t WS_X1B = 432 * MiB;
constexpr size_t WS_VT8 = 496 * MiB;
constexpr size_t WS_END = 512 * MiB;
static_assert(WS_X1B + (size_t)M * 1024 * 2 <= WS_END && WS_X1B >= WS_WD + (size_t)32 * 1024 * 512 * 2, "d_ws map");
static_assert(WS_MLIST + (size_t)16 * MOBA_CAP * 4 <= WS_END && WS_PML + (size_t)3 * M * 16 * 4 <= WS_MLIST && WS_PO + (size_t)3 * M * 512 * 2 <= WS_PML, "d_ws map");
static_assert(WS_HID + (size_t)73728 * 512 * 2 <= WS_WGU && WS_SO + (size_t)M * 2 * 1024 * 2 <= WS_HID && WS_WD + (size_t)32 * 1024 * 512 * 2 <= WS_PML, "d_ws map");
constexpr int CW_BAR = 4096;
constexpr int CW_MCNT = 16384;
constexpr int CW_ECNT = 16384 + 1024 * 16;
static_assert((CW_ECNT + 32 * 64) * 4 <= (int)CTL_ZERO_BYTES, "CTL words inside the memset region");

constexpr int RING_OFF = 0, RING_BYTES = 131072;
constexpr int LDSCTL_OFF = 147456, MISC_OFF = LDSCTL_OFF + 320;
constexpr int LDS_BYTES = 148480;
static_assert(MISC_OFF + 128 <= LDS_BYTES, "LDS map");

#define GAS __attribute__((address_space(1)))
#define LAS __attribute__((address_space(3)))
typedef unsigned short bf16;
typedef unsigned v4u __attribute__((ext_vector_type(4)));
typedef unsigned v2u __attribute__((ext_vector_type(2)));
typedef float f32x4 __attribute__((ext_vector_type(4)));
typedef float f32x2 __attribute__((ext_vector_type(2)));
typedef GAS unsigned gu32;
#define RLX_AGENT __ATOMIC_RELAXED, __HIP_MEMORY_SCOPE_AGENT
#define LDS_WAIT() asm volatile("s_waitcnt lgkmcnt(0)" ::: "memory")
#define VM_WAIT() asm volatile("s_waitcnt vmcnt(0)" ::: "memory")
__device__ __forceinline__ unsigned f2bf(float f) { unsigned u = __builtin_bit_cast(unsigned, f); return (u + 0x7fffu + ((u >> 16) & 1u)) >> 16; }
__device__ __forceinline__ unsigned pk2(float lo, float hi) { return f2bf(lo) | (f2bf(hi) << 16); }
__device__ __forceinline__ float bf_lo(unsigned u) { return __uint_as_float(u << 16); }
__device__ __forceinline__ float bf_hi(unsigned u) { return __uint_as_float(u & 0xffff0000u); }

#define XB_TMO      128
#define XB_XCNT(j)  (256  + 64 * (j))
#define XB_XSUB(j)  (1280 + 64 * (j))
#define XB_XGEN(j)  (2304 + 64 * (j))
#define XB_TOP      3328
#define XB_TOPGEN   3392
#define XCD_BAR_WORDS 3456
#define XB_SPIN_CAP (1u << 18)

__device__ __forceinline__ unsigned xb_ld(unsigned* p)              { return __hip_atomic_load(p, __ATOMIC_RELAXED, __HIP_MEMORY_SCOPE_AGENT); }
__device__ __forceinline__ unsigned xb_add(unsigned* p, unsigned v) { return __hip_atomic_fetch_add(p, v, __ATOMIC_RELAXED, __HIP_MEMORY_SCOPE_AGENT); }
__device__ __forceinline__ unsigned xb_xcc_id() { return (unsigned)__builtin_amdgcn_s_getreg((3 << 11) | 20) & 0xFu; }
#define XB_SPIN(cond, bar) do { unsigned _sp = 0; while (cond) { __builtin_amdgcn_s_sleep(1); \
    if ((++_sp & 255u) == 0u) { if (xb_ld(&(bar)[XB_TMO])) break; if (_sp > XB_SPIN_CAP) { atomicAdd(&(bar)[XB_TMO], 1u); break; } } } } while (0)

struct XcdBarrier {
    unsigned* bar; unsigned x;
    volatile LAS unsigned* st;
};
__device__ __forceinline__ XcdBarrier xcd_barrier_post(unsigned* bar, volatile LAS unsigned* st, bool leader  ) {
    XcdBarrier b; b.bar = bar; b.x = xb_xcc_id(); b.st = st;
    if (leader) (void)xb_add(&bar[XB_XCNT(b.x)], 1u);
    return b;
}
__device__ __forceinline__ void xcd_barrier_complete(unsigned* bar, unsigned x, unsigned& nloc, unsigned& nx) {
    const unsigned G = gridDim.x * gridDim.y * gridDim.z;
    unsigned sum, cnt, mine, sp = 0u;
    for (;;) {
        sum = 0u; cnt = 0u; mine = 0u;
#pragma unroll
        for (unsigned j = 0; j < 16; ++j) { const unsigned c = xb_ld(&bar[XB_XCNT(j)]); sum += c; cnt += (c > 0u) ? 1u : 0u; mine = (j == x) ? c : mine; }
        if (sum == G) break;
        __builtin_amdgcn_s_sleep(1);
        if ((++sp & 255u) == 0u) { if (xb_ld(&bar[XB_TMO])) break; if (sp > XB_SPIN_CAP) { atomicAdd(&bar[XB_TMO], 1u); break; } }
    }
    nloc = mine > 0u ? mine : 1u; nx = cnt > 0u ? cnt : 1u;
}
__device__ __forceinline__ void xcd_barrier(const XcdBarrier& b, bool leader  ) {
    asm volatile("s_waitcnt vmcnt(0)" ::: "memory");
    __syncthreads();
    if (leader) {
        unsigned* bar = b.bar;
        __builtin_amdgcn_s_waitcnt(0);
        unsigned nloc = b.st[0], nx = b.st[1];
        if (nloc == 0u) { xcd_barrier_complete(bar, b.x, nloc, nx); b.st[0] = nloc; b.st[1] = nx; }
        const unsigned old = xb_add(&bar[XB_XSUB(b.x)], 1u);
        const unsigned gen = old / nloc;
        if (old + 1u == (gen + 1u) * nloc) {
            __builtin_amdgcn_fence(__ATOMIC_RELEASE, "agent");
            asm volatile("s_waitcnt vmcnt(0)" ::: "memory");
            const unsigned og = xb_add(&bar[XB_TOP], 1u);
            const unsigned tg = og / nx;
            if (og + 1u == (tg + 1u) * nx) xb_add(&bar[XB_TOPGEN], 1u);
            else XB_SPIN(xb_ld(&bar[XB_TOPGEN]) == tg, bar);
            __builtin_amdgcn_fence(__ATOMIC_ACQUIRE, "agent");
            xb_add(&bar[XB_XGEN(b.x)], 1u);
            asm volatile("s_waitcnt vmcnt(0)" ::: "memory");
        } else {
            XB_SPIN(xb_ld(&bar[XB_XGEN(b.x)]) == gen, bar);
            __builtin_amdgcn_fence(__ATOMIC_ACQUIRE, "agent");
            asm volatile("s_waitcnt vmcnt(0)" ::: "memory");
        }
    }
    __syncthreads();
}

struct Frame {
    LAS unsigned char* lds;
    volatile LAS unsigned* MISC;
    gu32* ctl;
    int tid, lane, wave;
    int vcu, G;
    float* out; unsigned char* ws;
};
typedef __attribute__((address_space(4))) const unsigned char* kptr_t;
__device__ __forceinline__ kptr_t karg() { kptr_t p = (kptr_t)__builtin_amdgcn_kernarg_segment_ptr(); asm volatile("" : "+s"(p)); return p; }
#define INP(kp, i) (*(const float* const __attribute__((address_space(4)))*)((kp) + 8 * (i)))
__device__ __forceinline__ float shx(float v, int o, int lane) { return __builtin_bit_cast(float, __builtin_amdgcn_ds_bpermute((lane ^ o) << 2, __builtin_bit_cast(int, v))); }
__device__ __forceinline__ int shfl_i(int v, int src) { return __builtin_amdgcn_ds_bpermute(src << 2, v); }
template<int CTRL> __device__ __forceinline__ float dpp_f(float v) { return __builtin_bit_cast(float, __builtin_amdgcn_update_dpp(0, __builtin_bit_cast(int, v), CTRL, 0xf, 0xf, true)); }
__device__ __forceinline__ float sum16_dpp(float v) {
    v += dpp_f<0xB1>(v); v += dpp_f<0x4E>(v); v += dpp_f<0x141>(v); v += dpp_f<0x140>(v); return v; }
__device__ __forceinline__ float wave_sum(float v, int  ) {
    v = sum16_dpp(v);
    { auto rr = __builtin_amdgcn_permlane16_swap(__float_as_uint(v), __float_as_uint(v), false, false); v = __uint_as_float(rr[0]) + __uint_as_float(rr[1]); }
    { auto rr = __builtin_amdgcn_permlane32_swap(__float_as_uint(v), __float_as_uint(v), false, false); v = __uint_as_float(rr[0]) + __uint_as_float(rr[1]); }
    return v;
}
#define PHASE_BEGIN(F) do { (F).lane = lane_now(); (F).tid = (F).wave * 64 + (F).lane; \
    { const kptr_t kq_ = karg(); (F).out = *(float* const __attribute__((address_space(4)))*)(kq_ + 184); (F).ws = *(unsigned char* const __attribute__((address_space(4)))*)(kq_ + 192); (F).ctl = (gu32*)(F).ws; } } while (0)
__device__ __forceinline__ float silu_f(float v) { return v / (1.f + __expf(-v)); }
__device__ __forceinline__ int rel_bucket(int d) {
    if (d < 16) return d;
    const int thr[15] = {19, 21, 24, 27, 31, 35, 40, 46, 52, 59, 67, 77, 87, 99, 113};
    int b = 16;
#pragma unroll
    for (int i = 0; i < 15; ++i) b += (d >= thr[i]) ? 1 : 0;
    return b;
}
__device__ __forceinline__ void p0_transpose_item(const float* W, int K, int N, bf16* WT, size_t dst_row0, LAS float* scr, int k0, int n0, int lane) {
    {
        f32x4 t_[8]; const int r_ = lane >> 3, c_ = lane & 7;
#pragma unroll
        for (int i = 0; i < 8; ++i) t_[i] = *(const GAS f32x4*)(W + (size_t)(k0 + r_ + 8 * i) * N + n0 + 4 * c_);
#pragma unroll
        for (int i = 0; i < 8; ++i) { LAS float* d_ = scr + (r_ + 8 * i) * 33 + 4 * c_; d_[0] = t_[i].x; d_[1] = t_[i].y; d_[2] = t_[i].z; d_[3] = t_[i].w; } }
    LDS_WAIT(); asm volatile("" ::: "memory");
    const int c = lane & 7;
#pragma unroll
    for (int j = 0; j < 4; ++j) { const int n = (lane >> 3) + 8 * j; const LAS float* s = scr + (8 * c) * 33 + n;
        v4u o; o.x = pk2(s[0 * 33], s[1 * 33]); o.y = pk2(s[2 * 33], s[3 * 33]); o.z = pk2(s[4 * 33], s[5 * 33]); o.w = pk2(s[6 * 33], s[7 * 33]);
        *(GAS v4u*)(WT + (dst_row0 + n) * K + k0 + 8 * c) = o; }
    LDS_WAIT(); asm volatile("" ::: "memory");
}

__device__ __forceinline__ void p0_transpose_item8(const float* W, int K, int N, unsigned char* WT, size_t dst_row0, LAS float* scr, int k0, int n0, int lane) {
    {
        f32x4 t_[8]; const int r_ = lane >> 3, c_ = lane & 7;
#pragma unroll
        for (int i = 0; i < 8; ++i) t_[i] = *(const GAS f32x4*)(W + (size_t)(k0 + r_ + 8 * i) * N + n0 + 4 * c_);
#pragma unroll
        for (int i = 0; i < 8; ++i) { LAS float* d_ = scr + (r_ + 8 * i) * 33 + 4 * c_; d_[0] = t_[i].x; d_[1] = t_[i].y; d_[2] = t_[i].z; d_[3] = t_[i].w; } }
    LDS_WAIT(); asm volatile("" ::: "memory");
    const int c = lane & 3;
#pragma unroll
    for (int j = 0; j < 2; ++j) { const int n = (lane >> 2) + 16 * j; const LAS float* s = scr + (16 * c) * 33 + n;
        int w[4];
#pragma unroll
        for (int q = 0; q < 4; ++q) { int t = 0; t = __builtin_amdgcn_cvt_pk_fp8_f32(s[(4 * q) * 33] * W8_SCALE, s[(4 * q + 1) * 33] * W8_SCALE, t, false);
            t = __builtin_amdgcn_cvt_pk_fp8_f32(s[(4 * q + 2) * 33] * W8_SCALE, s[(4 * q + 3) * 33] * W8_SCALE, t, true); w[q] = t; }
        *(GAS v4u*)(WT + (dst_row0 + n) * K + k0 + 16 * c) = (v4u){(unsigned)w[0], (unsigned)w[1], (unsigned)w[2], (unsigned)w[3]}; }
    LDS_WAIT(); asm volatile("" ::: "memory");
}
__device__ __forceinline__ void p0_prologue(Frame& F) {
    PHASE_BEGIN(F);
    const kptr_t kp = karg();
    const float* c = INP(kp, 1); const float* w_ada = INP(kp, 2); const float* b_ada = INP(kp, 3);
    float* mod = (float*)(F.ws + WS_MOD);
    LAS float* cs = (LAS float*)(F.lds);
    LAS float* part = (LAS float*)(F.lds + 8192);
    for (int cg = blockIdx.x; cg < 192; cg += F.G) {
        for (int i = F.tid; i < 2048; i += NWAVES * 64) cs[i] = silu_f(c[i]);
        __syncthreads();
        const int l31 = F.lane & 31, hf = F.lane >> 5, col = cg * 32 + l31, k0 = (F.wave * 2 + hf) * 64; float a0 = 0.f, a1 = 0.f;
        float wv_[64];
#pragma unroll
        for (int k = 0; k < 64; ++k) wv_[k] = w_ada[(size_t)(k0 + k) * 6144 + col];
#pragma unroll
        for (int k = 0; k < 64; ++k) { a0 += cs[k0 + k] * wv_[k]; a1 += cs[1024 + k0 + k] * wv_[k]; }
        { auto rr = __builtin_amdgcn_permlane32_swap(__float_as_uint(a0), __float_as_uint(a0), false, false); a0 = __uint_as_float(rr[0]) + __uint_as_float(rr[1]); }
        { auto rr = __builtin_amdgcn_permlane32_swap(__float_as_uint(a1), __float_as_uint(a1), false, false); a1 = __uint_as_float(rr[0]) + __uint_as_float(rr[1]); }
        if (hf == 0) { part[(F.wave * 2 + 0) * 32 + l31] = a0; part[(F.wave * 2 + 1) * 32 + l31] = a1; }
        __syncthreads();
        if (F.wave < 2 && hf == 0) { float s = 0.f;
#pragma unroll
            for (int w = 0; w < 8; ++w) s += part[(w * 2 + F.wave) * 32 + l31];
            mod[F.wave * 6144 + col] = s + b_ada[col]; }
        __syncthreads();
    }
    if (blockIdx.x == F.G - 1) {
        const float* rb = INP(kp, 15); float* bg = (float*)(F.ws + WS_BIASG);
        for (int i = F.tid; i < 12 * 128; i += NWAVES * 64) { const int h = i >> 7, d = i & 127; bg[i] = (rb[rel_bucket(d) * 12 + h] - rb[31 * 12 + h]) * LOG2E; }
        float* b4 = (float*)(F.ws + WS_BT4);
        for (int i = F.tid; i < 12 * 2048; i += NWAVES * 64) { const int h = i >> 11, k = i & 2047, d = (k & 511) + (k >> 9) - 256;
            b4[i] = d < 0 ? -INFINITY : (d < 128 ? (rb[rel_bucket(d) * 12 + h] - rb[31 * 12 + h]) * LOG2E : 0.f); }
    }
    __syncthreads();
    LAS float* scr = (LAS float*)(F.lds + RING_OFF + F.wave * 16384);
    const int gw = F.vcu * NWAVES + F.wave, NGW = F.G * NWAVES;
    constexpr int I_IN = 16 * 96, I_OUT = 16 * 32;
    for (int it = gw; it < I_IN + I_OUT; it += NGW) {
        if (it < I_IN) { const int kb = it / 96, nb = it % 96; p0_transpose_item(INP(kp, 8), 1024, 3072, (bf16*)(F.ws + WS_WIN), (size_t)(32 * nb), scr, 64 * kb, 32 * nb, F.lane); }
        else { const int r = it - I_IN, kb = r / 32, nb = r % 32; p0_transpose_item(INP(kp, 14), 1024, 1024, (bf16*)(F.ws + WS_WOUT), (size_t)(32 * nb), scr, 64 * kb, 32 * nb, F.lane); }
    }
}
__device__ __forceinline__ void expert_weights(Frame& F) {
    const kptr_t kp = karg();
    PHASE_BEGIN(F);
    LAS float* scr = (LAS float*)(F.lds + RING_OFF + F.wave * 16384);
    const int gw = F.vcu * NWAVES + F.wave, NGW = F.G * NWAVES;
    constexpr int I_G = 32 * 16 * 16, I_D = 32 * 8 * 32, I_ALL = 2 * I_G + I_D;
#define EW_DECODE(it_, W_, K_, N_, WT_, R0_, k0_, n0_) const float* W_; int K_, N_, k0_, n0_; unsigned char* WT_; size_t R0_; \
    if ((it_) < 2 * I_G) { const int up_ = (it_) >= I_G ? 1 : 0, r_ = (it_) - up_ * I_G, e_ = r_ >> 8, kb_ = (r_ >> 4) & 15, nb_ = r_ & 15; n0_ = 32 * nb_; k0_ = 64 * kb_; K_ = 1024; N_ = 512; \
        W_ = INP(kp, 20 + up_) + (size_t)e_ * 1024 * 512; WT_ = (unsigned char*)(F.ws + WS_WGU); R0_ = (size_t)e_ * 1024 + (n0_ >> 7) * 256 + up_ * 128 + (n0_ & 127); } \
    else { const int r_ = (it_) - 2 * I_G, e_ = r_ >> 8, kb_ = (r_ >> 5) & 7, nb_ = r_ & 31; n0_ = 32 * nb_; k0_ = 64 * kb_; K_ = 512; N_ = 1024; \
        W_ = INP(kp, 22) + (size_t)e_ * 512 * 1024; WT_ = (unsigned char*)(F.ws + WS_WD); R0_ = (size_t)e_ * 1024 + 32 * nb_; }
    f32x4 t_[8]; const int r_l = F.lane >> 3, c_l = F.lane & 7;
    if (gw < I_ALL) { EW_DECODE(gw, W0, K0, N0, WT0, R00, k00, n00);
#pragma unroll
        for (int i = 0; i < 8; ++i) t_[i] = *(const GAS f32x4*)(W0 + (size_t)(k00 + r_l + 8 * i) * N0 + n00 + 4 * c_l); }
    for (int it = gw; it < I_ALL; it += NGW) {
        EW_DECODE(it, W, K, N, WT, R0, k0, n0);
#pragma unroll
        for (int i = 0; i < 8; ++i) { LAS float* d_ = scr + (r_l + 8 * i) * 33 + 4 * c_l; d_[0] = t_[i].x; d_[1] = t_[i].y; d_[2] = t_[i].z; d_[3] = t_[i].w; }
        LDS_WAIT(); asm volatile("" ::: "memory");
        if (it + NGW < I_ALL) { EW_DECODE(it + NGW, Wn, Kn, Nn, WTn, R0n, k0n, n0n);
#pragma unroll
            for (int i = 0; i < 8; ++i) t_[i] = *(const GAS f32x4*)(Wn + (size_t)(k0n + r_l + 8 * i) * Nn + n0n + 4 * c_l); }
        const int c = F.lane & 3;
#pragma unroll
        for (int j = 0; j < 2; ++j) { const int n = (F.lane >> 2) + 16 * j; const LAS float* s = scr + (16 * c) * 33 + n;
            int w[4];
#pragma unroll
            for (int q = 0; q < 4; ++q) { int tt = 0; tt = __builtin_amdgcn_cvt_pk_fp8_f32(s[(4 * q) * 33] * W8_SCALE, s[(4 * q + 1) * 33] * W8_SCALE, tt, false);
                tt = __builtin_amdgcn_cvt_pk_fp8_f32(s[(4 * q + 2) * 33] * W8_SCALE, s[(4 * q + 3) * 33] * W8_SCALE, tt, true); w[q] = tt; }
            *(GAS v4u*)(WT + (R0 + n) * K + k0 + 16 * c) = (v4u){(unsigned)w[0], (unsigned)w[1], (unsigned)w[2], (unsigned)w[3]}; }
        LDS_WAIT(); asm volatile("" ::: "memory");
    }
#undef EW_DECODE
}
__device__ __forceinline__ void p1_prenorm(Frame& F) {
    PHASE_BEGIN(F);
    const kptr_t kp = karg();
    const float* x = INP(kp, 0); const float* gain = INP(kp, 4); const float* mod = (const float*)(F.ws + WS_MOD); bf16* XN = (bf16*)(F.ws + WS_XN);
    const int gw = F.vcu * NWAVES + F.wave, NGW = F.G * NWAVES;
    for (int b = 0; b < BATCH; ++b) {
        f32x4 ge[4], sh[4];
#pragma unroll
        for (int j = 0; j < 4; ++j) { const int c = 4 * F.lane + 256 * j; const f32x4 g = *(const f32x4*)(gain + c), sc = *(const f32x4*)(mod + b * 6144 + 1024 + c); ge[j] = g * (sc + 1.f); sh[j] = *(const f32x4*)(mod + b * 6144 + c); }
        f32x4 nv[4];
        { const GAS f32x4* xr = (const GAS f32x4*)(x + (size_t)(b * T + gw) * D) + F.lane;
#pragma unroll
          for (int j = 0; j < 4; ++j) nv[j] = xr[64 * j]; }
        for (int m = b * T + gw; m < (b + 1) * T; m += NGW) {
            int ln = F.lane; asm volatile("" : "+v"(ln));
            f32x4 v[4]; float s = 0.f;
#pragma unroll
            for (int j = 0; j < 4; ++j) { v[j] = nv[j]; s += (v[j].x * v[j].x + v[j].y * v[j].y) + (v[j].z * v[j].z + v[j].w * v[j].w); }
            { const int mn = (m + NGW < (b + 1) * T) ? m + NGW : m; const GAS f32x4* xr = (const GAS f32x4*)(x + (size_t)mn * D) + ln;
#pragma unroll
              for (int j = 0; j < 4; ++j) nv[j] = xr[64 * j]; }
            const float r = 1.f / sqrtf(wave_sum(s, F.lane) * (1.f / D) + EPS);
            GAS unsigned long long* o8 = (GAS unsigned long long*)(XN + (size_t)m * D) + ln;
#pragma unroll
            for (int j = 0; j < 4; ++j) { const f32x4 h = v[j] * r * ge[j] + sh[j]; o8[64 * j] = (unsigned long long)pk2(h.x, h.y) | ((unsigned long long)pk2(h.z, h.w) << 32); }
        }
    }
}
__device__ __forceinline__ void p3_kmean(Frame& F) {
    PHASE_BEGIN(F);
    const bf16* QKV = (const bf16*)(F.ws + WS_QKV);
    const int gw = F.vcu * NWAVES + F.wave, NGW = F.G * NWAVES;
    LAS unsigned char* tile = (LAS unsigned char*)(F.lds + RING_OFF + F.wave * 16384);
    unsigned char* VT = (unsigned char*)(F.ws + WS_VT8);
    for (int it = gw; it < 2 * 4 * 256; it += NGW) {
        const int b = it >> 10, h = (it >> 8) & 3, t = it & 255;
        const int kk = F.lane, k31 = kk & 31, hi_ = (k31 >> 2) & 1, s_ = (k31 & 3) + 4 * (k31 >> 3) + 16 * (kk >> 5), pos = 32 * hi_ + s_;
        const bf16* src = QKV + ((size_t)(b * T + 64 * t + kk)) * NPROJ + 1024 + h * 128;
#pragma unroll 4
        for (int c = 0; c < 16; ++c) { const v4u v = *(const GAS v4u*)(src + 8 * c);
            const float f[8] = {bf_lo(v.x), bf_hi(v.x), bf_lo(v.y), bf_hi(v.y), bf_lo(v.z), bf_hi(v.z), bf_lo(v.w), bf_hi(v.w)};
            int w0 = 0, w1 = 0;
            w0 = __builtin_amdgcn_cvt_pk_fp8_f32(f[0] * 8.f, f[1] * 8.f, w0, false); w0 = __builtin_amdgcn_cvt_pk_fp8_f32(f[2] * 8.f, f[3] * 8.f, w0, true);
            w1 = __builtin_amdgcn_cvt_pk_fp8_f32(f[4] * 8.f, f[5] * 8.f, w1, false); w1 = __builtin_amdgcn_cvt_pk_fp8_f32(f[6] * 8.f, f[7] * 8.f, w1, true);
#pragma unroll
            for (int j = 0; j < 4; ++j) { tile[(8 * c + j) * 64 + pos] = (unsigned char)((unsigned)w0 >> (8 * j)); tile[(8 * c + 4 + j) * 64 + pos] = (unsigned char)((unsigned)w1 >> (8 * j)); } }
        LDS_WAIT(); asm volatile("" ::: "memory");
#pragma unroll
        for (int i = 0; i < 8; ++i) { const int idx = i * 64 + F.lane, d = idx >> 2, c = idx & 3;
            const v4u o = *(const LAS v4u*)(tile + d * 64 + 16 * c);
            *(GAS v4u*)(VT + ((size_t)((b * 4 + h) * 128 + d)) * T + 64 * t + 16 * c) = o; }
        LDS_WAIT(); asm volatile("" ::: "memory");
    }
}
__device__ __forceinline__ int moba_list_base(int bh, int j) { return bh * MOBA_CAP + 256 * (63 * j - (j * (j - 1)) / 2); }
__device__ __forceinline__ void p4_moba_select(Frame& F) {
    PHASE_BEGIN(F);
    const bf16* QKV = (const bf16*)(F.ws + WS_QKV); const float* km = (const float*)(F.ws + WS_KMEAN); unsigned* mlist = (unsigned*)(F.ws + WS_MLIST);
    LAS float* kml = (LAS float*)(F.lds);
    for (int bi = blockIdx.x, pass = 0; bi < 512; bi += F.G, ++pass) {
        const int bh = bi >> 5, qg = (pass & 1) ? 31 - (bi & 31) : (bi & 31), b = bh >> 3, h = bh & 7;
        for (int i = F.tid; i < 1024; i += NWAVES * 64) ((LAS f32x4*)kml)[i] = ((const f32x4*)(km + (size_t)bh * 4096))[i];
        __syncthreads();
        const int q = qg * 512 + F.wave * 64 + F.lane, own = (qg * 512 + F.wave * 64) >> 8;
        if (own > 0) {
            float qf[64];
            const bf16* qp = QKV + ((size_t)(b * T + q)) * NPROJ + 1536 + h * 64;
#pragma unroll
            for (int c8 = 0; c8 < 8; ++c8) { const v4u v = *(const GAS v4u*)(qp + c8 * 8);
                qf[c8 * 8 + 0] = bf_lo(v.x); qf[c8 * 8 + 1] = bf_hi(v.x); qf[c8 * 8 + 2] = bf_lo(v.y); qf[c8 * 8 + 3] = bf_hi(v.y); qf[c8 * 8 + 4] = bf_lo(v.z); qf[c8 * 8 + 5] = bf_hi(v.z); qf[c8 * 8 + 6] = bf_lo(v.w); qf[c8 * 8 + 7] = bf_hi(v.w); }
            float v0 = -INFINITY, v1 = -INFINITY, v2 = -INFINITY; int i0 = 64, i1 = 64, i2 = 64;
            for (int j = 0; j < own; ++j) {
                float g = 0.f;
#pragma unroll
                for (int d4 = 0; d4 < 16; ++d4) { const f32x4 kv = ((const LAS f32x4*)kml)[j * 16 + d4]; g += qf[d4 * 4] * kv.x + qf[d4 * 4 + 1] * kv.y + qf[d4 * 4 + 2] * kv.z + qf[d4 * 4 + 3] * kv.w; }
                if (g > v0) { v2 = v1; i2 = i1; v1 = v0; i1 = i0; v0 = g; i0 = j; }
                else if (g > v1) { v2 = v1; i2 = i1; v1 = g; i1 = j; }
                else if (g > v2) { v2 = g; i2 = j; }
            }
            int cntj = 0, r0 = 0, r1 = 0, r2 = 0; const unsigned long long ltm = (1ull << F.lane) - 1ull;
            for (int j = 0; j < own; ++j) {
                const bool s0 = (i0 == j), s1 = (i1 == j), s2 = (i2 == j);
                const unsigned long long mask = __ballot(s0 || s1 || s2);
                if (F.lane == j) cntj = (int)__popcll(mask);
                const int rk = (int)__popcll(mask & ltm);
                r0 = s0 ? rk : r0; r1 = s1 ? rk : r1; r2 = s2 ? rk : r2;
            }
            int basej = 0;
            if (F.lane < own && cntj > 0) basej = (int)__hip_atomic_fetch_add(F.ctl + CW_MCNT + (bh * 64 + F.lane) * 16, (unsigned)cntj, RLX_AGENT);
            const int b0 = shfl_i(basej, i0 & 63), b1 = shfl_i(basej, i1 & 63), b2 = shfl_i(basej, i2 & 63);
            if (i0 < 64) mlist[(size_t)moba_list_base(bh, i0) + b0 + r0] = (unsigned)q;
            if (i1 < 64) mlist[(size_t)moba_list_base(bh, i1) + b1 + r1] = (unsigned)q | (1u << 14);
            if (i2 < 64) mlist[(size_t)moba_list_base(bh, i2) + b2 + r2] = (unsigned)q | (2u << 14);
        }
        __syncthreads();
    }
}
__device__ __forceinline__ void p5_moba_gather(Frame& F, char* lds_generic) {
    PHASE_BEGIN(F);
    LAS int* pre = (LAS int*)(F.lds + 106496);
    LAS int* tmp = (LAS int*)(F.lds + 106496 + 4224);
    for (int i = F.tid; i < 1024; i += NWAVES * 64) { const unsigned c = __hip_atomic_load(F.ctl + CW_MCNT + i * 16, RLX_AGENT); tmp[i] = (int)((c + 255u) >> 8); }
    __syncthreads();
    if (F.wave == 0) { int loc[16]; int s = 0;
#pragma unroll
        for (int k = 0; k < 16; ++k) { loc[k] = s; s += tmp[F.lane * 16 + k]; }
        int incl = s;
#pragma unroll
        for (int o = 1; o < 64; o <<= 1) { const int t = shfl_i(incl, F.lane >= o ? F.lane - o : F.lane); if (F.lane >= o) incl += t; }
        const int excl = incl - s;
#pragma unroll
        for (int k = 0; k < 16; ++k) pre[F.lane * 16 + k] = excl + loc[k];
        if (F.lane == 63) pre[1024] = incl; }
    __syncthreads();
    const int U = pre[1024];
    const bf16* QKV = (const bf16*)(F.ws + WS_QKV); const unsigned* mlist = (const unsigned*)(F.ws + WS_MLIST);
#define P5_DECODE(L_, x_, chunk_, n_) do { int lo_ = 0, hi_ = 1024; while (hi_ - lo_ > 1) { const int mid_ = (lo_ + hi_) >> 1; if (pre[mid_] <= (L_)) lo_ = mid_; else hi_ = mid_; } \
        x_ = __builtin_amdgcn_readfirstlane(lo_); chunk_ = (L_) - __builtin_amdgcn_readfirstlane(pre[x_]); const int cnt_ = __builtin_amdgcn_readfirstlane((int)__hip_atomic_load(F.ctl + CW_MCNT + x_ * 16, RLX_AGENT)); \
        n_ = (cnt_ - chunk_ * 256) < 256 ? (cnt_ - chunk_ * 256) : 256; } while (0)
    const int ei = F.wave * 32 + (F.lane & 31);
    int last_h = -1, x = 0, chunk = 0, n = 1; unsigned gcur = 0u;
    int L = blockIdx.x;
    if (L < U) { P5_DECODE(L, x, chunk, n); gcur = mlist[(size_t)moba_list_base(x >> 6, x & 63) + chunk * 256 + (ei < n ? ei : n - 1)]; }
    for (; L < U; L += F.G) {
        const int bh = x >> 6, j = x & 63, b = bh >> 3, h = bh & 7, ncur = n;
        const int Ln = L + F.G; int xn = 0, chunkn = 0, nn = 1; unsigned gnext = 0u;
        if (Ln < U) { P5_DECODE(Ln, xn, chunkn, nn); gnext = mlist[(size_t)moba_list_base(xn >> 6, xn & 63) + chunkn * 256 + (ei < nn ? ei : nn - 1)]; }
        const attn_body::bf16* base = (const attn_body::bf16*)QKV + (size_t)b * T * NPROJ;
        attn_body::MobaMerge mm{nullptr, nullptr, 0, 0, 0};
        attn_body::GatherArgs ga{gcur, ncur, (float*)(F.ws + WS_PML), (attn_body::bf16*)(F.ws + WS_PO), (long)b * T, h};
        attn_body::attn_unit<8, 2>(base + 1536 + h * 64, base + 2048 + h * 64, base + 2560 + h * 64, nullptr, 0, j * 256, 4,
                                   (const float*)(F.ws + WS_BIASG) + (4 + h) * 128, mm, ga, lds_generic, F.wave, h != last_h);
        last_h = h; x = xn; chunk = chunkn; n = nn; gcur = gnext;
    }
#undef P5_DECODE
}
__device__ __forceinline__ void p6_attention(Frame& F, char* lds_generic) {
    PHASE_BEGIN(F);
    const attn_body::bf16* QKV = (const attn_body::bf16*)(F.ws + WS_QKV);
    const int c = blockIdx.x, G = F.G;
    const kptr_t kp = karg();
    const float l1 = wave_sum(INP(kp, 9)[F.lane] * INP(kp, 10)[F.lane], F.lane), l2 = wave_sum(INP(kp, 11)[F.lane] * INP(kp, 12)[F.lane], F.lane);
    const float lam = expf(l1) - expf(l2) + LAMBDA_INIT; const float* gnp = INP(kp, 13);
#ifndef PROBE_REPD
#define PROBE_REPD 1
#define PROBE_REPO 1
#endif
    for (int rep_ = 0; rep_ < PROBE_REPD; ++rep_)
    for (int ii = 0;; ++ii) {
        const int i = ii >> 1, mp = ii & 1;
        const long Lp = (long)i * G + ((i & 1) ? (G - 1 - c) : c);
        if (Lp >= 512) break;
        const int qb = 63 - (int)(Lp >> 3), st = (int)(Lp & 7), b = st >> 2, hd = st & 3;
        const attn_body::bf16* base = QKV + (size_t)b * T * NPROJ;
        attn_body::attn_unit128f<8>((const unsigned char*)base + hd * 128 + mp * 64, (const unsigned char*)base + 512 + hd * 128 + mp * 64, (const unsigned char*)(F.ws + WS_VT8) + (size_t)((b * 4 + hd) * 128) * T,
                                   (attn_body::bf16*)(F.ws + WS_OD) + (size_t)b * T * 1024 + (hd * 2) * 128, qb * 256, 4 * (qb + 1),
                                   (const float*)(F.ws + WS_BT4) + hd * 2048, lds_generic, F.wave,
                                   mp ? (attn_body::bf16*)(F.ws + WS_XN) + (size_t)b * T * 1024 + hd * 128 : nullptr, gnp, lam, 1.f - LAMBDA_INIT
#if defined(STAMP_PROBE)
                                   , (blockIdx.x == STAMP_BLOCK && ii == 0) ? (float*)(F.ws + WS_BIASG + 32768) : nullptr
#endif
                                   );
    }
    for (int rep_ = 0; rep_ < PROBE_REPO; ++rep_)
    for (int i = 0;; ++i) {
        const long L = (long)i * G + ((i & 1) ? (G - 1 - c) : c);
        if (L >= 1024) break;
        const int o = (int)L, b = o >> 9, h = (o >> 6) & 7, qb = o & 63;
        const attn_body::bf16* base = QKV + (size_t)b * T * NPROJ;
        attn_body::MobaMerge mm{(const float*)(F.ws + WS_PML), (const attn_body::bf16*)(F.ws + WS_PO), (long)b * T + qb * 256, h, qb < 3 ? qb : 3};
        attn_body::attn_unit<8, 1>(base + 1536 + h * 64, base + 2048 + h * 64, base + 2560 + h * 64,
                                   (attn_body::bf16*)(F.ws + WS_XN) + (size_t)b * T * 1024 + 512 + h * 64, qb * 256, qb * 256, 4,
                                   (const float*)(F.ws + WS_BIASG) + (4 + h) * 128, mm, attn_body::GatherArgs{0u, 0, nullptr, nullptr, 0, 0}, lds_generic, F.wave);
    }
}
__device__ __forceinline__ void p7_ydiff(Frame& F) {
    expert_weights(F);
}
__device__ __forceinline__ void p9_postmix_route(Frame& F) {
    PHASE_BEGIN(F);
    const kptr_t kp = karg();
    const float* x = INP(kp, 0); const bf16* yo = (const bf16*)(F.ws + WS_YO); const float* mod = (const float*)(F.ws + WS_MOD);
    bf16* XN = (bf16*)(F.ws + WS_XN); float* tokw = (float*)(F.ws + WS_TOKW); int* elist = (int*)(F.ws + WS_ELIST);
    LAS float* WE = (LAS float*)(F.lds); LAS float* WG = (LAS float*)(F.lds + 131072);
    for (int f = F.tid; f < 32768; f += NWAVES * 64) { const int k = f >> 5, cc = f & 31; const int l = (k & 255) >> 2, kk = ((k >> 8) << 2) | (k & 3), g = cc >> 3, hf = (cc >> 2) & 1, ii = cc & 3;
        WE[((((g * 16 + kk) * 2 + hf) * 64 + l) << 2) + ii] = INP(kp, 18)[f]; }
    for (int f = F.tid; f < 4096; f += NWAVES * 64) { const int k = f >> 2, ii = f & 3; const int l = (k & 255) >> 2, kk = ((k >> 8) << 2) | (k & 3); WG[((kk * 64 + l) << 2) + ii] = INP(kp, 16)[f]; }
    __syncthreads();
    const int gw = F.vcu * NWAVES + F.wave, NGW = F.G * NWAVES;
    const float bg0 = INP(kp, 17)[0], bg1 = INP(kp, 17)[1], bg2 = INP(kp, 17)[2], bg3 = INP(kp, 17)[3];
    int nst = 0, st_e0 = 0, st_e1 = 0, st_m = 0;
    for (int b = 0; b < BATCH; ++b) {
        f32x4 a1[4], ge[4], sh[4];
#pragma unroll
        for (int j = 0; j < 4; ++j) { const int c = 4 * F.lane + 256 * j; a1[j] = *(const f32x4*)(INP(kp, 5) + c) * *(const f32x4*)(mod + b * 6144 + 2048 + c);
            ge[j] = *(const f32x4*)(INP(kp, 6) + c) * (*(const f32x4*)(mod + b * 6144 + 4096 + c) + 1.f); sh[j] = *(const f32x4*)(mod + b * 6144 + 3072 + c); }
        v2u nyb[4]; f32x4 nxv[4];
        { const int m0 = b * T + gw; const GAS v2u* yr = (const GAS v2u*)(yo + (size_t)m0 * D) + F.lane; const GAS f32x4* xr = (const GAS f32x4*)(x + (size_t)m0 * D) + F.lane;
#pragma unroll
          for (int j = 0; j < 4; ++j) { nyb[j] = yr[64 * j]; nxv[j] = xr[64 * j]; } }
        for (int m = b * T + gw; m < (b + 1) * T; m += NGW) {
            int ln = F.lane; asm volatile("" : "+v"(ln));
            f32x4 xv[4]; float s = 0.f, s2 = 0.f;
            {   f32x4 y[4];
#pragma unroll
                for (int j = 0; j < 4; ++j) { const v2u yb = nyb[j]; y[j] = (f32x4){bf_lo(yb.x), bf_hi(yb.x), bf_lo(yb.y), bf_hi(yb.y)}; xv[j] = nxv[j]; s += (y[j].x * y[j].x + y[j].y * y[j].y) + (y[j].z * y[j].z + y[j].w * y[j].w); }
                { const int mn = (m + NGW < (b + 1) * T) ? m + NGW : m; const GAS v2u* yr = (const GAS v2u*)(yo + (size_t)mn * D) + ln; const GAS f32x4* xr = (const GAS f32x4*)(x + (size_t)mn * D) + ln;
#pragma unroll
                  for (int j = 0; j < 4; ++j) { nyb[j] = yr[64 * j]; nxv[j] = xr[64 * j]; } }
                const float r1 = 1.f / sqrtf(wave_sum(s, F.lane) * (1.f / D) + EPS);
                GAS unsigned long long* x1r = (GAS unsigned long long*)((bf16*)(F.ws + WS_X1B) + (size_t)m * D) + ln;
#pragma unroll
                for (int j = 0; j < 4; ++j) { xv[j] = xv[j] + a1[j] * (y[j] * r1); x1r[64 * j] = (unsigned long long)pk2(xv[j].x, xv[j].y) | ((unsigned long long)pk2(xv[j].z, xv[j].w) << 32); s2 += (xv[j].x * xv[j].x + xv[j].y * xv[j].y) + (xv[j].z * xv[j].z + xv[j].w * xv[j].w); }
            }
            const float r2 = 1.f / sqrtf(wave_sum(s2, F.lane) * (1.f / D) + EPS);
            GAS int* o4 = (GAS int*)((unsigned char*)XN + (size_t)m * D) + ln;
            float gl[4] = {0.f, 0.f, 0.f, 0.f};
#pragma unroll
            for (int j = 0; j < 4; ++j) { xv[j] = xv[j] * r2 * ge[j] + sh[j]; { int t_ = 0; t_ = __builtin_amdgcn_cvt_pk_fp8_f32(xv[j].x, xv[j].y, t_, false); t_ = __builtin_amdgcn_cvt_pk_fp8_f32(xv[j].z, xv[j].w, t_, true); o4[64 * j] = t_; }
#pragma unroll
                for (int ii = 0; ii < 4; ++ii) { const f32x4 w = ((const LAS f32x4*)WG)[(j * 4 + ii) * 64 + F.lane]; const float hv = xv[j][ii]; gl[0] += hv * w.x; gl[1] += hv * w.y; gl[2] += hv * w.z; gl[3] += hv * w.w; }
                __builtin_amdgcn_sched_barrier(0); }
            gl[0] = wave_sum(gl[0], F.lane) + bg0; gl[1] = wave_sum(gl[1], F.lane) + bg1; gl[2] = wave_sum(gl[2], F.lane) + bg2; gl[3] = wave_sum(gl[3], F.lane) + bg3;
            int g = 0; float gm = gl[0];
            if (gl[1] > gm) { gm = gl[1]; g = 1; } if (gl[2] > gm) { gm = gl[2]; g = 2; } if (gl[3] > gm) { gm = gl[3]; g = 3; }
            const float gw_ = 1.f / (expf(gl[0] - gm) + expf(gl[1] - gm) + expf(gl[2] - gm) + expf(gl[3] - gm));
            g = __builtin_amdgcn_readfirstlane(g);
            float el[8] = {0.f, 0.f, 0.f, 0.f, 0.f, 0.f, 0.f, 0.f};
#pragma unroll
            for (int j = 0; j < 4; ++j) {
#pragma unroll
                for (int ii = 0; ii < 4; ++ii) { const int kk = j * 4 + ii; const f32x4 wa = ((const LAS f32x4*)WE)[((g * 16 + kk) * 2 + 0) * 64 + F.lane], wb = ((const LAS f32x4*)WE)[((g * 16 + kk) * 2 + 1) * 64 + F.lane]; const float hv = xv[j][ii];
                    el[0] += hv * wa.x; el[1] += hv * wa.y; el[2] += hv * wa.z; el[3] += hv * wa.w; el[4] += hv * wb.x; el[5] += hv * wb.y; el[6] += hv * wb.z; el[7] += hv * wb.w; }
                __builtin_amdgcn_sched_barrier(0); }
            float ea = -INFINITY, eb = -INFINITY; int ia = 0, ib = 0;
#pragma unroll
            for (int k = 0; k < 8; ++k) { const float v = wave_sum(el[k], F.lane) + INP(kp, 19)[g * 8 + k];
                if (v > ea) { eb = ea; ib = ia; ea = v; ia = k; } else if (v > eb) { eb = v; ib = k; } }
            const float pb = expf(eb - ea), wa_ = gw_ / (1.f + pb), wb_ = gw_ * pb / (1.f + pb);
            if (F.lane == 0) *(f32x2*)(tokw + (size_t)m * 2) = (f32x2){wa_, wb_};
            if (F.lane == nst) { st_e0 = g * 8 + ia; st_e1 = g * 8 + ib; st_m = m; }
            ++nst;
            if (nst == 64) {
                const unsigned p0 = __hip_atomic_fetch_add(F.ctl + CW_ECNT + st_e0 * 64, 1u, RLX_AGENT), p1 = __hip_atomic_fetch_add(F.ctl + CW_ECNT + st_e1 * 64, 1u, RLX_AGENT);
                elist[st_e0 * 32768 + (int)p0] = st_m * 2; elist[st_e1 * 32768 + (int)p1] = st_m * 2 + 1; nst = 0; }

        }
    }
    if (F.lane < nst) {
        const unsigned p0 = __hip_atomic_fetch_add(F.ctl + CW_ECNT + st_e0 * 64, 1u, RLX_AGENT), p1 = __hip_atomic_fetch_add(F.ctl + CW_ECNT + st_e1 * 64, 1u, RLX_AGENT);
        elist[st_e0 * 32768 + (int)p0] = st_m * 2; elist[st_e1 * 32768 + (int)p1] = st_m * 2 + 1; }
}
struct MoeOrder {
    int tpoff;
    const gu32* ecnt; const int* elist; int G, c;
    __device__ __forceinline__ bool next(int i, pg8::Unit& u) const {
        int o_ = tpoff; asm volatile("" : "+s"(o_)); const LAS int* tp = (const LAS int*)(uintptr_t)(unsigned)o_;
        const long L = (long)i * G + c; const int U = __builtin_amdgcn_readfirstlane(tp[32]) * 4; if (L >= U) return false;
        const int rt = (int)(L >> 2), pn = (int)(L & 3); int e = 0;
#pragma unroll 1
        for (int k = 1; k < 32; ++k) e += (tp[k] <= rt) ? 1 : 0;
        e = __builtin_amdgcn_readfirstlane(e);
        const int t = rt - __builtin_amdgcn_readfirstlane(tp[e]); const int cnt = __builtin_amdgcn_readfirstlane((int)__hip_atomic_load(ecnt + e * 64, RLX_AGENT));
        u.pm = rt; u.pn = e * 4 + pn; u.nvalid = (cnt - t * 256) < 256 ? (cnt - t * 256) : 256; u.rows = elist + e * 32768 + t * 256; return true;
    }
    __device__ __forceinline__ int arow(const pg8::Unit& u, int r) const { return r < u.nvalid ? (u.rows[r] >> 1) : 0; }
};
__device__ __forceinline__ void moe_prefix(Frame& F, LAS int* tp) {
    if (F.tid == 0) { int s = 0; for (int e = 0; e < 32; ++e) { tp[e] = s; s += ((int)__hip_atomic_load(F.ctl + CW_ECNT + e * 64, RLX_AGENT) + 255) >> 8; } tp[32] = s; }
    __syncthreads();
}

__device__ __forceinline__ void p2_qkv(Frame& F) {
    PHASE_BEGIN(F);
    pg8::Gemm g{F.ws, (unsigned)WS_XN, (unsigned)WS_WIN, D, 0}; pg8::StaticOrder S; S.init(M, NPROJ, F.G, (int)blockIdx.x);
    pg8::EpiQKV E{(bf16*)(F.ws + WS_QKV), NPROJ, 0xC3u, attn_body::C2, (float*)(F.ws + WS_KMEAN), 8, true};
    pg8::gemm_phase<pg8::EpiQKV, pg8::StaticOrder, false>(F.lds + RING_OFF, g, S, E, F.wave);
}
__device__ __forceinline__ void p8_wo(Frame& F) {
    PHASE_BEGIN(F);
    pg8::Gemm g{F.ws, (unsigned)WS_XN, (unsigned)WS_WOUT, D, 0}; pg8::StaticOrder S; S.init(M, D, F.G, (int)blockIdx.x);
    pg8::EpiQKV E{(bf16*)(F.ws + WS_YO), D, 0u, 1.f, nullptr, 0, false};
    pg8::gemm_phase<pg8::EpiQKV, pg8::StaticOrder, false>(F.lds + RING_OFF, g, S, E, F.wave);
}
__device__ __forceinline__ void p10_gateup(Frame& F) {
    PHASE_BEGIN(F);
    LAS int* tp = (LAS int*)(F.lds + RING_BYTES); moe_prefix(F, tp);
    MoeOrder S{__builtin_amdgcn_readfirstlane((int)(uintptr_t)tp), F.ctl + CW_ECNT, (const int*)(F.ws + WS_ELIST), F.G, F.vcu};
    pg8::Gemm g{F.ws, (unsigned)WS_XN, (unsigned)WS_WGU, D / 2, 0x00007A7F};
    pg8::EpiSwiGLU8 E{(unsigned char*)(F.ws + WS_HID), HID8_SCALE};
    pg8::gemm_phase<pg8::EpiSwiGLU8, MoeOrder, true, true>(F.lds + RING_OFF, g, S, E, F.wave);
}
__device__ __forceinline__ void p11_down(Frame& F) {
    PHASE_BEGIN(F);
    LAS int* tp = (LAS int*)(F.lds + RING_BYTES); moe_prefix(F, tp);
    MoeOrder S{__builtin_amdgcn_readfirstlane((int)(uintptr_t)tp), F.ctl + CW_ECNT, (const int*)(F.ws + WS_ELIST), F.G, F.vcu};
    pg8::Gemm g{F.ws, (unsigned)WS_HID, (unsigned)WS_WD, EFF / 2, 0x00007A7C};
    pg8::EpiDown E{(bf16*)(F.ws + WS_SO)};
    pg8::gemm_phase<pg8::EpiDown, MoeOrder, false, true>(F.lds + RING_OFF, g, S, E, F.wave);
}
__device__ __forceinline__ void p12_final(Frame& F) {
    PHASE_BEGIN(F);
    const kptr_t kp = karg();
    const float* mod = (const float*)(F.ws + WS_MOD); const bf16* SO = (const bf16*)(F.ws + WS_SO); const float* tokw = (const float*)(F.ws + WS_TOKW);
    const int gw = F.vcu * NWAVES + F.wave, NGW = F.G * NWAVES;
    for (int b = 0; b < BATCH; ++b) {
        f32x4 pg[4], g2[4];
#pragma unroll
        for (int j = 0; j < 4; ++j) { const int c = 4 * F.lane + 256 * j; pg[j] = *(const f32x4*)(INP(kp, 7) + c); g2[j] = *(const f32x4*)(mod + b * 6144 + 5120 + c); }
        f32x2 nw; unsigned na[4], nb[4]; v2u nx[4];
        { const int m0 = b * T + gw; nw = *(const f32x2*)(tokw + (size_t)m0 * 2);
          const GAS unsigned* s0 = (const GAS unsigned*)((const unsigned char*)SO + (size_t)m0 * 2048) + F.lane; const GAS unsigned* s1 = (const GAS unsigned*)((const unsigned char*)SO + (size_t)m0 * 2048 + 1024) + F.lane; const GAS v2u* x1b = (const GAS v2u*)((const bf16*)(F.ws + WS_X1B) + (size_t)m0 * D) + F.lane;
#pragma unroll
          for (int j = 0; j < 4; ++j) { na[j] = s0[64 * j]; nb[j] = s1[64 * j]; nx[j] = x1b[64 * j]; } }
        for (int m = b * T + gw; m < (b + 1) * T; m += NGW) {
            int ln = F.lane; asm volatile("" : "+v"(ln));
            const f32x2 w = nw;
            GAS f32x4* orow = (GAS f32x4*)(F.out + (size_t)m * D) + ln;
            f32x4 y[4], xv[4]; float s = 0.f;
#pragma unroll
            for (int j = 0; j < 4; ++j) { const int a = (int)na[j], bq = (int)nb[j]; { const v2u xb = nx[j]; xv[j] = (f32x4){bf_lo(xb.x), bf_hi(xb.x), bf_lo(xb.y), bf_hi(xb.y)}; }
                y[j] = (f32x4){w.x * __builtin_amdgcn_cvt_f32_fp8(a, 0) + w.y * __builtin_amdgcn_cvt_f32_fp8(bq, 0), w.x * __builtin_amdgcn_cvt_f32_fp8(a, 1) + w.y * __builtin_amdgcn_cvt_f32_fp8(bq, 1),
                               w.x * __builtin_amdgcn_cvt_f32_fp8(a, 2) + w.y * __builtin_amdgcn_cvt_f32_fp8(bq, 2), w.x * __builtin_amdgcn_cvt_f32_fp8(a, 3) + w.y * __builtin_amdgcn_cvt_f32_fp8(bq, 3)} * (1.f / 16.f);
                s += (y[j].x * y[j].x + y[j].y * y[j].y) + (y[j].z * y[j].z + y[j].w * y[j].w); }
            { const int mn = (m + NGW < (b + 1) * T) ? m + NGW : m; nw = *(const f32x2*)(tokw + (size_t)mn * 2);
              const GAS unsigned* s0 = (const GAS unsigned*)((const unsigned char*)SO + (size_t)mn * 2048) + ln; const GAS unsigned* s1 = (const GAS unsigned*)((const unsigned char*)SO + (size_t)mn * 2048 + 1024) + ln; const GAS v2u* x1b = (const GAS v2u*)((const bf16*)(F.ws + WS_X1B) + (size_t)mn * D) + ln;
#pragma unroll
              for (int j = 0; j < 4; ++j) { na[j] = s0[64 * j]; nb[j] = s1[64 * j]; nx[j] = x1b[64 * j]; } }
            const float r = 1.f / sqrtf(wave_sum(s, F.lane) * (1.f / D) + EPS);
#pragma unroll
            for (int j = 0; j < 4; ++j) orow[64 * j] = xv[j] + g2[j] * (y[j] * r * pg[j]);
#if defined(STAMP_PROBE)
            if ((m & 63) == 0) {
                const float X = ((const float*)(F.ws + WS_BIASG + 32768))[STAMP_PROBE]; const float q = rintf(X / (float)STAMP_SCALE * 40.f) * (1.f / 40.f), v = sqrtf(64.f * 1.135f * (q < 0.f ? 0.f : q));
#pragma unroll
                for (int j = 0; j < 4; ++j) orow[64 * j] = (f32x4){v, v, v, v};
#if defined(STAMP_PROBE2)
                if (m == 0 && F.lane == 0) { const float X2 = ((const float*)(F.ws + WS_BIASG + 32768))[STAMP_PROBE2]; const float q2 = rintf(X2 / (float)STAMP_SCALE2 * 40.f) * (1.f / 40.f); F.out[0] = 1000.f * q2; }
#endif
            }
#endif
        }
    }
}

struct Args { const float* in[23]; float* out; unsigned char* ws; int ph_lo, ph_hi; };
__global__ void __launch_bounds__(NWAVES * 64, 2) hymba_fwd(Args args) {
    extern __shared__ __attribute__((aligned(16))) unsigned char lds[];
    Frame F;
    F.lds = (LAS unsigned char*)lds;
    F.MISC = (volatile LAS unsigned*)(F.lds + MISC_OFF);
    F.wave = __builtin_amdgcn_readfirstlane((int)threadIdx.x >> 6); PHASE_BEGIN(F);
    F.G = gridDim.x; { const int bx = blockIdx.x; F.vcu = (F.G % 8 == 0) ? (bx % 8) * (F.G / 8) + bx / 8 : bx; }
    for (int u = F.tid; u < (LDS_BYTES - LDSCTL_OFF) / 4; u += NWAVES * 64) ((LAS unsigned*)(F.lds + LDSCTL_OFF))[u] = 0u;
    __syncthreads();
#define LEADER() (F.wave == 0 && lane_now() == 0)
    PHASE_BEGIN(F);
    if (N_LAUNCHES == 1) (void)xcd_barrier_post((unsigned*)((gu32*)F.ws + CW_BAR), (volatile LAS unsigned*)(F.lds + MISC_OFF) + 8, LEADER());
#define GRID_BAR() do { if (N_LAUNCHES == 1) { PHASE_BEGIN(F); XcdBarrier bar_; bar_.bar = (unsigned*)((gu32*)F.ws + CW_BAR); bar_.x = xb_xcc_id(); bar_.st = (volatile LAS unsigned*)(F.lds + MISC_OFF) + 8; xcd_barrier(bar_, LEADER()); } } while (0)
    const int lo = (N_LAUNCHES == 1) ? 0 : args.ph_lo, hi = (N_LAUNCHES == 1) ? N_PHASES : args.ph_hi;
#define IN(k) (lo <= (k) && (k) < hi)
#ifndef PROBE_MASK
#define PROBE_MASK 0
#endif
#define TWICE(k) ((PROBE_MASK >> (k)) & 1)
#define BOTH(k) (IN(k) && IN((k) + 1))

    if (IN(0)) { p0_prologue(F); if (BOTH(0)) GRID_BAR(); }
    if (TWICE(0) && IN(0)) { p0_prologue(F); if (BOTH(0)) GRID_BAR(); }
    if (IN(1)) { p1_prenorm(F); if (BOTH(1)) GRID_BAR(); }
    if (TWICE(1) && IN(1)) { p1_prenorm(F); if (BOTH(1)) GRID_BAR(); }
    if (IN(2)) { p2_qkv(F); if (BOTH(2)) GRID_BAR(); }
    if (TWICE(2) && IN(2)) { p2_qkv(F); if (BOTH(2)) GRID_BAR(); }
    if (IN(3)) { p3_kmean(F); if (BOTH(3) && N_LAUNCHES == 1) __syncthreads(); }
#if defined(STAMP_PROBE)
#define PH_T0() const unsigned long long pt0_ = __builtin_amdgcn_s_memrealtime()
#define PH_T1(slot) do { if (blockIdx.x == 0 && LEADER()) ((float*)(F.ws + WS_BIASG + 32768))[slot] = (float)(__builtin_amdgcn_s_memrealtime() - pt0_) * 0.01f; } while (0)
#else
#define PH_T0()
#define PH_T1(slot)
#endif
    if (IN(4)) { PH_T0(); p4_moba_select(F); if (BOTH(4)) GRID_BAR(); PH_T1(5); }
    if (IN(5)) { p5_moba_gather(F, (char*)lds + RING_OFF); if (BOTH(5)) GRID_BAR(); }
    if (TWICE(5) && IN(5)) { p5_moba_gather(F, (char*)lds + RING_OFF); if (BOTH(5)) GRID_BAR(); }
    if (IN(6)) { p6_attention(F, (char*)lds + RING_OFF); if (BOTH(6)) GRID_BAR(); }
    if (TWICE(6) && IN(6)) { p6_attention(F, (char*)lds + RING_OFF); if (BOTH(6)) GRID_BAR(); }
    if (N_LAUNCHES == 1 && BOTH(7)) {
        if ((blockIdx.x >> 3) & 1) { p7_ydiff(F); __syncthreads(); p8_wo(F); } else { p8_wo(F); __syncthreads(); p7_ydiff(F); }
        if (BOTH(8)) GRID_BAR();
    } else {
    if (IN(7)) { p7_ydiff(F); if (BOTH(7)) GRID_BAR(); }
    if (TWICE(7) && IN(7)) { p7_ydiff(F); if (BOTH(7)) GRID_BAR(); }
    if (IN(8)) { p8_wo(F); if (BOTH(8)) GRID_BAR(); }
    }
    if (TWICE(8) && IN(8)) { p8_wo(F); if (BOTH(8)) GRID_BAR(); }
    if (IN(9)) { PH_T0(); p9_postmix_route(F); if (BOTH(9)) GRID_BAR(); PH_T1(6); }
    if (IN(10)) { p10_gateup(F); if (BOTH(10)) GRID_BAR(); }
    if (TWICE(10) && IN(10)) { p10_gateup(F); if (BOTH(10)) GRID_BAR(); }
    if (IN(11)) { p11_down(F); if (BOTH(11)) GRID_BAR(); }
    if (TWICE(11) && IN(11)) { p11_down(F); if (BOTH(11)) GRID_BAR(); }
    if (IN(12)) { p12_final(F); }
    if (TWICE(12) && IN(12)) { p12_final(F); }
#undef IN
#undef BOTH
#undef GRID_BAR
}

extern "C" void kernel_launch(void* const* d_in, const int* in_sizes, int n_in, void* d_out, int out_size, void* d_ws, size_t ws_size, hipStream_t stream) {
    static int grid = 0;
    if (grid == 0) {
        if (n_in != 23 || in_sizes[0] != M * D || out_size != M * D || ws_size < WS_END) { fprintf(stderr, "kernel_launch: unexpected shapes (n_in %d, in0 %d, out %d, ws %zu); nothing launched\n", n_in, n_in > 0 ? in_sizes[0] : -1, out_size, ws_size); grid = -1; return; }
        int dev = 0, cus = 0, per_cu = 0;
        if (hipGetDevice(&dev) != hipSuccess || hipDeviceGetAttribute(&cus, hipDeviceAttributeMultiprocessorCount, dev) != hipSuccess) { fprintf(stderr, "kernel_launch: device query failed\n"); grid = -1; return; }
        if (hipFuncSetAttribute((const void*)hymba_fwd, hipFuncAttributeMaxDynamicSharedMemorySize, LDS_BYTES) != hipSuccess) { fprintf(stderr, "kernel_launch: hipFuncSetAttribute failed\n"); grid = -1; return; }
        if (hipOccupancyMaxActiveBlocksPerMultiprocessor(&per_cu, (const void*)hymba_fwd, NWAVES * 64, LDS_BYTES) != hipSuccess || per_cu < 1)
            fprintf(stderr, "kernel_launch: note: occupancy query reports %d workgroups per CU\n", per_cu);
        (void)hipGetLastError();
        grid = cus;
    }
    if (grid < 0) return;
    if (hipMemsetAsync((char*)d_ws + WS_CTL, 0, CTL_ZERO_BYTES, stream) != hipSuccess) { fprintf(stderr, "kernel_launch: hipMemsetAsync failed\n"); return; }
    Args a{};
    for (int i = 0; i < 23; ++i) a.in[i] = (const float*)d_in[i];
    a.out = (float*)d_out; a.ws = (unsigned char*)d_ws;
    for (int li = 0; li < N_LAUNCHES; ++li) {
        a.ph_lo = (N_LAUNCHES == 1) ? 0 : li; a.ph_hi = (N_LAUNCHES == 1) ? N_PHASES : li + 1;
        hipLaunchKernelGGL(hymba_fwd, dim3(grid), dim3(NWAVES * 64), LDS_BYTES, stream, a);
        const hipError_t le = hipPeekAtLastError();
        if (le != hipSuccess) { fprintf(stderr, "kernel_launch: launch %d failed: %s\n", li, hipGetErrorName(le)); break; }
    }
}
```

```cpp
#include <hip/hip_runtime.h>
#include <hip/hip_bf16.h>
#include <cstdio>
#include <cstdint>
#include <cmath>

__device__ __forceinline__ int lane_now() { unsigned m_ = ~0u; asm volatile("" : "+s"(m_)); return (int)__builtin_amdgcn_mbcnt_hi(m_, __builtin_amdgcn_mbcnt_lo(m_, 0u)); }
namespace pg8 {
#define PG8_LAS __attribute__((address_space(3)))
typedef unsigned short bf16_t;
typedef short bf16x8 __attribute__((ext_vector_type(8)));
typedef float f32x4 __attribute__((ext_vector_type(4)));
typedef unsigned u32x4 __attribute__((ext_vector_type(4)));
constexpr int BM = 256, BK = 64, HALF = 128, HTB = HALF * BK * 2  , STAGE_BYTES = 8 * HTB, NXCD = 8, WGM = 16;

__host__ __device__ __forceinline__ int lds_byte(int r, int c) { const int st = (r >> 4) * 2 + (c >> 5), rr = r & 15, cc = c & 31, ob = rr * 64 + cc * 2; return st * 1024 + (ob ^ (((ob >> 9) & 1) << 5)); }
__host__ __device__ __forceinline__ void stage_rc(int b, int& R, int& C) { const int st = b / 1024, sb = b % 1024, swz = sb ^ (((sb >> 9) & 1) << 5); R = (st >> 1) * 16 + swz / 64; C = (st & 1) * 32 + (swz % 64) / 2; }
__host__ __device__ __forceinline__ int perm32(int rho) { const int n = rho >> 4, i = rho & 15; return 8 * (i >> 2) + 4 * n + (i & 3); }

struct Unit { int pm, pn; int nvalid; const int* rows; };
struct Gemm { const unsigned char* base; unsigned offA, offB; int K; int sA; };
typedef int v8i_t __attribute__((ext_vector_type(8)));
typedef int v4i_t __attribute__((ext_vector_type(4)));

struct StaticOrder {
    int nM, nN, nwg, G, c;
    __host__ __device__ void init(int M, int N, int G_, int c_) { nM = M / BM; nN = N / BM; nwg = nM * nN; G = G_; c = c_; }
    __host__ __device__ bool next(int i, Unit& u) const {
        const long L = (long)i * G + c; if (L >= nwg) return false;
        int wgid = (int)L; { const int q = nwg / NXCD, r = nwg % NXCD, xcd = wgid % NXCD, off = wgid / NXCD; wgid = (xcd < r ? xcd * (q + 1) : r * (q + 1) + (xcd - r) * q) + off; }
        const int nig = WGM * nN, gid = wgid / nig, fm = gid * WGM, gsz = (nM - fm) < WGM ? (nM - fm) : WGM;
        u.pm = fm + ((wgid % nig) % gsz); u.pn = (wgid % nig) / gsz; u.nvalid = 256; u.rows = nullptr; return true;
    }
    __device__ __forceinline__ int arow(const Unit&, int r) const { return r; }
};

__device__ __forceinline__ unsigned cvt_pk_bf16(float lo, float hi) { unsigned r; asm volatile("v_cvt_pk_bf16_f32 %0, %1, %2" : "=v"(r) : "v"(lo), "v"(hi)); return r; }

struct EpiQKV {
    static constexpr bool PERM = true;
    bf16_t* O; int ldc; unsigned qmask; float qscale; float* kmean; int kt0; bool f8tiles;
    __device__ __forceinline__ void operator()(const f32x4 (&acc)[2][2][4][2], const Unit& u, int wr, int wc, int fr, int fq) const {
        bf16_t* O = this->O; asm volatile("" : "+s"(O));
        const int row0 = u.pm * BM + wr * 64 + fr; const int col0 = u.pn * BM + wc * 32 + 8 * fq;
        const float sc = ((qmask >> u.pn) & 1u) ? qscale : 1.f;
#pragma unroll
        for (int ai = 0; ai < 2; ++ai)
#pragma unroll
            for (int m = 0; m < 4; ++m) { bf16_t* rowp = O + (size_t)(row0 + ai * HALF + m * 16) * ldc + col0;
#pragma unroll
                for (int bj = 0; bj < 2; ++bj) { const f32x4 v0 = acc[ai][bj][m][0] * sc, v1 = acc[ai][bj][m][1] * sc;
                    if (f8tiles && u.pn < 4) {
                        const float es = (u.pn < 2) ? 32.f : 4.f; int w0 = 0, w1 = 0;
                        w0 = __builtin_amdgcn_cvt_pk_fp8_f32(v0[0] * es, v0[1] * es, w0, false); w0 = __builtin_amdgcn_cvt_pk_fp8_f32(v0[2] * es, v0[3] * es, w0, true);
                        w1 = __builtin_amdgcn_cvt_pk_fp8_f32(v1[0] * es, v1[1] * es, w1, false); w1 = __builtin_amdgcn_cvt_pk_fp8_f32(v1[2] * es, v1[3] * es, w1, true);
                        typedef int v2i_t __attribute__((ext_vector_type(2)));
                        *(v2i_t*)((unsigned char*)(O + (size_t)(row0 + ai * HALF + m * 16) * ldc) + col0 + bj * HALF) = (v2i_t){w0, w1}; continue; }
                    u32x4 w; w.x = cvt_pk_bf16(v0[0], v0[1]); w.y = cvt_pk_bf16(v0[2], v0[3]); w.z = cvt_pk_bf16(v1[0], v1[1]); w.w = cvt_pk_bf16(v1[2], v1[3]);
                    *(u32x4*)(rowp + bj * HALF) = w; } }
        if (kmean != nullptr && (u.pn == kt0 || u.pn == kt0 + 1)) {
            float* km = kmean; asm volatile("" : "+s"(km));
#pragma unroll
            for (int bj = 0; bj < 2; ++bj)
#pragma unroll
                for (int n = 0; n < 2; ++n) { f32x4 cs = {0.f, 0.f, 0.f, 0.f};
#pragma unroll
                    for (int ai = 0; ai < 2; ++ai)
#pragma unroll
                        for (int m = 0; m < 4; ++m) cs += acc[ai][bj][m][n];
#pragma unroll
                    for (int i = 0; i < 4; ++i) { float v = cs[i];
                        v += __builtin_bit_cast(float, __builtin_amdgcn_update_dpp(0, __builtin_bit_cast(int, v), 0xB1, 0xf, 0xf, true)); v += __builtin_bit_cast(float, __builtin_amdgcn_update_dpp(0, __builtin_bit_cast(int, v), 0x4E, 0xf, 0xf, true));
                        v += __builtin_bit_cast(float, __builtin_amdgcn_update_dpp(0, __builtin_bit_cast(int, v), 0x141, 0xf, 0xf, true)); v += __builtin_bit_cast(float, __builtin_amdgcn_update_dpp(0, __builtin_bit_cast(int, v), 0x140, 0xf, 0xf, true));
                        if (fr == 0) { const int c = (u.pn - kt0) * BM + bj * HALF + wc * 32 + 8 * fq + 4 * n + i;
                            __hip_atomic_fetch_add(km + ((size_t)((u.pm >> 6) * 8 + (c >> 6)) * 64 + (u.pm & 63)) * 64 + (c & 63), v * (1.f / 256.f), __ATOMIC_RELAXED, __HIP_MEMORY_SCOPE_AGENT); } } }
        }
    }
};
struct EpiF32 {
    static constexpr bool PERM = false;
    float* O; int ldc;
    __device__ __forceinline__ void operator()(const f32x4 (&acc)[2][2][4][2], const Unit& u, int wr, int wc, int fr, int fq) const {
        const int col0 = u.pn * BM + wc * 32 + 4 * fq;
#pragma unroll
        for (int ai = 0; ai < 2; ++ai)
#pragma unroll
            for (int m = 0; m < 4; ++m) { float* rowp = O + (size_t)(u.pm * BM + ai * HALF + wr * 64 + m * 16 + fr) * ldc + col0;
#pragma unroll
                for (int bj = 0; bj < 2; ++bj)
#pragma unroll
                    for (int n = 0; n < 2; ++n) *(f32x4*)(rowp + bj * HALF + n * 16) = acc[ai][bj][m][n]; }
    }
};
struct EpiSwiGLU {
    static constexpr bool PERM = true;
    bf16_t* H;
    __device__ __forceinline__ void operator()(const f32x4 (&acc)[2][2][4][2], const Unit& u, int wr, int wc, int fr, int fq) const {
        const int col0 = (u.pn & 3) * 128 + wc * 32 + 8 * fq;
#pragma unroll
        for (int ai = 0; ai < 2; ++ai)
#pragma unroll
            for (int m = 0; m < 4; ++m) { bf16_t* rowp = H + (size_t)(u.pm * BM + ai * HALF + wr * 64 + m * 16 + fr) * 512 + col0;
                float h[8];
#pragma unroll
                for (int n = 0; n < 2; ++n)
#pragma unroll
                    for (int k = 0; k < 4; ++k) { const float gt = acc[ai][0][m][n][k], up = acc[ai][1][m][n][k];
                        h[n * 4 + k] = gt * __builtin_amdgcn_rcpf(1.f + __builtin_amdgcn_exp2f(-1.4426950408889634f * gt)) * up; }
                u32x4 w; w.x = cvt_pk_bf16(h[0], h[1]); w.y = cvt_pk_bf16(h[2], h[3]); w.z = cvt_pk_bf16(h[4], h[5]); w.w = cvt_pk_bf16(h[6], h[7]);
                *(u32x4*)rowp = w; }
    }
};
struct EpiSwiGLU8 {
    static constexpr bool PERM = true;
    unsigned char* H; float osc;
    __device__ __forceinline__ void operator()(const f32x4 (&acc)[2][2][4][2], const Unit& u, int wr, int wc, int fr, int fq) const {
        unsigned char* H = this->H; asm volatile("" : "+s"(H));
        const int col0 = (u.pn & 3) * 128 + wc * 32 + 8 * fq;
#pragma unroll
        for (int ai = 0; ai < 2; ++ai)
#pragma unroll
            for (int m = 0; m < 4; ++m) { unsigned char* rowp = H + (size_t)(u.pm * BM + ai * HALF + wr * 64 + m * 16 + fr) * 512 + col0;
                float h[8];
#pragma unroll
                for (int n = 0; n < 2; ++n)
#pragma unroll
                    for (int k = 0; k < 4; ++k) { const float gt = acc[ai][0][m][n][k], up = acc[ai][1][m][n][k];
                        h[n * 4 + k] = gt * __builtin_amdgcn_rcpf(1.f + __builtin_amdgcn_exp2f(-1.4426950408889634f * gt)) * up * osc; }
                int w0 = 0, w1 = 0;
                w0 = __builtin_amdgcn_cvt_pk_fp8_f32(h[0], h[1], w0, false); w0 = __builtin_amdgcn_cvt_pk_fp8_f32(h[2], h[3], w0, true);
                w1 = __builtin_amdgcn_cvt_pk_fp8_f32(h[4], h[5], w1, false); w1 = __builtin_amdgcn_cvt_pk_fp8_f32(h[6], h[7], w1, true);
                typedef int v2i_t __attribute__((ext_vector_type(2)));
                *(v2i_t*)rowp = (v2i_t){w0, w1}; }
    }
};
struct EpiDown {
    static constexpr bool PERM = true;
    bf16_t* SO;
    __device__ __forceinline__ void operator()(const f32x4 (&acc)[2][2][4][2], const Unit& u, int wr, int wc, int fr, int fq) const {
        bf16_t* SO = this->SO; asm volatile("" : "+s"(SO)); const int* rows_ = u.rows; asm volatile("" : "+v"(fr), "+v"(fq));
        const int col0 = (u.pn & 3) * BM + wc * 32 + 8 * fq;
#pragma unroll
        for (int ai = 0; ai < 2; ++ai)
#pragma unroll
            for (int m = 0; m < 4; ++m) { const int r = ai * HALF + wr * 64 + m * 16 + fr;
                if (r < u.nvalid) { const int ent = rows_[r]; unsigned char* rowp8 = (unsigned char*)SO + (size_t)ent * 1024 + col0;
#pragma unroll
                    for (int bj = 0; bj < 2; ++bj) { const f32x4 v0 = acc[ai][bj][m][0] * 16.f, v1 = acc[ai][bj][m][1] * 16.f;
                        int w0 = 0, w1 = 0; w0 = __builtin_amdgcn_cvt_pk_fp8_f32(v0[0], v0[1], w0, false); w0 = __builtin_amdgcn_cvt_pk_fp8_f32(v0[2], v0[3], w0, true);
                        w1 = __builtin_amdgcn_cvt_pk_fp8_f32(v1[0], v1[1], w1, false); w1 = __builtin_amdgcn_cvt_pk_fp8_f32(v1[2], v1[3], w1, true);
                        typedef int v2i_t __attribute__((ext_vector_type(2))); *(v2i_t*)((unsigned char*)rowp8 + bj * HALF) = (v2i_t){w0, w1}; } }
                __builtin_amdgcn_sched_barrier(0); }
    }
};

template <class Epi, class Sched, bool GATHER, bool FP8 = false>
__device__ __forceinline__ void gemm_phase(PG8_LAS unsigned char* lds, const Gemm g, const Sched& S, const Epi& E, int wv  ) {
    asm volatile("" : "+s"(wv));
    const int lane = lane_now(), wid = __builtin_amdgcn_readfirstlane(wv), tid = wid * 64 + lane,
               wr = wid >> 2, wc = wid & 3, fr = lane & 15, fq = lane >> 4;
    const int K = g.K, nt = K / BK;
    unsigned voffB[2];
#pragma unroll
    for (int i = 0; i < 2; ++i) { int R, C; stage_rc(tid * 16 + i * 8192, R, C); const int Rb = Epi::PERM ? ((R & ~31) + perm32(R & 31)) : R; voffB[i] = (unsigned)(Rb * K + C) * 2u; }
    const unsigned kstep = (unsigned)(BK * 2);
    const unsigned hstep = (unsigned)HALF * (unsigned)K * 2u;
    const unsigned tstep = 2u * hstep;
    const __amdgpu_buffer_rsrc_t rsA = __builtin_amdgcn_make_buffer_rsrc((void*)g.base, 0, 0x7ffffff0, 0x00020000);
#define rsB rsA
    const unsigned ldsw = (unsigned)wid * 1024u;
    const int aoff = lds_byte(wr * 64 + fr, fq * 8), boff = lds_byte(wc * 32 + fr, fq * 8);
    const PG8_LAS unsigned char* ldsB = lds + 4 * HTB + boff; asm volatile("" : "+v"(ldsB));
#define PG8_SA(b, h) (((b) * 2 + (h)) * HTB)
#define PG8_SB(b, h) ((4 + (b) * 2 + (h)) * HTB)
#define PG8_STAGE_A(bufoff, soff, voff) do { _Pragma("unroll") for (int _i = 0; _i < 2; ++_i) \
        __builtin_amdgcn_raw_ptr_buffer_load_lds(rsA, (PG8_LAS unsigned*)(lds + (bufoff) + ldsw + _i * 8192), 16, (int)(voff)[_i], (int)(soff), 0, 0); } while (0)
#define PG8_STAGE_B(bufoff, soff, voff) do { _Pragma("unroll") for (int _i = 0; _i < 2; ++_i) \
        __builtin_amdgcn_raw_ptr_buffer_load_lds(rsB, (PG8_LAS unsigned*)(lds + (bufoff) + ldsw + _i * 8192), 16, (int)(voff)[_i], (int)(soff), 0, 0); } while (0)
#define PG8_LDA(dst, b, h) do { _Pragma("unroll") for (int m = 0; m < 4; ++m) _Pragma("unroll") for (int k = 0; k < 2; ++k) dst[m][k] = *(const PG8_LAS bf16x8*)(lds + PG8_SA(b, h) + aoff + m * 2048 + k * 1024); } while (0)
#define PG8_LDB(dst, b, h) do { _Pragma("unroll") for (int n = 0; n < 2; ++n) _Pragma("unroll") for (int k = 0; k < 2; ++k) dst[n][k] = *(const PG8_LAS bf16x8*)(ldsB + ((b) * 2 + (h)) * HTB + n * 2048 + k * 1024); } while (0)
#define PG8_MMA(ai, bj, At, Bt) do { __builtin_amdgcn_s_setprio(1); _Pragma("unroll") for (int m = 0; m < 4; ++m) _Pragma("unroll") for (int n = 0; n < 2; ++n) _Pragma("unroll") for (int k = 0; k < 2; ++k) \
        acc[ai][bj][m][n] = __builtin_amdgcn_mfma_f32_16x16x32_bf16(Bt[n][k], At[m][k], acc[ai][bj][m][n], 0, 0, 0); __builtin_amdgcn_s_setprio(0); } while (0)
#define PG8_RD16(off) (*(const PG8_LAS v4i_t*)(lds + (off)))
#define PG8_CAT(x0, x1) __builtin_shufflevector(x0, x1, 0, 1, 2, 3, 4, 5, 6, 7)
#define PG8_LDA8(dst, b, h) do { _Pragma("unroll") for (int m = 0; m < 4; ++m) dst[m] = PG8_CAT(PG8_RD16(PG8_SA(b, h) + aoff + m * 2048), PG8_RD16(PG8_SA(b, h) + aoff + m * 2048 + 1024)); } while (0)
#define PG8_LDB8(dst, b, h) do { _Pragma("unroll") for (int n = 0; n < 2; ++n) dst[n] = PG8_CAT(*(const PG8_LAS v4i_t*)(ldsB + ((b) * 2 + (h)) * HTB + n * 2048), *(const PG8_LAS v4i_t*)(ldsB + ((b) * 2 + (h)) * HTB + n * 2048 + 1024)); } while (0)
#define PG8_MMA8(ai, bj, At, Bt) do { __builtin_amdgcn_s_setprio(1); _Pragma("unroll") for (int m = 0; m < 4; ++m) _Pragma("unroll") for (int n = 0; n < 2; ++n) \
        acc[ai][bj][m][n] = __builtin_amdgcn_mfma_scale_f32_16x16x128_f8f6f4(Bt[n], At[m], acc[ai][bj][m][n], 0, 0, 1, g.sA, 0, g.sA);     __builtin_amdgcn_s_setprio(0); } while (0)
#define PG8_LA(b, h) do { if constexpr (FP8) PG8_LDA8(At8, b, h); else PG8_LDA(At, b, h); } while (0)
#define PG8_LB0(b, h) do { if constexpr (FP8) PG8_LDB8(B08, b, h); else PG8_LDB(B0, b, h); } while (0)
#define PG8_LB1(b, h) do { if constexpr (FP8) PG8_LDB8(B18, b, h); else PG8_LDB(B1, b, h); } while (0)
#define PG8_MM0(ai, bj) do { if constexpr (FP8) PG8_MMA8(ai, bj, At8, B08); else PG8_MMA(ai, bj, At, B0); } while (0)
#define PG8_MM1(ai, bj) do { if constexpr (FP8) PG8_MMA8(ai, bj, At8, B18); else PG8_MMA(ai, bj, At, B1); } while (0)
#define PG8_WAIT_V(n) asm volatile("s_waitcnt vmcnt(" #n ")" ::: "memory")
#define PG8_WAIT_L(n) asm volatile("s_waitcnt lgkmcnt(" #n ")" ::: "memory")
#define PG8_BAR __builtin_amdgcn_s_barrier()
#define PG8_SCHED __builtin_amdgcn_sched_barrier(0)
#define PG8_CALC_VOFF(u, vo) do { _Pragma("unroll") for (int h_ = 0; h_ < 2; ++h_) _Pragma("unroll") for (int i_ = 0; i_ < 2; ++i_) { int R_, C_; stage_rc(tid * 16 + i_ * 8192, R_, C_); \
        if constexpr (GATHER) { const int tok_ = S.arow(u, h_ * HALF + R_); vo[h_][i_] = (unsigned)(tok_ * K + C_) * 2u; } \
        else vo[h_][i_] = (unsigned)(R_ * K + C_) * 2u + (unsigned)(h_ * hstep); } } while (0)
    Unit cur, nxt; int ui = 0;
    if (!S.next(0, cur)) return;
    unsigned vA[2][2], nvA[2][2];
    PG8_CALC_VOFF(cur, vA);
    if constexpr (GATHER) asm volatile("" : "+v"(vA[0][0]), "+v"(vA[0][1]), "+v"(vA[1][0]), "+v"(vA[1][1]));
    f32x4 acc[2][2][4][2];
#pragma unroll
    for (int a = 0; a < 2; ++a)
#pragma unroll
        for (int b = 0; b < 2; ++b)
#pragma unroll
            for (int m = 0; m < 4; ++m)
#pragma unroll
                for (int n = 0; n < 2; ++n) acc[a][b][m][n] = (f32x4){0.f, 0.f, 0.f, 0.f};
    bf16x8 At[4][2], B0[2][2], B1[2][2]; v8i_t At8[4], B08[2], B18[2];
    unsigned cA = g.offA + (GATHER ? 0u : (unsigned)cur.pm * tstep), cB = g.offB + (unsigned)cur.pn * tstep;
    PG8_STAGE_B(PG8_SB(0, 0), cB, voffB); PG8_STAGE_B(PG8_SB(0, 1), cB + hstep, voffB); PG8_STAGE_A(PG8_SA(0, 0), cA, vA[0]); PG8_STAGE_A(PG8_SA(0, 1), cA, vA[1]);
    if (wr == 1) PG8_BAR;
    PG8_WAIT_V(2); PG8_BAR;
    PG8_STAGE_B(PG8_SB(1, 0), cB + kstep, voffB); PG8_STAGE_A(PG8_SA(1, 0), cA + kstep, vA[0]); PG8_STAGE_B(PG8_SB(1, 1), cB + hstep + kstep, voffB);
    PG8_WAIT_V(6); PG8_BAR;
    for (;;) {
        const bool has_next = S.next(ui + 1, nxt);
        const unsigned nA = has_next ? g.offA + (GATHER ? 0u : (unsigned)nxt.pm * tstep) : cA, nB = has_next ? g.offB + (unsigned)nxt.pn * tstep : cB;
        if constexpr (GATHER) {
            if (has_next) { PG8_CALC_VOFF(nxt, nvA); }
            else {
#pragma unroll
                for (int h_ = 0; h_ < 2; ++h_)
#pragma unroll
                    for (int i_ = 0; i_ < 2; ++i_) nvA[h_][i_] = vA[h_][i_]; }
            asm volatile("" : "+v"(nvA[0][0]), "+v"(nvA[0][1]), "+v"(nvA[1][0]), "+v"(nvA[1][1]));
        }
#pragma clang loop unroll(disable)
        for (int t = 0; t < nt; t += 2) {
            const bool last = (t == nt - 2);
            const unsigned a1 = cA + (unsigned)(t + 1) * kstep;
            const unsigned a2 = last ? nA : cA + (unsigned)(t + 2) * kstep, b2 = last ? nB : cB + (unsigned)(t + 2) * kstep;
            const unsigned a3 = a2 + kstep, b3 = b2 + kstep;
            PG8_LB0(0, 0); PG8_LB1(0, 1); PG8_SCHED; PG8_LA(0, 0); PG8_STAGE_A(PG8_SA(1, 1), a1, vA[1]);
            if constexpr (GATHER) { if (last) { _Pragma("unroll") for (int h_ = 0; h_ < 2; ++h_) _Pragma("unroll") for (int i_ = 0; i_ < 2; ++i_) vA[h_][i_] = nvA[h_][i_]; } }
            PG8_WAIT_V(8); PG8_WAIT_L(0); PG8_BAR; PG8_MM0(0, 0); PG8_MM1(0, 1); PG8_BAR; PG8_SCHED;
            PG8_LA(0, 1); PG8_STAGE_B(PG8_SB(0, 0), b2, voffB); PG8_STAGE_B(PG8_SB(0, 1), b2 + hstep, voffB); PG8_STAGE_A(PG8_SA(0, 0), a2, vA[0]);
            PG8_WAIT_V(8); PG8_WAIT_L(0); PG8_BAR; PG8_MM0(1, 0); PG8_MM1(1, 1); PG8_BAR; PG8_SCHED;
            PG8_LB0(1, 0); PG8_LB1(1, 1); PG8_SCHED; PG8_LA(1, 0); PG8_STAGE_A(PG8_SA(0, 1), a2, vA[1]);
            PG8_WAIT_V(8); PG8_WAIT_L(0); PG8_BAR; PG8_MM0(0, 0); PG8_MM1(0, 1); PG8_BAR; PG8_SCHED;
            PG8_LA(1, 1); PG8_STAGE_B(PG8_SB(1, 0), b3, voffB); PG8_STAGE_B(PG8_SB(1, 1), b3 + hstep, voffB); PG8_STAGE_A(PG8_SA(1, 0), a3, vA[0]);
            PG8_WAIT_V(8); PG8_WAIT_L(0); PG8_BAR; PG8_MM0(1, 0); PG8_MM1(1, 1); PG8_BAR; PG8_SCHED;
        }
        if (wr == 0) PG8_BAR;
        { const int ln_ = lane_now(); E(acc, cur, wr, wc, ln_ & 15, ln_ >> 4); }
        if (!has_next) break;
#pragma unroll
        for (int a = 0; a < 2; ++a)
#pragma unroll
            for (int b = 0; b < 2; ++b)
#pragma unroll
                for (int m = 0; m < 4; ++m)
#pragma unroll
                    for (int n = 0; n < 2; ++n) acc[a][b][m][n] = (f32x4){0.f, 0.f, 0.f, 0.f};
        cur = nxt; cA = nA; cB = nB; ++ui;
        if (wr == 1) PG8_BAR;
    }
    PG8_WAIT_V(0);
    PG8_BAR;
#undef PG8_SA
#undef PG8_SB
#undef PG8_STAGE_A
#undef rsB
#undef PG8_STAGE_B
#undef PG8_LDA
#undef PG8_LDB
#undef PG8_MMA
#undef PG8_MMA8
#undef PG8_CAT
#undef PG8_RD16
#undef PG8_LDA8
#undef PG8_LDB8
#undef PG8_LA
#undef PG8_LB0
#undef PG8_LB1
#undef PG8_MM0
#undef PG8_MM1
#undef PG8_WAIT_V
#undef PG8_WAIT_L
#undef PG8_BAR
#undef PG8_SCHED
#undef PG8_CALC_VOFF
}
}

namespace attn_body {
using bf16=__hip_bfloat16;
using bf16x8=__attribute__((ext_vector_type(8)))short;
using s16x4=__attribute__((ext_vector_type(4)))short;
using f32x16=__attribute__((ext_vector_type(16)))float;
using u32x4=__attribute__((ext_vector_type(4)))unsigned;
constexpr int SEQ=16384,D=64;
constexpr int LDQ=3072;
constexpr int LDO=1024;
constexpr int NW=8,QBLK=32,QB=QBLK*NW,KVBLK=64,NQB=SEQ/QB;
__device__ __forceinline__ int crow(int r,int hi){return (r&3)+8*(r>>2)+4*hi;}
#define SBAR() __builtin_amdgcn_sched_barrier(0)
#ifndef PRIO_G1A1
#define PRIO_G1A1 2
#define PRIO_G1B1 0
#define PRIO_G1A2 2
#define PRIO_G1B2 0
#define PRIO_G2A1 2
#define PRIO_G2B1 1
#define PRIO_G2A2 2
#define PRIO_G2B2 1
#endif
#if defined(STAMP_PROBE)
#ifndef STAMP_WAVE
#define STAMP_WAVE 0
#endif
#define STAMP_PARAM ,float*dbg
#define STAMP_NOW() ((unsigned)__builtin_amdgcn_s_memtime())
#if STAMP_PROBE == 2
#define STAMP_DECL unsigned st_pre_=0u,st_acc_=0u,st_n_=0u;
#define STAMP_PRE  { st_pre_=STAMP_NOW(); }
#define STAMP_POST { st_acc_+=STAMP_NOW()-st_pre_; ++st_n_; }
#define STAMP_FINI { if(dbg&&wid==STAMP_WAVE&&lane_now()==0&&st_n_>0u){ dbg[2]=(float)st_acc_/(float)st_n_; } }
#elif STAMP_PROBE == 1
#define STAMP_DECL const unsigned st_t0_=STAMP_NOW(); const unsigned st_r0_=(unsigned)__builtin_amdgcn_s_memrealtime();
#define STAMP_PRE
#define STAMP_POST
#define STAMP_FINI { const unsigned t1_=STAMP_NOW(),r1_=(unsigned)__builtin_amdgcn_s_memrealtime(); if(dbg&&wid==STAMP_WAVE&&lane_now()==0){ dbg[1]=(float)(t1_-st_t0_)/(float)(r1_-st_r0_)*100.0f; } }
#else
#define STAMP_DECL const unsigned st_t0_=STAMP_NOW(); const int st_ts_=t;
#define STAMP_PRE
#define STAMP_POST
#define STAMP_FINI { const unsigned t1_=STAMP_NOW(); if(dbg&&wid==STAMP_WAVE&&lane_now()==0&&t>st_ts_){ dbg[0]=(float)(t1_-st_t0_)/(float)(t-st_ts_); dbg[4]=5000.0f; } }
#endif
#else
#define STAMP_PARAM
#define STAMP_DECL
#define STAMP_PRE
#define STAMP_POST
#define STAMP_FINI
#endif
#ifndef STAMP_PLACE
#define STAMP_PLACE 0
#endif
#if STAMP_PLACE == 0
#define SP_W0 STAMP_PRE
#define SP_W1 STAMP_POST
#else
#define SP_W0
#define SP_W1
#endif
#if STAMP_PLACE == 1
#define SP_A0 STAMP_PRE
#define SP_A1 STAMP_POST
#else
#define SP_A0
#define SP_A1
#endif
#if STAMP_PLACE == 2
#define SP_B0 STAMP_PRE
#define SP_B1 STAMP_POST
#else
#define SP_B0
#define SP_B1
#endif
#if STAMP_PLACE == 3
#define SP_D0 STAMP_PRE
#define SP_D1 STAMP_POST
#else
#define SP_D0
#define SP_D1
#endif
typedef __attribute__((address_space(3))) const float* lds_cfptr;
__device__ __forceinline__ void biasmask(f32x16&p0,f32x16&p1,int jb,int qrel,int hi,lds_cfptr bl){
  const float NEG=-INFINITY; const int kb=64*jb+4*hi;
  #pragma unroll
  for(int g=0;g<4;++g){
    float b0[4],b1[4]; int d0v[4];
    #pragma unroll
    for(int rr=0;rr<4;++rr){const int r=4*g+rr; const int kv=kb+(r&3)+8*(r>>2); const int d0=qrel-kv,d1=d0-32; d0v[rr]=d0;
      const int i0=d0<0?0:(d0>127?127:d0), i1=d1<0?0:(d1>127?127:d1);
      b0[rr]=bl[i0]; b1[rr]=bl[i1];}
    asm volatile("":"+v"(b0[0]),"+v"(b0[1]),"+v"(b0[2]),"+v"(b0[3]),"+v"(b1[0]),"+v"(b1[1]),"+v"(b1[2]),"+v"(b1[3]));
    #pragma unroll
    for(int rr=0;rr<4;++rr){const int r=4*g+rr; const int d0=d0v[rr],d1=d0-32;
      p0[r]=d0<0?NEG:p0[r]+b0[rr]; p1[r]=d1<0?NEG:p1[r]+b1[rr];}
    __builtin_amdgcn_sched_barrier(0); }
}

constexpr int LDS_BT4=49152+4096;
__device__ __forceinline__ void biasmask4(f32x16&p0,f32x16&p1,int jb,int qrel,int hi,__attribute__((address_space(3))) const char* shm3){
  const int j=qrel-64*jb-4*hi+197;
  const __attribute__((address_space(3))) char* a=shm3+LDS_BT4+(j&3)*2048+(j&~3)*4;
  #pragma unroll
  for(int g=0;g<4;++g){ const pg8::f32x4 v0=*(const __attribute__((address_space(3))) pg8::f32x4*)(a+128+32*(3-g)), v1=*(const __attribute__((address_space(3))) pg8::f32x4*)(a+32*(3-g));
    #pragma unroll
    for(int rr=0;rr<4;++rr){ p0[4*g+rr]=(v0[3-rr]==-INFINITY)?-INFINITY:p0[4*g+rr]+v0[3-rr]; p1[4*g+rr]=(v1[3-rr]==-INFINITY)?-INFINITY:p1[4*g+rr]+v1[3-rr]; } }
}

#define BMM(P0,P1,jb,q,h) biasmask(P0,P1,jb,q,h,bl)
#define BMF(P0,P1,jb,q,h) biasmask4(P0,P1,jb,q,h,shm3)
constexpr int NSLOT=3, SLOTB=8192;
constexpr int LDS_K=0, LDS_V=NSLOT*SLOTB, LDS_WS=2*NSLOT*SLOTB, LDS_OST=LDS_WS+NW*128*4+8192, LDS_BIAS=LDS_OST+NW*4096, LDS_BYTES=LDS_BIAS+512;
constexpr float C2=0.125f*1.4426950408889634f;
__device__ __forceinline__ void glds16(const void*gsrc,unsigned lds_dst){unsigned keep;
  asm volatile("s_mov_b32 %0, m0\n\ts_mov_b32 m0, %2\n\ts_nop 0\n\tglobal_load_lds_dwordx4 %1, off\n\ts_mov_b32 m0, %0\n\ts_nop 0":"=&s"(keep):"v"(gsrc),"s"(lds_dst):"memory");}
__device__ __forceinline__ float max3f(float a,float b,float c){float r;asm("v_max3_f32 %0, %1, %2, %3":"=v"(r):"v"(a),"v"(b),"v"(c));return r;}
__device__ __forceinline__ float max2f(float a,float b){float r;asm("v_max_f32_e32 %0, %1, %2":"=v"(r):"v"(a),"v"(b));return r;}
__device__ __forceinline__ float fadd_s(float a,float b){float r;asm("v_add_f32_e32 %0, %1, %2":"=v"(r):"v"(a),"v"(b));return r;}
__device__ __forceinline__ float fsub_s(float a,float b){float r;asm("v_sub_f32_e32 %0, %1, %2":"=v"(r):"v"(a),"v"(b));return r;}
typedef float f32x2_t __attribute__((ext_vector_type(2))); typedef __bf16 bf16x2_t __attribute__((ext_vector_type(2)));
__device__ __forceinline__ unsigned cvtpk_s(float lo,float hi){f32x2_t v={lo,hi};bf16x2_t b=__builtin_convertvector(v,bf16x2_t);return __builtin_bit_cast(unsigned,b);}
#define WAIT_BAR(N) asm volatile("s_waitcnt vmcnt(" #N ") lgkmcnt(0)\n\ts_barrier":::"memory")

__device__ __forceinline__ void qkt(f32x16&p0,f32x16&p1,const char*Kslot,const bf16x8*qr,const f32x16&negm,int r32,int hi){
  const char*kb=Kslot+hi*1024+r32*16;
  #pragma unroll
  for(int d0=0;d0<4;++d0){
    const bf16x8 b0=*reinterpret_cast<const bf16x8*>(kb+d0*2048);
    const bf16x8 b1=*reinterpret_cast<const bf16x8*>(kb+d0*2048+512);
    if(d0==0){p0=__builtin_amdgcn_mfma_f32_32x32x16_bf16(b0,qr[0],negm,0,0,0);p1=__builtin_amdgcn_mfma_f32_32x32x16_bf16(b1,qr[0],negm,0,0,0);}
    else{p0=__builtin_amdgcn_mfma_f32_32x32x16_bf16(b0,qr[d0],p0,0,0,0);p1=__builtin_amdgcn_mfma_f32_32x32x16_bf16(b1,qr[d0],p1,0,0,0);}}
}
typedef __attribute__((address_space(3))) const char* lds_cptr;
typedef short v4i16_t __attribute__((ext_vector_type(4)));
__device__ __forceinline__ void kload8(bf16x8*kf,lds_cptr kp){
  kf[0]=*(const __attribute__((address_space(3))) bf16x8*)(kp);      kf[1]=*(const __attribute__((address_space(3))) bf16x8*)(kp+512);
  kf[2]=*(const __attribute__((address_space(3))) bf16x8*)(kp+2048); kf[3]=*(const __attribute__((address_space(3))) bf16x8*)(kp+2560);
  kf[4]=*(const __attribute__((address_space(3))) bf16x8*)(kp+4096); kf[5]=*(const __attribute__((address_space(3))) bf16x8*)(kp+4608);
  kf[6]=*(const __attribute__((address_space(3))) bf16x8*)(kp+6144); kf[7]=*(const __attribute__((address_space(3))) bf16x8*)(kp+6656);
}
__device__ __forceinline__ void kload2(bf16x8*kf,lds_cptr kp,int j){ kf[2*j]=*(const __attribute__((address_space(3))) bf16x8*)(kp+j*2048); kf[2*j+1]=*(const __attribute__((address_space(3))) bf16x8*)(kp+j*2048+512); }
__device__ __forceinline__ s16x4 vtr(lds_cptr p){ return __builtin_bit_cast(s16x4,__builtin_amdgcn_ds_read_tr16_b64_v4i16((__attribute__((address_space(3))) v4i16_t*)p)); }
__device__ __forceinline__ float rowmax(const f32x16&p0,const f32x16&p1){
  float a=max3f(p0[0],p0[1],p1[0]),b=max3f(p0[2],p0[3],p1[1]);a=max3f(a,p1[2],p1[3]);
  #pragma unroll
  for(int r=4;r<16;r+=4){a=max3f(a,p0[r],p0[r+1]);b=max3f(b,p0[r+2],p0[r+3]);a=max3f(a,p1[r],p1[r+1]);b=max3f(b,p1[r+2],p1[r+3]);}
  const float m=max2f(a,b);
  auto rr=__builtin_amdgcn_permlane32_swap(__float_as_uint(m),__float_as_uint(m),false,false);
  return max2f(__uint_as_float(rr[0]),__uint_as_float(rr[1]));
}
__device__ __forceinline__ float rowmax_c(const f32x16&p0,const f32x16&p1){
  float a=__builtin_fmaxf(p0[0],p1[0]);
  #pragma unroll
  for(int r=1;r<16;++r){a=__builtin_fmaxf(a,__builtin_fmaxf(p0[r],p1[r]));}
  auto rr=__builtin_amdgcn_permlane32_swap(__float_as_uint(a),__float_as_uint(a),false,false);
  return __builtin_fmaxf(__uint_as_float(rr[0]),__uint_as_float(rr[1]));
}
__device__ __forceinline__ void pv(f32x16*o,int vb,bf16x8 pa0,bf16x8 pa1,bf16x8 pa2,bf16x8 pa3){
  #pragma unroll
  for(int d0=0;d0<2;++d0){s16x4 lo[4],hi[4];
    #pragma unroll
    for(int ks=0;ks<4;++ks){
      asm volatile("ds_read_b64_tr_b16 %0,%1 offset:%c2":"=&v"(lo[ks]):"v"(vb),"i"(d0*4096+ks*1024):"memory");
      asm volatile("ds_read_b64_tr_b16 %0,%1 offset:%c2":"=&v"(hi[ks]):"v"(vb),"i"(d0*4096+ks*1024+512):"memory");}
    asm volatile("s_waitcnt lgkmcnt(0)":::"memory");SBAR();
    #define PK(k) (bf16x8){lo[k][0],lo[k][1],lo[k][2],lo[k][3],hi[k][0],hi[k][1],hi[k][2],hi[k][3]}
    o[d0]=__builtin_amdgcn_mfma_f32_32x32x16_bf16(pa0,PK(0),o[d0],0,0,0);
    o[d0]=__builtin_amdgcn_mfma_f32_32x32x16_bf16(pa1,PK(1),o[d0],0,0,0);
    o[d0]=__builtin_amdgcn_mfma_f32_32x32x16_bf16(pa2,PK(2),o[d0],0,0,0);
    o[d0]=__builtin_amdgcn_mfma_f32_32x32x16_bf16(pa3,PK(3),o[d0],0,0,0);
    #undef PK
  }
}
__device__ __forceinline__ float bflo(unsigned u){return __uint_as_float(u<<16);}
__device__ __forceinline__ float bfhi(unsigned u){return __uint_as_float(u&0xffff0000u);}

struct MobaMerge { const float* pml; const bf16* po; long grow0; int h; int ns; };
constexpr long MROWS=2L*SEQ;
struct GatherArgs { unsigned gent; int n; float* pml; bf16* po; long growb; int h; };
__device__ __forceinline__ void gbias(f32x16&p0,f32x16&p1,int dq,int hi,lds_cfptr bl){
  #pragma unroll
  for(int g=0;g<4;++g){
    #pragma unroll
    for(int rr=0;rr<4;++rr){const int r=4*g+rr; const int d0=dq-(4*hi+(r&3)+8*(r>>2)),d1=d0-32;
      const int i0=d0<0?0:(d0>127?127:d0), i1=d1<0?0:(d1>127?127:d1);
      p0[r]+=bl[i0]; p1[r]+=bl[i1];}
    __builtin_amdgcn_sched_barrier(0); }
}

template<int THRL,int MODE> __device__ __forceinline__ void attn_unit(const bf16*Qp,const bf16*__restrict__ Kp,const bf16*__restrict__ Vp,bf16*Op,int q0,int kv0,int NT,const float*biasG,const MobaMerge&mm,const GatherArgs&ga,char*shm,int wv,bool newtab=true){
  const int lane=lane_now();
  asm volatile("":"+s"(wv)); const int wid=__builtin_amdgcn_readfirstlane(wv), tid=wid*64+lane, r32=lane&31, hi=lane>>5;
  unsigned gent=0u; int qloc=0;
  if constexpr(MODE==2){ gent=ga.gent; qloc=(int)(gent&0x3FFFu); }
  const bf16*Qw=(MODE==2)?(Qp+(long)(qloc-r32)*LDQ):(Qp+(long)(q0+wid*QBLK)*LDQ);
  const bf16*Kh=Kp+(long)kv0*LDQ,*Vh=Vp+(long)kv0*LDQ;
  const unsigned lds0=(unsigned)(uintptr_t)shm;
  float*wsf=(float*)(shm+LDS_WS)+wid*128;
  const lds_cptr shm3=(lds_cptr)shm;
  asm volatile("":"+s"(biasG));
  if(newtab && wid==0){ glds16((const char*)biasG+lane*16,(unsigned)__builtin_amdgcn_readfirstlane(lds0+LDS_BIAS)); }
  const lds_cfptr bl=(lds_cfptr)(shm3+LDS_BIAS);
  const bf16*ksrc=Kh+(long)lane*LDQ+wid*8;
  const bf16*vsrc=Vh+(long)(16*(wid&3)+(lane>>2))*LDQ+(wid>>2)*32+(lane&3)*8;
  const unsigned kdst=lds0+LDS_K+wid*1024, vdst=lds0+LDS_V+wid*1024;
  #define DMA_K(t,slot) glds16(ksrc+(long)(t)*KVBLK*LDQ,(unsigned)__builtin_amdgcn_readfirstlane(kdst+(slot)))
  #define DMA_V(t,slot) glds16(vsrc+(long)(t)*KVBLK*LDQ,(unsigned)__builtin_amdgcn_readfirstlane(vdst+(slot)))
  const int vb0=(int)(lds0+LDS_V)+((lane>>4)&1)*32+(lane&3)*8+(4*hi+((lane&15)>>2))*64;
  const char*Kbase=shm+LDS_K; bf16x8 kf[8];
  const lds_cptr kp0=shm3+LDS_K+hi*1024+r32*16; const lds_cptr vp0=shm3+LDS_V+((lane>>4)&1)*32+(lane&3)*8+(4*hi+((lane&15)>>2))*64;
  DMA_K(0,0);DMA_V(0,0);DMA_K(1,SLOTB);
  bf16x8 qr[4];
  #pragma unroll
  for(int d0=0;d0<4;++d0)qr[d0]=*reinterpret_cast<const bf16x8*>(&Qw[(long)r32*LDQ+d0*16+hi*8]);
  float mhat=0.f,l_reg=0.f;f32x16 o[2];o[0]=f32x16{};o[1]=f32x16{};f32x16 negm=f32x16{};asm volatile("":"+v"(negm));
  const int qrel=wid*QBLK+r32;
  const bool nearq=(MODE==2)?(bool)__any(qloc-(kv0+128)<128+113):false;
  #define CMASK(P0,P1,t) do{ if constexpr(MODE==2){ if((t)>=2 && nearq)gbias(P0,P1,qloc-(kv0+64*(t)),hi,bl); } else { int jb_=(t)-(NT-4); if(jb_>=-2 && (32*wid-(64*jb_+63))<113)BMM(P0,P1,jb_,qrel,hi); } }while(0)
  bool resc=false;
  #define START(P0,P1) do{ const float rm=rowmax(P0,P1); resc=false; \
    { const float dl=rm; mhat=fadd_s(mhat,dl); \
      _Pragma("unroll") for(int r=0;r<16;++r){P0[r]=fsub_s(P0[r],dl);P1[r]=fsub_s(P1[r],dl);} \
      _Pragma("unroll") for(int r=0;r<16;++r)negm[r]=-mhat; asm volatile("":"+v"(negm)); } \
    _Pragma("unroll") for(int r=0;r<16;++r)P0[r]=__builtin_amdgcn_exp2f(P0[r]); }while(0)
  #define RESC() do{ if(resc){ asm volatile("s_waitcnt lgkmcnt(0)":::"memory"); \
      _Pragma("unroll") for(int d_=0;d_<2;++d_) _Pragma("unroll") for(int r=0;r<16;++r)o[d_][r]*=wsf[crow(r,hi)]; } }while(0)
  f32x16 pA0,pA1,pB0,pB1;
  int sl_prev=0,sl_cur=0,sl_next=SLOTB;
  #define ROT() do{sl_prev=sl_cur;sl_cur=sl_next;sl_next=(sl_next==(NSLOT-1)*SLOTB)?0:sl_next+SLOTB;}while(0)
  DMA_K(2,2*SLOTB);
  WAIT_BAR(3);
  qkt(pA0,pA1,Kbase,qr,negm,r32,hi);asm volatile("s_nop 15\n\ts_nop 7":"+v"(pA0),"+v"(pA1));CMASK(pA0,pA1,0);
  START(pA0,pA1);
  _Pragma("unroll") for(int r=0;r<16;++r)pA1[r]=__builtin_amdgcn_exp2f(pA1[r]);
  WAIT_BAR(0);
  DMA_K(3,0);DMA_V(1,SLOTB);
  ROT();
  kload8(kf,kp0+sl_cur);
  WAIT_BAR(2);
  s16x4 vlo[8],vhi[8]; u32x4 pw0,pw1,pw2,pw3;
  #define PKW(P,B) cvtpk_s(P[B],P[B+1])
  #define PAF(k) __builtin_bit_cast(bf16x8,pw##k)
  #define VFR(i) (bf16x8){vlo[i][0],vlo[i][1],vlo[i][2],vlo[i][3],vhi[i][0],vhi[i][1],vhi[i][2],vhi[i][3]}
  #define PIN(x) asm volatile("":"+v"(x))
  #define MX3(a,b,c) __builtin_fmaxf(__builtin_fmaxf((a),(b)),(c))
  #define GAPA(MF,A0,A1,A2,A3,W0,W1,PW) do{ MF; sacc+=A0; sacc+=A1; sacc+=A2; sacc+=A3; PIN(sacc); W0; W1; PIN(PW); SBAR(); }while(0)
  #define EX(v) __builtin_amdgcn_exp2f(v)
  #define GAPB(MF,X,B) do{ MF; { float e0_=EX(X[B]),e1_=EX(X[B+1]),e2_=EX(X[B+2]),e3_=EX(X[B+3]); asm volatile("":"+v"(e0_),"+v"(e1_),"+v"(e2_),"+v"(e3_)); X[B]=e0_;X[B+1]=e1_;X[B+2]=e2_;X[B+3]=e3_; } SBAR(); }while(0)
  #define VRD(i) do{ vlo[i]=vtr(vp_+(((i)>>2)*4096+((i)&3)*1024)); vhi[i]=vtr(vp_+(((i)>>2)*4096+((i)&3)*1024+512)); }while(0)
  #define KRD(G,j) do{ if(G){ kload2(kf,kp0+sl_next,j); SBAR(); } }while(0)
  #define STEP(C0,C1,P0,P1,t,GK,GV,GL) do{ SBAR(); \
    const lds_cptr vp_=vp0+sl_prev; \
    VRD(0); SBAR(); float sacc=(P0[0]+P0[1]); \
    GAPA(C0=__builtin_amdgcn_mfma_f32_32x32x16_bf16(kf[0],qr[0],negm,0,0,0), P0[2],P0[3],P0[4],P0[5],     pw0[0]=PKW(P0,0), pw0[1]=PKW(P0,2), pw0); \
    VRD(4); SBAR(); GAPA(C1=__builtin_amdgcn_mfma_f32_32x32x16_bf16(kf[1],qr[0],negm,0,0,0), P0[6],P0[7],P0[8],P0[9],     pw0[2]=PKW(P0,4), pw0[3]=PKW(P0,6), pw0); \
    VRD(1); SBAR(); GAPA(C0=__builtin_amdgcn_mfma_f32_32x32x16_bf16(kf[2],qr[1],C0,0,0,0),   P0[10],P0[11],P0[12],P0[13], pw1[0]=PKW(P0,8), pw1[1]=PKW(P0,10), pw1); \
    VRD(5); SBAR(); GAPA(C1=__builtin_amdgcn_mfma_f32_32x32x16_bf16(kf[3],qr[1],C1,0,0,0),   P0[14],P0[15],P1[0],P1[1],   pw1[2]=PKW(P0,12),pw1[3]=PKW(P0,14), pw1); \
    VRD(2); SBAR(); GAPA(C0=__builtin_amdgcn_mfma_f32_32x32x16_bf16(kf[4],qr[2],C0,0,0,0),   P1[2],P1[3],P1[4],P1[5],     pw2[0]=PKW(P1,0), pw2[1]=PKW(P1,2), pw2); \
    VRD(6); SBAR(); GAPA(C1=__builtin_amdgcn_mfma_f32_32x32x16_bf16(kf[5],qr[2],C1,0,0,0),   P1[6],P1[7],P1[8],P1[9],     pw2[2]=PKW(P1,4), pw2[3]=PKW(P1,6), pw2); \
    VRD(3); SBAR(); GAPA(C0=__builtin_amdgcn_mfma_f32_32x32x16_bf16(kf[6],qr[3],C0,0,0,0),   P1[10],P1[11],P1[12],P1[13], pw3[0]=PKW(P1,8), pw3[1]=PKW(P1,10), pw3); \
    VRD(7); SBAR(); GAPA(C1=__builtin_amdgcn_mfma_f32_32x32x16_bf16(kf[7],qr[3],C1,0,0,0),   P1[14],P1[15],0.f,0.f,       pw3[2]=PKW(P1,12),pw3[3]=PKW(P1,14), pw3); \
    l_reg+=sacc; \
    CMASK(C0,C1,t); \
    { float a=MX3(C0[0],C0[1],C1[0]),b=MX3(C0[2],C0[3],C1[1]); a=MX3(a,C1[2],C1[3]); \
      _Pragma("unroll") for(int r=4;r<16;r+=4){a=MX3(a,C0[r],C0[r+1]);b=MX3(b,C0[r+2],C0[r+3]);a=MX3(a,C1[r],C1[r+1]);b=MX3(b,C1[r+2],C1[r+3]);} \
      float rm=__builtin_fmaxf(a,b); { auto rr=__builtin_amdgcn_permlane32_swap(__float_as_uint(rm),__float_as_uint(rm),false,false); rm=__builtin_fmaxf(__uint_as_float(rr[0]),__uint_as_float(rr[1])); } \
      resc=false; \
      if(__builtin_expect(__any(rm>(float)THRL),0)){ const float dl=__builtin_fmaxf(rm,0.f); mhat+=dl; \
        _Pragma("unroll") for(int r=0;r<16;++r){C0[r]-=dl;C1[r]-=dl;} \
        _Pragma("unroll") for(int r=0;r<16;++r)negm[r]=-mhat; asm volatile("":"+v"(negm)); \
        const float f=__builtin_amdgcn_exp2f(-dl); l_reg*=f; if(hi==0)wsf[r32]=f; resc=true; } } \
    SBAR(); \
    GAPB(o[0]=__builtin_amdgcn_mfma_f32_32x32x16_bf16(PAF(0),VFR(0),o[0],0,0,0), C0,0); \
    GAPB(o[1]=__builtin_amdgcn_mfma_f32_32x32x16_bf16(PAF(0),VFR(4),o[1],0,0,0), C0,4); \
    KRD(GL,0); GAPB(o[0]=__builtin_amdgcn_mfma_f32_32x32x16_bf16(PAF(1),VFR(1),o[0],0,0,0), C0,8); \
    KRD(GL,1); GAPB(o[1]=__builtin_amdgcn_mfma_f32_32x32x16_bf16(PAF(1),VFR(5),o[1],0,0,0), C0,12); \
    KRD(GL,2); GAPB(o[0]=__builtin_amdgcn_mfma_f32_32x32x16_bf16(PAF(2),VFR(2),o[0],0,0,0), C1,0); \
    KRD(GL,3); GAPB(o[1]=__builtin_amdgcn_mfma_f32_32x32x16_bf16(PAF(2),VFR(6),o[1],0,0,0), C1,4); \
    GAPB(o[0]=__builtin_amdgcn_mfma_f32_32x32x16_bf16(PAF(3),VFR(3),o[0],0,0,0), C1,8); \
    GAPB(o[1]=__builtin_amdgcn_mfma_f32_32x32x16_bf16(PAF(3),VFR(7),o[1],0,0,0), C1,12); \
    if(GK){DMA_K((t)+3,sl_cur);} if(GV){DMA_V((t)+1,sl_next);}   \
    }while(0)
  int t=1;
  #undef CMASK
  #define CMASK(P0,P1,t) do{}while(0)
  for(;t+7<NT;t+=2){
    STEP(pB0,pB1,pA0,pA1,t,true,true,true);     WAIT_BAR(2); RESC(); ROT();
    STEP(pA0,pA1,pB0,pB1,t+1,true,true,true);   WAIT_BAR(2); RESC(); ROT();
  }
  #undef CMASK
  #define CMASK(P0,P1,t) do{ if constexpr(MODE==2){ if((t)>=2 && nearq)gbias(P0,P1,qloc-(kv0+64*(t)),hi,bl); } else { int jb_=(t)-(NT-4); if(jb_>=-2 && (32*wid-(64*jb_+63))<113)BMM(P0,P1,jb_,qrel,hi); } }while(0)
  #define ENDW(tt) do{ if((tt)+3<NT){WAIT_BAR(2);} else if((tt)+2<NT){WAIT_BAR(1);} else {WAIT_BAR(0);} }while(0)
  for(;t+1<NT;t+=2){
    STEP(pB0,pB1,pA0,pA1,t,(t+3<NT),(t+1<NT),(t+1<NT));       ENDW(t);   RESC(); ROT();
    STEP(pA0,pA1,pB0,pB1,t+1,(t+4<NT),(t+2<NT),(t+2<NT));     ENDW(t+1); RESC(); ROT();
  }
  u32x4 mpp[4][3]; f32x2_t mmv[3];
  if constexpr(MODE==1){
    const float*pml_=mm.pml; const bf16*po_=mm.po; asm volatile("":"+s"(pml_),"+s"(po_));
    const int lane_p=lane_now(); const long gr=mm.grow0+wid*QBLK+(lane_p&31);
    #pragma unroll
    for(int s_=0;s_<3;++s_){ mmv[s_]=(f32x2_t){-INFINITY,0.f}; if(s_<mm.ns) mmv[s_]=*(const f32x2_t*)(pml_+((long)s_*MROWS+gr)*16+mm.h*2); }
    #pragma unroll
    for(int i=0;i<4;++i){ const int row=i*8+(lane_p>>3),ch=lane_p&7;
      #pragma unroll
      for(int s_=0;s_<3;++s_){ mpp[i][s_]=(u32x4){0u,0u,0u,0u}; if(s_<mm.ns) mpp[i][s_]=*(const u32x4*)(po_+(((long)s_*MROWS+mm.grow0+wid*QBLK+row)*8+mm.h)*64+ch*8); } }
    SBAR();
  }
  STEP(pB0,pB1,pA0,pA1,NT-1,false,false,false); RESC();
  { float sacc=pB0[0]+pB0[1]; _Pragma("unroll") for(int r=2;r<16;++r)sacc+=pB0[r]; _Pragma("unroll") for(int r=0;r<16;++r)sacc+=pB1[r]; l_reg+=sacc;
    pw0=(u32x4){PKW(pB0,0),PKW(pB0,2),PKW(pB0,4),PKW(pB0,6)};pw1=(u32x4){PKW(pB0,8),PKW(pB0,10),PKW(pB0,12),PKW(pB0,14)};pw2=(u32x4){PKW(pB1,0),PKW(pB1,2),PKW(pB1,4),PKW(pB1,6)};pw3=(u32x4){PKW(pB1,8),PKW(pB1,10),PKW(pB1,12),PKW(pB1,14)};
    SBAR(); pv(o,vb0+sl_cur,PAF(0),PAF(1),PAF(2),PAF(3)); }
  #undef PKW
  #undef PAF
  #undef VFR
  #undef PIN
  #undef MX3
  #undef GAPA
  #undef GAPB
  #undef EX
  #undef VRD
  #undef KRD
  #undef STEP
  #undef ENDW
  {auto rr=__builtin_amdgcn_permlane32_swap(__float_as_uint(l_reg),__float_as_uint(l_reg),false,false);l_reg=__uint_as_float(rr[0])+__uint_as_float(rr[1]);}
  const float*pml_=mm.pml; const bf16*po_=mm.po; if constexpr(MODE==1){ asm volatile("":"+s"(pml_),"+s"(po_)); }
  if constexpr(MODE==1){
    const long gr=mm.grow0+wid*QBLK+r32; float ms[3],ls[3],as[3]; float Mx=mhat;
    #pragma unroll
    for(int s=0;s<3;++s){ ms[s]=mmv[s].x; ls[s]=mmv[s].y; if(s<mm.ns){ Mx=__builtin_fmaxf(Mx,ms[s]); } }
    const float a0=__builtin_amdgcn_exp2f(mhat-Mx); float L=a0*l_reg;
    #pragma unroll
    for(int s=0;s<3;++s){ as[s]=(s<mm.ns)?__builtin_amdgcn_exp2f(ms[s]-Mx):0.f; L+=as[s]*ls[s]; }
    const float inv=1.0f/L;
    if(hi==0){wsf[32+r32]=a0*inv;wsf[64+r32]=as[0]*inv;wsf[96+r32]=as[1]*inv;wsf[r32]=as[2]*inv;}
  } else if constexpr(MODE==2){
    float*gpml_=ga.pml; asm volatile("":"+s"(gpml_));
    if(hi==0){ wsf[32+r32]=1.0f; if(wid*QBLK+r32<ga.n){ f32x2_t v={mhat,l_reg}; *(f32x2_t*)(gpml_+((long)(gent>>14)*MROWS+ga.growb+qloc)*16+ga.h*2)=v; } }
  } else {
    if(hi==0)wsf[32+r32]=1.0f/l_reg;
  }
  asm volatile("s_waitcnt lgkmcnt(0)":::"memory");
  float rli[16];
  #pragma unroll
  for(int r=0;r<16;++r)rli[r]=wsf[32+crow(r,hi)];
  { asm volatile("":"+s"(Op)); }
  bf16*Ow=Op+(long)(q0+wid*QBLK)*LDO;
  { bf16*stg=(bf16*)(shm+LDS_OST)+wid*2048;
    #pragma unroll
    for(int r=0;r<16;++r){const int orow=crow(r,hi);
      #pragma unroll
      for(int d0=0;d0<2;++d0)stg[orow*64+d0*32+r32]=__float2bfloat16(o[d0][r]*rli[r]);}
    asm volatile("s_waitcnt lgkmcnt(0)":::"memory");
    int lane_e=lane; asm volatile("":"+v"(lane_e));
    #pragma unroll
    for(int i=0;i<4;++i){const int row=i*8+(lane_e>>3),ch=lane_e&7; u32x4 v=*(const u32x4*)(stg+row*64+ch*8);
      if constexpr(MODE==1){
        float a[8]={bflo(v.x),bfhi(v.x),bflo(v.y),bfhi(v.y),bflo(v.z),bfhi(v.z),bflo(v.w),bfhi(v.w)};
        #pragma unroll
        for(int s=0;s<3;++s){ if(s<mm.ns){ const float c=wsf[(s==0?64:(s==1?96:0))+row];
            const u32x4 pp=mpp[i][s];
            a[0]+=c*bflo(pp.x);a[1]+=c*bfhi(pp.x);a[2]+=c*bflo(pp.y);a[3]+=c*bfhi(pp.y);a[4]+=c*bflo(pp.z);a[5]+=c*bfhi(pp.z);a[6]+=c*bflo(pp.w);a[7]+=c*bfhi(pp.w);} }
        v.x=cvtpk_s(a[0],a[1]);v.y=cvtpk_s(a[2],a[3]);v.z=cvtpk_s(a[4],a[5]);v.w=cvtpk_s(a[6],a[7]);
      }
      if constexpr(MODE==2){ bf16*gpo_=ga.po; asm volatile("":"+s"(gpo_)); const unsigned er=(unsigned)__builtin_amdgcn_ds_bpermute(row<<2,(int)gent); if(wid*QBLK+row<ga.n) *(u32x4*)(gpo_+(((long)(er>>14)*MROWS+ga.growb+(long)(er&0x3FFFu))*8+ga.h)*64+ch*8)=v; }
      else *(u32x4*)(Ow+(long)row*LDO+ch*8)=v;} }
  asm volatile("s_waitcnt lgkmcnt(0)\n\ts_barrier":::"memory");
  #undef DMA_K
  #undef DMA_V
  #undef CMASK
  #undef START
  #undef RESC
  #undef ROT
}


constexpr int VSLOTB=16384;
constexpr int W_LDS_K=0, W_LDS_V=NSLOT*SLOTB, W_LDS_WS=W_LDS_V+NSLOT*VSLOTB, W_LDS_OST=W_LDS_WS+NW*128*4, W_LDS_BIAS=W_LDS_OST+NW*4096, W_LDS_BYTES=W_LDS_BIAS+512;
__device__ __forceinline__ void pv128(f32x16*o,int vb,bf16x8 pa0,bf16x8 pa1,bf16x8 pa2,bf16x8 pa3){
  #pragma unroll
  for(int d0=0;d0<4;++d0){s16x4 lo[4],hi[4];
    #pragma unroll
    for(int ks=0;ks<4;++ks){
      asm volatile("ds_read_b64_tr_b16 %0,%1 offset:%c2":"=&v"(lo[ks]):"v"(vb),"i"(d0*4096+ks*1024):"memory");
      asm volatile("ds_read_b64_tr_b16 %0,%1 offset:%c2":"=&v"(hi[ks]):"v"(vb),"i"(d0*4096+ks*1024+512):"memory");}
    asm volatile("s_waitcnt lgkmcnt(0)":::"memory");SBAR();
    #define PK(k) (bf16x8){lo[k][0],lo[k][1],lo[k][2],lo[k][3],hi[k][0],hi[k][1],hi[k][2],hi[k][3]}
    o[d0]=__builtin_amdgcn_mfma_f32_32x32x16_bf16(pa0,PK(0),o[d0],0,0,0);
    o[d0]=__builtin_amdgcn_mfma_f32_32x32x16_bf16(pa1,PK(1),o[d0],0,0,0);
    o[d0]=__builtin_amdgcn_mfma_f32_32x32x16_bf16(pa2,PK(2),o[d0],0,0,0);
    o[d0]=__builtin_amdgcn_mfma_f32_32x32x16_bf16(pa3,PK(3),o[d0],0,0,0);
    #undef PK
  }
}
template<int THRL> __device__ __forceinline__ void attn_unit128(const bf16*Qp,const bf16*__restrict__ Kp,const bf16*__restrict__ Vp,bf16*Op,int q0,int NT,const float*biasG,char*shm,int wv STAMP_PARAM){
  const int lane=lane_now();
  asm volatile("":"+s"(wv)); const int wid=__builtin_amdgcn_readfirstlane(wv), tid=wid*64+lane, r32=lane&31, hi=lane>>5;
  const bf16*Qw=Qp+(long)(q0+wid*QBLK)*LDQ;
  const bf16*Kh=Kp,*Vh=Vp;
  const unsigned lds0=(unsigned)(uintptr_t)shm;
  float*wsf=(float*)(shm+W_LDS_WS)+wid*128;
  const lds_cptr shm3=(lds_cptr)shm;
  asm volatile("":"+s"(biasG));
  { __attribute__((address_space(3))) float* blw=(__attribute__((address_space(3))) float*)(shm3+W_LDS_BIAS); if(tid<128)blw[tid]=biasG[tid]; }
  const lds_cfptr bl=(lds_cfptr)(shm3+W_LDS_BIAS);
  const bf16*ksrc=Kh+(long)lane*LDQ+wid*8;
  const bf16*vsrc=Vh+(long)(16*(wid&3)+(lane>>2))*LDQ+(wid>>2)*32+(lane&3)*8;
  const unsigned kdst=lds0+W_LDS_K+wid*1024, vdst=lds0+W_LDS_V+wid*1024;
  #define DMA_K(t,slot) glds16(ksrc+(long)(t)*KVBLK*LDQ,(unsigned)__builtin_amdgcn_readfirstlane(kdst+(slot)))
  #define DMA_V(t,slot) do{ glds16(vsrc+(long)(t)*KVBLK*LDQ,(unsigned)__builtin_amdgcn_readfirstlane(vdst+2*(slot))); glds16(vsrc+(long)(t)*KVBLK*LDQ+64,(unsigned)__builtin_amdgcn_readfirstlane(vdst+2*(slot)+8192)); }while(0)
  const int vb0=(int)(lds0+W_LDS_V)+((lane>>4)&1)*32+(lane&3)*8+(4*hi+((lane&15)>>2))*64;
  const char*Kbase=shm+W_LDS_K; bf16x8 kf[8];
  const lds_cptr kp0=shm3+W_LDS_K+hi*1024+r32*16; const lds_cptr vp0=shm3+W_LDS_V+((lane>>4)&1)*32+(lane&3)*8+(4*hi+((lane&15)>>2))*64;
  asm volatile("s_waitcnt vmcnt(0)":::"memory");
  DMA_K(0,0);DMA_V(0,0);DMA_K(1,SLOTB);
  bf16x8 qr[4];
  #pragma unroll
  for(int d0=0;d0<4;++d0)qr[d0]=*reinterpret_cast<const bf16x8*>(&Qw[(long)r32*LDQ+d0*16+hi*8]);
  float mhat=0.f,l_reg=0.f;f32x16 o[4];o[0]=f32x16{};o[1]=f32x16{};o[2]=f32x16{};o[3]=f32x16{};f32x16 negm=f32x16{};asm volatile("":"+v"(negm));
  const int qrel=wid*QBLK+r32;
  #define CMASK(P0,P1,t) do{int jb_=(t)-(NT-4); if(jb_>=-2 && (32*wid-(64*jb_+63))<113)biasmask(P0,P1,jb_,qrel,hi,bl);}while(0)
  bool resc=false;
  #define RESC() do{ if(resc){ asm volatile("s_waitcnt lgkmcnt(0)":::"memory"); \
      _Pragma("unroll") for(int d_=0;d_<4;++d_) _Pragma("unroll") for(int r=0;r<16;++r)o[d_][r]*=wsf[crow(r,hi)]; } }while(0)
  f32x16 C0,C1; u32x4 pw0,pw1,pw2,pw3;
  int sl_prev=0,sl_cur=0,sl_next=SLOTB;
  #define ROT() do{sl_prev=sl_cur;sl_cur=sl_next;sl_next=(sl_next==(NSLOT-1)*SLOTB)?0:sl_next+SLOTB;}while(0)
  #define PKW(P,B) cvtpk_s(P[B],P[B+1])
  DMA_K(2,2*SLOTB);
  WAIT_BAR(3);
  qkt(C0,C1,Kbase,qr,negm,r32,hi);asm volatile("s_nop 15\n\ts_nop 7":"+v"(C0),"+v"(C1));CMASK(C0,C1,0);
  { const float rm=rowmax(C0,C1); mhat=rm;
    _Pragma("unroll") for(int r=0;r<16;++r)negm[r]=-mhat; asm volatile("":"+v"(negm));
    _Pragma("unroll") for(int r=0;r<16;++r){C0[r]=__builtin_amdgcn_exp2f(C0[r]-mhat);C1[r]=__builtin_amdgcn_exp2f(C1[r]-mhat);}
    float sacc=0.f; _Pragma("unroll") for(int r=0;r<16;++r)sacc+=C0[r]+C1[r]; l_reg+=sacc;
    pw0=(u32x4){PKW(C0,0),PKW(C0,2),PKW(C0,4),PKW(C0,6)};pw1=(u32x4){PKW(C0,8),PKW(C0,10),PKW(C0,12),PKW(C0,14)};pw2=(u32x4){PKW(C1,0),PKW(C1,2),PKW(C1,4),PKW(C1,6)};pw3=(u32x4){PKW(C1,8),PKW(C1,10),PKW(C1,12),PKW(C1,14)}; }
  const __attribute__((address_space(3))) char* qlds=(const __attribute__((address_space(3))) char*)(shm3+W_LDS_OST+wid*4096+lane*16);
  { __attribute__((address_space(3))) char* qw=(__attribute__((address_space(3))) char*)(shm3+W_LDS_OST+wid*4096+lane*16);
    #pragma unroll
    for(int d0=0;d0<4;++d0)*(__attribute__((address_space(3))) bf16x8*)(qw+d0*1024)=qr[d0]; }
  WAIT_BAR(0);
  DMA_K(3,0);DMA_V(1,SLOTB);
  ROT();
  kload8(kf,kp0+sl_cur);
  WAIT_BAR(3);
  s16x4 vlo[8],vhi[8];
  #define PAF(k) __builtin_bit_cast(bf16x8,pw##k)
  #define VFR(i) (bf16x8){vlo[i][0],vlo[i][1],vlo[i][2],vlo[i][3],vhi[i][0],vhi[i][1],vhi[i][2],vhi[i][3]}
  #define PIN(x) asm volatile("":"+v"(x))
  #define MX3(a,b,c) __builtin_fmaxf(__builtin_fmaxf((a),(b)),(c))
  #define EX(v) __builtin_amdgcn_exp2f(v)
  #define GA(MF) do{ MF; SBAR(); }while(0)
  #define EX2(X,B) do{ float e0_=EX(X[B]), e1_=EX(X[B+1]); asm volatile("":"+v"(e0_),"+v"(e1_)); X[B]=e0_; X[B+1]=e1_; }while(0)
  #define GB0(MF,X,B) do{ MF; EX2(X,B); SBAR(); }while(0)
  #define GB1(MF,X,B,PWD,Y,YB) do{ MF; EX2(X,B); sacc+=Y[YB]; sacc+=Y[YB+1]; PIN(sacc); { unsigned pk_=PKW(Y,YB); PIN(pk_); PWD=pk_; } SBAR(); }while(0)
  #define VRS(s,i) do{ vlo[s]=vtr(vp_+(((i)>>2)*4096+((i)&3)*1024)); vhi[s]=vtr(vp_+(((i)>>2)*4096+((i)&3)*1024+512)); SBAR(); }while(0)
  #define KRD(G,j) do{ if(G){ kload2(kf,kp0+sl_next,j); SBAR(); } }while(0)
  #define MF(a,b,c) __builtin_amdgcn_mfma_f32_32x32x16_bf16(a,b,c,0,0,0)
  #define QL(d) (*(const __attribute__((address_space(3))) bf16x8*)(qlds+(d)*1024))
  #define STEP(t,GK,GV,GL) do{ SBAR(); \
    const lds_cptr vp_=vp0+2*sl_prev; \
    bf16x8 qa_=QL(0),qb_=QL(1); SBAR(); \
    VRS(0,0);  GA(C0=MF(kf[0],qa_,negm)); \
    VRS(1,4);  GA(C1=MF(kf[1],qa_,negm)); qa_=QL(2); SBAR(); \
    VRS(2,8);  GA(C0=MF(kf[2],qb_,C0)); \
    VRS(3,12); GA(C1=MF(kf[3],qb_,C1)); qb_=QL(3); SBAR(); \
    VRS(4,1);  GA(C0=MF(kf[4],qa_,C0)); \
    VRS(5,5);  GA(C1=MF(kf[5],qa_,C1)); \
    VRS(6,9);  GA(C0=MF(kf[6],qb_,C0)); \
    VRS(7,13); GA(C1=MF(kf[7],qb_,C1)); \
    CMASK(C0,C1,t); \
    { float a=MX3(C0[0],C0[1],C1[0]),b=MX3(C0[2],C0[3],C1[1]); a=MX3(a,C1[2],C1[3]); \
      _Pragma("unroll") for(int r=4;r<16;r+=4){a=MX3(a,C0[r],C0[r+1]);b=MX3(b,C0[r+2],C0[r+3]);a=MX3(a,C1[r],C1[r+1]);b=MX3(b,C1[r+2],C1[r+3]);} \
      float rm=__builtin_fmaxf(a,b); { auto rr=__builtin_amdgcn_permlane32_swap(__float_as_uint(rm),__float_as_uint(rm),false,false); rm=__builtin_fmaxf(__uint_as_float(rr[0]),__uint_as_float(rr[1])); } \
      resc=false; \
      if(__builtin_expect(__any(rm>(float)THRL),0)){ const float dl=__builtin_fmaxf(rm,0.f); mhat+=dl; \
        _Pragma("unroll") for(int r=0;r<16;++r){C0[r]-=dl;C1[r]-=dl;} \
        _Pragma("unroll") for(int r=0;r<16;++r)negm[r]=-mhat; asm volatile("":"+v"(negm)); \
        const float f=__builtin_amdgcn_exp2f(-dl); l_reg*=f; if(hi==0)wsf[r32]=f; resc=true; } } \
    SBAR(); float sacc=0.f; \
    GB0(o[0]=MF(PAF(0),VFR(0),o[0]), C0,0); \
    GB0(o[1]=MF(PAF(0),VFR(1),o[1]), C0,2); \
    GB0(o[2]=MF(PAF(0),VFR(2),o[2]), C0,4); \
    GB0(o[3]=MF(PAF(0),VFR(3),o[3]), C0,6); \
    VRS(0,2);  GB1(o[0]=MF(PAF(1),VFR(4),o[0]), C0,8,  pw0[0],C0,0); \
    VRS(1,6);  GB1(o[1]=MF(PAF(1),VFR(5),o[1]), C0,10, pw0[1],C0,2); \
    VRS(2,10); GB1(o[2]=MF(PAF(1),VFR(6),o[2]), C0,12, pw0[2],C0,4); \
    VRS(3,14); GB1(o[3]=MF(PAF(1),VFR(7),o[3]), C0,14, pw0[3],C0,6); \
    VRS(4,3);  KRD(GL,0); GB1(o[0]=MF(PAF(2),VFR(0),o[0]), C1,0, pw1[0],C0,8); \
    VRS(5,7);  KRD(GL,1); GB1(o[1]=MF(PAF(2),VFR(1),o[1]), C1,2, pw1[1],C0,10); \
    VRS(6,11); GB1(o[2]=MF(PAF(2),VFR(2),o[2]), C1,4, pw1[2],C0,12); \
    VRS(7,15); GB1(o[3]=MF(PAF(2),VFR(3),o[3]), C1,6, pw1[3],C0,14); \
    KRD(GL,2); GB1(o[0]=MF(PAF(3),VFR(4),o[0]), C1,8,  pw2[0],C1,0); \
    KRD(GL,3); GB1(o[1]=MF(PAF(3),VFR(5),o[1]), C1,10, pw2[1],C1,2); \
    GB1(o[2]=MF(PAF(3),VFR(6),o[2]), C1,12, pw2[2],C1,4); \
    GB1(o[3]=MF(PAF(3),VFR(7),o[3]), C1,14, pw2[3],C1,6); \
    sacc+=C1[8];sacc+=C1[9];pw3[0]=PKW(C1,8); sacc+=C1[10];sacc+=C1[11];pw3[1]=PKW(C1,10); sacc+=C1[12];sacc+=C1[13];pw3[2]=PKW(C1,12); sacc+=C1[14];sacc+=C1[15];pw3[3]=PKW(C1,14); \
    l_reg+=sacc; \
    if(GK){DMA_K((t)+3,sl_cur);} if(GV){DMA_V((t)+1,sl_next);}   \
    }while(0)
  int t=1;
  #undef CMASK
  #define CMASK(P0,P1,t) do{}while(0)
  STAMP_DECL
  for(;t+7<NT;t+=2){
    STEP(t,true,true,true);     STAMP_PRE WAIT_BAR(3); STAMP_POST RESC(); ROT();
    STEP(t+1,true,true,true);   STAMP_PRE WAIT_BAR(3); STAMP_POST RESC(); ROT();
  }
  STAMP_FINI
  #undef CMASK
  #define CMASK(P0,P1,t) do{int jb_=(t)-(NT-4); if(jb_>=-2 && (32*wid-(64*jb_+63))<113)biasmask(P0,P1,jb_,qrel,hi,bl);}while(0)
  #define ENDW(tt) do{ if((tt)+3<NT){WAIT_BAR(3);} else if((tt)+2<NT){WAIT_BAR(2);} else {WAIT_BAR(0);} }while(0)
  for(;t+1<NT;t+=2){
    STEP(t,(t+3<NT),(t+1<NT),(t+1<NT));       ENDW(t);   RESC(); ROT();
    STEP(t+1,(t+4<NT),(t+2<NT),(t+2<NT));     ENDW(t+1); RESC(); ROT();
  }
  STEP(NT-1,false,false,false); RESC();
  SBAR(); pv128(o,vb0+2*sl_cur,PAF(0),PAF(1),PAF(2),PAF(3));
  #undef PKW
  #undef PAF
  #undef VFR
  #undef PIN
  #undef MX3
  #undef EX
  #undef EX2
  #undef GA
  #undef GB0
  #undef GB1
  #undef VRS
  #undef KRD
  #undef MF
  #undef QL
  #undef STEP
  #undef ENDW
  {auto rr=__builtin_amdgcn_permlane32_swap(__float_as_uint(l_reg),__float_as_uint(l_reg),false,false);l_reg=__uint_as_float(rr[0])+__uint_as_float(rr[1]);}
  if(hi==0)wsf[32+r32]=1.0f/l_reg;
  asm volatile("s_waitcnt lgkmcnt(0)":::"memory");
  float rli[16];
  #pragma unroll
  for(int r=0;r<16;++r)rli[r]=wsf[32+crow(r,hi)];
  { asm volatile("":"+s"(Op)); }
  bf16*Ow=Op+(long)(q0+wid*QBLK)*LDO;
  { bf16*stg=(bf16*)(shm+W_LDS_OST)+wid*2048;
    int lane_e=lane; asm volatile("":"+v"(lane_e));
    #pragma unroll
    for(int ph=0;ph<2;++ph){
      #pragma unroll
      for(int r=0;r<16;++r){const int orow=crow(r,hi);
        #pragma unroll
        for(int d0=0;d0<2;++d0)stg[orow*64+d0*32+r32]=__float2bfloat16(o[2*ph+d0][r]*rli[r]);}
      asm volatile("s_waitcnt lgkmcnt(0)":::"memory");
      #pragma unroll
      for(int i=0;i<4;++i){const int row=i*8+(lane_e>>3),ch=lane_e&7; const u32x4 v=*(const u32x4*)(stg+row*64+ch*8); *(u32x4*)(Ow+(long)row*LDO+ph*64+ch*8)=v;}
      asm volatile("s_waitcnt lgkmcnt(0)":::"memory"); } }
  asm volatile("s_waitcnt lgkmcnt(0)\n\ts_barrier":::"memory");
  #undef DMA_K
  #undef DMA_V
  #undef CMASK
  #undef RESC
  #undef ROT
}


constexpr int F_KSL=4096, F_VSL=8192;
constexpr int F_LDS_K=0, F_LDS_V=4*F_KSL, F_LDS_WS=4*F_KSL+4*F_VSL, F_LDS_OST=F_LDS_WS+NW*128*4+8192, F_LDS_BIAS=F_LDS_OST+NW*4096, F_LDS_BYTES=F_LDS_BIAS+512;
typedef int v8i_t __attribute__((ext_vector_type(8)));
typedef int v4i_t __attribute__((ext_vector_type(4)));
constexpr float PSH=5.f;
template<int THRL> __device__ __forceinline__ void attn_unit128f(const unsigned char*Qp8,const unsigned char*__restrict__ Kp8,const unsigned char*__restrict__ VT,bf16*Op,int q0,int NT,const float*biasG,char*shm,int wv,bf16*Yp,const float*gnp,float lam,float gmul STAMP_PARAM){
  const int lane=lane_now();
  asm volatile("":"+s"(wv)); const int wid=__builtin_amdgcn_readfirstlane(wv), tid=wid*64+lane, r32=lane&31, hi=lane>>5;
  constexpr long LDB=2L*LDQ;
  const unsigned lds0=(unsigned)(uintptr_t)shm;
  float*wsf=(float*)(shm+F_LDS_WS)+wid*128;
  const lds_cptr shm3=(lds_cptr)shm;
  asm volatile("":"+s"(biasG));
  glds16((const char*)biasG+wid*1024+lane*16,(unsigned)__builtin_amdgcn_readfirstlane(lds0+LDS_BT4+wid*1024));
  const __amdgpu_buffer_rsrc_t rs=__builtin_amdgcn_make_buffer_rsrc((void*)Kp8,0,0x7ffffff0,0x00020000);
  const unsigned kvo=(unsigned)(lane*(int)LDB+16*(wid&3));
  const unsigned vvo=(unsigned)(lane*SEQ+16*(wid&3));
  const unsigned vrel=(unsigned)(VT-Kp8);
  typedef __attribute__((address_space(3))) unsigned* lds_uptr;
  #define DK(t,slot) __builtin_amdgcn_raw_ptr_buffer_load_lds(rs,(lds_uptr)(shm3+F_LDS_K+(wid&3)*1024+(slot)),16,(int)kvo,(int)((t)*(KVBLK*(int)LDB)),0,0)
  #define DV(t,slot) do{ __builtin_amdgcn_raw_ptr_buffer_load_lds(rs,(lds_uptr)(shm3+F_LDS_V+(wid&3)*2048+(slot)),16,(int)vvo,(int)(vrel+(unsigned)((t)*KVBLK)),0,0); \
      __builtin_amdgcn_raw_ptr_buffer_load_lds(rs,(lds_uptr)(shm3+F_LDS_V+(wid&3)*2048+1024+(slot)),16,(int)vvo,(int)(vrel+(unsigned)(64*SEQ)+(unsigned)((t)*KVBLK)),0,0); }while(0)
  #define KLD(dst,base) do{ dst=__builtin_shufflevector(*(const __attribute__((address_space(3))) v4i_t*)(base),*(const __attribute__((address_space(3))) v4i_t*)((base)+1024),0,1,2,3,4,5,6,7); }while(0)
  #define MFQ(a,b,c) __builtin_amdgcn_mfma_scale_f32_32x32x64_f8f6f4(a,b,c,0,0,0,0x00007A7D,1,0x00007A7D)
  v8i_t kf[2];
  const lds_cptr kp0=shm3+F_LDS_K+hi*2048+r32*16; const lds_cptr vp0=shm3+F_LDS_V+hi*4096+r32*16;
  if(wid<4){ DK(0,0); DV(0,0); } else { DK(1,F_KSL); DV(1,F_VSL); }
  SBAR();
  v8i_t qf; { const unsigned char*qp=Qp8+(long)(q0+wid*QBLK+r32)*LDB+32*hi; qf=__builtin_shufflevector(*(const v4i_t*)qp,*(const v4i_t*)(qp+16),0,1,2,3,4,5,6,7); }
  f32x16 o[4];o[0]=f32x16{};o[1]=f32x16{};o[2]=f32x16{};o[3]=f32x16{};pg8::f32x4 l4={0.f,0.f,0.f,0.f};f32x16 negm=f32x16{};asm volatile("":"+v"(negm));
  v8i_t ones8; { const int ov_=(((lane>>4)&1)==((lane>>3)&1))?0x50505050:0; ones8=(v8i_t){ov_,ov_,ov_,ov_,ov_,ov_,ov_,ov_}; } asm volatile("":"+v"(ones8));
  #define MFL(a,c) __builtin_amdgcn_mfma_scale_f32_16x16x128_f8f6f4(a,ones8,c,0,0,0,0x00007C7F,1,0x00007C7F)
  #define CMASK(P0,P1,t) do{int jb_=(t)-(NT-4); if(jb_>=-2 && (32*wid-(64*jb_+63))<113){ const int l_=lane_now(); BMF(P0,P1,jb_,wid*QBLK+(l_&31),l_>>5); } }while(0)
  bool resc=false;
  #define RESC() do{ if(resc){ asm volatile("s_waitcnt lgkmcnt(0)":::"memory"); const int l_=lane_now(), h_=l_>>5, lr_=4*(l_>>4)+16*((l_>>3)&1);     \
      _Pragma("unroll") for(int d_=0;d_<4;++d_) _Pragma("unroll") for(int r=0;r<16;++r)o[d_][r]*=wsf[crow(r,h_)]; \
      _Pragma("unroll") for(int i_=0;i_<4;++i_)l4[i_]*=wsf[lr_+i_]; } }while(0)
  f32x16 C0,C1; v8i_t PA,PB;
  #if defined(PROBE_XLDS)
  v4i_t xdummy={0,0,0,0}; asm volatile("":"+v"(xdummy));
  #endif
  #define PK8(X,B) __builtin_amdgcn_cvt_pk_fp8_f32(X[B+2],X[B+3],__builtin_amdgcn_cvt_pk_fp8_f32(X[B],X[B+1],0,false),true)
  SBAR();
  if(wid<4){ DK(2,2*F_KSL); } else { DK(3,3*F_KSL); }
  WAIT_BAR(5);
  { KLD(kf[0],kp0); KLD(kf[1],kp0+512); C0=MFQ(kf[0],qf,negm); C1=MFQ(kf[1],qf,negm); }
  asm volatile("s_nop 15\n\ts_nop 7":"+v"(C0),"+v"(C1));CMASK(C0,C1,0);
  { const float rm=rowmax(C0,C1); const float mhat=rm-PSH;
    _Pragma("unroll") for(int r=0;r<16;++r)negm[r]=-mhat; asm volatile("":"+v"(negm));
    _Pragma("unroll") for(int r=0;r<16;++r){C0[r]=__builtin_amdgcn_exp2f(C0[r]-mhat);C1[r]=__builtin_amdgcn_exp2f(C1[r]-mhat);}
    PA=(v8i_t){PK8(C0,0),PK8(C0,4),PK8(C0,8),PK8(C0,12),PK8(C1,0),PK8(C1,4),PK8(C1,8),PK8(C1,12)}; PB=PA; }
  WAIT_BAR(0);
  KLD(kf[0],kp0+F_KSL); KLD(kf[1],kp0+F_KSL+512);
  v8i_t vf[2];
  #define PIN(x) asm volatile("":"+v"(x))
  #define PK8O(X,B,OLD) __builtin_amdgcn_cvt_pk_fp8_f32(X[B+2],X[B+3],__builtin_amdgcn_cvt_pk_fp8_f32(X[B],X[B+1],OLD,false),true)
  #define MX3(a,b,c) max3f((a),(b),(c))
  #define EX(v) __builtin_amdgcn_exp2f(v)
  #define GA(MF) do{ MF; SBAR(); }while(0)
  #define VRS(sl,q) do{ vf[sl]=__builtin_shufflevector(*(const __attribute__((address_space(3))) v4i_t*)(vp_+(q)*512),*(const __attribute__((address_space(3))) v4i_t*)(vp_+(q)*512+2048),0,1,2,3,4,5,6,7); SBAR(); }while(0)
  #define KRD(G,j) do{ if(G){ KLD(kf[j],kq_+(j)*512); SBAR(); } }while(0)
  #define MF8(a,b,c) __builtin_amdgcn_mfma_scale_f32_32x32x64_f8f6f4(a,b,c,0,0,0,0x00007C7F,1,0x00007C7F)
  #define GB(q,PC,PN,X,B,D0,D1) do{ o[q]=MF8(PC,vf[(q)&1],o[q]); if((q)<2){ VRS((q)&1,(q)+2); } \
      { float e0_=EX(X[B]),e1_=EX(X[B+1]),e2_=EX(X[B+2]),e3_=EX(X[B+3]),e4_=EX(X[B+4]),e5_=EX(X[B+5]),e6_=EX(X[B+6]),e7_=EX(X[B+7]); \
        asm volatile("":"+v"(e0_),"+v"(e1_),"+v"(e2_),"+v"(e3_),"+v"(e4_),"+v"(e5_),"+v"(e6_),"+v"(e7_)); \
        X[B]=e0_;X[B+1]=e1_;X[B+2]=e2_;X[B+3]=e3_;X[B+4]=e4_;X[B+5]=e5_;X[B+6]=e6_;X[B+7]=e7_; \
        { int pk0_=PK8O(X,B,PN[D0]),pk1_=PK8O(X,B+4,PN[D1]); PIN(pk0_); PIN(pk1_); PN[D0]=pk0_; PN[D1]=pk1_; } } XTRA(X,B); SBAR(); }while(0)
  #define PH_A(t,PS,VR,PRA,PR) do{ __builtin_amdgcn_s_setprio(PRA); \
    if(VR){ VRS(0,0); } GA(C0=MFQ(kf[0],qf,negm)); \
    if(VR){ VRS(1,1); } GA(C1=MFQ(kf[1],qf,negm)); \
    l4=MFL(PS,l4); SBAR();     \
    asm volatile("s_nop 15\n\ts_nop 2":"+v"(C0),"+v"(C1));     \
    CMASK(C0,C1,t); \
    { float a,b;     \
      asm("v_max3_f32 %0, %2, %3, %4\n\tv_max3_f32 %1, %5, %6, %7\n\tv_max3_f32 %0, %0, %8, %9\n\tv_max3_f32 %1, %1, %10, %11\n\tv_max3_f32 %0, %0, %12, %13\n\tv_max3_f32 %1, %1, %14, %15\n\tv_max3_f32 %0, %0, %16, %17" \
          :"=&v"(a),"=&v"(b):"v"(C0[0]),"v"(C0[1]),"v"(C0[2]),"v"(C0[3]),"v"(C0[4]),"v"(C0[5]),"v"(C0[6]),"v"(C0[7]),"v"(C0[8]),"v"(C0[9]),"v"(C0[10]),"v"(C0[11]),"v"(C0[12]),"v"(C0[13]),"v"(C0[14]),"v"(C0[15])); \
      asm("v_max3_f32 %1, %1, %2, %3\n\tv_max3_f32 %0, %0, %4, %5\n\tv_max3_f32 %1, %1, %6, %7\n\tv_max3_f32 %0, %0, %8, %9\n\tv_max3_f32 %1, %1, %10, %11\n\tv_max3_f32 %0, %0, %12, %13\n\tv_max3_f32 %1, %1, %14, %15\n\tv_max3_f32 %0, %0, %16, %17\n\tv_max_f32 %0, %0, %1" \
          :"+v"(a),"+v"(b):"v"(C1[0]),"v"(C1[1]),"v"(C1[2]),"v"(C1[3]),"v"(C1[4]),"v"(C1[5]),"v"(C1[6]),"v"(C1[7]),"v"(C1[8]),"v"(C1[9]),"v"(C1[10]),"v"(C1[11]),"v"(C1[12]),"v"(C1[13]),"v"(C1[14]),"v"(C1[15])); \
      float rm=a; \
      resc=false; \
      if(__builtin_expect(__any(rm>(float)THRL),0)){ { auto rr=__builtin_amdgcn_permlane32_swap(__float_as_uint(rm),__float_as_uint(rm),false,false); rm=__builtin_fmaxf(__uint_as_float(rr[0]),__uint_as_float(rr[1])); } \
        const float dl=__builtin_fmaxf(rm-PSH,0.f); const float nm_=negm[0]-dl;     \
        _Pragma("unroll") for(int r=0;r<16;++r){C0[r]-=dl;C1[r]-=dl;} \
        _Pragma("unroll") for(int r=0;r<16;++r)negm[r]=nm_; asm volatile("":"+v"(negm)); \
        const float f=__builtin_amdgcn_exp2f(-dl); { const int l_=lane_now(); if(l_<32)wsf[l_]=f; } resc=true; } } \
    __builtin_amdgcn_s_setprio(PR); SBAR(); }while(0)
  #define PH_B(PC,PN,GL) do{ \
    KRD(GL,0); GB(0,PC,PN,C0,0,0,1); \
    GB(1,PC,PN,C0,8,2,3); \
    KRD(GL,1); GB(2,PC,PN,C1,0,4,5); \
    GB(3,PC,PN,C1,8,6,7); }while(0)
  #if defined(PROBE_XEXP)
  #define XTRA(X,B) do{ float d_; asm volatile("v_exp_f32 %0, %1\n\tv_exp_f32 %0, %2\n\tv_exp_f32 %0, %3\n\tv_exp_f32 %0, %4\n\tv_exp_f32 %0, %1\n\tv_exp_f32 %0, %2\n\tv_exp_f32 %0, %3\n\tv_exp_f32 %0, %4":"=&v"(d_):"v"(X[B]),"v"(X[B+1]),"v"(X[B+2]),"v"(X[B+3])); }while(0)
  #elif defined(PROBE_XCVT)
  #define XTRA(X,B) do{ int d_; asm volatile("v_cvt_pk_fp8_f32 %0, %1, %2\n\tv_cvt_pk_fp8_f32 %0, %3, %4\n\tv_cvt_pk_fp8_f32 %0, %1, %2\n\tv_cvt_pk_fp8_f32 %0, %3, %4\n\tv_cvt_pk_fp8_f32 %0, %1, %2\n\tv_cvt_pk_fp8_f32 %0, %3, %4\n\tv_cvt_pk_fp8_f32 %0, %1, %2\n\tv_cvt_pk_fp8_f32 %0, %3, %4":"=&v"(d_):"v"(X[B]),"v"(X[B+1]),"v"(X[B+2]),"v"(X[B+3])); }while(0)
  #elif defined(PROBE_XMFMA)
  #define XTRA(X,B) do{ pg8::f32x4 d_=__builtin_amdgcn_mfma_scale_f32_16x16x128_f8f6f4(PA,ones8,l4,0,0,0,0x00007C7F,1,0x00007C7F); asm volatile("":"+v"(d_)); }while(0)
  #elif defined(PROBE_XLDS)
  #define XTRA(X,B) do{ asm volatile("ds_read_b128 %0, %1":"+v"(xdummy):"v"((unsigned)(uintptr_t)vp_):"memory"); }while(0)
  #elif defined(PROBE_XNOP)
  #define XTRA(X,B) do{ asm volatile("s_nop 15\n\ts_nop 15"); }while(0)
  #elif defined(PROBE_XADD)
  #define XTRA(X,B) do{ float d_; asm volatile("v_add_f32 %0, %1, %2\n\tv_add_f32 %0, %3, %4\n\tv_add_f32 %0, %1, %2\n\tv_add_f32 %0, %3, %4\n\tv_add_f32 %0, %1, %2\n\tv_add_f32 %0, %3, %4\n\tv_add_f32 %0, %1, %2\n\tv_add_f32 %0, %3, %4":"=&v"(d_):"v"(X[B]),"v"(X[B+1]),"v"(X[B+2]),"v"(X[B+3])); }while(0)
  #else
  #define XTRA(X,B) do{}while(0)
  #endif
  #define ST1(t,PC,PN,VS,KS,GL,PRA_,PRB_) do{ SBAR(); \
    const lds_cptr vp_=vp0+(VS); const lds_cptr kq_=kp0+(KS); \
    SP_A0 PH_A(t,PC,true,PRA_,PRB_); SP_A1 \
    SP_B0 PH_B(PC,PN,GL); SP_B1 \
    RESC(); }while(0)
  #define ST2(t,PC,PN,VS,KS,GL,GA2,PRA_,PRB_) do{ SBAR(); \
    const lds_cptr vp_=vp0+(VS); const lds_cptr kq_=kp0+(KS); \
    SP_B0 VRS(0,0); VRS(1,1); \
    PH_B(PC,PN,GL); SP_B1 \
    RESC(); \
    SP_A0 if(GA2){ PH_A((t)+1,PN,false,PRA_,PRB_); } SP_A1 \
    }while(0)
  if(wid>=4){ const lds_cptr vp_=vp0; PH_A(1,PA,false,PRIO_G2A2,PRIO_G2B1); }
  asm volatile("s_waitcnt lgkmcnt(0)\n\ts_barrier":::"memory");
  int vb=0, kb=2*F_KSL, t=1;
  #define IV1(t,GK3) do{ if(GK3){ DK((t)+3,kb^(2*F_KSL)); } DV((t)+1,vb^(2*F_VSL)); \
      ST1(t,PA,PB,vb,kb,true,PRIO_G1A1,PRIO_G1B1); ST1((t)+1,PB,PA,vb+F_VSL,kb+F_KSL,true,PRIO_G1A2,PRIO_G1B2); \
      SP_W0 WAIT_BAR(0); SP_W1 vb^=2*F_VSL; kb^=2*F_KSL; }while(0)
  #define IV2(t,GK4) do{ if(GK4){ DK((t)+4,(kb^(2*F_KSL))+F_KSL); } DV((t)+2,(vb^(2*F_VSL))+F_VSL); \
      ST2(t,PA,PB,vb,kb,true,true,PRIO_G2A1,PRIO_G2B2); ST2((t)+1,PB,PA,vb+F_VSL,kb+F_KSL,true,true,PRIO_G2A2,PRIO_G2B1); \
      SP_W0 WAIT_BAR(0); SP_W1 vb^=2*F_VSL; kb^=2*F_KSL; }while(0)
  if(wid<4){
    #undef CMASK
    #define CMASK(P0,P1,t) do{}while(0)
    STAMP_DECL
    for(;t+8<NT;t+=2){ IV1(t,true); }
    STAMP_FINI
    #undef CMASK
    #define CMASK(P0,P1,t) do{int jb_=(t)-(NT-4); if(jb_>=-2 && (32*wid-(64*jb_+63))<113){ const int l_=lane_now(); BMF(P0,P1,jb_,wid*QBLK+(l_&31),l_>>5); } }while(0)
    for(;t+1<NT;t+=2){ IV1(t,(t+3<NT)); }
    ST1(NT-1,PA,PB,vb,kb,false,PRIO_G1A1,PRIO_G1B1);
  } else {
    #undef CMASK
    #define CMASK(P0,P1,t) do{}while(0)
    STAMP_DECL
    for(;t+8<NT;t+=2){ IV2(t,true); }
    STAMP_FINI
    #undef CMASK
    #define CMASK(P0,P1,t) do{int jb_=(t)-(NT-4); if(jb_>=-2 && (32*wid-(64*jb_+63))<113){ const int l_=lane_now(); BMF(P0,P1,jb_,wid*QBLK+(l_&31),l_>>5); } }while(0)
    for(;t+1<NT;t+=2){ IV2(t,(t+4<NT)); }
    ST2(NT-1,PA,PB,vb,kb,false,false,0,0);
  }
  #if defined(PROBE_XLDS)
  asm volatile("s_waitcnt lgkmcnt(0)":"+v"(xdummy)::"memory");
  #endif
  __builtin_amdgcn_s_setprio(0);
  { SBAR(); const lds_cptr vp_=vp0+vb+F_VSL; VRS(0,0);VRS(1,1);
    o[0]=MF8(PB,vf[0],o[0]); o[1]=MF8(PB,vf[1],o[1]); VRS(0,2);VRS(1,3); o[2]=MF8(PB,vf[0],o[2]); o[3]=MF8(PB,vf[1],o[3]); l4=MFL(PB,l4); }
  #undef PK8
  #undef PK8O
  #undef PIN
  #undef MX3
  #undef EX
  #undef GA
  #undef GB
  #undef VRS
  #undef KRD
  #undef MFQ
  #undef MF8
  #undef MFL
  #undef KLD
  #undef ST1
  #undef ST2
  #undef IV1
  #undef IV2
  #undef XTRA
  #undef PH_A
  #undef PH_B
  float rli[16];
  const int lane_e=lane_now(), r32e=lane_e&31, hie=lane_e>>5;
  if((lane_e&7)==0){ const int lr_=4*(lane_e>>4)+16*((lane_e>>3)&1); _Pragma("unroll") for(int i_=0;i_<4;++i_)wsf[64+lr_+i_]=l4[i_]; }
  asm volatile("s_waitcnt lgkmcnt(0)":::"memory");
  #pragma unroll
  for(int r=0;r<16;++r)rli[r]=1.0f/wsf[64+crow(r,hie)];
  { asm volatile("":"+s"(Op)); }
  bf16*Ow=Op+(long)(q0+wid*QBLK)*LDO;
  bf16*stg=(bf16*)(shm+F_LDS_OST)+wid*2048;
  if(Yp==nullptr){
    #pragma unroll
    for(int ph=0;ph<2;++ph){
      #pragma unroll
      for(int r=0;r<16;++r){const int orow=crow(r,hie);
        #pragma unroll
        for(int d0=0;d0<2;++d0)stg[orow*64+d0*32+r32e]=__float2bfloat16(o[2*ph+d0][r]*rli[r]);}
      asm volatile("s_waitcnt lgkmcnt(0)":::"memory");
      #pragma unroll
      for(int i=0;i<4;++i){const int row=i*8+(lane_e>>3),ch=lane_e&7; const u32x4 v=*(const u32x4*)(stg+row*64+ch*8); *(u32x4*)(Ow+(long)row*LDO+ph*64+ch*8)=v;}
      asm volatile("s_waitcnt lgkmcnt(0)":::"memory"); }
  } else {
    asm volatile("":"+s"(Yp),"+s"(gnp));
    const int ch=lane_e&7, rw=lane_e>>3;
    u32x4 o1v[2][4], o2v[2][4]; float gnv[2][8];
    #pragma unroll
    for(int ph=0;ph<2;++ph){
      #pragma unroll
      for(int i=0;i<4;++i) o1v[ph][i]=*(const u32x4*)(Ow+(long)(i*8+rw)*LDO+ph*64+ch*8);
      #pragma unroll
      for(int k=0;k<8;++k) gnv[ph][k]=gnp[ph*64+ch*8+k]*gmul; }
    #pragma unroll
    for(int ph=0;ph<2;++ph){
      #pragma unroll
      for(int r=0;r<16;++r){const int orow=crow(r,hie);
        #pragma unroll
        for(int d0=0;d0<2;++d0)stg[orow*64+d0*32+r32e]=__float2bfloat16(o[2*ph+d0][r]*rli[r]);}
      asm volatile("s_waitcnt lgkmcnt(0)":::"memory");
      #pragma unroll
      for(int i=0;i<4;++i) o2v[ph][i]=*(const u32x4*)(stg+(i*8+rw)*64+ch*8);
      asm volatile("s_waitcnt lgkmcnt(0)":::"memory"); }
    bf16*Yw=Yp+(long)(q0+wid*QBLK)*1024;
    #pragma unroll
    for(int i=0;i<4;++i){
      float v[2][8]; float sq=0.f;
      #pragma unroll
      for(int ph=0;ph<2;++ph){ const u32x4 a=o1v[ph][i], b=o2v[ph][i];
        v[ph][0]=bflo(a.x)-lam*bflo(b.x); v[ph][1]=bfhi(a.x)-lam*bfhi(b.x); v[ph][2]=bflo(a.y)-lam*bflo(b.y); v[ph][3]=bfhi(a.y)-lam*bfhi(b.y);
        v[ph][4]=bflo(a.z)-lam*bflo(b.z); v[ph][5]=bfhi(a.z)-lam*bfhi(b.z); v[ph][6]=bflo(a.w)-lam*bflo(b.w); v[ph][7]=bfhi(a.w)-lam*bfhi(b.w);
        #pragma unroll
        for(int k=0;k<8;++k) sq+=v[ph][k]*v[ph][k]; }
      sq+=__builtin_bit_cast(float,__builtin_amdgcn_update_dpp(0,__builtin_bit_cast(int,sq),0xB1,0xf,0xf,true));
      sq+=__builtin_bit_cast(float,__builtin_amdgcn_update_dpp(0,__builtin_bit_cast(int,sq),0x4E,0xf,0xf,true));
      sq+=__builtin_bit_cast(float,__builtin_amdgcn_update_dpp(0,__builtin_bit_cast(int,sq),0x141,0xf,0xf,true));
      const float rn=1.0f/sqrtf(sq*(1.0f/128.0f)+1e-6f);
      #pragma unroll
      for(int ph=0;ph<2;++ph){ u32x4 y;
        y.x=cvtpk_s(v[ph][0]*rn*gnv[ph][0],v[ph][1]*rn*gnv[ph][1]); y.y=cvtpk_s(v[ph][2]*rn*gnv[ph][2],v[ph][3]*rn*gnv[ph][3]);
        y.z=cvtpk_s(v[ph][4]*rn*gnv[ph][4],v[ph][5]*rn*gnv[ph][5]); y.w=cvtpk_s(v[ph][6]*rn*gnv[ph][6],v[ph][7]*rn*gnv[ph][7]);
        *(u32x4*)(Yw+(long)(i*8+rw)*1024+ph*64+ch*8)=y; } }
  }
  asm volatile("s_waitcnt lgkmcnt(0)\n\ts_barrier":::"memory");
  #undef DK
  #undef DV
  #undef CMASK
  #undef RESC
}
#undef SBAR
#undef WAIT_BAR
}

#ifndef STAMP_BLOCK
#define STAMP_BLOCK 0
#endif
#ifndef STAMP_SCALE
#define STAMP_SCALE 10000
#endif
constexpr int NWAVES = 8;
#ifndef MK_N_LAUNCHES
#define MK_N_LAUNCHES 1
#endif
constexpr int N_PHASES = 13;
constexpr int N_LAUNCHES = MK_N_LAUNCHES;

constexpr int BATCH = 2, T = 16384, D = 1024, M = BATCH * T;
constexpr int NPROJ = 3072;
constexpr int NEXP = 32, EFF = 512;
constexpr float EPS = 1e-6f, LOG2E = 1.4426950408889634f;
constexpr float LAMBDA_INIT = 0.2f;
constexpr int MOBA_CAP = 256 * 2016;

constexpr size_t MiB = 1u << 20;
constexpr size_t WS_CTL = 0, CTL_ZERO_BYTES = 1 * MiB;
constexpr size_t WS_MOD = 1 * MiB;
constexpr size_t WS_BIASG = 1 * MiB + 64 * 1024;
constexpr size_t WS_BT4 = 1 * MiB + 128 * 1024;
constexpr size_t WS_KMEAN = 512 * 1024;
constexpr size_t WS_TOKW = 2 * MiB;
constexpr size_t WS_ELIST = 3 * MiB;
constexpr size_t WS_WIN = 8 * MiB, WS_WOUT = 14 * MiB;
constexpr size_t WS_XN = 16 * MiB;
constexpr size_t WS_QKV = 80 * MiB;
constexpr size_t WS_OD = 272 * MiB;
constexpr size_t WS_PO = 336 * MiB;
constexpr size_t WS_PML = 432 * MiB;
constexpr size_t WS_MLIST = 438 * MiB;
constexpr float W8_SCALE = 32.f, HID8_SCALE = 8.f, Y8_SCALE = 16.f;
constexpr size_t WS_WGU = 336 * MiB, WS_WD = 400 * MiB;
constexpr size_t WS_YO = 80 * MiB;
constexpr size_t WS_HID = 208 * MiB;
constexpr size_t WS_SO = 80 * MiB;
constexpr size_t WS_X1B = 432 * MiB;
constexpr size_t WS_VT8 = 496 * MiB;
constexpr size_t WS_END = 512 * MiB;
static_assert(WS_X1B + (size_t)M * 1024 * 2 <= WS_END && WS_X1B >= WS_WD + (size_t)32 * 1024 * 512 * 2, "d_ws map");
static_assert(WS_MLIST + (size_t)16 * MOBA_CAP * 4 <= WS_END && WS_PML + (size_t)3 * M * 16 * 4 <= WS_MLIST && WS_PO + (size_t)3 * M * 512 * 2 <= WS_PML, "d_ws map");
static_assert(WS_HID + (size_t)73728 * 512 * 2 <= WS_WGU && WS_SO + (size_t)M * 2 * 1024 * 2 <= WS_HID && WS_WD + (size_t)32 * 1024 * 512 * 2 <= WS_PML, "d_ws map");
constexpr int CW_BAR = 4096;
constexpr int CW_MCNT = 16384;
constexpr int CW_ECNT = 16384 + 1024 * 16;
static_assert((CW_ECNT + 32 * 64) * 4 <= (int)CTL_ZERO_BYTES, "CTL words inside the memset region");

constexpr int RING_OFF = 0, RING_BYTES = 131072;
constexpr int LDSCTL_OFF = 147456, MISC_OFF = LDSCTL_OFF + 320;
constexpr int LDS_BYTES = 148480;
static_assert(MISC_OFF + 128 <= LDS_BYTES, "LDS map");

#define GAS __attribute__((address_space(1)))
#define LAS __attribute__((address_space(3)))
typedef unsigned short bf16;
typedef unsigned v4u __attribute__((ext_vector_type(4)));
typedef unsigned v2u __attribute__((ext_vector_type(2)));
typedef float f32x4 __attribute__((ext_vector_type(4)));
typedef float f32x2 __attribute__((ext_vector_type(2)));
typedef GAS unsigned gu32;
#define RLX_AGENT __ATOMIC_RELAXED, __HIP_MEMORY_SCOPE_AGENT
#define LDS_WAIT() asm volatile("s_waitcnt lgkmcnt(0)" ::: "memory")
#define VM_WAIT() asm volatile("s_waitcnt vmcnt(0)" ::: "memory")
__device__ __forceinline__ unsigned f2bf(float f) { unsigned u = __builtin_bit_cast(unsigned, f); return (u + 0x7fffu + ((u >> 16) & 1u)) >> 16; }
__device__ __forceinline__ unsigned pk2(float lo, float hi) { return f2bf(lo) | (f2bf(hi) << 16); }
__device__ __forceinline__ float bf_lo(unsigned u) { return __uint_as_float(u << 16); }
__device__ __forceinline__ float bf_hi(unsigned u) { return __uint_as_float(u & 0xffff0000u); }

#define XB_TMO      128
#define XB_XCNT(j)  (256  + 64 * (j))
#define XB_XSUB(j)  (1280 + 64 * (j))
#define XB_XGEN(j)  (2304 + 64 * (j))
#define XB_TOP      3328
#define XB_TOPGEN   3392
#define XCD_BAR_WORDS 3456
#define XB_SPIN_CAP (1u << 18)

__device__ __forceinline__ unsigned xb_ld(unsigned* p)              { return __hip_atomic_load(p, __ATOMIC_RELAXED, __HIP_MEMORY_SCOPE_AGENT); }
__device__ __forceinline__ unsigned xb_add(unsigned* p, unsigned v) { return __hip_atomic_fetch_add(p, v, __ATOMIC_RELAXED, __HIP_MEMORY_SCOPE_AGENT); }
__device__ __forceinline__ unsigned xb_xcc_id() { return (unsigned)__builtin_amdgcn_s_getreg((3 << 11) | 20) & 0xFu; }
#define XB_SPIN(cond, bar) do { unsigned _sp = 0; while (cond) { __builtin_amdgcn_s_sleep(1); \
    if ((++_sp & 255u) == 0u) { if (xb_ld(&(bar)[XB_TMO])) break; if (_sp > XB_SPIN_CAP) { atomicAdd(&(bar)[XB_TMO], 1u); break; } } } } while (0)

struct XcdBarrier {
    unsigned* bar; unsigned x;
    volatile LAS unsigned* st;
};
__device__ __forceinline__ XcdBarrier xcd_barrier_post(unsigned* bar, volatile LAS unsigned* st, bool leader  ) {
    XcdBarrier b; b.bar = bar; b.x = xb_xcc_id(); b.st = st;
    if (leader) (void)xb_add(&bar[XB_XCNT(b.x)], 1u);
    return b;
}
__device__ __forceinline__ void xcd_barrier_complete(unsigned* bar, unsigned x, unsigned& nloc, unsigned& nx) {
    const unsigned G = gridDim.x * gridDim.y * gridDim.z;
    unsigned sum, cnt, mine, sp = 0u;
    for (;;) {
        sum = 0u; cnt = 0u; mine = 0u;
#pragma unroll
        for (unsigned j = 0; j < 16; ++j) { const unsigned c = xb_ld(&bar[XB_XCNT(j)]); sum += c; cnt += (c > 0u) ? 1u : 0u; mine = (j == x) ? c : mine; }
        if (sum == G) break;
        __builtin_amdgcn_s_sleep(1);
        if ((++sp & 255u) == 0u) { if (xb_ld(&bar[XB_TMO])) break; if (sp > XB_SPIN_CAP) { atomicAdd(&bar[XB_TMO], 1u); break; } }
    }
    nloc = mine > 0u ? mine : 1u; nx = cnt > 0u ? cnt : 1u;
}
__device__ __forceinline__ void xcd_barrier(const XcdBarrier& b, bool leader  ) {
    asm volatile("s_waitcnt vmcnt(0)" ::: "memory");
    __syncthreads();
    if (leader) {
        unsigned* bar = b.bar;
        __builtin_amdgcn_s_waitcnt(0);
        unsigned nloc = b.st[0], nx = b.st[1];
        if (nloc == 0u) { xcd_barrier_complete(bar, b.x, nloc, nx); b.st[0] = nloc; b.st[1] = nx; }
        const unsigned old = xb_add(&bar[XB_XSUB(b.x)], 1u);
        const unsigned gen = old / nloc;
        if (old + 1u == (gen + 1u) * nloc) {
            __builtin_amdgcn_fence(__ATOMIC_RELEASE, "agent");
            asm volatile("s_waitcnt vmcnt(0)" ::: "memory");
            const unsigned og = xb_add(&bar[XB_TOP], 1u);
            const unsigned tg = og / nx;
            if (og + 1u == (tg + 1u) * nx) xb_add(&bar[XB_TOPGEN], 1u);
            else XB_SPIN(xb_ld(&bar[XB_TOPGEN]) == tg, bar);
            __builtin_amdgcn_fence(__ATOMIC_ACQUIRE, "agent");
            xb_add(&bar[XB_XGEN(b.x)], 1u);
            asm volatile("s_waitcnt vmcnt(0)" ::: "memory");
        } else {
            XB_SPIN(xb_ld(&bar[XB_XGEN(b.x)]) == gen, bar);
            __builtin_amdgcn_fence(__ATOMIC_ACQUIRE, "agent");
            asm volatile("s_waitcnt vmcnt(0)" ::: "memory");
        }
    }
    __syncthreads();
}

struct Frame {
    LAS unsigned char* lds;
    volatile LAS unsigned* MISC;
    gu32* ctl;
    int tid, lane, wave;
    int vcu, G;
    float* out; unsigned char* ws;
};
typedef __attribute__((address_space(4))) const unsigned char* kptr_t;
__device__ __forceinline__ kptr_t karg() { kptr_t p = (kptr_t)__builtin_amdgcn_kernarg_segment_ptr(); asm volatile("" : "+s"(p)); return p; }
#define INP(kp, i) (*(const float* const __attribute__((address_space(4)))*)((kp) + 8 * (i)))
__device__ __forceinline__ float shx(float v, int o, int lane) { return __builtin_bit_cast(float, __builtin_amdgcn_ds_bpermute((lane ^ o) << 2, __builtin_bit_cast(int, v))); }
__device__ __forceinline__ int shfl_i(int v, int src) { return __builtin_amdgcn_ds_bpermute(src << 2, v); }
template<int CTRL> __device__ __forceinline__ float dpp_f(float v) { return __builtin_bit_cast(float, __builtin_amdgcn_update_dpp(0, __builtin_bit_cast(int, v), CTRL, 0xf, 0xf, true)); }
__device__ __forceinline__ float sum16_dpp(float v) {
    v += dpp_f<0xB1>(v); v += dpp_f<0x4E>(v); v += dpp_f<0x141>(v); v += dpp_f<0x140>(v); return v; }
__device__ __forceinline__ float wave_sum(float v, int  ) {
    v = sum16_dpp(v);
    { auto rr = __builtin_amdgcn_permlane16_swap(__float_as_uint(v), __float_as_uint(v), false, false); v = __uint_as_float(rr[0]) + __uint_as_float(rr[1]); }
    { auto rr = __builtin_amdgcn_permlane32_swap(__float_as_uint(v), __float_as_uint(v), false, false); v = __uint_as_float(rr[0]) + __uint_as_float(rr[1]); }
    return v;
}
#define PHASE_BEGIN(F) do { (F).lane = lane_now(); (F).tid = (F).wave * 64 + (F).lane; \
    { const kptr_t kq_ = karg(); (F).out = *(float* const __attribute__((address_space(4)))*)(kq_ + 184); (F).ws = *(unsigned char* const __attribute__((address_space(4)))*)(kq_ + 192); (F).ctl = (gu32*)(F).ws; } } while (0)
__device__ __forceinline__ float silu_f(float v) { return v / (1.f + __expf(-v)); }
__device__ __forceinline__ int rel_bucket(int d) {
    if (d < 16) return d;
    const int thr[15] = {19, 21, 24, 27, 31, 35, 40, 46, 52, 59, 67, 77, 87, 99, 113};
    int b = 16;
#pragma unroll
    for (int i = 0; i < 15; ++i) b += (d >= thr[i]) ? 1 : 0;
    return b;
}
__device__ __forceinline__ void p0_transpose_item(const float* W, int K, int N, bf16* WT, size_t dst_row0, LAS float* scr, int k0, int n0, int lane) {
    {
        f32x4 t_[8]; const int r_ = lane >> 3, c_ = lane & 7;
#pragma unroll
        for (int i = 0; i < 8; ++i) t_[i] = *(const GAS f32x4*)(W + (size_t)(k0 + r_ + 8 * i) * N + n0 + 4 * c_);
#pragma unroll
        for (int i = 0; i < 8; ++i) { LAS float* d_ = scr + (r_ + 8 * i) * 33 + 4 * c_; d_[0] = t_[i].x; d_[1] = t_[i].y; d_[2] = t_[i].z; d_[3] = t_[i].w; } }
    LDS_WAIT(); asm volatile("" ::: "memory");
    const int c = lane & 7;
#pragma unroll
    for (int j = 0; j < 4; ++j) { const int n = (lane >> 3) + 8 * j; const LAS float* s = scr + (8 * c) * 33 + n;
        v4u o; o.x = pk2(s[0 * 33], s[1 * 33]); o.y = pk2(s[2 * 33], s[3 * 33]); o.z = pk2(s[4 * 33], s[5 * 33]); o.w = pk2(s[6 * 33], s[7 * 33]);
        *(GAS v4u*)(WT + (dst_row0 + n) * K + k0 + 8 * c) = o; }
    LDS_WAIT(); asm volatile("" ::: "memory");
}

__device__ __forceinline__ void p0_transpose_item8(const float* W, int K, int N, unsigned char* WT, size_t dst_row0, LAS float* scr, int k0, int n0, int lane) {
    {
        f32x4 t_[8]; const int r_ = lane >> 3, c_ = lane & 7;
#pragma unroll
        for (int i = 0; i < 8; ++i) t_[i] = *(const GAS f32x4*)(W + (size_t)(k0 + r_ + 8 * i) * N + n0 + 4 * c_);
#pragma unroll
        for (int i = 0; i < 8; ++i) { LAS float* d_ = scr + (r_ + 8 * i) * 33 + 4 * c_; d_[0] = t_[i].x; d_[1] = t_[i].y; d_[2] = t_[i].z; d_[3] = t_[i].w; } }
    LDS_WAIT(); asm volatile("" ::: "memory");
    const int c = lane & 3;
#pragma unroll
    for (int j = 0; j < 2; ++j) { const int n = (lane >> 2) + 16 * j; const LAS float* s = scr + (16 * c) * 33 + n;
        int w[4];
#pragma unroll
        for (int q = 0; q < 4; ++q) { int t = 0; t = __builtin_amdgcn_cvt_pk_fp8_f32(s[(4 * q) * 33] * W8_SCALE, s[(4 * q + 1) * 33] * W8_SCALE, t, false);
            t = __builtin_amdgcn_cvt_pk_fp8_f32(s[(4 * q + 2) * 33] * W8_SCALE, s[(4 * q + 3) * 33] * W8_SCALE, t, true); w[q] = t; }
        *(GAS v4u*)(WT + (dst_row0 + n) * K + k0 + 16 * c) = (v4u){(unsigned)w[0], (unsigned)w[1], (unsigned)w[2], (unsigned)w[3]}; }
    LDS_WAIT(); asm volatile("" ::: "memory");
}
__device__ __forceinline__ void p0_prologue(Frame& F) {
    PHASE_BEGIN(F);
    const kptr_t kp = karg();
    const float* c = INP(kp, 1); const float* w_ada = INP(kp, 2); const float* b_ada = INP(kp, 3);
    float* mod = (float*)(F.ws + WS_MOD);
    LAS float* cs = (LAS float*)(F.lds);
    LAS float* part = (LAS float*)(F.lds + 8192);
    for (int cg = blockIdx.x; cg < 192; cg += F.G) {
        for (int i = F.tid; i < 2048; i += NWAVES * 64) cs[i] = silu_f(c[i]);
        __syncthreads();
        const int l31 = F.lane & 31, hf = F.lane >> 5, col = cg * 32 + l31, k0 = (F.wave * 2 + hf) * 64; float a0 = 0.f, a1 = 0.f;
        float wv_[64];
#pragma unroll
        for (int k = 0; k < 64; ++k) wv_[k] = w_ada[(size_t)(k0 + k) * 6144 + col];
#pragma unroll
        for (int k = 0; k < 64; ++k) { a0 += cs[k0 + k] * wv_[k]; a1 += cs[1024 + k0 + k] * wv_[k]; }
        { auto rr = __builtin_amdgcn_permlane32_swap(__float_as_uint(a0), __float_as_uint(a0), false, false); a0 = __uint_as_float(rr[0]) + __uint_as_float(rr[1]); }
        { auto rr = __builtin_amdgcn_permlane32_swap(__float_as_uint(a1), __float_as_uint(a1), false, false); a1 = __uint_as_float(rr[0]) + __uint_as_float(rr[1]); }
        if (hf == 0) { part[(F.wave * 2 + 0) * 32 + l31] = a0; part[(F.wave * 2 + 1) * 32 + l31] = a1; }
        __syncthreads();
        if (F.wave < 2 && hf == 0) { float s = 0.f;
#pragma unroll
            for (int w = 0; w < 8; ++w) s += part[(w * 2 + F.wave) * 32 + l31];
            mod[F.wave * 6144 + col] = s + b_ada[col]; }
        __syncthreads();
    }
    if (blockIdx.x == F.G - 1) {
        const float* rb = INP(kp, 15); float* bg = (float*)(F.ws + WS_BIASG);
        for (int i = F.tid; i < 12 * 128; i += NWAVES * 64) { const int h = i >> 7, d = i & 127; bg[i] = (rb[rel_bucket(d) * 12 + h] - rb[31 * 12 + h]) * LOG2E; }
        float* b4 = (float*)(F.ws + WS_BT4);
        for (int i = F.tid; i < 12 * 2048; i += NWAVES * 64) { const int h = i >> 11, k = i & 2047, d = (k & 511) + (k >> 9) - 256;
            b4[i] = d < 0 ? -INFINITY : (d < 128 ? (rb[rel_bucket(d) * 12 + h] - rb[31 * 12 + h]) * LOG2E : 0.f); }
    }
    __syncthreads();
    LAS float* scr = (LAS float*)(F.lds + RING_OFF + F.wave * 16384);
    const int gw = F.vcu * NWAVES + F.wave, NGW = F.G * NWAVES;
    constexpr int I_IN = 16 * 96, I_OUT = 16 * 32;
    for (int it = gw; it < I_IN + I_OUT; it += NGW) {
        if (it < I_IN) { const int kb = it / 96, nb = it % 96; p0_transpose_item(INP(kp, 8), 1024, 3072, (bf16*)(F.ws + WS_WIN), (size_t)(32 * nb), scr, 64 * kb, 32 * nb, F.lane); }
        else { const int r = it - I_IN, kb = r / 32, nb = r % 32; p0_transpose_item(INP(kp, 14), 1024, 1024, (bf16*)(F.ws + WS_WOUT), (size_t)(32 * nb), scr, 64 * kb, 32 * nb, F.lane); }
    }
}
__device__ __forceinline__ void expert_weights(Frame& F) {
    const kptr_t kp = karg();
    PHASE_BEGIN(F);
    LAS float* scr = (LAS float*)(F.lds + RING_OFF + F.wave * 16384);
    const int gw = F.vcu * NWAVES + F.wave, NGW = F.G * NWAVES;
    constexpr int I_G = 32 * 16 * 16, I_D = 32 * 8 * 32, I_ALL = 2 * I_G + I_D;
#define EW_DECODE(it_, W_, K_, N_, WT_, R0_, k0_, n0_) const float* W_; int K_, N_, k0_, n0_; unsigned char* WT_; size_t R0_; \
    if ((it_) < 2 * I_G) { const int up_ = (it_) >= I_G ? 1 : 0, r_ = (it_) - up_ * I_G, e_ = r_ >> 8, kb_ = (r_ >> 4) & 15, nb_ = r_ & 15; n0_ = 32 * nb_; k0_ = 64 * kb_; K_ = 1024; N_ = 512; \
        W_ = INP(kp, 20 + up_) + (size_t)e_ * 1024 * 512; WT_ = (unsigned char*)(F.ws + WS_WGU); R0_ = (size_t)e_ * 1024 + (n0_ >> 7) * 256 + up_ * 128 + (n0_ & 127); } \
    else { const int r_ = (it_) - 2 * I_G, e_ = r_ >> 8, kb_ = (r_ >> 5) & 7, nb_ = r_ & 31; n0_ = 32 * nb_; k0_ = 64 * kb_; K_ = 512; N_ = 1024; \
        W_ = INP(kp, 22) + (size_t)e_ * 512 * 1024; WT_ = (unsigned char*)(F.ws + WS_WD); R0_ = (size_t)e_ * 1024 + 32 * nb_; }
    f32x4 t_[8]; const int r_l = F.lane >> 3, c_l = F.lane & 7;
    if (gw < I_ALL) { EW_DECODE(gw, W0, K0, N0, WT0, R00, k00, n00);
#pragma unroll
        for (int i = 0; i < 8; ++i) t_[i] = *(const GAS f32x4*)(W0 + (size_t)(k00 + r_l + 8 * i) * N0 + n00 + 4 * c_l); }
    for (int it = gw; it < I_ALL; it += NGW) {
        EW_DECODE(it, W, K, N, WT, R0, k0, n0);
#pragma unroll
        for (int i = 0; i < 8; ++i) { LAS float* d_ = scr + (r_l + 8 * i) * 33 + 4 * c_l; d_[0] = t_[i].x; d_[1] = t_[i].y; d_[2] = t_[i].z; d_[3] = t_[i].w; }
        LDS_WAIT(); asm volatile("" ::: "memory");
        if (it + NGW < I_ALL) { EW_DECODE(it + NGW, Wn, Kn, Nn, WTn, R0n, k0n, n0n);
#pragma unroll
            for (int i = 0; i < 8; ++i) t_[i] = *(const GAS f32x4*)(Wn + (size_t)(k0n + r_l + 8 * i) * Nn + n0n + 4 * c_l); }
        const int c = F.lane & 3;
#pragma unroll
        for (int j = 0; j < 2; ++j) { const int n = (F.lane >> 2) + 16 * j; const LAS float* s = scr + (16 * c) * 33 + n;
            int w[4];
#pragma unroll
            for (int q = 0; q < 4; ++q) { int tt = 0; tt = __builtin_amdgcn_cvt_pk_fp8_f32(s[(4 * q) * 33] * W8_SCALE, s[(4 * q + 1) * 33] * W8_SCALE, tt, false);
                tt = __builtin_amdgcn_cvt_pk_fp8_f32(s[(4 * q + 2) * 33] * W8_SCALE, s[(4 * q + 3) * 33] * W8_SCALE, tt, true); w[q] = tt; }
            *(GAS v4u*)(WT + (R0 + n) * K + k0 + 16 * c) = (v4u){(unsigned)w[0], (unsigned)w[1], (unsigned)w[2], (unsigned)w[3]}; }
        LDS_WAIT(); asm volatile("" ::: "memory");
    }
#undef EW_DECODE
}
__device__ __forceinline__ void p1_prenorm(Frame& F) {
    PHASE_BEGIN(F);
    const kptr_t kp = karg();
    const float* x = INP(kp, 0); const float* gain = INP(kp, 4); const float* mod = (const float*)(F.ws + WS_MOD); bf16* XN = (bf16*)(F.ws + WS_XN);
    const int gw = F.vcu * NWAVES + F.wave, NGW = F.G * NWAVES;
    for (int b = 0; b < BATCH; ++b) {
        f32x4 ge[4], sh[4];
#pragma unroll
        for (int j = 0; j < 4; ++j) { const int c = 4 * F.lane + 256 * j; const f32x4 g = *(const f32x4*)(gain + c), sc = *(const f32x4*)(mod + b * 6144 + 1024 + c); ge[j] = g * (sc + 1.f); sh[j] = *(const f32x4*)(mod + b * 6144 + c); }
        f32x4 nv[4];
        { const GAS f32x4* xr = (const GAS f32x4*)(x + (size_t)(b * T + gw) * D) + F.lane;
#pragma unroll
          for (int j = 0; j < 4; ++j) nv[j] = xr[64 * j]; }
        for (int m = b * T + gw; m < (b + 1) * T; m += NGW) {
            int ln = F.lane; asm volatile("" : "+v"(ln));
            f32x4 v[4]; float s = 0.f;
#pragma unroll
            for (int j = 0; j < 4; ++j) { v[j] = nv[j]; s += (v[j].x * v[j].x + v[j].y * v[j].y) + (v[j].z * v[j].z + v[j].w * v[j].w); }
            { const int mn = (m + NGW < (b + 1) * T) ? m + NGW : m; const GAS f32x4* xr = (const GAS f32x4*)(x + (size_t)mn * D) + ln;
#pragma unroll
              for (int j = 0; j < 4; ++j) nv[j] = xr[64 * j]; }
            const float r = 1.f / sqrtf(wave_sum(s, F.lane) * (1.f / D) + EPS);
            GAS unsigned long long* o8 = (GAS unsigned long long*)(XN + (size_t)m * D) + ln;
#pragma unroll
            for (int j = 0; j < 4; ++j) { const f32x4 h = v[j] * r * ge[j] + sh[j]; o8[64 * j] = (unsigned long long)pk2(h.x, h.y) | ((unsigned long long)pk2(h.z, h.w) << 32); }
        }
    }
}
__device__ __forceinline__ void p3_kmean(Frame& F) {
    PHASE_BEGIN(F);
    const bf16* QKV = (const bf16*)(F.ws + WS_QKV);
    const int gw = F.vcu * NWAVES + F.wave, NGW = F.G * NWAVES;
    LAS unsigned char* tile = (LAS unsigned char*)(F.lds + RING_OFF + F.wave * 16384);
    unsigned char* VT = (unsigned char*)(F.ws + WS_VT8);
    for (int it = gw; it < 2 * 4 * 256; it += NGW) {
        const int b = it >> 10, h = (it >> 8) & 3, t = it & 255;
        const int kk = F.lane, k31 = kk & 31, hi_ = (k31 >> 2) & 1, s_ = (k31 & 3) + 4 * (k31 >> 3) + 16 * (kk >> 5), pos = 32 * hi_ + s_;
        const bf16* src = QKV + ((size_t)(b * T + 64 * t + kk)) * NPROJ + 1024 + h * 128;
#pragma unroll 4
        for (int c = 0; c < 16; ++c) { const v4u v = *(const GAS v4u*)(src + 8 * c);
            const float f[8] = {bf_lo(v.x), bf_hi(v.x), bf_lo(v.y), bf_hi(v.y), bf_lo(v.z), bf_hi(v.z), bf_lo(v.w), bf_hi(v.w)};
            int w0 = 0, w1 = 0;
            w0 = __builtin_amdgcn_cvt_pk_fp8_f32(f[0] * 8.f, f[1] * 8.f, w0, false); w0 = __builtin_amdgcn_cvt_pk_fp8_f32(f[2] * 8.f, f[3] * 8.f, w0, true);
            w1 = __builtin_amdgcn_cvt_pk_fp8_f32(f[4] * 8.f, f[5] * 8.f, w1, false); w1 = __builtin_amdgcn_cvt_pk_fp8_f32(f[6] * 8.f, f[7] * 8.f, w1, true);
#pragma unroll
            for (int j = 0; j < 4; ++j) { tile[(8 * c + j) * 64 + pos] = (unsigned char)((unsigned)w0 >> (8 * j)); tile[(8 * c + 4 + j) * 64 + pos] = (unsigned char)((unsigned)w1 >> (8 * j)); } }
        LDS_WAIT(); asm volatile("" ::: "memory");
#pragma unroll
        for (int i = 0; i < 8; ++i) { const int idx = i * 64 + F.lane, d = idx >> 2, c = idx & 3;
            const v4u o = *(const LAS v4u*)(tile + d * 64 + 16 * c);
            *(GAS v4u*)(VT + ((size_t)((b * 4 + h) * 128 + d)) * T + 64 * t + 16 * c) = o; }
        LDS_WAIT(); asm volatile("" ::: "memory");
    }
}
__device__ __forceinline__ int moba_list_base(int bh, int j) { return bh * MOBA_CAP + 256 * (63 * j - (j * (j - 1)) / 2); }
__device__ __forceinline__ void p4_moba_select(Frame& F) {
    PHASE_BEGIN(F);
    const bf16* QKV = (const bf16*)(F.ws + WS_QKV); const float* km = (const float*)(F.ws + WS_KMEAN); unsigned* mlist = (unsigned*)(F.ws + WS_MLIST);
    LAS float* kml = (LAS float*)(F.lds);
    for (int bi = blockIdx.x, pass = 0; bi < 512; bi += F.G, ++pass) {
        const int bh = bi >> 5, qg = (pass & 1) ? 31 - (bi & 31) : (bi & 31), b = bh >> 3, h = bh & 7;
        for (int i = F.tid; i < 1024; i += NWAVES * 64) ((LAS f32x4*)kml)[i] = ((const f32x4*)(km + (size_t)bh * 4096))[i];
        __syncthreads();
        const int q = qg * 512 + F.wave * 64 + F.lane, own = (qg * 512 + F.wave * 64) >> 8;
        if (own > 0) {
            float qf[64];
            const bf16* qp = QKV + ((size_t)(b * T + q)) * NPROJ + 1536 + h * 64;
#pragma unroll
            for (int c8 = 0; c8 < 8; ++c8) { const v4u v = *(const GAS v4u*)(qp + c8 * 8);
                qf[c8 * 8 + 0] = bf_lo(v.x); qf[c8 * 8 + 1] = bf_hi(v.x); qf[c8 * 8 + 2] = bf_lo(v.y); qf[c8 * 8 + 3] = bf_hi(v.y); qf[c8 * 8 + 4] = bf_lo(v.z); qf[c8 * 8 + 5] = bf_hi(v.z); qf[c8 * 8 + 6] = bf_lo(v.w); qf[c8 * 8 + 7] = bf_hi(v.w); }
            float v0 = -INFINITY, v1 = -INFINITY, v2 = -INFINITY; int i0 = 64, i1 = 64, i2 = 64;
            for (int j = 0; j < own; ++j) {
                float g = 0.f;
#pragma unroll
                for (int d4 = 0; d4 < 16; ++d4) { const f32x4 kv = ((const LAS f32x4*)kml)[j * 16 + d4]; g += qf[d4 * 4] * kv.x + qf[d4 * 4 + 1] * kv.y + qf[d4 * 4 + 2] * kv.z + qf[d4 * 4 + 3] * kv.w; }
                if (g > v0) { v2 = v1; i2 = i1; v1 = v0; i1 = i0; v0 = g; i0 = j; }
                else if (g > v1) { v2 = v1; i2 = i1; v1 = g; i1 = j; }
                else if (g > v2) { v2 = g; i2 = j; }
            }
            int cntj = 0, r0 = 0, r1 = 0, r2 = 0; const unsigned long long ltm = (1ull << F.lane) - 1ull;
            for (int j = 0; j < own; ++j) {
                const bool s0 = (i0 == j), s1 = (i1 == j), s2 = (i2 == j);
                const unsigned long long mask = __ballot(s0 || s1 || s2);
                if (F.lane == j) cntj = (int)__popcll(mask);
                const int rk = (int)__popcll(mask & ltm);
                r0 = s0 ? rk : r0; r1 = s1 ? rk : r1; r2 = s2 ? rk : r2;
            }
            int basej = 0;
            if (F.lane < own && cntj > 0) basej = (int)__hip_atomic_fetch_add(F.ctl + CW_MCNT + (bh * 64 + F.lane) * 16, (unsigned)cntj, RLX_AGENT);
            const int b0 = shfl_i(basej, i0 & 63), b1 = shfl_i(basej, i1 & 63), b2 = shfl_i(basej, i2 & 63);
            if (i0 < 64) mlist[(size_t)moba_list_base(bh, i0) + b0 + r0] = (unsigned)q;
            if (i1 < 64) mlist[(size_t)moba_list_base(bh, i1) + b1 + r1] = (unsigned)q | (1u << 14);
            if (i2 < 64) mlist[(size_t)moba_list_base(bh, i2) + b2 + r2] = (unsigned)q | (2u << 14);
        }
        __syncthreads();
    }
}
__device__ __forceinline__ void p5_moba_gather(Frame& F, char* lds_generic) {
    PHASE_BEGIN(F);
    LAS int* pre = (LAS int*)(F.lds + 106496);
    LAS int* tmp = (LAS int*)(F.lds + 106496 + 4224);
    for (int i = F.tid; i < 1024; i += NWAVES * 64) { const unsigned c = __hip_atomic_load(F.ctl + CW_MCNT + i * 16, RLX_AGENT); tmp[i] = (int)((c + 255u) >> 8); }
    __syncthreads();
    if (F.wave == 0) { int loc[16]; int s = 0;
#pragma unroll
        for (int k = 0; k < 16; ++k) { loc[k] = s; s += tmp[F.lane * 16 + k]; }
        int incl = s;
#pragma unroll
        for (int o = 1; o < 64; o <<= 1) { const int t = shfl_i(incl, F.lane >= o ? F.lane - o : F.lane); if (F.lane >= o) incl += t; }
        const int excl = incl - s;
#pragma unroll
        for (int k = 0; k < 16; ++k) pre[F.lane * 16 + k] = excl + loc[k];
        if (F.lane == 63) pre[1024] = incl; }
    __syncthreads();
    const int U = pre[1024];
    const bf16* QKV = (const bf16*)(F.ws + WS_QKV); const unsigned* mlist = (const unsigned*)(F.ws + WS_MLIST);
#define P5_DECODE(L_, x_, chunk_, n_) do { int lo_ = 0, hi_ = 1024; while (hi_ - lo_ > 1) { const int mid_ = (lo_ + hi_) >> 1; if (pre[mid_] <= (L_)) lo_ = mid_; else hi_ = mid_; } \
        x_ = __builtin_amdgcn_readfirstlane(lo_); chunk_ = (L_) - __builtin_amdgcn_readfirstlane(pre[x_]); const int cnt_ = __builtin_amdgcn_readfirstlane((int)__hip_atomic_load(F.ctl + CW_MCNT + x_ * 16, RLX_AGENT)); \
        n_ = (cnt_ - chunk_ * 256) < 256 ? (cnt_ - chunk_ * 256) : 256; } while (0)
    const int ei = F.wave * 32 + (F.lane & 31);
    int last_h = -1, x = 0, chunk = 0, n = 1; unsigned gcur = 0u;
    int L = blockIdx.x;
    if (L < U) { P5_DECODE(L, x, chunk, n); gcur = mlist[(size_t)moba_list_base(x >> 6, x & 63) + chunk * 256 + (ei < n ? ei : n - 1)]; }
    for (; L < U; L += F.G) {
        const int bh = x >> 6, j = x & 63, b = bh >> 3, h = bh & 7, ncur = n;
        const int Ln = L + F.G; int xn = 0, chunkn = 0, nn = 1; unsigned gnext = 0u;
        if (Ln < U) { P5_DECODE(Ln, xn, chunkn, nn); gnext = mlist[(size_t)moba_list_base(xn >> 6, xn & 63) + chunkn * 256 + (ei < nn ? ei : nn - 1)]; }
        const attn_body::bf16* base = (const attn_body::bf16*)QKV + (size_t)b * T * NPROJ;
        attn_body::MobaMerge mm{nullptr, nullptr, 0, 0, 0};
        attn_body::GatherArgs ga{gcur, ncur, (float*)(F.ws + WS_PML), (attn_body::bf16*)(F.ws + WS_PO), (long)b * T, h};
        attn_body::attn_unit<8, 2>(base + 1536 + h * 64, base + 2048 + h * 64, base + 2560 + h * 64, nullptr, 0, j * 256, 4,
                                   (const float*)(F.ws + WS_BIASG) + (4 + h) * 128, mm, ga, lds_generic, F.wave, h != last_h);
        last_h = h; x = xn; chunk = chunkn; n = nn; gcur = gnext;
    }
#undef P5_DECODE
}
__device__ __forceinline__ void p6_attention(Frame& F, char* lds_generic) {
    PHASE_BEGIN(F);
    const attn_body::bf16* QKV = (const attn_body::bf16*)(F.ws + WS_QKV);
    const int c = blockIdx.x, G = F.G;
    const kptr_t kp = karg();
    const float l1 = wave_sum(INP(kp, 9)[F.lane] * INP(kp, 10)[F.lane], F.lane), l2 = wave_sum(INP(kp, 11)[F.lane] * INP(kp, 12)[F.lane], F.lane);
    const float lam = expf(l1) - expf(l2) + LAMBDA_INIT; const float* gnp = INP(kp, 13);
#ifndef PROBE_REPD
#define PROBE_REPD 1
#define PROBE_REPO 1
#endif
    for (int rep_ = 0; rep_ < PROBE_REPD; ++rep_)
    for (int ii = 0;; ++ii) {
        const int i = ii >> 1, mp = ii & 1;
        const long Lp = (long)i * G + ((i & 1) ? (G - 1 - c) : c);
        if (Lp >= 512) break;
        const int qb = 63 - (int)(Lp >> 3), st = (int)(Lp & 7), b = st >> 2, hd = st & 3;
        const attn_body::bf16* base = QKV + (size_t)b * T * NPROJ;
        attn_body::attn_unit128f<8>((const unsigned char*)base + hd * 128 + mp * 64, (const unsigned char*)base + 512 + hd * 128 + mp * 64, (const unsigned char*)(F.ws + WS_VT8) + (size_t)((b * 4 + hd) * 128) * T,
                                   (attn_body::bf16*)(F.ws + WS_OD) + (size_t)b * T * 1024 + (hd * 2) * 128, qb * 256, 4 * (qb + 1),
                                   (const float*)(F.ws + WS_BT4) + hd * 2048, lds_generic, F.wave,
                                   mp ? (attn_body::bf16*)(F.ws + WS_XN) + (size_t)b * T * 1024 + hd * 128 : nullptr, gnp, lam, 1.f - LAMBDA_INIT
#if defined(STAMP_PROBE)
                                   , (blockIdx.x == STAMP_BLOCK && ii == 0) ? (float*)(F.ws + WS_BIASG + 32768) : nullptr
#endif
                                   );
    }
    for (int rep_ = 0; rep_ < PROBE_REPO; ++rep_)
    for (int i = 0;; ++i) {
        const long L = (long)i * G + ((i & 1) ? (G - 1 - c) : c);
        if (L >= 1024) break;
        const int o = (int)L, b = o >> 9, h = (o >> 6) & 7, qb = o & 63;
        const attn_body::bf16* base = QKV + (size_t)b * T * NPROJ;
        attn_body::MobaMerge mm{(const float*)(F.ws + WS_PML), (const attn_body::bf16*)(F.ws + WS_PO), (long)b * T + qb * 256, h, qb < 3 ? qb : 3};
        attn_body::attn_unit<8, 1>(base + 1536 + h * 64, base + 2048 + h * 64, base + 2560 + h * 64,
                                   (attn_body::bf16*)(F.ws + WS_XN) + (size_t)b * T * 1024 + 512 + h * 64, qb * 256, qb * 256, 4,
                                   (const float*)(F.ws + WS_BIASG) + (4 + h) * 128, mm, attn_body::GatherArgs{0u, 0, nullptr, nullptr, 0, 0}, lds_generic, F.wave);
    }
}
__device__ __forceinline__ void p7_ydiff(Frame& F) {
    expert_weights(F);
}
__device__ __forceinline__ void p9_postmix_route(Frame& F) {
    PHASE_BEGIN(F);
    const kptr_t kp = karg();
    const float* x = INP(kp, 0); const bf16* yo = (const bf16*)(F.ws + WS_YO); const float* mod = (const float*)(F.ws + WS_MOD);
    bf16* XN = (bf16*)(F.ws + WS_XN); float* tokw = (float*)(F.ws + WS_TOKW); int* elist = (int*)(F.ws + WS_ELIST);
    LAS float* WE = (LAS float*)(F.lds); LAS float* WG = (LAS float*)(F.lds + 131072);
    for (int f = F.tid; f < 32768; f += NWAVES * 64) { const int k = f >> 5, cc = f & 31; const int l = (k & 255) >> 2, kk = ((k >> 8) << 2) | (k & 3), g = cc >> 3, hf = (cc >> 2) & 1, ii = cc & 3;
        WE[((((g * 16 + kk) * 2 + hf) * 64 + l) << 2) + ii] = INP(kp, 18)[f]; }
    for (int f = F.tid; f < 4096; f += NWAVES * 64) { const int k = f >> 2, ii = f & 3; const int l = (k & 255) >> 2, kk = ((k >> 8) << 2) | (k & 3); WG[((kk * 64 + l) << 2) + ii] = INP(kp, 16)[f]; }
    __syncthreads();
    const int gw = F.vcu * NWAVES + F.wave, NGW = F.G * NWAVES;
    const float bg0 = INP(kp, 17)[0], bg1 = INP(kp, 17)[1], bg2 = INP(kp, 17)[2], bg3 = INP(kp, 17)[3];
    int nst = 0, st_e0 = 0, st_e1 = 0, st_m = 0;
    for (int b = 0; b < BATCH; ++b) {
        f32x4 a1[4], ge[4], sh[4];
#pragma unroll
        for (int j = 0; j < 4; ++j) { const int c = 4 * F.lane + 256 * j; a1[j] = *(const f32x4*)(INP(kp, 5) + c) * *(const f32x4*)(mod + b * 6144 + 2048 + c);
            ge[j] = *(const f32x4*)(INP(kp, 6) + c) * (*(const f32x4*)(mod + b * 6144 + 4096 + c) + 1.f); sh[j] = *(const f32x4*)(mod + b * 6144 + 3072 + c); }
        v2u nyb[4]; f32x4 nxv[4];
        { const int m0 = b * T + gw; const GAS v2u* yr = (const GAS v2u*)(yo + (size_t)m0 * D) + F.lane; const GAS f32x4* xr = (const GAS f32x4*)(x + (size_t)m0 * D) + F.lane;
#pragma unroll
          for (int j = 0; j < 4; ++j) { nyb[j] = yr[64 * j]; nxv[j] = xr[64 * j]; } }
        for (int m = b * T + gw; m < (b + 1) * T; m += NGW) {
            int ln = F.lane; asm volatile("" : "+v"(ln));
            f32x4 xv[4]; float s = 0.f, s2 = 0.f;
            {   f32x4 y[4];
#pragma unroll
                for (int j = 0; j < 4; ++j) { const v2u yb = nyb[j]; y[j] = (f32x4){bf_lo(yb.x), bf_hi(yb.x), bf_lo(yb.y), bf_hi(yb.y)}; xv[j] = nxv[j]; s += (y[j].x * y[j].x + y[j].y * y[j].y) + (y[j].z * y[j].z + y[j].w * y[j].w); }
                { const int mn = (m + NGW < (b + 1) * T) ? m + NGW : m; const GAS v2u* yr = (const GAS v2u*)(yo + (size_t)mn * D) + ln; const GAS f32x4* xr = (const GAS f32x4*)(x + (size_t)mn * D) + ln;
#pragma unroll
                  for (int j = 0; j < 4; ++j) { nyb[j] = yr[64 * j]; nxv[j] = xr[64 * j]; } }
                const float r1 = 1.f / sqrtf(wave_sum(s, F.lane) * (1.f / D) + EPS);
                GAS unsigned long long* x1r = (GAS unsigned long long*)((bf16*)(F.ws + WS_X1B) + (size_t)m * D) + ln;
#pragma unroll
                for (int j = 0; j < 4; ++j) { xv[j] = xv[j] + a1[j] * (y[j] * r1); x1r[64 * j] = (unsigned long long)pk2(xv[j].x, xv[j].y) | ((unsigned long long)pk2(xv[j].z, xv[j].w) << 32); s2 += (xv[j].x * xv[j].x + xv[j].y * xv[j].y) + (xv[j].z * xv[j].z + xv[j].w * xv[j].w); }
            }
            const float r2 = 1.f / sqrtf(wave_sum(s2, F.lane) * (1.f / D) + EPS);
            GAS int* o4 = (GAS int*)((unsigned char*)XN + (size_t)m * D) + ln;
            float gl[4] = {0.f, 0.f, 0.f, 0.f};
#pragma unroll
            for (int j = 0; j < 4; ++j) { xv[j] = xv[j] * r2 * ge[j] + sh[j]; { int t_ = 0; t_ = __builtin_amdgcn_cvt_pk_fp8_f32(xv[j].x, xv[j].y, t_, false); t_ = __builtin_amdgcn_cvt_pk_fp8_f32(xv[j].z, xv[j].w, t_, true); o4[64 * j] = t_; }
#pragma unroll
                for (int ii = 0; ii < 4; ++ii) { const f32x4 w = ((const LAS f32x4*)WG)[(j * 4 + ii) * 64 + F.lane]; const float hv = xv[j][ii]; gl[0] += hv * w.x; gl[1] += hv * w.y; gl[2] += hv * w.z; gl[3] += hv * w.w; }
                __builtin_amdgcn_sched_barrier(0); }
            gl[0] = wave_sum(gl[0], F.lane) + bg0; gl[1] = wave_sum(gl[1], F.lane) + bg1; gl[2] = wave_sum(gl[2], F.lane) + bg2; gl[3] = wave_sum(gl[3], F.lane) + bg3;
            int g = 0; float gm = gl[0];
            if (gl[1] > gm) { gm = gl[1]; g = 1; } if (gl[2] > gm) { gm = gl[2]; g = 2; } if (gl[3] > gm) { gm = gl[3]; g = 3; }
            const float gw_ = 1.f / (expf(gl[0] - gm) + expf(gl[1] - gm) + expf(gl[2] - gm) + expf(gl[3] - gm));
            g = __builtin_amdgcn_readfirstlane(g);
            float el[8] = {0.f, 0.f, 0.f, 0.f, 0.f, 0.f, 0.f, 0.f};
#pragma unroll
            for (int j = 0; j < 4; ++j) {
#pragma unroll
                for (int ii = 0; ii < 4; ++ii) { const int kk = j * 4 + ii; const f32x4 wa = ((const LAS f32x4*)WE)[((g * 16 + kk) * 2 + 0) * 64 + F.lane], wb = ((const LAS f32x4*)WE)[((g * 16 + kk) * 2 + 1) * 64 + F.lane]; const float hv = xv[j][ii];
                    el[0] += hv * wa.x; el[1] += hv * wa.y; el[2] += hv * wa.z; el[3] += hv * wa.w; el[4] += hv * wb.x; el[5] += hv * wb.y; el[6] += hv * wb.z; el[7] += hv * wb.w; }
                __builtin_amdgcn_sched_barrier(0); }
            float ea = -INFINITY, eb = -INFINITY; int ia = 0, ib = 0;
#pragma unroll
            for (int k = 0; k < 8; ++k) { const float v = wave_sum(el[k], F.lane) + INP(kp, 19)[g * 8 + k];
                if (v > ea) { eb = ea; ib = ia; ea = v; ia = k; } else if (v > eb) { eb = v; ib = k; } }
            const float pb = expf(eb - ea), wa_ = gw_ / (1.f + pb), wb_ = gw_ * pb / (1.f + pb);
            if (F.lane == 0) *(f32x2*)(tokw + (size_t)m * 2) = (f32x2){wa_, wb_};
            if (F.lane == nst) { st_e0 = g * 8 + ia; st_e1 = g * 8 + ib; st_m = m; }
            ++nst;
            if (nst == 64) {
                const unsigned p0 = __hip_atomic_fetch_add(F.ctl + CW_ECNT + st_e0 * 64, 1u, RLX_AGENT), p1 = __hip_atomic_fetch_add(F.ctl + CW_ECNT + st_e1 * 64, 1u, RLX_AGENT);
                elist[st_e0 * 32768 + (int)p0] = st_m * 2; elist[st_e1 * 32768 + (int)p1] = st_m * 2 + 1; nst = 0; }

        }
    }
    if (F.lane < nst) {
        const unsigned p0 = __hip_atomic_fetch_add(F.ctl + CW_ECNT + st_e0 * 64, 1u, RLX_AGENT), p1 = __hip_atomic_fetch_add(F.ctl + CW_ECNT + st_e1 * 64, 1u, RLX_AGENT);
        elist[st_e0 * 32768 + (int)p0] = st_m * 2; elist[st_e1 * 32768 + (int)p1] = st_m * 2 + 1; }
}
struct MoeOrder {
    int tpoff;
    const gu32* ecnt; const int* elist; int G, c;
    __device__ __forceinline__ bool next(int i, pg8::Unit& u) const {
        int o_ = tpoff; asm volatile("" : "+s"(o_)); const LAS int* tp = (const LAS int*)(uintptr_t)(unsigned)o_;
        const long L = (long)i * G + c; const int U = __builtin_amdgcn_readfirstlane(tp[32]) * 4; if (L >= U) return false;
        const int rt = (int)(L >> 2), pn = (int)(L & 3); int e = 0;
#pragma unroll 1
        for (int k = 1; k < 32; ++k) e += (tp[k] <= rt) ? 1 : 0;
        e = __builtin_amdgcn_readfirstlane(e);
        const int t = rt - __builtin_amdgcn_readfirstlane(tp[e]); const int cnt = __builtin_amdgcn_readfirstlane((int)__hip_atomic_load(ecnt + e * 64, RLX_AGENT));
        u.pm = rt; u.pn = e * 4 + pn; u.nvalid = (cnt - t * 256) < 256 ? (cnt - t * 256) : 256; u.rows = elist + e * 32768 + t * 256; return true;
    }
    __device__ __forceinline__ int arow(const pg8::Unit& u, int r) const { return r < u.nvalid ? (u.rows[r] >> 1) : 0; }
};
__device__ __forceinline__ void moe_prefix(Frame& F, LAS int* tp) {
    if (F.tid == 0) { int s = 0; for (int e = 0; e < 32; ++e) { tp[e] = s; s += ((int)__hip_atomic_load(F.ctl + CW_ECNT + e * 64, RLX_AGENT) + 255) >> 8; } tp[32] = s; }
    __syncthreads();
}

__device__ __forceinline__ void p2_qkv(Frame& F) {
    PHASE_BEGIN(F);
    pg8::Gemm g{F.ws, (unsigned)WS_XN, (unsigned)WS_WIN, D, 0}; pg8::StaticOrder S; S.init(M, NPROJ, F.G, (int)blockIdx.x);
    pg8::EpiQKV E{(bf16*)(F.ws + WS_QKV), NPROJ, 0xC3u, attn_body::C2, (float*)(F.ws + WS_KMEAN), 8, true};
    pg8::gemm_phase<pg8::EpiQKV, pg8::StaticOrder, false>(F.lds + RING_OFF, g, S, E, F.wave);
}
__device__ __forceinline__ void p8_wo(Frame& F) {
    PHASE_BEGIN(F);
    pg8::Gemm g{F.ws, (unsigned)WS_XN, (unsigned)WS_WOUT, D, 0}; pg8::StaticOrder S; S.init(M, D, F.G, (int)blockIdx.x);
    pg8::EpiQKV E{(bf16*)(F.ws + WS_YO), D, 0u, 1.f, nullptr, 0, false};
    pg8::gemm_phase<pg8::EpiQKV, pg8::StaticOrder, false>(F.lds + RING_OFF, g, S, E, F.wave);
}
__device__ __forceinline__ void p10_gateup(Frame& F) {
    PHASE_BEGIN(F);
    LAS int* tp = (LAS int*)(F.lds + RING_BYTES); moe_prefix(F, tp);
    MoeOrder S{__builtin_amdgcn_readfirstlane((int)(uintptr_t)tp), F.ctl + CW_ECNT, (const int*)(F.ws + WS_ELIST), F.G, F.vcu};
    pg8::Gemm g{F.ws, (unsigned)WS_XN, (unsigned)WS_WGU, D / 2, 0x00007A7F};
    pg8::EpiSwiGLU8 E{(unsigned char*)(F.ws + WS_HID), HID8_SCALE};
    pg8::gemm_phase<pg8::EpiSwiGLU8, MoeOrder, true, true>(F.lds + RING_OFF, g, S, E, F.wave);
}
__device__ __forceinline__ void p11_down(Frame& F) {
    PHASE_BEGIN(F);
    LAS int* tp = (LAS int*)(F.lds + RING_BYTES); moe_prefix(F, tp);
    MoeOrder S{__builtin_amdgcn_readfirstlane((int)(uintptr_t)tp), F.ctl + CW_ECNT, (const int*)(F.ws + WS_ELIST), F.G, F.vcu};
    pg8::Gemm g{F.ws, (unsigned)WS_HID, (unsigned)WS_WD, EFF / 2, 0x00007A7C};
    pg8::EpiDown E{(bf16*)(F.ws + WS_SO)};
    pg8::gemm_phase<pg8::EpiDown, MoeOrder, false, true>(F.lds + RING_OFF, g, S, E, F.wave);
}
__device__ __forceinline__ void p12_final(Frame& F) {
    PHASE_BEGIN(F);
    const kptr_t kp = karg();
    const float* mod = (const float*)(F.ws + WS_MOD); const bf16* SO = (const bf16*)(F.ws + WS_SO); const float* tokw = (const float*)(F.ws + WS_TOKW);
    const int gw = F.vcu * NWAVES + F.wave, NGW = F.G * NWAVES;
    for (int b = 0; b < BATCH; ++b) {
        f32x4 pg[4], g2[4];
#pragma unroll
        for (int j = 0; j < 4; ++j) { const int c = 4 * F.lane + 256 * j; pg[j] = *(const f32x4*)(INP(kp, 7) + c); g2[j] = *(const f32x4*)(mod + b * 6144 + 5120 + c); }
        f32x2 nw; unsigned na[4], nb[4]; v2u nx[4];
        { const int m0 = b * T + gw; nw = *(const f32x2*)(tokw + (size_t)m0 * 2);
          const GAS unsigned* s0 = (const GAS unsigned*)((const unsigned char*)SO + (size_t)m0 * 2048) + F.lane; const GAS unsigned* s1 = (const GAS unsigned*)((const unsigned char*)SO + (size_t)m0 * 2048 + 1024) + F.lane; const GAS v2u* x1b = (const GAS v2u*)((const bf16*)(F.ws + WS_X1B) + (size_t)m0 * D) + F.lane;
#pragma unroll
          for (int j = 0; j < 4; ++j) { na[j] = s0[64 * j]; nb[j] = s1[64 * j]; nx[j] = x1b[64 * j]; } }
        for (int m = b * T + gw; m < (b + 1) * T; m += NGW) {
            int ln = F.lane; asm volatile("" : "+v"(ln));
            const f32x2 w = nw;
            GAS f32x4* orow = (GAS f32x4*)(F.out + (size_t)m * D) + ln;
            f32x4 y[4], xv[4]; float s = 0.f;
#pragma unroll
            for (int j = 0; j < 4; ++j) { const int a = (int)na[j], bq = (int)nb[j]; { const v2u xb = nx[j]; xv[j] = (f32x4){bf_lo(xb.x), bf_hi(xb.x), bf_lo(xb.y), bf_hi(xb.y)}; }
                y[j] = (f32x4){w.x * __builtin_amdgcn_cvt_f32_fp8(a, 0) + w.y * __builtin_amdgcn_cvt_f32_fp8(bq, 0), w.x * __builtin_amdgcn_cvt_f32_fp8(a, 1) + w.y * __builtin_amdgcn_cvt_f32_fp8(bq, 1),
                               w.x * __builtin_amdgcn_cvt_f32_fp8(a, 2) + w.y * __builtin_amdgcn_cvt_f32_fp8(bq, 2), w.x * __builtin_amdgcn_cvt_f32_fp8(a, 3) + w.y * __builtin_amdgcn_cvt_f32_fp8(bq, 3)} * (1.f / 16.f);
                s += (y[j].x * y[j].x + y[j].y * y[j].y) + (y[j].z * y[j].z + y[j].w * y[j].w); }
            { const int mn = (m + NGW < (b + 1) * T) ? m + NGW : m; nw = *(const f32x2*)(tokw + (size_t)mn * 2);
              const GAS unsigned* s0 = (const GAS unsigned*)((const unsigned char*)SO + (size_t)mn * 2048) + ln; const GAS unsigned* s1 = (const GAS unsigned*)((const unsigned char*)SO + (size_t)mn * 2048 + 1024) + ln; const GAS v2u* x1b = (const GAS v2u*)((const bf16*)(F.ws + WS_X1B) + (size_t)mn * D) + ln;
#pragma unroll
              for (int j = 0; j < 4; ++j) { na[j] = s0[64 * j]; nb[j] = s1[64 * j]; nx[j] = x1b[64 * j]; } }
            const float r = 1.f / sqrtf(wave_sum(s, F.lane) * (1.f / D) + EPS);
#pragma unroll
            for (int j = 0; j < 4; ++j) orow[64 * j] = xv[j] + g2[j] * (y[j] * r * pg[j]);
#if defined(STAMP_PROBE)
            if ((m & 63) == 0) {
                const float X = ((const float*)(F.ws + WS_BIASG + 32768))[STAMP_PROBE]; const float q = rintf(X / (float)STAMP_SCALE * 40.f) * (1.f / 40.f), v = sqrtf(64.f * 1.135f * (q < 0.f ? 0.f : q));
#pragma unroll
                for (int j = 0; j < 4; ++j) orow[64 * j] = (f32x4){v, v, v, v};
#if defined(STAMP_PROBE2)
                if (m == 0 && F.lane == 0) { const float X2 = ((const float*)(F.ws + WS_BIASG + 32768))[STAMP_PROBE2]; const float q2 = rintf(X2 / (float)STAMP_SCALE2 * 40.f) * (1.f / 40.f); F.out[0] = 1000.f * q2; }
#endif
            }
#endif
        }
    }
}

struct Args { const float* in[23]; float* out; unsigned char* ws; int ph_lo, ph_hi; };
__global__ void __launch_bounds__(NWAVES * 64, 2) hymba_fwd(Args args) {
    extern __shared__ __attribute__((aligned(16))) unsigned char lds[];
    Frame F;
    F.lds = (LAS unsigned char*)lds;
    F.MISC = (volatile LAS unsigned*)(F.lds + MISC_OFF);
    F.wave = __builtin_amdgcn_readfirstlane((int)threadIdx.x >> 6); PHASE_BEGIN(F);
    F.G = gridDim.x; { const int bx = blockIdx.x; F.vcu = (F.G % 8 == 0) ? (bx % 8) * (F.G / 8) + bx / 8 : bx; }
    for (int u = F.tid; u < (LDS_BYTES - LDSCTL_OFF) / 4; u += NWAVES * 64) ((LAS unsigned*)(F.lds + LDSCTL_OFF))[u] = 0u;
    __syncthreads();
#define LEADER() (F.wave == 0 && lane_now() == 0)
    PHASE_BEGIN(F);
    if (N_LAUNCHES == 1) (void)xcd_barrier_post((unsigned*)((gu32*)F.ws + CW_BAR), (volatile LAS unsigned*)(F.lds + MISC_OFF) + 8, LEADER());
#define GRID_BAR() do { if (N_LAUNCHES == 1) { PHASE_BEGIN(F); XcdBarrier bar_; bar_.bar = (unsigned*)((gu32*)F.ws + CW_BAR); bar_.x = xb_xcc_id(); bar_.st = (volatile LAS unsigned*)(F.lds + MISC_OFF) + 8; xcd_barrier(bar_, LEADER()); } } while (0)
    const int lo = (N_LAUNCHES == 1) ? 0 : args.ph_lo, hi = (N_LAUNCHES == 1) ? N_PHASES : args.ph_hi;
#define IN(k) (lo <= (k) && (k) < hi)
#ifndef PROBE_MASK
#define PROBE_MASK 0
#endif
#define TWICE(k) ((PROBE_MASK >> (k)) & 1)
#define BOTH(k) (IN(k) && IN((k) + 1))

    if (IN(0)) { p0_prologue(F); if (BOTH(0)) GRID_BAR(); }
    if (TWICE(0) && IN(0)) { p0_prologue(F); if (BOTH(0)) GRID_BAR(); }
    if (IN(1)) { p1_prenorm(F); if (BOTH(1)) GRID_BAR(); }
    if (TWICE(1) && IN(1)) { p1_prenorm(F); if (BOTH(1)) GRID_BAR(); }
    if (IN(2)) { p2_qkv(F); if (BOTH(2)) GRID_BAR(); }
    if (TWICE(2) && IN(2)) { p2_qkv(F); if (BOTH(2)) GRID_BAR(); }
    if (IN(3)) { p3_kmean(F); if (BOTH(3) && N_LAUNCHES == 1) __syncthreads(); }
#if defined(STAMP_PROBE)
#define PH_T0() const unsigned long long pt0_ = __builtin_amdgcn_s_memrealtime()
#define PH_T1(slot) do { if (blockIdx.x == 0 && LEADER()) ((float*)(F.ws + WS_BIASG + 32768))[slot] = (float)(__builtin_amdgcn_s_memrealtime() - pt0_) * 0.01f; } while (0)
#else
#define PH_T0()
#define PH_T1(slot)
#endif
    if (IN(4)) { PH_T0(); p4_moba_select(F); if (BOTH(4)) GRID_BAR(); PH_T1(5); }
    if (IN(5)) { p5_moba_gather(F, (char*)lds + RING_OFF); if (BOTH(5)) GRID_BAR(); }
    if (TWICE(5) && IN(5)) { p5_moba_gather(F, (char*)lds + RING_OFF); if (BOTH(5)) GRID_BAR(); }
    if (IN(6)) { p6_attention(F, (char*)lds + RING_OFF); if (BOTH(6)) GRID_BAR(); }
    if (TWICE(6) && IN(6)) { p6_attention(F, (char*)lds + RING_OFF); if (BOTH(6)) GRID_BAR(); }
    if (N_LAUNCHES == 1 && BOTH(7)) {
        if ((blockIdx.x >> 3) & 1) { p7_ydiff(F); __syncthreads(); p8_wo(F); } else { p8_wo(F); __syncthreads(); p7_ydiff(F); }
        if (BOTH(8)) GRID_BAR();
    } else {
    if (IN(7)) { p7_ydiff(F); if (BOTH(7)) GRID_BAR(); }
    if (TWICE(7) && IN(7)) { p7_ydiff(F); if (BOTH(7)) GRID_BAR(); }
    if (IN(8)) { p8_wo(F); if (BOTH(8)) GRID_BAR(); }
    }
    if (TWICE(8) && IN(8)) { p8_wo(F); if (BOTH(8)) GRID_BAR(); }
    if (IN(9)) { PH_T0(); p9_postmix_route(F); if (BOTH(9)) GRID_BAR(); PH_T1(6); }
    if (IN(10)) { p10_gateup(F); if (BOTH(10)) GRID_BAR(); }
    if (TWICE(10) && IN(10)) { p10_gateup(F); if (BOTH(10)) GRID_BAR(); }
    if (IN(11)) { p11_down(F); if (BOTH(11)) GRID_BAR(); }
    if (TWICE(11) && IN(11)) { p11_down(F); if (BOTH(11)) GRID_BAR(); }
    if (IN(12)) { p12_final(F); }
    if (TWICE(12) && IN(12)) { p12_final(F); }
#undef IN
#undef BOTH
#undef GRID_BAR
}

extern "C" void kernel_launch(void* const* d_in, const int* in_sizes, int n_in, void* d_out, int out_size, void* d_ws, size_t ws_size, hipStream_t stream) {
    static int grid = 0;
    if (grid == 0) {
        if (n_in != 23 || in_sizes[0] != M * D || out_size != M * D || ws_size < WS_END) { fprintf(stderr, "kernel_launch: unexpected shapes (n_in %d, in0 %d, out %d, ws %zu); nothing launched\n", n_in, n_in > 0 ? in_sizes[0] : -1, out_size, ws_size); grid = -1; return; }
        int dev = 0, cus = 0, per_cu = 0;
        if (hipGetDevice(&dev) != hipSuccess || hipDeviceGetAttribute(&cus, hipDeviceAttributeMultiprocessorCount, dev) != hipSuccess) { fprintf(stderr, "kernel_launch: device query failed\n"); grid = -1; return; }
        if (hipFuncSetAttribute((const void*)hymba_fwd, hipFuncAttributeMaxDynamicSharedMemorySize, LDS_BYTES) != hipSuccess) { fprintf(stderr, "kernel_launch: hipFuncSetAttribute failed\n"); grid = -1; return; }
        if (hipOccupancyMaxActiveBlocksPerMultiprocessor(&per_cu, (const void*)hymba_fwd, NWAVES * 64, LDS_BYTES) != hipSuccess || per_cu < 1)
            fprintf(stderr, "kernel_launch: note: occupancy query reports %d workgroups per CU\n", per_cu);
        (void)hipGetLastError();
        grid = cus;
    }
    if (grid < 0) return;
    if (hipMemsetAsync((char*)d_ws + WS_CTL, 0, CTL_ZERO_BYTES, stream) != hipSuccess) { fprintf(stderr, "kernel_launch: hipMemsetAsync failed\n"); return; }
    Args a{};
    for (int i = 0; i < 23; ++i) a.in[i] = (const float*)d_in[i];
    a.out = (float*)d_out; a.ws = (unsigned char*)d_ws;
    for (int li = 0; li < N_LAUNCHES; ++li) {
        a.ph_lo = (N_LAUNCHES == 1) ? 0 : li; a.ph_hi = (N_LAUNCHES == 1) ? N_PHASES : li + 1;
        hipLaunchKernelGGL(hymba_fwd, dim3(grid), dim3(NWAVES * 64), LDS_BYTES, stream, a);
        const hipError_t le = hipPeekAtLastError();
        if (le != hipSuccess) { fprintf(stderr, "kernel_launch: launch %d failed: %s\n", li, hipGetErrorName(le)); break; }
    }
}
```

```cpp
#include <hip/hip_runtime.h>
#include <hip/hip_bf16.h>
#include <cstdio>
#include <cstdint>
#include <cmath>

__device__ __forceinline__ int lane_now() { unsigned m_ = ~0u; asm volatile("" : "+s"(m_)); return (int)__builtin_amdgcn_mbcnt_hi(m_, __builtin_amdgcn_mbcnt_lo(m_, 0u)); }
namespace pg8 {
#define PG8_LAS __attribute__((address_space(3)))
typedef unsigned short bf16_t;
typedef short bf16x8 __attribute__((ext_vector_type(8)));
typedef float f32x4 __attribute__((ext_vector_type(4)));
typedef unsigned u32x4 __attribute__((ext_vector_type(4)));
constexpr int BM = 256, BK = 64, HALF = 128, HTB = HALF * BK * 2  , STAGE_BYTES = 8 * HTB, NXCD = 8, WGM = 12;

__host__ __device__ __forceinline__ int lds_byte(int r, int c) { const int st = (r >> 4) * 2 + (c >> 5), rr = r & 15, cc = c & 31, ob = rr * 64 + cc * 2; return st * 1024 + (ob ^ (((ob >> 9) & 1) << 5)); }
__host__ __device__ __forceinline__ void stage_rc(int b, int& R, int& C) { const int st = b / 1024, sb = b % 1024, swz = sb ^ (((sb >> 9) & 1) << 5); R = (st >> 1) * 16 + swz / 64; C = (st & 1) * 32 + (swz % 64) / 2; }
__host__ __device__ __forceinline__ int perm32(int rho) { const int n = rho >> 4, i = rho & 15; return 8 * (i >> 2) + 4 * n + (i & 3); }

struct Unit { int pm, pn; int nvalid; const int* rows; };
struct Gemm { const unsigned char* base; unsigned offA, offB; int K; int sA; };
typedef int v8i_t __attribute__((ext_vector_type(8)));
typedef int v4i_t __attribute__((ext_vector_type(4)));

struct StaticOrder {
    int nM, nN, nwg, G, c;
    __host__ __device__ void init(int M, int N, int G_, int c_) { nM = M / BM; nN = N / BM; nwg = nM * nN; G = G_; c = c_; }
    __host__ __device__ bool next(int i, Unit& u) const {
        const long L = (long)i * G + c; if (L >= nwg) return false;
        int wgid = (int)L; { const int q = nwg / NXCD, r = nwg % NXCD, xcd = wgid % NXCD, off = wgid / NXCD; wgid = (xcd < r ? xcd * (q + 1) : r * (q + 1) + (xcd - r) * q) + off; }
        const int nig = WGM * nN, gid = wgid / nig, fm = gid * WGM, gsz = (nM - fm) < WGM ? (nM - fm) : WGM;
        u.pm = fm + ((wgid % nig) % gsz); u.pn = (wgid % nig) / gsz; u.nvalid = 256; u.rows = nullptr; return true;
    }
    __device__ __forceinline__ int arow(const Unit&, int r) const { return r; }
};

__device__ __forceinline__ unsigned cvt_pk_bf16(float lo, float hi) { unsigned r; asm volatile("v_cvt_pk_bf16_f32 %0, %1, %2" : "=v"(r) : "v"(lo), "v"(hi)); return r; }

struct EpiQKV {
    static constexpr bool PERM = true;
    bf16_t* O; int ldc; unsigned qmask; float qscale; float* kmean; int kt0; bool f8tiles;
    __device__ __forceinline__ void operator()(const f32x4 (&acc)[2][2][4][2], const Unit& u, int wr, int wc, int fr, int fq) const {
        bf16_t* O = this->O; asm volatile("" : "+s"(O));
        const int row0 = u.pm * BM + wr * 64 + fr; const int col0 = u.pn * BM + wc * 32 + 8 * fq;
        const float sc = ((qmask >> u.pn) & 1u) ? qscale : 1.f;
#pragma unroll
        for (int ai = 0; ai < 2; ++ai)
#pragma unroll
            for (int m = 0; m < 4; ++m) { bf16_t* rowp = O + (size_t)(row0 + ai * HALF + m * 16) * ldc + col0;
                if (f8tiles && u.pn < 4) {
                    const float es = (u.pn < 2) ? 32.f : 4.f; int w[2][2];
#pragma unroll
                    for (int bj = 0; bj < 2; ++bj) { const f32x4 v0 = acc[ai][bj][m][0] * sc, v1 = acc[ai][bj][m][1] * sc; int w0 = 0, w1 = 0;
                        w0 = __builtin_amdgcn_cvt_pk_fp8_f32(v0[0] * es, v0[1] * es, w0, false); w0 = __builtin_amdgcn_cvt_pk_fp8_f32(v0[2] * es, v0[3] * es, w0, true);
                        w1 = __builtin_amdgcn_cvt_pk_fp8_f32(v1[0] * es, v1[1] * es, w1, false); w1 = __builtin_amdgcn_cvt_pk_fp8_f32(v1[2] * es, v1[3] * es, w1, true); w[bj][0] = w0; w[bj][1] = w1; }
                    { auto r0 = __builtin_amdgcn_permlane16_swap((unsigned)w[0][0], (unsigned)w[1][0], false, false); w[0][0] = (int)r0[0]; w[1][0] = (int)r0[1];
                      auto r1 = __builtin_amdgcn_permlane16_swap((unsigned)w[0][1], (unsigned)w[1][1], false, false); w[0][1] = (int)r1[0]; w[1][1] = (int)r1[1]; }
                    unsigned char* p8 = (unsigned char*)(O + (size_t)(row0 + ai * HALF + m * 16) * ldc) + col0 + ((fq & 1) ? HALF - 8 : 0);
                    *(u32x4*)p8 = (u32x4){(unsigned)w[0][0], (unsigned)w[0][1], (unsigned)w[1][0], (unsigned)w[1][1]}; continue; }
#pragma unroll
                for (int bj = 0; bj < 2; ++bj) { const f32x4 v0 = acc[ai][bj][m][0] * sc, v1 = acc[ai][bj][m][1] * sc;
                    u32x4 w; w.x = cvt_pk_bf16(v0[0], v0[1]); w.y = cvt_pk_bf16(v0[2], v0[3]); w.z = cvt_pk_bf16(v1[0], v1[1]); w.w = cvt_pk_bf16(v1[2], v1[3]);
                    *(u32x4*)(rowp + bj * HALF) = w; } }
        if (kmean != nullptr && (u.pn == kt0 || u.pn == kt0 + 1)) {
            float* km = kmean; asm volatile("" : "+s"(km));
#pragma unroll
            for (int bj = 0; bj < 2; ++bj)
#pragma unroll
                for (int n = 0; n < 2; ++n) { f32x4 cs = {0.f, 0.f, 0.f, 0.f};
#pragma unroll
                    for (int ai = 0; ai < 2; ++ai)
#pragma unroll
                        for (int m = 0; m < 4; ++m) cs += acc[ai][bj][m][n];
#pragma unroll
                    for (int i = 0; i < 4; ++i) { float v = cs[i];
                        v += __builtin_bit_cast(float, __builtin_amdgcn_update_dpp(0, __builtin_bit_cast(int, v), 0xB1, 0xf, 0xf, true)); v += __builtin_bit_cast(float, __builtin_amdgcn_update_dpp(0, __builtin_bit_cast(int, v), 0x4E, 0xf, 0xf, true));
                        v += __builtin_bit_cast(float, __builtin_amdgcn_update_dpp(0, __builtin_bit_cast(int, v), 0x141, 0xf, 0xf, true)); v += __builtin_bit_cast(float, __builtin_amdgcn_update_dpp(0, __builtin_bit_cast(int, v), 0x140, 0xf, 0xf, true));
                        if (fr == 0) { const int c = (u.pn - kt0) * BM + bj * HALF + wc * 32 + 8 * fq + 4 * n + i;
                            __hip_atomic_fetch_add(km + ((size_t)((u.pm >> 6) * 8 + (c >> 6)) * 64 + (u.pm & 63)) * 64 + (c & 63), v * (1.f / 256.f), __ATOMIC_RELAXED, __HIP_MEMORY_SCOPE_AGENT); } } }
        }
    }
};
struct EpiF32 {
    static constexpr bool PERM = false;
    float* O; int ldc;
    __device__ __forceinline__ void operator()(const f32x4 (&acc)[2][2][4][2], const Unit& u, int wr, int wc, int fr, int fq) const {
        const int col0 = u.pn * BM + wc * 32 + 4 * fq;
#pragma unroll
        for (int ai = 0; ai < 2; ++ai)
#pragma unroll
            for (int m = 0; m < 4; ++m) { float* rowp = O + (size_t)(u.pm * BM + ai * HALF + wr * 64 + m * 16 + fr) * ldc + col0;
#pragma unroll
                for (int bj = 0; bj < 2; ++bj)
#pragma unroll
                    for (int n = 0; n < 2; ++n) *(f32x4*)(rowp + bj * HALF + n * 16) = acc[ai][bj][m][n]; }
    }
};
struct EpiSwiGLU {
    static constexpr bool PERM = true;
    bf16_t* H;
    __device__ __forceinline__ void operator()(const f32x4 (&acc)[2][2][4][2], const Unit& u, int wr, int wc, int fr, int fq) const {
        const int col0 = (u.pn & 3) * 128 + wc * 32 + 8 * fq;
#pragma unroll
        for (int ai = 0; ai < 2; ++ai)
#pragma unroll
            for (int m = 0; m < 4; ++m) { bf16_t* rowp = H + (size_t)(u.pm * BM + ai * HALF + wr * 64 + m * 16 + fr) * 512 + col0;
                float h[8];
#pragma unroll
                for (int n = 0; n < 2; ++n)
#pragma unroll
                    for (int k = 0; k < 4; ++k) { const float gt = acc[ai][0][m][n][k], up = acc[ai][1][m][n][k];
                        h[n * 4 + k] = gt * __builtin_amdgcn_rcpf(1.f + __builtin_amdgcn_exp2f(-1.4426950408889634f * gt)) * up; }
                u32x4 w; w.x = cvt_pk_bf16(h[0], h[1]); w.y = cvt_pk_bf16(h[2], h[3]); w.z = cvt_pk_bf16(h[4], h[5]); w.w = cvt_pk_bf16(h[6], h[7]);
                *(u32x4*)rowp = w; }
    }
};
struct EpiSwiGLU8 {
    static constexpr bool PERM = true;
    unsigned char* H; float osc;
    __device__ __forceinline__ void operator()(const f32x4 (&acc)[2][2][4][2], const Unit& u, int wr, int wc, int fr, int fq) const {
        unsigned char* H = this->H; asm volatile("" : "+s"(H));
        const int col0 = (u.pn & 3) * 128 + wc * 32 + 8 * fq;
        const int odd = fq & 1;
#pragma unroll
        for (int ai = 0; ai < 2; ++ai)
#pragma unroll
            for (int m = 0; m < 4; m += 2) { int w[2][2];
#pragma unroll
                for (int mm = 0; mm < 2; ++mm) { float h[8];
#pragma unroll
                    for (int n = 0; n < 2; ++n)
#pragma unroll
                        for (int k = 0; k < 4; ++k) { const float gt = acc[ai][0][m + mm][n][k], up = acc[ai][1][m + mm][n][k];
                            h[n * 4 + k] = gt * __builtin_amdgcn_rcpf(1.f + __builtin_amdgcn_exp2f(-1.4426950408889634f * gt)) * up * osc; }
                    int w0 = 0, w1 = 0;
                    w0 = __builtin_amdgcn_cvt_pk_fp8_f32(h[0], h[1], w0, false); w0 = __builtin_amdgcn_cvt_pk_fp8_f32(h[2], h[3], w0, true);
                    w1 = __builtin_amdgcn_cvt_pk_fp8_f32(h[4], h[5], w1, false); w1 = __builtin_amdgcn_cvt_pk_fp8_f32(h[6], h[7], w1, true); w[mm][0] = w0; w[mm][1] = w1; }
                { auto r0 = __builtin_amdgcn_permlane16_swap((unsigned)w[0][0], (unsigned)w[1][0], false, false); w[0][0] = (int)r0[0]; w[1][0] = (int)r0[1];
                  auto r1 = __builtin_amdgcn_permlane16_swap((unsigned)w[0][1], (unsigned)w[1][1], false, false); w[0][1] = (int)r1[0]; w[1][1] = (int)r1[1]; }
                unsigned char* rowp = H + (size_t)(u.pm * BM + ai * HALF + wr * 64 + (m + odd) * 16 + fr) * 512 + col0 - 8 * odd;
                *(u32x4*)rowp = (u32x4){(unsigned)w[0][0], (unsigned)w[0][1], (unsigned)w[1][0], (unsigned)w[1][1]}; }
    }
};
struct EpiDown {
    static constexpr bool PERM = true;
    bf16_t* SO;
    __device__ __forceinline__ void operator()(const f32x4 (&acc)[2][2][4][2], const Unit& u, int wr, int wc, int fr, int fq) const {
        bf16_t* SO = this->SO; asm volatile("" : "+s"(SO)); const int* rows_ = u.rows; asm volatile("" : "+v"(fr), "+v"(fq));
        const int col0 = (u.pn & 3) * BM + wc * 32 + 8 * fq;
        const int odd = fq & 1;
#pragma unroll
        for (int ai = 0; ai < 2; ++ai)
#pragma unroll
            for (int m = 0; m < 4; ++m) { const int r = ai * HALF + wr * 64 + m * 16 + fr;
                int w[2][2];
#pragma unroll
                for (int bj = 0; bj < 2; ++bj) { const f32x4 v0 = acc[ai][bj][m][0] * 16.f, v1 = acc[ai][bj][m][1] * 16.f;
                    int w0 = 0, w1 = 0; w0 = __builtin_amdgcn_cvt_pk_fp8_f32(v0[0], v0[1], w0, false); w0 = __builtin_amdgcn_cvt_pk_fp8_f32(v0[2], v0[3], w0, true);
                    w1 = __builtin_amdgcn_cvt_pk_fp8_f32(v1[0], v1[1], w1, false); w1 = __builtin_amdgcn_cvt_pk_fp8_f32(v1[2], v1[3], w1, true); w[bj][0] = w0; w[bj][1] = w1; }
                { auto r0 = __builtin_amdgcn_permlane16_swap((unsigned)w[0][0], (unsigned)w[1][0], false, false); w[0][0] = (int)r0[0]; w[1][0] = (int)r0[1];
                  auto r1 = __builtin_amdgcn_permlane16_swap((unsigned)w[0][1], (unsigned)w[1][1], false, false); w[0][1] = (int)r1[0]; w[1][1] = (int)r1[1]; }
                if (r >= 0 && r < u.nvalid) { const int ent = rows_[r]; unsigned char* rowp8 = (unsigned char*)SO + (size_t)ent * 1024 + col0 + (odd ? HALF - 8 : 0);
                    *(u32x4*)rowp8 = odd ? (u32x4){(unsigned)w[0][0], (unsigned)w[0][1], (unsigned)w[1][0], (unsigned)w[1][1]} : (u32x4){(unsigned)w[0][0], (unsigned)w[0][1], (unsigned)w[1][0], (unsigned)w[1][1]}; }
                __builtin_amdgcn_sched_barrier(0); }
    }
};

template <class Epi, class Sched, bool GATHER, bool FP8 = false>
__device__ __forceinline__ void gemm_phase(PG8_LAS unsigned char* lds, const Gemm g, const Sched& S, const Epi& E, int wv  ) {
    asm volatile("" : "+s"(wv));
    const int lane = lane_now(), wid = __builtin_amdgcn_readfirstlane(wv), tid = wid * 64 + lane,
               wr = wid >> 2, wc = wid & 3, fr = lane & 15, fq = lane >> 4;
    const int K = g.K, nt = K / BK;
    unsigned voffB[2];
#pragma unroll
    for (int i = 0; i < 2; ++i) { int R, C; stage_rc(tid * 16 + i * 8192, R, C); const int Rb = Epi::PERM ? ((R & ~31) + perm32(R & 31)) : R; voffB[i] = (unsigned)(Rb * K + C) * 2u; }
    const unsigned kstep = (unsigned)(BK * 2);
    const unsigned hstep = (unsigned)HALF * (unsigned)K * 2u;
    const unsigned tstep = 2u * hstep;
    const __amdgpu_buffer_rsrc_t rsA = __builtin_amdgcn_make_buffer_rsrc((void*)g.base, 0, 0x7ffffff0, 0x00020000);
#define rsB rsA
    const unsigned ldsw = (unsigned)wid * 1024u;
    const int aoff = lds_byte(wr * 64 + fr, fq * 8), boff = lds_byte(wc * 32 + fr, fq * 8);
    const PG8_LAS unsigned char* ldsB = lds + 4 * HTB + boff; asm volatile("" : "+v"(ldsB));
#define PG8_SA(b, h) (((b) * 2 + (h)) * HTB)
#define PG8_SB(b, h) ((4 + (b) * 2 + (h)) * HTB)
#define PG8_STAGE_A(bufoff, soff, voff) do { _Pragma("unroll") for (int _i = 0; _i < 2; ++_i) \
        __builtin_amdgcn_raw_ptr_buffer_load_lds(rsA, (PG8_LAS unsigned*)(lds + (bufoff) + ldsw + _i * 8192), 16, (int)(voff)[_i], (int)(soff), 0, 0); } while (0)
#define PG8_STAGE_B(bufoff, soff, voff) do { _Pragma("unroll") for (int _i = 0; _i < 2; ++_i) \
        __builtin_amdgcn_raw_ptr_buffer_load_lds(rsB, (PG8_LAS unsigned*)(lds + (bufoff) + ldsw + _i * 8192), 16, (int)(voff)[_i], (int)(soff), 0, 0); } while (0)
#define PG8_LDA(dst, b, h) do { _Pragma("unroll") for (int m = 0; m < 4; ++m) _Pragma("unroll") for (int k = 0; k < 2; ++k) dst[m][k] = *(const PG8_LAS bf16x8*)(lds + PG8_SA(b, h) + aoff + m * 2048 + k * 1024); } while (0)
#define PG8_LDB(dst, b, h) do { _Pragma("unroll") for (int n = 0; n < 2; ++n) _Pragma("unroll") for (int k = 0; k < 2; ++k) dst[n][k] = *(const PG8_LAS bf16x8*)(ldsB + ((b) * 2 + (h)) * HTB + n * 2048 + k * 1024); } while (0)
#define PG8_MMA(ai, bj, At, Bt) do { __builtin_amdgcn_s_setprio(1); _Pragma("unroll") for (int m = 0; m < 4; ++m) _Pragma("unroll") for (int n = 0; n < 2; ++n) _Pragma("unroll") for (int k = 0; k < 2; ++k) \
        acc[ai][bj][m][n] = __builtin_amdgcn_mfma_f32_16x16x32_bf16(Bt[n][k], At[m][k], acc[ai][bj][m][n], 0, 0, 0); __builtin_amdgcn_s_setprio(0); } while (0)
#define PG8_RD16(off) (*(const PG8_LAS v4i_t*)(lds + (off)))
#define PG8_CAT(x0, x1) __builtin_shufflevector(x0, x1, 0, 1, 2, 3, 4, 5, 6, 7)
#define PG8_LDA8(dst, b, h) do { _Pragma("unroll") for (int m = 0; m < 4; ++m) dst[m] = PG8_CAT(PG8_RD16(PG8_SA(b, h) + aoff + m * 2048), PG8_RD16(PG8_SA(b, h) + aoff + m * 2048 + 1024)); } while (0)
#define PG8_LDB8(dst, b, h) do { _Pragma("unroll") for (int n = 0; n < 2; ++n) dst[n] = PG8_CAT(*(const PG8_LAS v4i_t*)(ldsB + ((b) * 2 + (h)) * HTB + n * 2048), *(const PG8_LAS v4i_t*)(ldsB + ((b) * 2 + (h)) * HTB + n * 2048 + 1024)); } while (0)
#define PG8_MMA8(ai, bj, At, Bt) do { __builtin_amdgcn_s_setprio(1); _Pragma("unroll") for (int m = 0; m < 4; ++m) _Pragma("unroll") for (int n = 0; n < 2; ++n) \
        acc[ai][bj][m][n] = __builtin_amdgcn_mfma_scale_f32_16x16x128_f8f6f4(Bt[n], At[m], acc[ai][bj][m][n], 0, 0, 1, g.sA, 0, g.sA);     __builtin_amdgcn_s_setprio(0); } while (0)
#define PG8_LA(b, h) do { if constexpr (FP8) PG8_LDA8(At8, b, h); else PG8_LDA(At, b, h); } while (0)
#define PG8_LB0(b, h) do { if constexpr (FP8) PG8_LDB8(B08, b, h); else PG8_LDB(B0, b, h); } while (0)
#define PG8_LB1(b, h) do { if constexpr (FP8) PG8_LDB8(B18, b, h); else PG8_LDB(B1, b, h); } while (0)
#define PG8_MM0(ai, bj) do { if constexpr (FP8) PG8_MMA8(ai, bj, At8, B08); else PG8_MMA(ai, bj, At, B0); } while (0)
#define PG8_MM1(ai, bj) do { if constexpr (FP8) PG8_MMA8(ai, bj, At8, B18); else PG8_MMA(ai, bj, At, B1); } while (0)
#define PG8_WAIT_V(n) asm volatile("s_waitcnt vmcnt(" #n ")" ::: "memory")
#define PG8_WAIT_L(n) asm volatile("s_waitcnt lgkmcnt(" #n ")" ::: "memory")
#define PG8_BAR __builtin_amdgcn_s_barrier()
#define PG8_SCHED __builtin_amdgcn_sched_barrier(0)
#define PG8_CALC_VOFF(u, vo) do { _Pragma("unroll") for (int h_ = 0; h_ < 2; ++h_) _Pragma("unroll") for (int i_ = 0; i_ < 2; ++i_) { int R_, C_; stage_rc(tid * 16 + i_ * 8192, R_, C_); \
        if constexpr (GATHER) { const int tok_ = S.arow(u, h_ * HALF + R_); vo[h_][i_] = (unsigned)(tok_ * K + C_) * 2u; } \
        else vo[h_][i_] = (unsigned)(R_ * K + C_) * 2u + (unsigned)(h_ * hstep); } } while (0)
    Unit cur, nxt; int ui = 0;
    if (!S.next(0, cur)) return;
    unsigned vA[2][2], nvA[2][2];
    PG8_CALC_VOFF(cur, vA);
    if constexpr (GATHER) asm volatile("" : "+v"(vA[0][0]), "+v"(vA[0][1]), "+v"(vA[1][0]), "+v"(vA[1][1]));
    f32x4 acc[2][2][4][2];
#pragma unroll
    for (int a = 0; a < 2; ++a)
#pragma unroll
        for (int b = 0; b < 2; ++b)
#pragma unroll
            for (int m = 0; m < 4; ++m)
#pragma unroll
                for (int n = 0; n < 2; ++n) acc[a][b][m][n] = (f32x4){0.f, 0.f, 0.f, 0.f};
    bf16x8 At[4][2], B0[2][2], B1[2][2]; v8i_t At8[4], B08[2], B18[2];
    unsigned cA = g.offA + (GATHER ? 0u : (unsigned)cur.pm * tstep), cB = g.offB + (unsigned)cur.pn * tstep;
    PG8_STAGE_B(PG8_SB(0, 0), cB, voffB); PG8_STAGE_B(PG8_SB(0, 1), cB + hstep, voffB); PG8_STAGE_A(PG8_SA(0, 0), cA, vA[0]); PG8_STAGE_A(PG8_SA(0, 1), cA, vA[1]);
    if (wr == 1) PG8_BAR;
    PG8_WAIT_V(2); PG8_BAR;
    PG8_STAGE_B(PG8_SB(1, 0), cB + kstep, voffB); PG8_STAGE_A(PG8_SA(1, 0), cA + kstep, vA[0]); PG8_STAGE_B(PG8_SB(1, 1), cB + hstep + kstep, voffB);
    PG8_WAIT_V(6); PG8_BAR;
    for (;;) {
        const bool has_next = S.next(ui + 1, nxt);
        const unsigned nA = has_next ? g.offA + (GATHER ? 0u : (unsigned)nxt.pm * tstep) : cA, nB = has_next ? g.offB + (unsigned)nxt.pn * tstep : cB;
        if constexpr (GATHER) {
            if (has_next) { PG8_CALC_VOFF(nxt, nvA); }
            else {
#pragma unroll
                for (int h_ = 0; h_ < 2; ++h_)
#pragma unroll
                    for (int i_ = 0; i_ < 2; ++i_) nvA[h_][i_] = vA[h_][i_]; }
            asm volatile("" : "+v"(nvA[0][0]), "+v"(nvA[0][1]), "+v"(nvA[1][0]), "+v"(nvA[1][1]));
        }
#pragma clang loop unroll(disable)
        for (int t = 0; t < nt; t += 2) {
            const bool last = (t == nt - 2);
            const unsigned a1 = cA + (unsigned)(t + 1) * kstep;
            const unsigned a2 = last ? nA : cA + (unsigned)(t + 2) * kstep, b2 = last ? nB : cB + (unsigned)(t + 2) * kstep;
            const unsigned a3 = a2 + kstep, b3 = b2 + kstep;
            PG8_LB0(0, 0); PG8_LB1(0, 1); PG8_SCHED; PG8_LA(0, 0); PG8_STAGE_A(PG8_SA(1, 1), a1, vA[1]);
            if constexpr (GATHER) { if (last) { _Pragma("unroll") for (int h_ = 0; h_ < 2; ++h_) _Pragma("unroll") for (int i_ = 0; i_ < 2; ++i_) vA[h_][i_] = nvA[h_][i_]; } }
            PG8_WAIT_V(8); PG8_WAIT_L(0); PG8_BAR; PG8_MM0(0, 0); PG8_MM1(0, 1); PG8_BAR; PG8_SCHED;
            PG8_LA(0, 1); PG8_STAGE_B(PG8_SB(0, 0), b2, voffB); PG8_STAGE_B(PG8_SB(0, 1), b2 + hstep, voffB); PG8_STAGE_A(PG8_SA(0, 0), a2, vA[0]);
            PG8_WAIT_V(8); PG8_WAIT_L(0); PG8_BAR; PG8_MM0(1, 0); PG8_MM1(1, 1); PG8_BAR; PG8_SCHED;
            PG8_LB0(1, 0); PG8_LB1(1, 1); PG8_SCHED; PG8_LA(1, 0); PG8_STAGE_A(PG8_SA(0, 1), a2, vA[1]);
            PG8_WAIT_V(8); PG8_WAIT_L(0); PG8_BAR; PG8_MM0(0, 0); PG8_MM1(0, 1); PG8_BAR; PG8_SCHED;
            PG8_LA(1, 1); PG8_STAGE_B(PG8_SB(1, 0), b3, voffB); PG8_STAGE_B(PG8_SB(1, 1), b3 + hstep, voffB); PG8_STAGE_A(PG8_SA(1, 0), a3, vA[0]);
            PG8_WAIT_V(8); PG8_WAIT_L(0); PG8_BAR; PG8_MM0(1, 0); PG8_MM1(1, 1); PG8_BAR; PG8_SCHED;
        }
        if (wr == 0) PG8_BAR;
        { const int ln_ = lane_now(); E(acc, cur, wr, wc, ln_ & 15, ln_ >> 4); }
        if (!has_next) break;
#pragma unroll
        for (int a = 0; a < 2; ++a)
#pragma unroll
            for (int b = 0; b < 2; ++b)
#pragma unroll
                for (int m = 0; m < 4; ++m)
#pragma unroll
                    for (int n = 0; n < 2; ++n) acc[a][b][m][n] = (f32x4){0.f, 0.f, 0.f, 0.f};
        cur = nxt; cA = nA; cB = nB; ++ui;
        if (wr == 1) PG8_BAR;
    }
    PG8_WAIT_V(0);
    PG8_BAR;
#undef PG8_SA
#undef PG8_SB
#undef PG8_STAGE_A
#undef rsB
#undef PG8_STAGE_B
#undef PG8_LDA
#undef PG8_LDB
#undef PG8_MMA
#undef PG8_MMA8
#undef PG8_CAT
#undef PG8_RD16
#undef PG8_LDA8
#undef PG8_LDB8
#undef PG8_LA
#undef PG8_LB0
#undef PG8_LB1
#undef PG8_MM0
#undef PG8_MM1
#undef PG8_WAIT_V
#undef PG8_WAIT_L
#undef PG8_BAR
#undef PG8_SCHED
#undef PG8_CALC_VOFF
}
}

namespace attn_body {
using bf16=__hip_bfloat16;
using bf16x8=__attribute__((ext_vector_type(8)))short;
using s16x4=__attribute__((ext_vector_type(4)))short;
using f32x16=__attribute__((ext_vector_type(16)))float;
using u32x4=__attribute__((ext_vector_type(4)))unsigned;
constexpr int SEQ=16384,D=64;
constexpr int LDQ=3072;
constexpr int LDO=1024;
constexpr int NW=8,QBLK=32,QB=QBLK*NW,KVBLK=64,NQB=SEQ/QB;
__device__ __forceinline__ int crow(int r,int hi){return (r&3)+8*(r>>2)+4*hi;}
#define SBAR() __builtin_amdgcn_sched_barrier(0)
#ifndef PRIO_G1A1
#define PRIO_G1A1 2
#define PRIO_G1B1 0
#define PRIO_G1A2 2
#define PRIO_G1B2 0
#define PRIO_G2A1 2
#define PRIO_G2B1 1
#define PRIO_G2A2 2
#define PRIO_G2B2 1
#endif
#if defined(STAMP_PROBE)
#ifndef STAMP_WAVE
#define STAMP_WAVE 0
#endif
#define STAMP_PARAM ,float*dbg
#define STAMP_NOW() ((unsigned)__builtin_amdgcn_s_memtime())
#if STAMP_PROBE == 2
#define STAMP_DECL unsigned st_pre_=0u,st_acc_=0u,st_n_=0u;
#define STAMP_PRE  { st_pre_=STAMP_NOW(); }
#define STAMP_POST { st_acc_+=STAMP_NOW()-st_pre_; ++st_n_; }
#define STAMP_FINI { if(dbg&&wid==STAMP_WAVE&&lane_now()==0&&st_n_>0u){ dbg[2]=(float)st_acc_/(float)st_n_; } }
#elif STAMP_PROBE == 1
#define STAMP_DECL const unsigned st_t0_=STAMP_NOW(); const unsigned st_r0_=(unsigned)__builtin_amdgcn_s_memrealtime();
#define STAMP_PRE
#define STAMP_POST
#define STAMP_FINI { const unsigned t1_=STAMP_NOW(),r1_=(unsigned)__builtin_amdgcn_s_memrealtime(); if(dbg&&wid==STAMP_WAVE&&lane_now()==0){ dbg[1]=(float)(t1_-st_t0_)/(float)(r1_-st_r0_)*100.0f; } }
#else
#define STAMP_DECL const unsigned st_t0_=STAMP_NOW(); const int st_ts_=t;
#define STAMP_PRE
#define STAMP_POST
#define STAMP_FINI { const unsigned t1_=STAMP_NOW(); if(dbg&&wid==STAMP_WAVE&&lane_now()==0&&t>st_ts_){ dbg[0]=(float)(t1_-st_t0_)/(float)(t-st_ts_); dbg[4]=5000.0f; } }
#endif
#else
#define STAMP_PARAM
#define STAMP_DECL
#define STAMP_PRE
#define STAMP_POST
#define STAMP_FINI
#endif
#ifndef STAMP_PLACE
#define STAMP_PLACE 0
#endif
#if STAMP_PLACE == 0
#define SP_W0 STAMP_PRE
#define SP_W1 STAMP_POST
#else
#define SP_W0
#define SP_W1
#endif
#if STAMP_PLACE == 1
#define SP_A0 STAMP_PRE
#define SP_A1 STAMP_POST
#else
#define SP_A0
#define SP_A1
#endif
#if STAMP_PLACE == 2
#define SP_B0 STAMP_PRE
#define SP_B1 STAMP_POST
#else
#define SP_B0
#define SP_B1
#endif
#if STAMP_PLACE == 3
#define SP_D0 STAMP_PRE
#define SP_D1 STAMP_POST
#else
#define SP_D0
#define SP_D1
#endif
typedef __attribute__((address_space(3))) const float* lds_cfptr;
__device__ __forceinline__ void biasmask(f32x16&p0,f32x16&p1,int jb,int qrel,int hi,lds_cfptr bl){
  const float NEG=-INFINITY; const int kb=64*jb+4*hi;
  #pragma unroll
  for(int g=0;g<4;++g){
    float b0[4],b1[4]; int d0v[4];
    #pragma unroll
    for(int rr=0;rr<4;++rr){const int r=4*g+rr; const int kv=kb+(r&3)+8*(r>>2); const int d0=qrel-kv,d1=d0-32; d0v[rr]=d0;
      const int i0=d0<0?0:(d0>127?127:d0), i1=d1<0?0:(d1>127?127:d1);
      b0[rr]=bl[i0]; b1[rr]=bl[i1];}
    asm volatile("":"+v"(b0[0]),"+v"(b0[1]),"+v"(b0[2]),"+v"(b0[3]),"+v"(b1[0]),"+v"(b1[1]),"+v"(b1[2]),"+v"(b1[3]));
    #pragma unroll
    for(int rr=0;rr<4;++rr){const int r=4*g+rr; const int d0=d0v[rr],d1=d0-32;
      p0[r]=d0<0?NEG:p0[r]+b0[rr]; p1[r]=d1<0?NEG:p1[r]+b1[rr];}
    __builtin_amdgcn_sched_barrier(0); }
}

constexpr int LDS_BT4=49152+4096;
__device__ __forceinline__ void biasmask4(f32x16&p0,f32x16&p1,int jb,int qrel,int hi,__attribute__((address_space(3))) const char* shm3){
  const int j=qrel-64*jb-4*hi+197;
  const __attribute__((address_space(3))) char* a=shm3+LDS_BT4+(j&3)*2048+(j&~3)*4;
  #pragma unroll
  for(int g=0;g<4;++g){ const pg8::f32x4 v0=*(const __attribute__((address_space(3))) pg8::f32x4*)(a+128+32*(3-g)), v1=*(const __attribute__((address_space(3))) pg8::f32x4*)(a+32*(3-g));
    #pragma unroll
    for(int rr=0;rr<4;++rr){ p0[4*g+rr]=(v0[3-rr]==-INFINITY)?-INFINITY:p0[4*g+rr]+v0[3-rr]; p1[4*g+rr]=(v1[3-rr]==-INFINITY)?-INFINITY:p1[4*g+rr]+v1[3-rr]; } }
}

#define BMM(P0,P1,jb,q,h) biasmask(P0,P1,jb,q,h,bl)
#define BMF(P0,P1,jb,q,h) biasmask4(P0,P1,jb,q,h,shm3)
constexpr int NSLOT=3, SLOTB=8192;
constexpr int LDS_K=0, LDS_V=NSLOT*SLOTB, LDS_WS=2*NSLOT*SLOTB, LDS_OST=LDS_WS+NW*128*4+8192, LDS_BIAS=LDS_OST+NW*4096, LDS_BYTES=LDS_BIAS+512;
constexpr float C2=0.125f*1.4426950408889634f;
__device__ __forceinline__ void glds16(const void*gsrc,unsigned lds_dst){unsigned keep;
  asm volatile("s_mov_b32 %0, m0\n\ts_mov_b32 m0, %2\n\ts_nop 0\n\tglobal_load_lds_dwordx4 %1, off\n\ts_mov_b32 m0, %0\n\ts_nop 0":"=&s"(keep):"v"(gsrc),"s"(lds_dst):"memory");}
__device__ __forceinline__ float max3f(float a,float b,float c){float r;asm("v_max3_f32 %0, %1, %2, %3":"=v"(r):"v"(a),"v"(b),"v"(c));return r;}
__device__ __forceinline__ float max2f(float a,float b){float r;asm("v_max_f32_e32 %0, %1, %2":"=v"(r):"v"(a),"v"(b));return r;}
__device__ __forceinline__ float fadd_s(float a,float b){float r;asm("v_add_f32_e32 %0, %1, %2":"=v"(r):"v"(a),"v"(b));return r;}
__device__ __forceinline__ float fsub_s(float a,float b){float r;asm("v_sub_f32_e32 %0, %1, %2":"=v"(r):"v"(a),"v"(b));return r;}
typedef float f32x2_t __attribute__((ext_vector_type(2))); typedef __bf16 bf16x2_t __attribute__((ext_vector_type(2)));
__device__ __forceinline__ unsigned cvtpk_s(float lo,float hi){f32x2_t v={lo,hi};bf16x2_t b=__builtin_convertvector(v,bf16x2_t);return __builtin_bit_cast(unsigned,b);}
#define WAIT_BAR(N) asm volatile("s_waitcnt vmcnt(" #N ") lgkmcnt(0)\n\ts_barrier":::"memory")

__device__ __forceinline__ void qkt(f32x16&p0,f32x16&p1,const char*Kslot,const bf16x8*qr,const f32x16&negm,int r32,int hi){
  const char*kb=Kslot+hi*1024+r32*16;
  #pragma unroll
  for(int d0=0;d0<4;++d0){
    const bf16x8 b0=*reinterpret_cast<const bf16x8*>(kb+d0*2048);
    const bf16x8 b1=*reinterpret_cast<const bf16x8*>(kb+d0*2048+512);
    if(d0==0){p0=__builtin_amdgcn_mfma_f32_32x32x16_bf16(b0,qr[0],negm,0,0,0);p1=__builtin_amdgcn_mfma_f32_32x32x16_bf16(b1,qr[0],negm,0,0,0);}
    else{p0=__builtin_amdgcn_mfma_f32_32x32x16_bf16(b0,qr[d0],p0,0,0,0);p1=__builtin_amdgcn_mfma_f32_32x32x16_bf16(b1,qr[d0],p1,0,0,0);}}
}
typedef __attribute__((address_space(3))) const char* lds_cptr;
typedef short v4i16_t __attribute__((ext_vector_type(4)));
__device__ __forceinline__ void kload8(bf16x8*kf,lds_cptr kp){
  kf[0]=*(const __attribute__((address_space(3))) bf16x8*)(kp);      kf[1]=*(const __attribute__((address_space(3))) bf16x8*)(kp+512);
  kf[2]=*(const __attribute__((address_space(3))) bf16x8*)(kp+2048); kf[3]=*(const __attribute__((address_space(3))) bf16x8*)(kp+2560);
  kf[4]=*(const __attribute__((address_space(3))) bf16x8*)(kp+4096); kf[5]=*(const __attribute__((address_space(3))) bf16x8*)(kp+4608);
  kf[6]=*(const __attribute__((address_space(3))) bf16x8*)(kp+6144); kf[7]=*(const __attribute__((address_space(3))) bf16x8*)(kp+6656);
}
__device__ __forceinline__ void kload2(bf16x8*kf,lds_cptr kp,int j){ kf[2*j]=*(const __attribute__((address_space(3))) bf16x8*)(kp+j*2048); kf[2*j+1]=*(const __attribute__((address_space(3))) bf16x8*)(kp+j*2048+512); }
__device__ __forceinline__ s16x4 vtr(lds_cptr p){ return __builtin_bit_cast(s16x4,__builtin_amdgcn_ds_read_tr16_b64_v4i16((__attribute__((address_space(3))) v4i16_t*)p)); }
__device__ __forceinline__ float rowmax(const f32x16&p0,const f32x16&p1){
  float a=max3f(p0[0],p0[1],p1[0]),b=max3f(p0[2],p0[3],p1[1]);a=max3f(a,p1[2],p1[3]);
  #pragma unroll
  for(int r=4;r<16;r+=4){a=max3f(a,p0[r],p0[r+1]);b=max3f(b,p0[r+2],p0[r+3]);a=max3f(a,p1[r],p1[r+1]);b=max3f(b,p1[r+2],p1[r+3]);}
  const float m=max2f(a,b);
  auto rr=__builtin_amdgcn_permlane32_swap(__float_as_uint(m),__float_as_uint(m),false,false);
  return max2f(__uint_as_float(rr[0]),__uint_as_float(rr[1]));
}
__device__ __forceinline__ float rowmax_c(const f32x16&p0,const f32x16&p1){
  float a=__builtin_fmaxf(p0[0],p1[0]);
  #pragma unroll
  for(int r=1;r<16;++r){a=__builtin_fmaxf(a,__builtin_fmaxf(p0[r],p1[r]));}
  auto rr=__builtin_amdgcn_permlane32_swap(__float_as_uint(a),__float_as_uint(a),false,false);
  return __builtin_fmaxf(__uint_as_float(rr[0]),__uint_as_float(rr[1]));
}
__device__ __forceinline__ void pv(f32x16*o,int vb,bf16x8 pa0,bf16x8 pa1,bf16x8 pa2,bf16x8 pa3){
  #pragma unroll
  for(int d0=0;d0<2;++d0){s16x4 lo[4],hi[4];
    #pragma unroll
    for(int ks=0;ks<4;++ks){
      asm volatile("ds_read_b64_tr_b16 %0,%1 offset:%c2":"=&v"(lo[ks]):"v"(vb),"i"(d0*4096+ks*1024):"memory");
      asm volatile("ds_read_b64_tr_b16 %0,%1 offset:%c2":"=&v"(hi[ks]):"v"(vb),"i"(d0*4096+ks*1024+512):"memory");}
    asm volatile("s_waitcnt lgkmcnt(0)":::"memory");SBAR();
    #define PK(k) (bf16x8){lo[k][0],lo[k][1],lo[k][2],lo[k][3],hi[k][0],hi[k][1],hi[k][2],hi[k][3]}
    o[d0]=__builtin_amdgcn_mfma_f32_32x32x16_bf16(pa0,PK(0),o[d0],0,0,0);
    o[d0]=__builtin_amdgcn_mfma_f32_32x32x16_bf16(pa1,PK(1),o[d0],0,0,0);
    o[d0]=__builtin_amdgcn_mfma_f32_32x32x16_bf16(pa2,PK(2),o[d0],0,0,0);
    o[d0]=__builtin_amdgcn_mfma_f32_32x32x16_bf16(pa3,PK(3),o[d0],0,0,0);
    #undef PK
  }
}
__device__ __forceinline__ float bflo(unsigned u){return __uint_as_float(u<<16);}
__device__ __forceinline__ float bfhi(unsigned u){return __uint_as_float(u&0xffff0000u);}

struct MobaMerge { const float* pml; const bf16* po; long grow0; int h; int ns; };
constexpr long MROWS=2L*SEQ;
struct QNext { bf16x8 a,b,c,d; };
struct GatherArgs { unsigned gent; int n; float* pml; bf16* po; long growb; int h; char* dump; };
__device__ __forceinline__ void gbias(f32x16&p0,f32x16&p1,int dq,int hi,lds_cfptr bl){
  #pragma unroll
  for(int g=0;g<4;++g){
    #pragma unroll
    for(int rr=0;rr<4;++rr){const int r=4*g+rr; const int d0=dq-(4*hi+(r&3)+8*(r>>2)),d1=d0-32;
      const int i0=d0<0?0:(d0>127?127:d0), i1=d1<0?0:(d1>127?127:d1);
      p0[r]+=bl[i0]; p1[r]+=bl[i1];}
    __builtin_amdgcn_sched_barrier(0); }
}

template<int THRL,int MODE> __device__ __forceinline__ QNext attn_unit(const bf16*Qp,const bf16*__restrict__ Kp,const bf16*__restrict__ Vp,bf16*Op,int q0,int kv0,int NT,const float*biasG,const MobaMerge&mm,const GatherArgs&ga,char*shm,int wv,bool newtab=true,bool pre=false,int sb=0,const bf16*nQl=nullptr,const bf16*nKh=nullptr,const bf16*nVh=nullptr,QNext qin=QNext{},bool keepbar=true){
  QNext qout{};
  const int lane=lane_now();
  asm volatile("":"+s"(wv)); const int wid=__builtin_amdgcn_readfirstlane(wv), tid=wid*64+lane, r32=lane&31, hi=lane>>5;
  unsigned gent=0u; int qloc=0;
  if constexpr(MODE==2){ gent=ga.gent; qloc=(int)(gent&0x3FFFu); }
  const bf16*Qw=(MODE==2)?(Qp+(long)(qloc-r32)*LDQ):(Qp+(long)(q0+wid*QBLK)*LDQ);
  const bf16*Kh=Kp+(long)kv0*LDQ,*Vh=Vp+(long)kv0*LDQ;
  const unsigned lds0=(unsigned)(uintptr_t)shm;
  float*wsf=(float*)(shm+LDS_WS)+wid*128;
  const lds_cptr shm3=(lds_cptr)shm;
  asm volatile("":"+s"(biasG));
  if(newtab && wid==0){ glds16((const char*)biasG+lane*16,(unsigned)__builtin_amdgcn_readfirstlane(lds0+LDS_BIAS)); }
  const lds_cfptr bl=(lds_cfptr)(shm3+LDS_BIAS);
  const bf16*ksrc=Kh+(long)lane*LDQ+wid*8;
  const bf16*vsrc=Vh+(long)(16*(wid&3)+(lane>>2))*LDQ+(wid>>2)*32+(lane&3)*8;
  const unsigned kdst=lds0+LDS_K+wid*1024, vdst=lds0+LDS_V+wid*1024;
  #define DMA_K(t,slot) glds16(ksrc+(long)(t)*KVBLK*LDQ,(unsigned)__builtin_amdgcn_readfirstlane(kdst+(slot)))
  #define DMA_V(t,slot) glds16(vsrc+(long)(t)*KVBLK*LDQ,(unsigned)__builtin_amdgcn_readfirstlane(vdst+(slot)))
  const int vb0=(int)(lds0+LDS_V)+((lane>>4)&1)*32+(lane&3)*8+(4*hi+((lane&15)>>2))*64;
  const char*Kbase=shm+LDS_K; bf16x8 kf[8];
  const lds_cptr kp0=shm3+LDS_K+hi*1024+r32*16; const lds_cptr vp0=shm3+LDS_V+((lane>>4)&1)*32+(lane&3)*8+(4*hi+((lane&15)>>2))*64;
  const int s0=sb, s1=(s0==(NSLOT-1)*SLOTB)?0:s0+SLOTB, s2=(s1==(NSLOT-1)*SLOTB)?0:s1+SLOTB;
  if(!pre){DMA_K(0,s0);DMA_V(0,s0);DMA_K(1,s1);}
  bf16x8 qr[4];
  if(MODE==2 && pre){
    { qr[0]=qin.a; qr[1]=qin.b; qr[2]=qin.c; qr[3]=qin.d; }
  } else {
    #pragma unroll
    for(int d0=0;d0<4;++d0)qr[d0]=*reinterpret_cast<const bf16x8*>(&Qw[(long)r32*LDQ+d0*16+hi*8]);
  }
  float mhat=0.f,l_reg=0.f;f32x16 o[2];o[0]=f32x16{};o[1]=f32x16{};f32x16 negm=f32x16{};asm volatile("":"+v"(negm));
  const int qrel=wid*QBLK+r32;
  const bool nearq=(MODE==2)?(bool)__any(qloc-(kv0+128)<128+113):false;
  #define CMASK(P0,P1,t) do{ if constexpr(MODE==2){ if((t)>=2 && nearq)gbias(P0,P1,qloc-(kv0+64*(t)),hi,bl); } else { int jb_=(t)-(NT-4); if(jb_>=-2 && (32*wid-(64*jb_+63))<113)BMM(P0,P1,jb_,qrel,hi); } }while(0)
  bool resc=false;
  #define START(P0,P1) do{ const float rm=rowmax(P0,P1); resc=false; \
    { const float dl=rm; mhat=fadd_s(mhat,dl); \
      _Pragma("unroll") for(int r=0;r<16;++r){P0[r]=fsub_s(P0[r],dl);P1[r]=fsub_s(P1[r],dl);} \
      _Pragma("unroll") for(int r=0;r<16;++r)negm[r]=-mhat; asm volatile("":"+v"(negm)); } \
    _Pragma("unroll") for(int r=0;r<16;++r)P0[r]=__builtin_amdgcn_exp2f(P0[r]); }while(0)
  #define RESC() do{ if(resc){ asm volatile("s_waitcnt lgkmcnt(0)":::"memory"); \
      _Pragma("unroll") for(int d_=0;d_<2;++d_) _Pragma("unroll") for(int r=0;r<16;++r)o[d_][r]*=wsf[crow(r,hi)]; } }while(0)
  f32x16 pA0,pA1,pB0,pB1;
  int sl_prev=s0,sl_cur=s0,sl_next=s1;
  #define ROT() do{sl_prev=sl_cur;sl_cur=sl_next;sl_next=(sl_next==(NSLOT-1)*SLOTB)?0:sl_next+SLOTB;}while(0)
  if(!pre){ DMA_K(2,s2);
    WAIT_BAR(3); }
  else { WAIT_BAR(7); }
  qkt(pA0,pA1,Kbase+s0,qr,negm,r32,hi);asm volatile("s_nop 15\n\ts_nop 7":"+v"(pA0),"+v"(pA1));CMASK(pA0,pA1,0);
  START(pA0,pA1);
  _Pragma("unroll") for(int r=0;r<16;++r)pA1[r]=__builtin_amdgcn_exp2f(pA1[r]);
  WAIT_BAR(0);
  DMA_K(3,s0);DMA_V(1,s1);
  ROT();
  kload8(kf,kp0+sl_cur);
  WAIT_BAR(2);
  s16x4 vlo[8],vhi[8]; u32x4 pw0,pw1,pw2,pw3;
  #define PKW(P,B) cvtpk_s(P[B],P[B+1])
  #define PAF(k) __builtin_bit_cast(bf16x8,pw##k)
  #define VFR(i) (bf16x8){vlo[i][0],vlo[i][1],vlo[i][2],vlo[i][3],vhi[i][0],vhi[i][1],vhi[i][2],vhi[i][3]}
  #define PIN(x) asm volatile("":"+v"(x))
  #define MX3(a,b,c) __builtin_fmaxf(__builtin_fmaxf((a),(b)),(c))
  #define GAPA(MF,A0,A1,A2,A3,W0,W1,PW) do{ MF; sacc+=A0; sacc+=A1; sacc+=A2; sacc+=A3; PIN(sacc); W0; W1; PIN(PW); SBAR(); }while(0)
  #define EX(v) __builtin_amdgcn_exp2f(v)
  #define GAPB(MF,X,B) do{ MF; { float e0_=EX(X[B]),e1_=EX(X[B+1]),e2_=EX(X[B+2]),e3_=EX(X[B+3]); asm volatile("":"+v"(e0_),"+v"(e1_),"+v"(e2_),"+v"(e3_)); X[B]=e0_;X[B+1]=e1_;X[B+2]=e2_;X[B+3]=e3_; } SBAR(); }while(0)
  #define VRD(i) do{ vlo[i]=vtr(vp_+(((i)>>2)*4096+((i)&3)*1024)); vhi[i]=vtr(vp_+(((i)>>2)*4096+((i)&3)*1024+512)); }while(0)
  #define KRD(G,j) do{ if(G){ kload2(kf,kp0+sl_next,j); SBAR(); } }while(0)
  #define STEP(C0,C1,P0,P1,t,GK,GV,GL) do{ SBAR(); \
    const lds_cptr vp_=vp0+sl_prev; \
    VRD(0); SBAR(); float sacc=(P0[0]+P0[1]); \
    GAPA(C0=__builtin_amdgcn_mfma_f32_32x32x16_bf16(kf[0],qr[0],negm,0,0,0), P0[2],P0[3],P0[4],P0[5],     pw0[0]=PKW(P0,0), pw0[1]=PKW(P0,2), pw0); \
    VRD(4); SBAR(); GAPA(C1=__builtin_amdgcn_mfma_f32_32x32x16_bf16(kf[1],qr[0],negm,0,0,0), P0[6],P0[7],P0[8],P0[9],     pw0[2]=PKW(P0,4), pw0[3]=PKW(P0,6), pw0); \
    VRD(1); SBAR(); GAPA(C0=__builtin_amdgcn_mfma_f32_32x32x16_bf16(kf[2],qr[1],C0,0,0,0),   P0[10],P0[11],P0[12],P0[13], pw1[0]=PKW(P0,8), pw1[1]=PKW(P0,10), pw1); \
    VRD(5); SBAR(); GAPA(C1=__builtin_amdgcn_mfma_f32_32x32x16_bf16(kf[3],qr[1],C1,0,0,0),   P0[14],P0[15],P1[0],P1[1],   pw1[2]=PKW(P0,12),pw1[3]=PKW(P0,14), pw1); \
    VRD(2); SBAR(); GAPA(C0=__builtin_amdgcn_mfma_f32_32x32x16_bf16(kf[4],qr[2],C0,0,0,0),   P1[2],P1[3],P1[4],P1[5],     pw2[0]=PKW(P1,0), pw2[1]=PKW(P1,2), pw2); \
    VRD(6); SBAR(); GAPA(C1=__builtin_amdgcn_mfma_f32_32x32x16_bf16(kf[5],qr[2],C1,0,0,0),   P1[6],P1[7],P1[8],P1[9],     pw2[2]=PKW(P1,4), pw2[3]=PKW(P1,6), pw2); \
    VRD(3); SBAR(); GAPA(C0=__builtin_amdgcn_mfma_f32_32x32x16_bf16(kf[6],qr[3],C0,0,0,0),   P1[10],P1[11],P1[12],P1[13], pw3[0]=PKW(P1,8), pw3[1]=PKW(P1,10), pw3); \
    VRD(7); SBAR(); GAPA(C1=__builtin_amdgcn_mfma_f32_32x32x16_bf16(kf[7],qr[3],C1,0,0,0),   P1[14],P1[15],0.f,0.f,       pw3[2]=PKW(P1,12),pw3[3]=PKW(P1,14), pw3); \
    l_reg+=sacc; \
    CMASK(C0,C1,t); \
    { float a=MX3(C0[0],C0[1],C1[0]),b=MX3(C0[2],C0[3],C1[1]); a=MX3(a,C1[2],C1[3]); \
      _Pragma("unroll") for(int r=4;r<16;r+=4){a=MX3(a,C0[r],C0[r+1]);b=MX3(b,C0[r+2],C0[r+3]);a=MX3(a,C1[r],C1[r+1]);b=MX3(b,C1[r+2],C1[r+3]);} \
      float rm=__builtin_fmaxf(a,b); { auto rr=__builtin_amdgcn_permlane32_swap(__float_as_uint(rm),__float_as_uint(rm),false,false); rm=__builtin_fmaxf(__uint_as_float(rr[0]),__uint_as_float(rr[1])); } \
      resc=false; \
      if(__builtin_expect(__any(rm>(float)THRL),0)){ const float dl=__builtin_fmaxf(rm,0.f); mhat+=dl; \
        _Pragma("unroll") for(int r=0;r<16;++r){C0[r]-=dl;C1[r]-=dl;} \
        _Pragma("unroll") for(int r=0;r<16;++r)negm[r]=-mhat; asm volatile("":"+v"(negm)); \
        const float f=__builtin_amdgcn_exp2f(-dl); l_reg*=f; if(hi==0)wsf[r32]=f; resc=true; } } \
    SBAR(); \
    GAPB(o[0]=__builtin_amdgcn_mfma_f32_32x32x16_bf16(PAF(0),VFR(0),o[0],0,0,0), C0,0); \
    GAPB(o[1]=__builtin_amdgcn_mfma_f32_32x32x16_bf16(PAF(0),VFR(4),o[1],0,0,0), C0,4); \
    KRD(GL,0); GAPB(o[0]=__builtin_amdgcn_mfma_f32_32x32x16_bf16(PAF(1),VFR(1),o[0],0,0,0), C0,8); \
    KRD(GL,1); GAPB(o[1]=__builtin_amdgcn_mfma_f32_32x32x16_bf16(PAF(1),VFR(5),o[1],0,0,0), C0,12); \
    KRD(GL,2); GAPB(o[0]=__builtin_amdgcn_mfma_f32_32x32x16_bf16(PAF(2),VFR(2),o[0],0,0,0), C1,0); \
    KRD(GL,3); GAPB(o[1]=__builtin_amdgcn_mfma_f32_32x32x16_bf16(PAF(2),VFR(6),o[1],0,0,0), C1,4); \
    GAPB(o[0]=__builtin_amdgcn_mfma_f32_32x32x16_bf16(PAF(3),VFR(3),o[0],0,0,0), C1,8); \
    GAPB(o[1]=__builtin_amdgcn_mfma_f32_32x32x16_bf16(PAF(3),VFR(7),o[1],0,0,0), C1,12); \
    if(GK){DMA_K((t)+3,sl_cur);} if(GV){DMA_V((t)+1,sl_next);}   \
    }while(0)
  int t=1;
  #undef CMASK
  #define CMASK(P0,P1,t) do{}while(0)
  for(;t+7<NT;t+=2){
    STEP(pB0,pB1,pA0,pA1,t,true,true,true);     WAIT_BAR(2); RESC(); ROT();
    STEP(pA0,pA1,pB0,pB1,t+1,true,true,true);   WAIT_BAR(2); RESC(); ROT();
  }
  #undef CMASK
  #define CMASK(P0,P1,t) do{ if constexpr(MODE==2){ if((t)>=2 && nearq)gbias(P0,P1,qloc-(kv0+64*(t)),hi,bl); } else { int jb_=(t)-(NT-4); if(jb_>=-2 && (32*wid-(64*jb_+63))<113)BMM(P0,P1,jb_,qrel,hi); } }while(0)
  #define ENDW(tt) do{ if((tt)+3<NT){WAIT_BAR(2);} else if((tt)+2<NT){WAIT_BAR(1);} else {WAIT_BAR(0);} }while(0)
  for(;t+1<NT;t+=2){
    STEP(pB0,pB1,pA0,pA1,t,(t+3<NT),(t+1<NT),(t+1<NT));       ENDW(t);   RESC(); ROT();
    STEP(pA0,pA1,pB0,pB1,t+1,(t+4<NT),(t+2<NT),(t+2<NT));     ENDW(t+1); RESC(); ROT();
  }
  u32x4 mpp[4][3]; f32x2_t mmv[3];
  if constexpr(MODE==1){
    const float*pml_=mm.pml; const bf16*po_=mm.po; asm volatile("":"+s"(pml_),"+s"(po_));
    const int lane_p=lane_now(); const long gr=mm.grow0+wid*QBLK+(lane_p&31);
    #pragma unroll
    for(int s_=0;s_<3;++s_){ mmv[s_]=(f32x2_t){-INFINITY,0.f}; if(s_<mm.ns) mmv[s_]=*(const f32x2_t*)(pml_+((long)s_*MROWS+gr)*16+mm.h*2); }
    #pragma unroll
    for(int i=0;i<4;++i){ const int row=i*8+(lane_p>>3),ch=lane_p&7;
      #pragma unroll
      for(int s_=0;s_<3;++s_){ mpp[i][s_]=(u32x4){0u,0u,0u,0u}; if(s_<mm.ns) mpp[i][s_]=*(const u32x4*)(po_+(((long)s_*MROWS+mm.grow0+wid*QBLK+row)*8+mm.h)*64+ch*8); } }
    SBAR();
  }
  if constexpr(MODE==2){ if(nKh!=nullptr){
      qout.a=*reinterpret_cast<const bf16x8*>(&nQl[hi*8]); qout.b=*reinterpret_cast<const bf16x8*>(&nQl[16+hi*8]); qout.c=*reinterpret_cast<const bf16x8*>(&nQl[32+hi*8]); qout.d=*reinterpret_cast<const bf16x8*>(&nQl[48+hi*8]);
      const bf16*ks2=nKh+(long)lane*LDQ+wid*8; const bf16*vs2=nVh+(long)(16*(wid&3)+(lane>>2))*LDQ+(wid>>2)*32+(lane&3)*8;
      const int n0=sl_next, n1=(n0==(NSLOT-1)*SLOTB)?0:n0+SLOTB, n2=(n1==(NSLOT-1)*SLOTB)?0:n1+SLOTB;
      glds16(ks2,(unsigned)__builtin_amdgcn_readfirstlane(kdst+n0)); glds16(vs2,(unsigned)__builtin_amdgcn_readfirstlane(vdst+n0));
      glds16(ks2+(long)KVBLK*LDQ,(unsigned)__builtin_amdgcn_readfirstlane(kdst+n1)); glds16(ks2+(long)2*KVBLK*LDQ,(unsigned)__builtin_amdgcn_readfirstlane(kdst+n2)); } }
  STEP(pB0,pB1,pA0,pA1,NT-1,false,false,false); RESC();
  { float sacc=pB0[0]+pB0[1]; _Pragma("unroll") for(int r=2;r<16;++r)sacc+=pB0[r]; _Pragma("unroll") for(int r=0;r<16;++r)sacc+=pB1[r]; l_reg+=sacc;
    pw0=(u32x4){PKW(pB0,0),PKW(pB0,2),PKW(pB0,4),PKW(pB0,6)};pw1=(u32x4){PKW(pB0,8),PKW(pB0,10),PKW(pB0,12),PKW(pB0,14)};pw2=(u32x4){PKW(pB1,0),PKW(pB1,2),PKW(pB1,4),PKW(pB1,6)};pw3=(u32x4){PKW(pB1,8),PKW(pB1,10),PKW(pB1,12),PKW(pB1,14)};
    SBAR(); pv(o,vb0+sl_cur,PAF(0),PAF(1),PAF(2),PAF(3)); }
  #undef PKW
  #undef PAF
  #undef VFR
  #undef PIN
  #undef MX3
  #undef GAPA
  #undef GAPB
  #undef EX
  #undef VRD
  #undef KRD
  #undef STEP
  #undef ENDW
  {auto rr=__builtin_amdgcn_permlane32_swap(__float_as_uint(l_reg),__float_as_uint(l_reg),false,false);l_reg=__uint_as_float(rr[0])+__uint_as_float(rr[1]);}
  const float*pml_=mm.pml; const bf16*po_=mm.po; if constexpr(MODE==1){ asm volatile("":"+s"(pml_),"+s"(po_)); }
  if constexpr(MODE==1){
    const long gr=mm.grow0+wid*QBLK+r32; float ms[3],ls[3],as[3]; float Mx=mhat;
    #pragma unroll
    for(int s=0;s<3;++s){ ms[s]=mmv[s].x; ls[s]=mmv[s].y; if(s<mm.ns){ Mx=__builtin_fmaxf(Mx,ms[s]); } }
    const float a0=__builtin_amdgcn_exp2f(mhat-Mx); float L=a0*l_reg;
    #pragma unroll
    for(int s=0;s<3;++s){ as[s]=(s<mm.ns)?__builtin_amdgcn_exp2f(ms[s]-Mx):0.f; L+=as[s]*ls[s]; }
    const float inv=1.0f/L;
    if(hi==0){wsf[32+r32]=a0*inv;wsf[64+r32]=as[0]*inv;wsf[96+r32]=as[1]*inv;wsf[r32]=as[2]*inv;}
  } else if constexpr(MODE==2){
    float*gpml_=ga.pml; asm volatile("":"+s"(gpml_));
    if(hi==0){ wsf[32+r32]=1.0f; { f32x2_t v={mhat,l_reg}; float*dst_=(wid*QBLK+r32<ga.n)?(gpml_+((long)(gent>>14)*MROWS+ga.growb+qloc)*16+ga.h*2):(float*)(ga.dump+1048576+tid*8); *(f32x2_t*)dst_=v; } }
  } else {
    if(hi==0)wsf[32+r32]=1.0f/l_reg;
  }
  asm volatile("s_waitcnt lgkmcnt(0)":::"memory");
  float rli[16];
  #pragma unroll
  for(int r=0;r<16;++r)rli[r]=wsf[32+crow(r,hi)];
  { asm volatile("":"+s"(Op)); }
  bf16*Ow=Op+(long)(q0+wid*QBLK)*LDO;
  { bf16*stg=(bf16*)(shm+LDS_OST)+wid*2048;
    #pragma unroll
    for(int r=0;r<16;++r){const int orow=crow(r,hi);
      #pragma unroll
      for(int d0=0;d0<2;++d0)stg[orow*64+d0*32+r32]=__float2bfloat16(o[d0][r]*rli[r]);}
    asm volatile("s_waitcnt lgkmcnt(0)":::"memory");
    int lane_e=lane; asm volatile("":"+v"(lane_e));
    #pragma unroll
    for(int i=0;i<4;++i){const int row=i*8+(lane_e>>3),ch=lane_e&7; u32x4 v=*(const u32x4*)(stg+row*64+ch*8);
      if constexpr(MODE==1){
        float a[8]={bflo(v.x),bfhi(v.x),bflo(v.y),bfhi(v.y),bflo(v.z),bfhi(v.z),bflo(v.w),bfhi(v.w)};
        #pragma unroll
        for(int s=0;s<3;++s){ if(s<mm.ns){ const float c=wsf[(s==0?64:(s==1?96:0))+row];
            const u32x4 pp=mpp[i][s];
            a[0]+=c*bflo(pp.x);a[1]+=c*bfhi(pp.x);a[2]+=c*bflo(pp.y);a[3]+=c*bfhi(pp.y);a[4]+=c*bflo(pp.z);a[5]+=c*bfhi(pp.z);a[6]+=c*bflo(pp.w);a[7]+=c*bfhi(pp.w);} }
        v.x=cvtpk_s(a[0],a[1]);v.y=cvtpk_s(a[2],a[3]);v.z=cvtpk_s(a[4],a[5]);v.w=cvtpk_s(a[6],a[7]);
      }
      if constexpr(MODE==2){ bf16*gpo_=ga.po; asm volatile("":"+s"(gpo_)); const unsigned er=(unsigned)__builtin_amdgcn_ds_bpermute(row<<2,(int)gent); bf16*dst_=(wid*QBLK+row<ga.n)?(gpo_+(((long)(er>>14)*MROWS+ga.growb+(long)(er&0x3FFFu))*8+ga.h)*64+ch*8):(bf16*)(ga.dump+(tid*4+i)*16); *(u32x4*)dst_=v; }
      else *(u32x4*)(Ow+(long)row*LDO+ch*8)=v;} }
  if(MODE!=2 || keepbar){ asm volatile("s_waitcnt lgkmcnt(0)\n\ts_barrier":::"memory"); }
  else { asm volatile("s_waitcnt lgkmcnt(0)":::"memory"); }
  #undef DMA_K
  #undef DMA_V
  #undef CMASK
  #undef START
  #undef RESC
  #undef ROT
  return qout;
}


constexpr int VSLOTB=16384;
constexpr int W_LDS_K=0, W_LDS_V=NSLOT*SLOTB, W_LDS_WS=W_LDS_V+NSLOT*VSLOTB, W_LDS_OST=W_LDS_WS+NW*128*4, W_LDS_BIAS=W_LDS_OST+NW*4096, W_LDS_BYTES=W_LDS_BIAS+512;
__device__ __forceinline__ void pv128(f32x16*o,int vb,bf16x8 pa0,bf16x8 pa1,bf16x8 pa2,bf16x8 pa3){
  #pragma unroll
  for(int d0=0;d0<4;++d0){s16x4 lo[4],hi[4];
    #pragma unroll
    for(int ks=0;ks<4;++ks){
      asm volatile("ds_read_b64_tr_b16 %0,%1 offset:%c2":"=&v"(lo[ks]):"v"(vb),"i"(d0*4096+ks*1024):"memory");
      asm volatile("ds_read_b64_tr_b16 %0,%1 offset:%c2":"=&v"(hi[ks]):"v"(vb),"i"(d0*4096+ks*1024+512):"memory");}
    asm volatile("s_waitcnt lgkmcnt(0)":::"memory");SBAR();
    #define PK(k) (bf16x8){lo[k][0],lo[k][1],lo[k][2],lo[k][3],hi[k][0],hi[k][1],hi[k][2],hi[k][3]}
    o[d0]=__builtin_amdgcn_mfma_f32_32x32x16_bf16(pa0,PK(0),o[d0],0,0,0);
    o[d0]=__builtin_amdgcn_mfma_f32_32x32x16_bf16(pa1,PK(1),o[d0],0,0,0);
    o[d0]=__builtin_amdgcn_mfma_f32_32x32x16_bf16(pa2,PK(2),o[d0],0,0,0);
    o[d0]=__builtin_amdgcn_mfma_f32_32x32x16_bf16(pa3,PK(3),o[d0],0,0,0);
    #undef PK
  }
}
template<int THRL> __device__ __forceinline__ void attn_unit128(const bf16*Qp,const bf16*__restrict__ Kp,const bf16*__restrict__ Vp,bf16*Op,int q0,int NT,const float*biasG,char*shm,int wv STAMP_PARAM){
  const int lane=lane_now();
  asm volatile("":"+s"(wv)); const int wid=__builtin_amdgcn_readfirstlane(wv), tid=wid*64+lane, r32=lane&31, hi=lane>>5;
  const bf16*Qw=Qp+(long)(q0+wid*QBLK)*LDQ;
  const bf16*Kh=Kp,*Vh=Vp;
  const unsigned lds0=(unsigned)(uintptr_t)shm;
  float*wsf=(float*)(shm+W_LDS_WS)+wid*128;
  const lds_cptr shm3=(lds_cptr)shm;
  asm volatile("":"+s"(biasG));
  { __attribute__((address_space(3))) float* blw=(__attribute__((address_space(3))) float*)(shm3+W_LDS_BIAS); if(tid<128)blw[tid]=biasG[tid]; }
  const lds_cfptr bl=(lds_cfptr)(shm3+W_LDS_BIAS);
  const bf16*ksrc=Kh+(long)lane*LDQ+wid*8;
  const bf16*vsrc=Vh+(long)(16*(wid&3)+(lane>>2))*LDQ+(wid>>2)*32+(lane&3)*8;
  const unsigned kdst=lds0+W_LDS_K+wid*1024, vdst=lds0+W_LDS_V+wid*1024;
  #define DMA_K(t,slot) glds16(ksrc+(long)(t)*KVBLK*LDQ,(unsigned)__builtin_amdgcn_readfirstlane(kdst+(slot)))
  #define DMA_V(t,slot) do{ glds16(vsrc+(long)(t)*KVBLK*LDQ,(unsigned)__builtin_amdgcn_readfirstlane(vdst+2*(slot))); glds16(vsrc+(long)(t)*KVBLK*LDQ+64,(unsigned)__builtin_amdgcn_readfirstlane(vdst+2*(slot)+8192)); }while(0)
  const int vb0=(int)(lds0+W_LDS_V)+((lane>>4)&1)*32+(lane&3)*8+(4*hi+((lane&15)>>2))*64;
  const char*Kbase=shm+W_LDS_K; bf16x8 kf[8];
  const lds_cptr kp0=shm3+W_LDS_K+hi*1024+r32*16; const lds_cptr vp0=shm3+W_LDS_V+((lane>>4)&1)*32+(lane&3)*8+(4*hi+((lane&15)>>2))*64;
  asm volatile("s_waitcnt vmcnt(0)":::"memory");
  DMA_K(0,0);DMA_V(0,0);DMA_K(1,SLOTB);
  bf16x8 qr[4];
  #pragma unroll
  for(int d0=0;d0<4;++d0)qr[d0]=*reinterpret_cast<const bf16x8*>(&Qw[(long)r32*LDQ+d0*16+hi*8]);
  float mhat=0.f,l_reg=0.f;f32x16 o[4];o[0]=f32x16{};o[1]=f32x16{};o[2]=f32x16{};o[3]=f32x16{};f32x16 negm=f32x16{};asm volatile("":"+v"(negm));
  const int qrel=wid*QBLK+r32;
  #define CMASK(P0,P1,t) do{int jb_=(t)-(NT-4); if(jb_>=-2 && (32*wid-(64*jb_+63))<113)biasmask(P0,P1,jb_,qrel,hi,bl);}while(0)
  bool resc=false;
  #define RESC() do{ if(resc){ asm volatile("s_waitcnt lgkmcnt(0)":::"memory"); \
      _Pragma("unroll") for(int d_=0;d_<4;++d_) _Pragma("unroll") for(int r=0;r<16;++r)o[d_][r]*=wsf[crow(r,hi)]; } }while(0)
  f32x16 C0,C1; u32x4 pw0,pw1,pw2,pw3;
  int sl_prev=0,sl_cur=0,sl_next=SLOTB;
  #define ROT() do{sl_prev=sl_cur;sl_cur=sl_next;sl_next=(sl_next==(NSLOT-1)*SLOTB)?0:sl_next+SLOTB;}while(0)
  #define PKW(P,B) cvtpk_s(P[B],P[B+1])
  DMA_K(2,2*SLOTB);
  WAIT_BAR(3);
  qkt(C0,C1,Kbase,qr,negm,r32,hi);asm volatile("s_nop 15\n\ts_nop 7":"+v"(C0),"+v"(C1));CMASK(C0,C1,0);
  { const float rm=rowmax(C0,C1); mhat=rm;
    _Pragma("unroll") for(int r=0;r<16;++r)negm[r]=-mhat; asm volatile("":"+v"(negm));
    _Pragma("unroll") for(int r=0;r<16;++r){C0[r]=__builtin_amdgcn_exp2f(C0[r]-mhat);C1[r]=__builtin_amdgcn_exp2f(C1[r]-mhat);}
    float sacc=0.f; _Pragma("unroll") for(int r=0;r<16;++r)sacc+=C0[r]+C1[r]; l_reg+=sacc;
    pw0=(u32x4){PKW(C0,0),PKW(C0,2),PKW(C0,4),PKW(C0,6)};pw1=(u32x4){PKW(C0,8),PKW(C0,10),PKW(C0,12),PKW(C0,14)};pw2=(u32x4){PKW(C1,0),PKW(C1,2),PKW(C1,4),PKW(C1,6)};pw3=(u32x4){PKW(C1,8),PKW(C1,10),PKW(C1,12),PKW(C1,14)}; }
  const __attribute__((address_space(3))) char* qlds=(const __attribute__((address_space(3))) char*)(shm3+W_LDS_OST+wid*4096+lane*16);
  { __attribute__((address_space(3))) char* qw=(__attribute__((address_space(3))) char*)(shm3+W_LDS_OST+wid*4096+lane*16);
    #pragma unroll
    for(int d0=0;d0<4;++d0)*(__attribute__((address_space(3))) bf16x8*)(qw+d0*1024)=qr[d0]; }
  WAIT_BAR(0);
  DMA_K(3,0);DMA_V(1,SLOTB);
  ROT();
  kload8(kf,kp0+sl_cur);
  WAIT_BAR(3);
  s16x4 vlo[8],vhi[8];
  #define PAF(k) __builtin_bit_cast(bf16x8,pw##k)
  #define VFR(i) (bf16x8){vlo[i][0],vlo[i][1],vlo[i][2],vlo[i][3],vhi[i][0],vhi[i][1],vhi[i][2],vhi[i][3]}
  #define PIN(x) asm volatile("":"+v"(x))
  #define MX3(a,b,c) __builtin_fmaxf(__builtin_fmaxf((a),(b)),(c))
  #define EX(v) __builtin_amdgcn_exp2f(v)
  #define GA(MF) do{ MF; SBAR(); }while(0)
  #define EX2(X,B) do{ float e0_=EX(X[B]), e1_=EX(X[B+1]); asm volatile("":"+v"(e0_),"+v"(e1_)); X[B]=e0_; X[B+1]=e1_; }while(0)
  #define GB0(MF,X,B) do{ MF; EX2(X,B); SBAR(); }while(0)
  #define GB1(MF,X,B,PWD,Y,YB) do{ MF; EX2(X,B); sacc+=Y[YB]; sacc+=Y[YB+1]; PIN(sacc); { unsigned pk_=PKW(Y,YB); PIN(pk_); PWD=pk_; } SBAR(); }while(0)
  #define VRS(s,i) do{ vlo[s]=vtr(vp_+(((i)>>2)*4096+((i)&3)*1024)); vhi[s]=vtr(vp_+(((i)>>2)*4096+((i)&3)*1024+512)); SBAR(); }while(0)
  #define KRD(G,j) do{ if(G){ kload2(kf,kp0+sl_next,j); SBAR(); } }while(0)
  #define MF(a,b,c) __builtin_amdgcn_mfma_f32_32x32x16_bf16(a,b,c,0,0,0)
  #define QL(d) (*(const __attribute__((address_space(3))) bf16x8*)(qlds+(d)*1024))
  #define STEP(t,GK,GV,GL) do{ SBAR(); \
    const lds_cptr vp_=vp0+2*sl_prev; \
    bf16x8 qa_=QL(0),qb_=QL(1); SBAR(); \
    VRS(0,0);  GA(C0=MF(kf[0],qa_,negm)); \
    VRS(1,4);  GA(C1=MF(kf[1],qa_,negm)); qa_=QL(2); SBAR(); \
    VRS(2,8);  GA(C0=MF(kf[2],qb_,C0)); \
    VRS(3,12); GA(C1=MF(kf[3],qb_,C1)); qb_=QL(3); SBAR(); \
    VRS(4,1);  GA(C0=MF(kf[4],qa_,C0)); \
    VRS(5,5);  GA(C1=MF(kf[5],qa_,C1)); \
    VRS(6,9);  GA(C0=MF(kf[6],qb_,C0)); \
    VRS(7,13); GA(C1=MF(kf[7],qb_,C1)); \
    CMASK(C0,C1,t); \
    { float a=MX3(C0[0],C0[1],C1[0]),b=MX3(C0[2],C0[3],C1[1]); a=MX3(a,C1[2],C1[3]); \
      _Pragma("unroll") for(int r=4;r<16;r+=4){a=MX3(a,C0[r],C0[r+1]);b=MX3(b,C0[r+2],C0[r+3]);a=MX3(a,C1[r],C1[r+1]);b=MX3(b,C1[r+2],C1[r+3]);} \
      float rm=__builtin_fmaxf(a,b); { auto rr=__builtin_amdgcn_permlane32_swap(__float_as_uint(rm),__float_as_uint(rm),false,false); rm=__builtin_fmaxf(__uint_as_float(rr[0]),__uint_as_float(rr[1])); } \
      resc=false; \
      if(__builtin_expect(__any(rm>(float)THRL),0)){ const float dl=__builtin_fmaxf(rm,0.f); mhat+=dl; \
        _Pragma("unroll") for(int r=0;r<16;++r){C0[r]-=dl;C1[r]-=dl;} \
        _Pragma("unroll") for(int r=0;r<16;++r)negm[r]=-mhat; asm volatile("":"+v"(negm)); \
        const float f=__builtin_amdgcn_exp2f(-dl); l_reg*=f; if(hi==0)wsf[r32]=f; resc=true; } } \
    SBAR(); float sacc=0.f; \
    GB0(o[0]=MF(PAF(0),VFR(0),o[0]), C0,0); \
    GB0(o[1]=MF(PAF(0),VFR(1),o[1]), C0,2); \
    GB0(o[2]=MF(PAF(0),VFR(2),o[2]), C0,4); \
    GB0(o[3]=MF(PAF(0),VFR(3),o[3]), C0,6); \
    VRS(0,2);  GB1(o[0]=MF(PAF(1),VFR(4),o[0]), C0,8,  pw0[0],C0,0); \
    VRS(1,6);  GB1(o[1]=MF(PAF(1),VFR(5),o[1]), C0,10, pw0[1],C0,2); \
    VRS(2,10); GB1(o[2]=MF(PAF(1),VFR(6),o[2]), C0,12, pw0[2],C0,4); \
    VRS(3,14); GB1(o[3]=MF(PAF(1),VFR(7),o[3]), C0,14, pw0[3],C0,6); \
    VRS(4,3);  KRD(GL,0); GB1(o[0]=MF(PAF(2),VFR(0),o[0]), C1,0, pw1[0],C0,8); \
    VRS(5,7);  KRD(GL,1); GB1(o[1]=MF(PAF(2),VFR(1),o[1]), C1,2, pw1[1],C0,10); \
    VRS(6,11); GB1(o[2]=MF(PAF(2),VFR(2),o[2]), C1,4, pw1[2],C0,12); \
    VRS(7,15); GB1(o[3]=MF(PAF(2),VFR(3),o[3]), C1,6, pw1[3],C0,14); \
    KRD(GL,2); GB1(o[0]=MF(PAF(3),VFR(4),o[0]), C1,8,  pw2[0],C1,0); \
    KRD(GL,3); GB1(o[1]=MF(PAF(3),VFR(5),o[1]), C1,10, pw2[1],C1,2); \
    GB1(o[2]=MF(PAF(3),VFR(6),o[2]), C1,12, pw2[2],C1,4); \
    GB1(o[3]=MF(PAF(3),VFR(7),o[3]), C1,14, pw2[3],C1,6); \
    sacc+=C1[8];sacc+=C1[9];pw3[0]=PKW(C1,8); sacc+=C1[10];sacc+=C1[11];pw3[1]=PKW(C1,10); sacc+=C1[12];sacc+=C1[13];pw3[2]=PKW(C1,12); sacc+=C1[14];sacc+=C1[15];pw3[3]=PKW(C1,14); \
    l_reg+=sacc; \
    if(GK){DMA_K((t)+3,sl_cur);} if(GV){DMA_V((t)+1,sl_next);}   \
    }while(0)
  int t=1;
  #undef CMASK
  #define CMASK(P0,P1,t) do{}while(0)
  STAMP_DECL
  for(;t+7<NT;t+=2){
    STEP(t,true,true,true);     STAMP_PRE WAIT_BAR(3); STAMP_POST RESC(); ROT();
    STEP(t+1,true,true,true);   STAMP_PRE WAIT_BAR(3); STAMP_POST RESC(); ROT();
  }
  STAMP_FINI
  #undef CMASK
  #define CMASK(P0,P1,t) do{int jb_=(t)-(NT-4); if(jb_>=-2 && (32*wid-(64*jb_+63))<113)biasmask(P0,P1,jb_,qrel,hi,bl);}while(0)
  #define ENDW(tt) do{ if((tt)+3<NT){WAIT_BAR(3);} else if((tt)+2<NT){WAIT_BAR(2);} else {WAIT_BAR(0);} }while(0)
  for(;t+1<NT;t+=2){
    STEP(t,(t+3<NT),(t+1<NT),(t+1<NT));       ENDW(t);   RESC(); ROT();
    STEP(t+1,(t+4<NT),(t+2<NT),(t+2<NT));     ENDW(t+1); RESC(); ROT();
  }
  STEP(NT-1,false,false,false); RESC();
  SBAR(); pv128(o,vb0+2*sl_cur,PAF(0),PAF(1),PAF(2),PAF(3));
  #undef PKW
  #undef PAF
  #undef VFR
  #undef PIN
  #undef MX3
  #undef EX
  #undef EX2
  #undef GA
  #undef GB0
  #undef GB1
  #undef VRS
  #undef KRD
  #undef MF
  #undef QL
  #undef STEP
  #undef ENDW
  {auto rr=__builtin_amdgcn_permlane32_swap(__float_as_uint(l_reg),__float_as_uint(l_reg),false,false);l_reg=__uint_as_float(rr[0])+__uint_as_float(rr[1]);}
  if(hi==0)wsf[32+r32]=1.0f/l_reg;
  asm volatile("s_waitcnt lgkmcnt(0)":::"memory");
  float rli[16];
  #pragma unroll
  for(int r=0;r<16;++r)rli[r]=wsf[32+crow(r,hi)];
  { asm volatile("":"+s"(Op)); }
  bf16*Ow=Op+(long)(q0+wid*QBLK)*LDO;
  { bf16*stg=(bf16*)(shm+W_LDS_OST)+wid*2048;
    int lane_e=lane; asm volatile("":"+v"(lane_e));
    #pragma unroll
    for(int ph=0;ph<2;++ph){
      #pragma unroll
      for(int r=0;r<16;++r){const int orow=crow(r,hi);
        #pragma unroll
        for(int d0=0;d0<2;++d0)stg[orow*64+d0*32+r32]=__float2bfloat16(o[2*ph+d0][r]*rli[r]);}
      asm volatile("s_waitcnt lgkmcnt(0)":::"memory");
      #pragma unroll
      for(int i=0;i<4;++i){const int row=i*8+(lane_e>>3),ch=lane_e&7; const u32x4 v=*(const u32x4*)(stg+row*64+ch*8); *(u32x4*)(Ow+(long)row*LDO+ph*64+ch*8)=v;}
      asm volatile("s_waitcnt lgkmcnt(0)":::"memory"); } }
  asm volatile("s_waitcnt lgkmcnt(0)\n\ts_barrier":::"memory");
  #undef DMA_K
  #undef DMA_V
  #undef CMASK
  #undef RESC
  #undef ROT
}


constexpr int F_KSL=4096, F_VSL=8192;
constexpr int F_LDS_K=0, F_LDS_V=4*F_KSL, F_LDS_WS=4*F_KSL+4*F_VSL, F_LDS_OST=F_LDS_WS+NW*128*4+8192, F_LDS_BIAS=F_LDS_OST+NW*4096, F_LDS_BYTES=F_LDS_BIAS+512;
typedef int v8i_t __attribute__((ext_vector_type(8)));
typedef int v4i_t __attribute__((ext_vector_type(4)));
constexpr float PSH=5.f;
template<int THRL> __device__ __forceinline__ void attn_unit128f(const unsigned char*Qp8,const unsigned char*__restrict__ Kp8,const unsigned char*__restrict__ VT,bf16*Op,int q0,int NT,const float*biasG,char*shm,int wv,bf16*Yp,const float*gnp,float lam,float gmul STAMP_PARAM){
  const int lane=lane_now();
  asm volatile("":"+s"(wv)); const int wid=__builtin_amdgcn_readfirstlane(wv), tid=wid*64+lane, r32=lane&31, hi=lane>>5;
  constexpr long LDB=2L*LDQ;
  const unsigned lds0=(unsigned)(uintptr_t)shm;
  float*wsf=(float*)(shm+F_LDS_WS)+wid*128;
  const lds_cptr shm3=(lds_cptr)shm;
  asm volatile("":"+s"(biasG));
  glds16((const char*)biasG+wid*1024+lane*16,(unsigned)__builtin_amdgcn_readfirstlane(lds0+LDS_BT4+wid*1024));
  const __amdgpu_buffer_rsrc_t rs=__builtin_amdgcn_make_buffer_rsrc((void*)Kp8,0,0x7ffffff0,0x00020000);
  const unsigned kvo=(unsigned)(lane*(int)LDB+16*(wid&3));
  const unsigned vvo=(unsigned)(lane*SEQ+16*(wid&3));
  const unsigned vrel=(unsigned)(VT-Kp8);
  typedef __attribute__((address_space(3))) unsigned* lds_uptr;
  #define DK(t,slot) __builtin_amdgcn_raw_ptr_buffer_load_lds(rs,(lds_uptr)(shm3+F_LDS_K+(wid&3)*1024+(slot)),16,(int)kvo,(int)((t)*(KVBLK*(int)LDB)),0,0)
  #define DV(t,slot) do{ __builtin_amdgcn_raw_ptr_buffer_load_lds(rs,(lds_uptr)(shm3+F_LDS_V+(wid&3)*2048+(slot)),16,(int)vvo,(int)(vrel+(unsigned)((t)*KVBLK)),0,0); \
      __builtin_amdgcn_raw_ptr_buffer_load_lds(rs,(lds_uptr)(shm3+F_LDS_V+(wid&3)*2048+1024+(slot)),16,(int)vvo,(int)(vrel+(unsigned)(64*SEQ)+(unsigned)((t)*KVBLK)),0,0); }while(0)
  #define KLD(dst,base) do{ dst=__builtin_shufflevector(*(const __attribute__((address_space(3))) v4i_t*)(base),*(const __attribute__((address_space(3))) v4i_t*)((base)+1024),0,1,2,3,4,5,6,7); }while(0)
  #define MFQ(a,b,c) __builtin_amdgcn_mfma_scale_f32_32x32x64_f8f6f4(a,b,c,0,0,0,0x00007A7D,1,0x00007A7D)
  v8i_t kf[2];
  const lds_cptr kp0=shm3+F_LDS_K+hi*2048+r32*16; const lds_cptr vp0=shm3+F_LDS_V+hi*4096+r32*16;
  if(wid<4){ DK(0,0); DV(0,0); } else { DK(1,F_KSL); DV(1,F_VSL); }
  SBAR();
  v8i_t qf; { const unsigned char*qp=Qp8+(long)(q0+wid*QBLK+r32)*LDB+32*hi; qf=__builtin_shufflevector(*(const v4i_t*)qp,*(const v4i_t*)(qp+16),0,1,2,3,4,5,6,7); }
  f32x16 o[4];o[0]=f32x16{};o[1]=f32x16{};o[2]=f32x16{};o[3]=f32x16{};pg8::f32x4 l4={0.f,0.f,0.f,0.f};f32x16 negm=f32x16{};asm volatile("":"+v"(negm));
  v8i_t ones8; { const int ov_=(((lane>>4)&1)==((lane>>3)&1))?0x50505050:0; ones8=(v8i_t){ov_,ov_,ov_,ov_,ov_,ov_,ov_,ov_}; } asm volatile("":"+v"(ones8));
  #define MFL(a,c) __builtin_amdgcn_mfma_scale_f32_16x16x128_f8f6f4(a,ones8,c,0,0,0,0x00007C7F,1,0x00007C7F)
  #define CMASK(P0,P1,t) do{int jb_=(t)-(NT-4); if(jb_>=-2 && (32*wid-(64*jb_+63))<113){ const int l_=lane_now(); BMF(P0,P1,jb_,wid*QBLK+(l_&31),l_>>5); } }while(0)
  bool resc=false;
  #define RESC() do{ if(resc){ asm volatile("s_waitcnt lgkmcnt(0)":::"memory"); const int l_=lane_now(), h_=l_>>5, lr_=4*(l_>>4)+16*((l_>>3)&1);     \
      _Pragma("unroll") for(int d_=0;d_<4;++d_) _Pragma("unroll") for(int r=0;r<16;++r)o[d_][r]*=wsf[crow(r,h_)]; \
      _Pragma("unroll") for(int i_=0;i_<4;++i_)l4[i_]*=wsf[lr_+i_]; } }while(0)
  f32x16 C0,C1; v8i_t PA,PB;
  #if defined(PROBE_XLDS)
  v4i_t xdummy={0,0,0,0}; asm volatile("":"+v"(xdummy));
  #endif
  #define PK8(X,B) __builtin_amdgcn_cvt_pk_fp8_f32(X[B+2],X[B+3],__builtin_amdgcn_cvt_pk_fp8_f32(X[B],X[B+1],0,false),true)
  SBAR();
  if(wid<4){ DK(2,2*F_KSL); } else { DK(3,3*F_KSL); }
  WAIT_BAR(5);
  { KLD(kf[0],kp0); KLD(kf[1],kp0+512); C0=MFQ(kf[0],qf,negm); C1=MFQ(kf[1],qf,negm); }
  asm volatile("s_nop 15\n\ts_nop 7":"+v"(C0),"+v"(C1));CMASK(C0,C1,0);
  { const float rm=rowmax(C0,C1); const float mhat=rm-PSH;
    _Pragma("unroll") for(int r=0;r<16;++r)negm[r]=-mhat; asm volatile("":"+v"(negm));
    _Pragma("unroll") for(int r=0;r<16;++r){C0[r]=__builtin_amdgcn_exp2f(C0[r]-mhat);C1[r]=__builtin_amdgcn_exp2f(C1[r]-mhat);}
    PA=(v8i_t){PK8(C0,0),PK8(C0,4),PK8(C0,8),PK8(C0,12),PK8(C1,0),PK8(C1,4),PK8(C1,8),PK8(C1,12)}; PB=PA; }
  WAIT_BAR(0);
  KLD(kf[0],kp0+F_KSL); KLD(kf[1],kp0+F_KSL+512);
  v8i_t vf[2];
  #define PIN(x) asm volatile("":"+v"(x))
  #define PK8O(X,B,OLD) __builtin_amdgcn_cvt_pk_fp8_f32(X[B+2],X[B+3],__builtin_amdgcn_cvt_pk_fp8_f32(X[B],X[B+1],OLD,false),true)
  #define MX3(a,b,c) max3f((a),(b),(c))
  #define EX(v) __builtin_amdgcn_exp2f(v)
  #define GA(MF) do{ MF; SBAR(); }while(0)
  #define VRS(sl,q) do{ vf[sl]=__builtin_shufflevector(*(const __attribute__((address_space(3))) v4i_t*)(vp_+(q)*512),*(const __attribute__((address_space(3))) v4i_t*)(vp_+(q)*512+2048),0,1,2,3,4,5,6,7); SBAR(); }while(0)
  #define KRD(G,j) do{ if(G){ KLD(kf[j],kq_+(j)*512); SBAR(); } }while(0)
  #define MF8(a,b,c) __builtin_amdgcn_mfma_scale_f32_32x32x64_f8f6f4(a,b,c,0,0,0,0x00007C7F,1,0x00007C7F)
  #define GB(q,PC,PN,X,B,D0,D1) do{ o[q]=MF8(PC,vf[(q)&1],o[q]); if((q)<2){ VRS((q)&1,(q)+2); } \
      { float e0_=EX(X[B]),e1_=EX(X[B+1]),e2_=EX(X[B+2]),e3_=EX(X[B+3]),e4_=EX(X[B+4]),e5_=EX(X[B+5]),e6_=EX(X[B+6]),e7_=EX(X[B+7]); \
        asm volatile("":"+v"(e0_),"+v"(e1_),"+v"(e2_),"+v"(e3_),"+v"(e4_),"+v"(e5_),"+v"(e6_),"+v"(e7_)); \
        X[B]=e0_;X[B+1]=e1_;X[B+2]=e2_;X[B+3]=e3_;X[B+4]=e4_;X[B+5]=e5_;X[B+6]=e6_;X[B+7]=e7_; \
        { int pk0_=PK8O(X,B,PN[D0]),pk1_=PK8O(X,B+4,PN[D1]); PIN(pk0_); PIN(pk1_); PN[D0]=pk0_; PN[D1]=pk1_; } } XTRA(X,B); SBAR(); }while(0)
  #define PH_A(t,PS,VR,PRA,PR) do{ __builtin_amdgcn_s_setprio(PRA); \
    if(VR){ VRS(0,0); } GA(C0=MFQ(kf[0],qf,negm)); \
    if(VR){ VRS(1,1); } GA(C1=MFQ(kf[1],qf,negm)); \
    l4=MFL(PS,l4); SBAR();     \
    asm volatile("s_nop 15\n\ts_nop 2":"+v"(C0),"+v"(C1));     \
    CMASK(C0,C1,t); \
    { float a,b;     \
      asm("v_max3_f32 %0, %2, %3, %4\n\tv_max3_f32 %1, %5, %6, %7\n\tv_max3_f32 %0, %0, %8, %9\n\tv_max3_f32 %1, %1, %10, %11\n\tv_max3_f32 %0, %0, %12, %13\n\tv_max3_f32 %1, %1, %14, %15\n\tv_max3_f32 %0, %0, %16, %17" \
          :"=&v"(a),"=&v"(b):"v"(C0[0]),"v"(C0[1]),"v"(C0[2]),"v"(C0[3]),"v"(C0[4]),"v"(C0[5]),"v"(C0[6]),"v"(C0[7]),"v"(C0[8]),"v"(C0[9]),"v"(C0[10]),"v"(C0[11]),"v"(C0[12]),"v"(C0[13]),"v"(C0[14]),"v"(C0[15])); \
      asm("v_max3_f32 %1, %1, %2, %3\n\tv_max3_f32 %0, %0, %4, %5\n\tv_max3_f32 %1, %1, %6, %7\n\tv_max3_f32 %0, %0, %8, %9\n\tv_max3_f32 %1, %1, %10, %11\n\tv_max3_f32 %0, %0, %12, %13\n\tv_max3_f32 %1, %1, %14, %15\n\tv_max3_f32 %0, %0, %16, %17\n\tv_max_f32 %0, %0, %1" \
          :"+v"(a),"+v"(b):"v"(C1[0]),"v"(C1[1]),"v"(C1[2]),"v"(C1[3]),"v"(C1[4]),"v"(C1[5]),"v"(C1[6]),"v"(C1[7]),"v"(C1[8]),"v"(C1[9]),"v"(C1[10]),"v"(C1[11]),"v"(C1[12]),"v"(C1[13]),"v"(C1[14]),"v"(C1[15])); \
      float rm=a; \
      resc=false; \
      if(__builtin_expect(__any(rm>(float)THRL),0)){ { auto rr=__builtin_amdgcn_permlane32_swap(__float_as_uint(rm),__float_as_uint(rm),false,false); rm=__builtin_fmaxf(__uint_as_float(rr[0]),__uint_as_float(rr[1])); } \
        const float dl=__builtin_fmaxf(rm-PSH,0.f); const float nm_=negm[0]-dl;     \
        _Pragma("unroll") for(int r=0;r<16;++r){C0[r]-=dl;C1[r]-=dl;} \
        _Pragma("unroll") for(int r=0;r<16;++r)negm[r]=nm_; asm volatile("":"+v"(negm)); \
        const float f=__builtin_amdgcn_exp2f(-dl); { const int l_=lane_now(); if(l_<32)wsf[l_]=f; } resc=true; } } \
    __builtin_amdgcn_s_setprio(PR); SBAR(); }while(0)
  #define PH_B(PC,PN,GL) do{ \
    KRD(GL,0); GB(0,PC,PN,C0,0,0,1); \
    GB(1,PC,PN,C0,8,2,3); \
    KRD(GL,1); GB(2,PC,PN,C1,0,4,5); \
    GB(3,PC,PN,C1,8,6,7); }while(0)
  #if defined(PROBE_XEXP)
  #define XTRA(X,B) do{ float d_; asm volatile("v_exp_f32 %0, %1\n\tv_exp_f32 %0, %2\n\tv_exp_f32 %0, %3\n\tv_exp_f32 %0, %4\n\tv_exp_f32 %0, %1\n\tv_exp_f32 %0, %2\n\tv_exp_f32 %0, %3\n\tv_exp_f32 %0, %4":"=&v"(d_):"v"(X[B]),"v"(X[B+1]),"v"(X[B+2]),"v"(X[B+3])); }while(0)
  #elif defined(PROBE_XCVT)
  #define XTRA(X,B) do{ int d_; asm volatile("v_cvt_pk_fp8_f32 %0, %1, %2\n\tv_cvt_pk_fp8_f32 %0, %3, %4\n\tv_cvt_pk_fp8_f32 %0, %1, %2\n\tv_cvt_pk_fp8_f32 %0, %3, %4\n\tv_cvt_pk_fp8_f32 %0, %1, %2\n\tv_cvt_pk_fp8_f32 %0, %3, %4\n\tv_cvt_pk_fp8_f32 %0, %1, %2\n\tv_cvt_pk_fp8_f32 %0, %3, %4":"=&v"(d_):"v"(X[B]),"v"(X[B+1]),"v"(X[B+2]),"v"(X[B+3])); }while(0)
  #elif defined(PROBE_XMFMA)
  #define XTRA(X,B) do{ pg8::f32x4 d_=__builtin_amdgcn_mfma_scale_f32_16x16x128_f8f6f4(PA,ones8,l4,0,0,0,0x00007C7F,1,0x00007C7F); asm volatile("":"+v"(d_)); }while(0)
  #elif defined(PROBE_XLDS)
  #define XTRA(X,B) do{ asm volatile("ds_read_b128 %0, %1":"+v"(xdummy):"v"((unsigned)(uintptr_t)vp_):"memory"); }while(0)
  #elif defined(PROBE_XNOP)
  #define XTRA(X,B) do{ asm volatile("s_nop 15\n\ts_nop 15"); }while(0)
  #elif defined(PROBE_XADD)
  #define XTRA(X,B) do{ float d_; asm volatile("v_add_f32 %0, %1, %2\n\tv_add_f32 %0, %3, %4\n\tv_add_f32 %0, %1, %2\n\tv_add_f32 %0, %3, %4\n\tv_add_f32 %0, %1, %2\n\tv_add_f32 %0, %3, %4\n\tv_add_f32 %0, %1, %2\n\tv_add_f32 %0, %3, %4":"=&v"(d_):"v"(X[B]),"v"(X[B+1]),"v"(X[B+2]),"v"(X[B+3])); }while(0)
  #else
  #define XTRA(X,B) do{}while(0)
  #endif
  #define ST1(t,PC,PN,VS,KS,GL,PRA_,PRB_) do{ SBAR(); \
    const lds_cptr vp_=vp0+(VS); const lds_cptr kq_=kp0+(KS); \
    SP_A0 PH_A(t,PC,true,PRA_,PRB_); SP_A1 \
    SP_B0 PH_B(PC,PN,GL); SP_B1 \
    RESC(); }while(0)
  #define ST2(t,PC,PN,VS,KS,GL,GA2,PRA_,PRB_) do{ SBAR(); \
    const lds_cptr vp_=vp0+(VS); const lds_cptr kq_=kp0+(KS); \
    SP_B0 VRS(0,0); VRS(1,1); \
    PH_B(PC,PN,GL); SP_B1 \
    RESC(); \
    SP_A0 if(GA2){ PH_A((t)+1,PN,false,PRA_,PRB_); } SP_A1 \
    }while(0)
  if(wid>=4){ const lds_cptr vp_=vp0; PH_A(1,PA,false,PRIO_G2A2,PRIO_G2B1); }
  asm volatile("s_waitcnt lgkmcnt(0)\n\ts_barrier":::"memory");
  int vb=0, kb=2*F_KSL, t=1;
  #define IV1(t,GK3) do{ if(GK3){ DK((t)+3,kb^(2*F_KSL)); } DV((t)+1,vb^(2*F_VSL)); \
      ST1(t,PA,PB,vb,kb,true,PRIO_G1A1,PRIO_G1B1); ST1((t)+1,PB,PA,vb+F_VSL,kb+F_KSL,true,PRIO_G1A2,PRIO_G1B2); \
      SP_W0 WAIT_BAR(0); SP_W1 vb^=2*F_VSL; kb^=2*F_KSL; }while(0)
  #define IV2(t,GK4) do{ if(GK4){ DK((t)+4,(kb^(2*F_KSL))+F_KSL); } DV((t)+2,(vb^(2*F_VSL))+F_VSL); \
      ST2(t,PA,PB,vb,kb,true,true,PRIO_G2A1,PRIO_G2B2); ST2((t)+1,PB,PA,vb+F_VSL,kb+F_KSL,true,true,PRIO_G2A2,PRIO_G2B1); \
      SP_W0 WAIT_BAR(0); SP_W1 vb^=2*F_VSL; kb^=2*F_KSL; }while(0)
  if(wid<4){
    #undef CMASK
    #define CMASK(P0,P1,t) do{}while(0)
    STAMP_DECL
    for(;t+8<NT;t+=2){ IV1(t,true); }
    STAMP_FINI
    #undef CMASK
    #define CMASK(P0,P1,t) do{int jb_=(t)-(NT-4); if(jb_>=-2 && (32*wid-(64*jb_+63))<113){ const int l_=lane_now(); BMF(P0,P1,jb_,wid*QBLK+(l_&31),l_>>5); } }while(0)
    for(;t+1<NT;t+=2){ IV1(t,(t+3<NT)); }
    ST1(NT-1,PA,PB,vb,kb,false,PRIO_G1A1,PRIO_G1B1);
  } else {
    #undef CMASK
    #define CMASK(P0,P1,t) do{}while(0)
    STAMP_DECL
    for(;t+8<NT;t+=2){ IV2(t,true); }
    STAMP_FINI
    #undef CMASK
    #define CMASK(P0,P1,t) do{int jb_=(t)-(NT-4); if(jb_>=-2 && (32*wid-(64*jb_+63))<113){ const int l_=lane_now(); BMF(P0,P1,jb_,wid*QBLK+(l_&31),l_>>5); } }while(0)
    for(;t+1<NT;t+=2){ IV2(t,(t+4<NT)); }
    ST2(NT-1,PA,PB,vb,kb,false,false,0,0);
  }
  #if defined(PROBE_XLDS)
  asm volatile("s_waitcnt lgkmcnt(0)":"+v"(xdummy)::"memory");
  #endif
  __builtin_amdgcn_s_setprio(0);
  { SBAR(); const lds_cptr vp_=vp0+vb+F_VSL; VRS(0,0);VRS(1,1);
    o[0]=MF8(PB,vf[0],o[0]); o[1]=MF8(PB,vf[1],o[1]); VRS(0,2);VRS(1,3); o[2]=MF8(PB,vf[0],o[2]); o[3]=MF8(PB,vf[1],o[3]); l4=MFL(PB,l4); }
  #undef PK8
  #undef PK8O
  #undef PIN
  #undef MX3
  #undef EX
  #undef GA
  #undef GB
  #undef VRS
  #undef KRD
  #undef MFQ
  #undef MF8
  #undef MFL
  #undef KLD
  #undef ST1
  #undef ST2
  #undef IV1
  #undef IV2
  #undef XTRA
  #undef PH_A
  #undef PH_B
  float rli[16];
  const int lane_e=lane_now(), r32e=lane_e&31, hie=lane_e>>5;
  if((lane_e&7)==0){ const int lr_=4*(lane_e>>4)+16*((lane_e>>3)&1); _Pragma("unroll") for(int i_=0;i_<4;++i_)wsf[64+lr_+i_]=l4[i_]; }
  asm volatile("s_waitcnt lgkmcnt(0)":::"memory");
  #pragma unroll
  for(int r=0;r<16;++r)rli[r]=1.0f/wsf[64+crow(r,hie)];
  { asm volatile("":"+s"(Op)); }
  bf16*Ow=Op+(long)(q0+wid*QBLK)*LDO;
  bf16*stg=(bf16*)(shm+F_LDS_OST)+wid*2048;
  if(Yp==nullptr){
    #pragma unroll
    for(int ph=0;ph<2;++ph){
      #pragma unroll
      for(int r=0;r<16;++r){const int orow=crow(r,hie);
        #pragma unroll
        for(int d0=0;d0<2;++d0)stg[orow*64+d0*32+r32e]=__float2bfloat16(o[2*ph+d0][r]*rli[r]);}
      asm volatile("s_waitcnt lgkmcnt(0)":::"memory");
      #pragma unroll
      for(int i=0;i<4;++i){const int row=i*8+(lane_e>>3),ch=lane_e&7; const u32x4 v=*(const u32x4*)(stg+row*64+ch*8); *(u32x4*)(Ow+(long)row*LDO+ph*64+ch*8)=v;}
      asm volatile("s_waitcnt lgkmcnt(0)":::"memory"); }
  } else {
    asm volatile("":"+s"(Yp),"+s"(gnp));
    const int ch=lane_e&7, rw=lane_e>>3;
    u32x4 o1v[2][4], o2v[2][4]; float gnv[2][8];
    #pragma unroll
    for(int ph=0;ph<2;++ph){
      #pragma unroll
      for(int i=0;i<4;++i) o1v[ph][i]=*(const u32x4*)(Ow+(long)(i*8+rw)*LDO+ph*64+ch*8);
      #pragma unroll
      for(int k=0;k<8;++k) gnv[ph][k]=gnp[ph*64+ch*8+k]*gmul; }
    #pragma unroll
    for(int ph=0;ph<2;++ph){
      #pragma unroll
      for(int r=0;r<16;++r){const int orow=crow(r,hie);
        #pragma unroll
        for(int d0=0;d0<2;++d0)stg[orow*64+d0*32+r32e]=__float2bfloat16(o[2*ph+d0][r]*rli[r]);}
      asm volatile("s_waitcnt lgkmcnt(0)":::"memory");
      #pragma unroll
      for(int i=0;i<4;++i) o2v[ph][i]=*(const u32x4*)(stg+(i*8+rw)*64+ch*8);
      asm volatile("s_waitcnt lgkmcnt(0)":::"memory"); }
    bf16*Yw=Yp+(long)(q0+wid*QBLK)*1024;
    #pragma unroll
    for(int i=0;i<4;++i){
      float v[2][8]; float sq=0.f;
      #pragma unroll
      for(int ph=0;ph<2;++ph){ const u32x4 a=o1v[ph][i], b=o2v[ph][i];
        v[ph][0]=bflo(a.x)-lam*bflo(b.x); v[ph][1]=bfhi(a.x)-lam*bfhi(b.x); v[ph][2]=bflo(a.y)-lam*bflo(b.y); v[ph][3]=bfhi(a.y)-lam*bfhi(b.y);
        v[ph][4]=bflo(a.z)-lam*bflo(b.z); v[ph][5]=bfhi(a.z)-lam*bfhi(b.z); v[ph][6]=bflo(a.w)-lam*bflo(b.w); v[ph][7]=bfhi(a.w)-lam*bfhi(b.w);
        #pragma unroll
        for(int k=0;k<8;++k) sq+=v[ph][k]*v[ph][k]; }
      sq+=__builtin_bit_cast(float,__builtin_amdgcn_update_dpp(0,__builtin_bit_cast(int,sq),0xB1,0xf,0xf,true));
      sq+=__builtin_bit_cast(float,__builtin_amdgcn_update_dpp(0,__builtin_bit_cast(int,sq),0x4E,0xf,0xf,true));
      sq+=__builtin_bit_cast(float,__builtin_amdgcn_update_dpp(0,__builtin_bit_cast(int,sq),0x141,0xf,0xf,true));
      const float rn=1.0f/sqrtf(sq*(1.0f/128.0f)+1e-6f);
      #pragma unroll
      for(int ph=0;ph<2;++ph){ u32x4 y;
        y.x=cvtpk_s(v[ph][0]*rn*gnv[ph][0],v[ph][1]*rn*gnv[ph][1]); y.y=cvtpk_s(v[ph][2]*rn*gnv[ph][2],v[ph][3]*rn*gnv[ph][3]);
        y.z=cvtpk_s(v[ph][4]*rn*gnv[ph][4],v[ph][5]*rn*gnv[ph][5]); y.w=cvtpk_s(v[ph][6]*rn*gnv[ph][6],v[ph][7]*rn*gnv[ph][7]);
        *(u32x4*)(Yw+(long)(i*8+rw)*1024+ph*64+ch*8)=y; } }
  }
  asm volatile("s_waitcnt lgkmcnt(0)\n\ts_barrier":::"memory");
  #undef DK
  #undef DV
  #undef CMASK
  #undef RESC
}
#undef SBAR
#undef WAIT_BAR
}

#ifndef STAMP_BLOCK
#define STAMP_BLOCK 0
#endif
#ifndef STAMP_SCALE
#define STAMP_SCALE 10000
#endif
constexpr int NWAVES = 8;
#ifndef MK_N_LAUNCHES
#define MK_N_LAUNCHES 1
#endif
constexpr int N_PHASES = 13;
constexpr int N_LAUNCHES = MK_N_LAUNCHES;

constexpr int BATCH = 2, T = 16384, D = 1024, M = BATCH * T;
constexpr int NPROJ = 3072;
constexpr int NEXP = 32, EFF = 512;
constexpr float EPS = 1e-6f, LOG2E = 1.4426950408889634f;
constexpr float LAMBDA_INIT = 0.2f;
constexpr int MOBA_CAP = 256 * 2016;

constexpr size_t MiB = 1u << 20;
constexpr size_t WS_CTL = 0, CTL_ZERO_BYTES = 1 * MiB;
constexpr size_t WS_MOD = 1 * MiB;
constexpr size_t WS_BIASG = 1 * MiB + 64 * 1024;
constexpr size_t WS_BT4 = 1 * MiB + 128 * 1024;
constexpr size_t WS_KMEAN = 512 * 1024;
constexpr size_t WS_TOKW = 2 * MiB;
constexpr size_t WS_ELIST = 3 * MiB;
constexpr size_t WS_WIN = 8 * MiB, WS_WOUT = 14 * MiB;
constexpr size_t WS_XN = 16 * MiB;
constexpr size_t WS_QKV = 80 * MiB;
constexpr size_t WS_OD = 272 * MiB;
constexpr size_t WS_PO = 336 * MiB;
constexpr size_t WS_PML = 432 * MiB;
constexpr size_t WS_MLIST = 438 * MiB;
constexpr float W8_SCALE = 32.f, HID8_SCALE = 8.f, Y8_SCALE = 16.f;
constexpr size_t WS_WGU = 336 * MiB, WS_WD = 400 * MiB;
constexpr size_t WS_YO = 80 * MiB;
constexpr size_t WS_HID = 208 * MiB;
constexpr size_t WS_SO = 80 * MiB;
constexpr size_t WS_X1B = 432 * MiB;
constexpr size_t WS_VT8 = 496 * MiB;
constexpr size_t WS_END = 512 * MiB;
static_assert(WS_X1B + (size_t)M * 1024 * 2 <= WS_END && WS_X1B >= WS_WD + (size_t)32 * 1024 * 512 * 2, "d_ws map");
static_assert(WS_MLIST + (size_t)16 * MOBA_CAP * 4 <= WS_END && WS_PML + (size_t)3 * M * 16 * 4 <= WS_MLIST && WS_PO + (size_t)3 * M * 512 * 2 <= WS_PML, "d_ws map");
static_assert(WS_HID + (size_t)73728 * 512 * 2 <= WS_WGU && WS_SO + (size_t)M * 2 * 1024 * 2 <= WS_HID && WS_WD + (size_t)32 * 1024 * 512 * 2 <= WS_PML, "d_ws map");
constexpr int CW_BAR = 4096;
constexpr int CW_MCNT = 16384;
constexpr int CW_ECNT = 16384 + 1024 * 16;
static_assert((CW_ECNT + 32 * 64) * 4 <= (int)CTL_ZERO_BYTES, "CTL words inside the memset region");

constexpr int RING_OFF = 0, RING_BYTES = 131072;
constexpr int LDSCTL_OFF = 147456, MISC_OFF = LDSCTL_OFF + 320;
constexpr int LDS_BYTES = 148480;
static_assert(MISC_OFF + 128 <= LDS_BYTES, "LDS map");

#define GAS __attribute__((address_space(1)))
#define LAS __attribute__((address_space(3)))
typedef unsigned short bf16;
typedef unsigned v4u __attribute__((ext_vector_type(4)));
typedef unsigned v2u __attribute__((ext_vector_type(2)));
typedef float f32x4 __attribute__((ext_vector_type(4)));
typedef float f32x2 __attribute__((ext_vector_type(2)));
typedef GAS unsigned gu32;
#define RLX_AGENT __ATOMIC_RELAXED, __HIP_MEMORY_SCOPE_AGENT
#define LDS_WAIT() asm volatile("s_waitcnt lgkmcnt(0)" ::: "memory")
#define VM_WAIT() asm volatile("s_waitcnt vmcnt(0)" ::: "memory")
__device__ __forceinline__ unsigned f2bf(float f) { unsigned u = __builtin_bit_cast(unsigned, f); return (u + 0x7fffu + ((u >> 16) & 1u)) >> 16; }
__device__ __forceinline__ unsigned pk2(float lo, float hi) { return f2bf(lo) | (f2bf(hi) << 16); }
__device__ __forceinline__ float bf_lo(unsigned u) { return __uint_as_float(u << 16); }
__device__ __forceinline__ float bf_hi(unsigned u) { return __uint_as_float(u & 0xffff0000u); }

#define XB_TMO      128
#define XB_XCNT(j)  (256  + 64 * (j))
#define XB_XSUB(j)  (1280 + 64 * (j))
#define XB_XGEN(j)  (2304 + 64 * (j))
#define XB_TOP      3328
#define XB_TOPGEN   3392
#define XCD_BAR_WORDS 3456
#define XB_SPIN_CAP (1u << 18)

__device__ __forceinline__ unsigned xb_ld(unsigned* p)              { return __hip_atomic_load(p, __ATOMIC_RELAXED, __HIP_MEMORY_SCOPE_AGENT); }
__device__ __forceinline__ unsigned xb_add(unsigned* p, unsigned v) { return __hip_atomic_fetch_add(p, v, __ATOMIC_RELAXED, __HIP_MEMORY_SCOPE_AGENT); }
__device__ __forceinline__ unsigned xb_xcc_id() { return (unsigned)__builtin_amdgcn_s_getreg((3 << 11) | 20) & 0xFu; }
#define XB_SPIN(cond, bar) do { unsigned _sp = 0; while (cond) { __builtin_amdgcn_s_sleep(1); \
    if ((++_sp & 255u) == 0u) { if (xb_ld(&(bar)[XB_TMO])) break; if (_sp > XB_SPIN_CAP) { atomicAdd(&(bar)[XB_TMO], 1u); break; } } } } while (0)

struct XcdBarrier {
    unsigned* bar; unsigned x;
    volatile LAS unsigned* st;
};
__device__ __forceinline__ XcdBarrier xcd_barrier_post(unsigned* bar, volatile LAS unsigned* st, bool leader  ) {
    XcdBarrier b; b.bar = bar; b.x = xb_xcc_id(); b.st = st;
    if (leader) (void)xb_add(&bar[XB_XCNT(b.x)], 1u);
    return b;
}
__device__ __forceinline__ void xcd_barrier_complete(unsigned* bar, unsigned x, unsigned& nloc, unsigned& nx) {
    const unsigned G = gridDim.x * gridDim.y * gridDim.z;
    unsigned sum, cnt, mine, sp = 0u;
    for (;;) {
        sum = 0u; cnt = 0u; mine = 0u;
#pragma unroll
        for (unsigned j = 0; j < 16; ++j) { const unsigned c = xb_ld(&bar[XB_XCNT(j)]); sum += c; cnt += (c > 0u) ? 1u : 0u; mine = (j == x) ? c : mine; }
        if (sum == G) break;
        __builtin_amdgcn_s_sleep(1);
        if ((++sp & 255u) == 0u) { if (xb_ld(&bar[XB_TMO])) break; if (sp > XB_SPIN_CAP) { atomicAdd(&bar[XB_TMO], 1u); break; } }
    }
    nloc = mine > 0u ? mine : 1u; nx = cnt > 0u ? cnt : 1u;
}
__device__ __forceinline__ void xcd_barrier(const XcdBarrier& b, bool leader  ) {
    asm volatile("s_waitcnt vmcnt(0)" ::: "memory");
    __syncthreads();
    if (leader) {
        unsigned* bar = b.bar;
        __builtin_amdgcn_s_waitcnt(0);
        unsigned nloc = b.st[0], nx = b.st[1];
        if (nloc == 0u) { xcd_barrier_complete(bar, b.x, nloc, nx); b.st[0] = nloc; b.st[1] = nx; }
        const unsigned old = xb_add(&bar[XB_XSUB(b.x)], 1u);
        const unsigned gen = old / nloc;
        if (old + 1u == (gen + 1u) * nloc) {
            __builtin_amdgcn_fence(__ATOMIC_RELEASE, "agent");
            asm volatile("s_waitcnt vmcnt(0)" ::: "memory");
            const unsigned og = xb_add(&bar[XB_TOP], 1u);
            const unsigned tg = og / nx;
            if (og + 1u == (tg + 1u) * nx) xb_add(&bar[XB_TOPGEN], 1u);
            else XB_SPIN(xb_ld(&bar[XB_TOPGEN]) == tg, bar);
            __builtin_amdgcn_fence(__ATOMIC_ACQUIRE, "agent");
            xb_add(&bar[XB_XGEN(b.x)], 1u);
            asm volatile("s_waitcnt vmcnt(0)" ::: "memory");
        } else {
            XB_SPIN(xb_ld(&bar[XB_XGEN(b.x)]) == gen, bar);
            __builtin_amdgcn_fence(__ATOMIC_ACQUIRE, "agent");
            asm volatile("s_waitcnt vmcnt(0)" ::: "memory");
        }
    }
    __syncthreads();
}

struct Frame {
    LAS unsigned char* lds;
    volatile LAS unsigned* MISC;
    gu32* ctl;
    int tid, lane, wave;
    int vcu, G;
    float* out; unsigned char* ws;
};
typedef __attribute__((address_space(4))) const unsigned char* kptr_t;
__device__ __forceinline__ kptr_t karg() { kptr_t p = (kptr_t)__builtin_amdgcn_kernarg_segment_ptr(); asm volatile("" : "+s"(p)); return p; }
#define INP(kp, i) (*(const float* const __attribute__((address_space(4)))*)((kp) + 8 * (i)))
__device__ __forceinline__ float shx(float v, int o, int lane) { return __builtin_bit_cast(float, __builtin_amdgcn_ds_bpermute((lane ^ o) << 2, __builtin_bit_cast(int, v))); }
__device__ __forceinline__ int shfl_i(int v, int src) { return __builtin_amdgcn_ds_bpermute(src << 2, v); }
template<int CTRL> __device__ __forceinline__ float dpp_f(float v) { return __builtin_bit_cast(float, __builtin_amdgcn_update_dpp(0, __builtin_bit_cast(int, v), CTRL, 0xf, 0xf, true)); }
__device__ __forceinline__ float sum16_dpp(float v) {
    v += dpp_f<0xB1>(v); v += dpp_f<0x4E>(v); v += dpp_f<0x141>(v); v += dpp_f<0x140>(v); return v; }
__device__ __forceinline__ float wave_sum(float v, int  ) {
    v = sum16_dpp(v);
    { auto rr = __builtin_amdgcn_permlane16_swap(__float_as_uint(v), __float_as_uint(v), false, false); v = __uint_as_float(rr[0]) + __uint_as_float(rr[1]); }
    { auto rr = __builtin_amdgcn_permlane32_swap(__float_as_uint(v), __float_as_uint(v), false, false); v = __uint_as_float(rr[0]) + __uint_as_float(rr[1]); }
    return v;
}
#define PHASE_BEGIN(F) do { (F).lane = lane_now(); (F).tid = (F).wave * 64 + (F).lane; \
    { const kptr_t kq_ = karg(); (F).out = *(float* const __attribute__((address_space(4)))*)(kq_ + 184); (F).ws = *(unsigned char* const __attribute__((address_space(4)))*)(kq_ + 192); (F).ctl = (gu32*)(F).ws; } } while (0)
__device__ __forceinline__ float silu_f(float v) { return v / (1.f + __expf(-v)); }
__device__ __forceinline__ int rel_bucket(int d) {
    if (d < 16) return d;
    const int thr[15] = {19, 21, 24, 27, 31, 35, 40, 46, 52, 59, 67, 77, 87, 99, 113};
    int b = 16;
#pragma unroll
    for (int i = 0; i < 15; ++i) b += (d >= thr[i]) ? 1 : 0;
    return b;
}
__device__ __forceinline__ void p0_transpose_item(const float* W, int K, int N, bf16* WT, size_t dst_row0, LAS float* scr, int k0, int n0, int lane) {
    {
        f32x4 t_[8]; const int r_ = lane >> 3, c_ = lane & 7;
#pragma unroll
        for (int i = 0; i < 8; ++i) t_[i] = *(const GAS f32x4*)(W + (size_t)(k0 + r_ + 8 * i) * N + n0 + 4 * c_);
#pragma unroll
        for (int i = 0; i < 8; ++i) { LAS float* d_ = scr + (r_ + 8 * i) * 33 + 4 * c_; d_[0] = t_[i].x; d_[1] = t_[i].y; d_[2] = t_[i].z; d_[3] = t_[i].w; } }
    LDS_WAIT(); asm volatile("" ::: "memory");
    const int c = lane & 7;
#pragma unroll
    for (int j = 0; j < 4; ++j) { const int n = (lane >> 3) + 8 * j; const LAS float* s = scr + (8 * c) * 33 + n;
        v4u o; o.x = pk2(s[0 * 33], s[1 * 33]); o.y = pk2(s[2 * 33], s[3 * 33]); o.z = pk2(s[4 * 33], s[5 * 33]); o.w = pk2(s[6 * 33], s[7 * 33]);
        *(GAS v4u*)(WT + (dst_row0 + n) * K + k0 + 8 * c) = o; }
    LDS_WAIT(); asm volatile("" ::: "memory");
}

__device__ __forceinline__ void p0_transpose_item8(const float* W, int K, int N, unsigned char* WT, size_t dst_row0, LAS float* scr, int k0, int n0, int lane) {
    {
        f32x4 t_[8]; const int r_ = lane >> 3, c_ = lane & 7;
#pragma unroll
        for (int i = 0; i < 8; ++i) t_[i] = *(const GAS f32x4*)(W + (size_t)(k0 + r_ + 8 * i) * N + n0 + 4 * c_);
#pragma unroll
        for (int i = 0; i < 8; ++i) { LAS float* d_ = scr + (r_ + 8 * i) * 33 + 4 * c_; d_[0] = t_[i].x; d_[1] = t_[i].y; d_[2] = t_[i].z; d_[3] = t_[i].w; } }
    LDS_WAIT(); asm volatile("" ::: "memory");
    const int c = lane & 3;
#pragma unroll
    for (int j = 0; j < 2; ++j) { const int n = (lane >> 2) + 16 * j; const LAS float* s = scr + (16 * c) * 33 + n;
        int w[4];
#pragma unroll
        for (int q = 0; q < 4; ++q) { int t = 0; t = __builtin_amdgcn_cvt_pk_fp8_f32(s[(4 * q) * 33] * W8_SCALE, s[(4 * q + 1) * 33] * W8_SCALE, t, false);
            t = __builtin_amdgcn_cvt_pk_fp8_f32(s[(4 * q + 2) * 33] * W8_SCALE, s[(4 * q + 3) * 33] * W8_SCALE, t, true); w[q] = t; }
        *(GAS v4u*)(WT + (dst_row0 + n) * K + k0 + 16 * c) = (v4u){(unsigned)w[0], (unsigned)w[1], (unsigned)w[2], (unsigned)w[3]}; }
    LDS_WAIT(); asm volatile("" ::: "memory");
}
__device__ __forceinline__ void p0_prologue(Frame& F) {
    PHASE_BEGIN(F);
    const kptr_t kp = karg();
    const float* c = INP(kp, 1); const float* w_ada = INP(kp, 2); const float* b_ada = INP(kp, 3);
    float* mod = (float*)(F.ws + WS_MOD);
    LAS float* cs = (LAS float*)(F.lds);
    LAS float* part = (LAS float*)(F.lds + 8192);
    for (int cg = blockIdx.x; cg < 192; cg += F.G) {
        for (int i = F.tid; i < 2048; i += NWAVES * 64) cs[i] = silu_f(c[i]);
        __syncthreads();
        const int l31 = F.lane & 31, hf = F.lane >> 5, col = cg * 32 + l31, k0 = (F.wave * 2 + hf) * 64; float a0 = 0.f, a1 = 0.f;
        float wv_[64];
#pragma unroll
        for (int k = 0; k < 64; ++k) wv_[k] = w_ada[(size_t)(k0 + k) * 6144 + col];
#pragma unroll
        for (int k = 0; k < 64; ++k) { a0 += cs[k0 + k] * wv_[k]; a1 += cs[1024 + k0 + k] * wv_[k]; }
        { auto rr = __builtin_amdgcn_permlane32_swap(__float_as_uint(a0), __float_as_uint(a0), false, false); a0 = __uint_as_float(rr[0]) + __uint_as_float(rr[1]); }
        { auto rr = __builtin_amdgcn_permlane32_swap(__float_as_uint(a1), __float_as_uint(a1), false, false); a1 = __uint_as_float(rr[0]) + __uint_as_float(rr[1]); }
        if (hf == 0) { part[(F.wave * 2 + 0) * 32 + l31] = a0; part[(F.wave * 2 + 1) * 32 + l31] = a1; }
        __syncthreads();
        if (F.wave < 2 && hf == 0) { float s = 0.f;
#pragma unroll
            for (int w = 0; w < 8; ++w) s += part[(w * 2 + F.wave) * 32 + l31];
            mod[F.wave * 6144 + col] = s + b_ada[col]; }
        __syncthreads();
    }
    if (blockIdx.x == F.G - 1) {
        const float* rbg = INP(kp, 15); float* bg = (float*)(F.ws + WS_BIASG);
        LAS float* rb = (LAS float*)(F.lds + 12288);
        if (F.tid < 384) rb[F.tid] = rbg[F.tid];
        __syncthreads();
        for (int i = F.tid; i < 12 * 128; i += NWAVES * 64) { const int h = i >> 7, d = i & 127; bg[i] = (rb[rel_bucket(d) * 12 + h] - rb[31 * 12 + h]) * LOG2E; }
        float* b4 = (float*)(F.ws + WS_BT4);
        for (int i = F.tid; i < 12 * 2048; i += NWAVES * 64) { const int h = i >> 11, k = i & 2047, d = (k & 511) + (k >> 9) - 256;
            b4[i] = d < 0 ? -INFINITY : (d < 128 ? (rb[rel_bucket(d) * 12 + h] - rb[31 * 12 + h]) * LOG2E : 0.f); }
    }
    __syncthreads();
    LAS float* scr = (LAS float*)(F.lds + RING_OFF + F.wave * 16384);
    const int gw = F.vcu * NWAVES + F.wave, NGW = F.G * NWAVES;
    constexpr int I_IN = 16 * 96, I_OUT = 16 * 32;
    for (int it = gw; it < I_IN + I_OUT; it += NGW) {
        if (it < I_IN) { const int kb = it / 96, nb = it % 96; p0_transpose_item8(INP(kp, 8), 1024, 3072, (unsigned char*)(F.ws + WS_WIN), (size_t)(32 * nb), scr, 64 * kb, 32 * nb, F.lane); }
        else { const int r = it - I_IN, kb = r / 32, nb = r % 32; p0_transpose_item(INP(kp, 14), 1024, 1024, (bf16*)(F.ws + WS_WOUT), (size_t)(32 * nb), scr, 64 * kb, 32 * nb, F.lane); }
    }
}
__device__ __forceinline__ void expert_weights(Frame& F) {
    const kptr_t kp = karg();
    PHASE_BEGIN(F);
    LAS float* scr = (LAS float*)(F.lds + RING_OFF + F.wave * 16384);
    const int gw = F.vcu * NWAVES + F.wave, NGW = F.G * NWAVES;
    constexpr int I_G = 32 * 16 * 16, I_D = 32 * 8 * 32, I_ALL = 2 * I_G + I_D;
#define EW_DECODE(it_, W_, K_, N_, WT_, R0_, k0_, n0_) const float* W_; int K_, N_, k0_, n0_; unsigned char* WT_; size_t R0_; \
    if ((it_) < 2 * I_G) { const int up_ = (it_) >= I_G ? 1 : 0, r_ = (it_) - up_ * I_G, e_ = r_ >> 8, kb_ = (r_ >> 4) & 15, nb_ = r_ & 15; n0_ = 32 * nb_; k0_ = 64 * kb_; K_ = 1024; N_ = 512; \
        W_ = INP(kp, 20 + up_) + (size_t)e_ * 1024 * 512; WT_ = (unsigned char*)(F.ws + WS_WGU); R0_ = (size_t)e_ * 1024 + (n0_ >> 7) * 256 + up_ * 128 + (n0_ & 127); } \
    else { const int r_ = (it_) - 2 * I_G, e_ = r_ >> 8, kb_ = (r_ >> 5) & 7, nb_ = r_ & 31; n0_ = 32 * nb_; k0_ = 64 * kb_; K_ = 512; N_ = 1024; \
        W_ = INP(kp, 22) + (size_t)e_ * 512 * 1024; WT_ = (unsigned char*)(F.ws + WS_WD); R0_ = (size_t)e_ * 1024 + 32 * nb_; }
    f32x4 t_[8]; const int r_l = F.lane >> 3, c_l = F.lane & 7;
    if (gw < I_ALL) { EW_DECODE(gw, W0, K0, N0, WT0, R00, k00, n00);
#pragma unroll
        for (int i = 0; i < 8; ++i) t_[i] = *(const GAS f32x4*)(W0 + (size_t)(k00 + r_l + 8 * i) * N0 + n00 + 4 * c_l); }
    for (int it = gw; it < I_ALL; it += NGW) {
        EW_DECODE(it, W, K, N, WT, R0, k0, n0);
#pragma unroll
        for (int i = 0; i < 8; ++i) { LAS float* d_ = scr + (r_l + 8 * i) * 33 + 4 * c_l; d_[0] = t_[i].x; d_[1] = t_[i].y; d_[2] = t_[i].z; d_[3] = t_[i].w; }
        LDS_WAIT(); asm volatile("" ::: "memory");
        if (it + NGW < I_ALL) { EW_DECODE(it + NGW, Wn, Kn, Nn, WTn, R0n, k0n, n0n);
#pragma unroll
            for (int i = 0; i < 8; ++i) t_[i] = *(const GAS f32x4*)(Wn + (size_t)(k0n + r_l + 8 * i) * Nn + n0n + 4 * c_l); }
        const int c = F.lane & 3;
#pragma unroll
        for (int j = 0; j < 2; ++j) { const int n = (F.lane >> 2) + 16 * j; const LAS float* s = scr + (16 * c) * 33 + n;
            int w[4];
#pragma unroll
            for (int q = 0; q < 4; ++q) { int tt = 0; tt = __builtin_amdgcn_cvt_pk_fp8_f32(s[(4 * q) * 33] * W8_SCALE, s[(4 * q + 1) * 33] * W8_SCALE, tt, false);
                tt = __builtin_amdgcn_cvt_pk_fp8_f32(s[(4 * q + 2) * 33] * W8_SCALE, s[(4 * q + 3) * 33] * W8_SCALE, tt, true); w[q] = tt; }
            *(GAS v4u*)(WT + (R0 + n) * K + k0 + 16 * c) = (v4u){(unsigned)w[0], (unsigned)w[1], (unsigned)w[2], (unsigned)w[3]}; }
        LDS_WAIT(); asm volatile("" ::: "memory");
    }
#undef EW_DECODE
}
__device__ __forceinline__ void p1_prenorm(Frame& F) {
    PHASE_BEGIN(F);
    const kptr_t kp = karg();
    const float* x = INP(kp, 0); const float* gain = INP(kp, 4); const float* mod = (const float*)(F.ws + WS_MOD); bf16* XN = (bf16*)(F.ws + WS_XN);
    const int gw = F.vcu * NWAVES + F.wave, NGW = F.G * NWAVES;
    for (int b = 0; b < BATCH; ++b) {
        f32x4 ge[4], sh[4];
#pragma unroll
        for (int j = 0; j < 4; ++j) { const int c = 4 * F.lane + 256 * j; const f32x4 g = *(const f32x4*)(gain + c), sc = *(const f32x4*)(mod + b * 6144 + 1024 + c); ge[j] = g * (sc + 1.f); sh[j] = *(const f32x4*)(mod + b * 6144 + c); }
        f32x4 nv[4];
        { const GAS f32x4* xr = (const GAS f32x4*)(x + (size_t)(b * T + gw) * D) + F.lane;
#pragma unroll
          for (int j = 0; j < 4; ++j) nv[j] = xr[64 * j]; }
        for (int m = b * T + gw; m < (b + 1) * T; m += NGW) {
            int ln = F.lane; asm volatile("" : "+v"(ln));
            f32x4 v[4]; float s = 0.f;
#pragma unroll
            for (int j = 0; j < 4; ++j) { v[j] = nv[j]; s += (v[j].x * v[j].x + v[j].y * v[j].y) + (v[j].z * v[j].z + v[j].w * v[j].w); }
            { const int mn = (m + NGW < (b + 1) * T) ? m + NGW : m; const GAS f32x4* xr = (const GAS f32x4*)(x + (size_t)mn * D) + ln;
#pragma unroll
              for (int j = 0; j < 4; ++j) nv[j] = xr[64 * j]; }
            const float r = 1.f / sqrtf(wave_sum(s, F.lane) * (1.f / D) + EPS);
            GAS int* o8 = (GAS int*)((unsigned char*)XN + (size_t)m * D) + ln;
#pragma unroll
            for (int j = 0; j < 4; ++j) { const f32x4 h = v[j] * r * ge[j] + sh[j]; int t_ = 0; t_ = __builtin_amdgcn_cvt_pk_fp8_f32(h.x, h.y, t_, false); t_ = __builtin_amdgcn_cvt_pk_fp8_f32(h.z, h.w, t_, true); o8[64 * j] = t_; }
        }
    }
}
__device__ __forceinline__ void p3_kmean(Frame& F) {
    PHASE_BEGIN(F);
    const bf16* QKV = (const bf16*)(F.ws + WS_QKV);
    const int gw = F.vcu * NWAVES + F.wave, NGW = F.G * NWAVES;
    LAS unsigned char* tile = (LAS unsigned char*)(F.lds + RING_OFF + F.wave * 16384);
    unsigned char* VT = (unsigned char*)(F.ws + WS_VT8);
    for (int it = gw; it < 2 * 4 * 256; it += NGW) {
        const int b = it >> 10, h = (it >> 8) & 3, t = it & 255;
        const int kk = F.lane, k31 = kk & 31, hi_ = (k31 >> 2) & 1, s_ = (k31 & 3) + 4 * (k31 >> 3) + 16 * (kk >> 5), pos = 32 * hi_ + s_;
        const bf16* src = QKV + ((size_t)(b * T + 64 * t + kk)) * NPROJ + 1024 + h * 128;
        v4u vraw[16];
#pragma unroll
        for (int c = 0; c < 16; ++c) vraw[c] = *(const GAS v4u*)(src + 8 * c);
        __builtin_amdgcn_sched_barrier(0);
#pragma unroll
        for (int c = 0; c < 16; ++c) { const v4u v = vraw[c];
            const float f[8] = {bf_lo(v.x), bf_hi(v.x), bf_lo(v.y), bf_hi(v.y), bf_lo(v.z), bf_hi(v.z), bf_lo(v.w), bf_hi(v.w)};
            int w0 = 0, w1 = 0;
            w0 = __builtin_amdgcn_cvt_pk_fp8_f32(f[0] * 8.f, f[1] * 8.f, w0, false); w0 = __builtin_amdgcn_cvt_pk_fp8_f32(f[2] * 8.f, f[3] * 8.f, w0, true);
            w1 = __builtin_amdgcn_cvt_pk_fp8_f32(f[4] * 8.f, f[5] * 8.f, w1, false); w1 = __builtin_amdgcn_cvt_pk_fp8_f32(f[6] * 8.f, f[7] * 8.f, w1, true);
#pragma unroll
            for (int j = 0; j < 4; ++j) { tile[(8 * c + j) * 64 + pos] = (unsigned char)((unsigned)w0 >> (8 * j)); tile[(8 * c + 4 + j) * 64 + pos] = (unsigned char)((unsigned)w1 >> (8 * j)); } }
        LDS_WAIT(); asm volatile("" ::: "memory");
#pragma unroll
        for (int i = 0; i < 8; ++i) { const int idx = i * 64 + F.lane, d = idx >> 2, c = idx & 3;
            const v4u o = *(const LAS v4u*)(tile + d * 64 + 16 * c);
            *(GAS v4u*)(VT + ((size_t)((b * 4 + h) * 128 + d)) * T + 64 * t + 16 * c) = o; }
        LDS_WAIT(); asm volatile("" ::: "memory");
    }
}
__device__ __forceinline__ int moba_list_base(int bh, int j) { return bh * MOBA_CAP + 256 * (63 * j - (j * (j - 1)) / 2); }
__device__ __forceinline__ void p4_moba_select(Frame& F) {
    PHASE_BEGIN(F);
    const bf16* QKV = (const bf16*)(F.ws + WS_QKV); const float* km = (const float*)(F.ws + WS_KMEAN); unsigned* mlist = (unsigned*)(F.ws + WS_MLIST);
    LAS float* kml = (LAS float*)(F.lds);
    for (int bi = blockIdx.x, pass = 0; bi < 512; bi += F.G, ++pass) {
        const int bh = bi >> 5, qg = (pass & 1) ? 31 - (bi & 31) : (bi & 31), b = bh >> 3, h = bh & 7;
        for (int i = F.tid; i < 1024; i += NWAVES * 64) ((LAS f32x4*)kml)[i] = ((const f32x4*)(km + (size_t)bh * 4096))[i];
        __syncthreads();
        const int q = qg * 512 + F.wave * 64 + F.lane, own = (qg * 512 + F.wave * 64) >> 8;
        if (own > 0) {
            typedef float f32x2v __attribute__((ext_vector_type(2)));
            f32x2v q2[32];
            const bf16* qp = QKV + ((size_t)(b * T + q)) * NPROJ + 1536 + h * 64;
#pragma unroll
            for (int c8 = 0; c8 < 8; ++c8) { const v4u v = *(const GAS v4u*)(qp + c8 * 8);
                q2[c8 * 4 + 0] = (f32x2v){bf_lo(v.x), bf_hi(v.x)}; q2[c8 * 4 + 1] = (f32x2v){bf_lo(v.y), bf_hi(v.y)}; q2[c8 * 4 + 2] = (f32x2v){bf_lo(v.z), bf_hi(v.z)}; q2[c8 * 4 + 3] = (f32x2v){bf_lo(v.w), bf_hi(v.w)}; }
            float v0 = -INFINITY, v1 = -INFINITY, v2 = -INFINITY; int i0 = 64, i1 = 64, i2 = 64;
            for (int j = 0; j < own; ++j) {
                f32x2v ga = {0.f, 0.f}, gb = {0.f, 0.f};
#pragma unroll
                for (int d4 = 0; d4 < 16; ++d4) { const f32x4 kv = ((const LAS f32x4*)kml)[j * 16 + d4]; ga = __builtin_elementwise_fma(q2[d4 * 2], (f32x2v){kv.x, kv.y}, ga); gb = __builtin_elementwise_fma(q2[d4 * 2 + 1], (f32x2v){kv.z, kv.w}, gb); }
                const float g = (ga.x + ga.y) + (gb.x + gb.y);
                if (g > v0) { v2 = v1; i2 = i1; v1 = v0; i1 = i0; v0 = g; i0 = j; }
                else if (g > v1) { v2 = v1; i2 = i1; v1 = g; i1 = j; }
                else if (g > v2) { v2 = g; i2 = j; }
            }
            int cntj = 0, r0 = 0, r1 = 0, r2 = 0; const unsigned long long ltm = (1ull << F.lane) - 1ull;
            for (int j = 0; j < own; ++j) {
                const bool s0 = (i0 == j), s1 = (i1 == j), s2 = (i2 == j);
                const unsigned long long mask = __ballot(s0 || s1 || s2);
                if (F.lane == j) cntj = (int)__popcll(mask);
                const int rk = (int)__popcll(mask & ltm);
                r0 = s0 ? rk : r0; r1 = s1 ? rk : r1; r2 = s2 ? rk : r2;
            }
            int basej = 0;
            if (F.lane < own && cntj > 0) basej = (int)__hip_atomic_fetch_add(F.ctl + CW_MCNT + (bh * 64 + F.lane) * 16, (unsigned)cntj, RLX_AGENT);
            const int b0 = shfl_i(basej, i0 & 63), b1 = shfl_i(basej, i1 & 63), b2 = shfl_i(basej, i2 & 63);
            if (i0 < 64) mlist[(size_t)moba_list_base(bh, i0) + b0 + r0] = (unsigned)q;
            if (i1 < 64) mlist[(size_t)moba_list_base(bh, i1) + b1 + r1] = (unsigned)q | (1u << 14);
            if (i2 < 64) mlist[(size_t)moba_list_base(bh, i2) + b2 + r2] = (unsigned)q | (2u << 14);
        }
        __syncthreads();
    }
}
__device__ __forceinline__ void p5_moba_gather(Frame& F, char* lds_generic) {
    PHASE_BEGIN(F);
    LAS int* pre = (LAS int*)(F.lds + 106496);
    LAS int* tmp = (LAS int*)(F.lds + 106496 + 4224);
    for (int i = F.tid; i < 1024; i += NWAVES * 64) { const unsigned c = __hip_atomic_load(F.ctl + CW_MCNT + i * 16, RLX_AGENT); tmp[i] = (int)((c + 255u) >> 8); }
    __syncthreads();
    if (F.wave == 0) { int loc[16]; int s = 0;
#pragma unroll
        for (int k = 0; k < 16; ++k) { loc[k] = s; s += tmp[F.lane * 16 + k]; }
        int incl = s;
#pragma unroll
        for (int o = 1; o < 64; o <<= 1) { const int t = shfl_i(incl, F.lane >= o ? F.lane - o : F.lane); if (F.lane >= o) incl += t; }
        const int excl = incl - s;
#pragma unroll
        for (int k = 0; k < 16; ++k) pre[F.lane * 16 + k] = excl + loc[k];
        if (F.lane == 63) pre[1024] = incl; }
    __syncthreads();
    const int U = pre[1024];
    const bf16* QKV = (const bf16*)(F.ws + WS_QKV); const unsigned* mlist = (const unsigned*)(F.ws + WS_MLIST);
    LAS int* udec = (LAS int*)(F.lds + 106496 + 4224 + 4096);
    { const int Lk = blockIdx.x + F.lane * F.G;
      if (F.wave == 0 && Lk < U) { int lo_ = 0, hi_ = 1024; while (hi_ - lo_ > 1) { const int mid_ = (lo_ + hi_) >> 1; if (pre[mid_] <= Lk) lo_ = mid_; else hi_ = mid_; }
          const int ch_ = Lk - pre[lo_]; const int cnt_ = (int)__hip_atomic_load(F.ctl + CW_MCNT + lo_ * 16, RLX_AGENT);
          udec[F.lane * 3 + 0] = lo_; udec[F.lane * 3 + 1] = ch_; udec[F.lane * 3 + 2] = (cnt_ - ch_ * 256) < 256 ? (cnt_ - ch_ * 256) : 256; } }
    __syncthreads();
#define P5_DECODE(L_, x_, chunk_, n_) do { const int k_ = ((L_) - (int)blockIdx.x) / F.G; x_ = __builtin_amdgcn_readfirstlane(udec[k_ * 3 + 0]); chunk_ = __builtin_amdgcn_readfirstlane(udec[k_ * 3 + 1]); n_ = __builtin_amdgcn_readfirstlane(udec[k_ * 3 + 2]); } while (0)
    const int ei = F.wave * 32 + (F.lane & 31);
    int last_h = -1, x = 0, chunk = 0, n = 1; unsigned gcur = 0u;
    int L = blockIdx.x;
    attn_body::QNext qn{}; bool pfd = false; int sb = 0;
    if (L < U) { P5_DECODE(L, x, chunk, n); gcur = mlist[(size_t)moba_list_base(x >> 6, x & 63) + chunk * 256 + (ei < n ? ei : n - 1)]; }
    for (; L < U; L += F.G) {
        const int bh = x >> 6, j = x & 63, b = bh >> 3, h = bh & 7, ncur = n;
        const int Ln = L + F.G; int xn = 0, chunkn = 0, nn = 1; unsigned gnext = 0u;
        if (Ln < U) { P5_DECODE(Ln, xn, chunkn, nn); gnext = mlist[(size_t)moba_list_base(xn >> 6, xn & 63) + chunkn * 256 + (ei < nn ? ei : nn - 1)]; }
        const attn_body::bf16* base = (const attn_body::bf16*)QKV + (size_t)b * T * NPROJ;
        attn_body::MobaMerge mm{nullptr, nullptr, 0, 0, 0};
        attn_body::GatherArgs ga{gcur, ncur, (float*)(F.ws + WS_PML), (attn_body::bf16*)(F.ws + WS_PO), (long)b * T, h, (char*)(F.ws + WS_OD)};
        const bool hasn = Ln < U; const int bhn = xn >> 6, jn = xn & 63, hnn = bhn & 7;
        const attn_body::bf16* basen = (const attn_body::bf16*)QKV + (size_t)(bhn >> 3) * T * NPROJ;
        const attn_body::bf16* nQl = basen + 1536 + hnn * 64 + (long)(gnext & 0x3FFFu) * attn_body::LDQ;
        const attn_body::bf16* nKh = hasn ? basen + 2048 + hnn * 64 + (long)jn * 256 * attn_body::LDQ : nullptr;
        const attn_body::bf16* nVh = basen + 2560 + hnn * 64 + (long)jn * 256 * attn_body::LDQ;
        qn = attn_body::attn_unit<8, 2>(base + 1536 + h * 64, base + 2048 + h * 64, base + 2560 + h * 64, nullptr, 0, j * 256, 4,
                                   (const float*)(F.ws + WS_BIASG) + (4 + h) * 128, mm, ga, lds_generic, F.wave, h != last_h, pfd, sb, nQl, nKh, nVh, qn, !(hasn && hnn == h));
        pfd = hasn; sb = hasn ? ((sb == (attn_body::NSLOT - 1) * attn_body::SLOTB) ? 0 : sb + attn_body::SLOTB) : 0;
        last_h = h; x = xn; chunk = chunkn; n = nn; gcur = gnext;
    }
#undef P5_DECODE
}
__device__ __forceinline__ void p6_attention(Frame& F, char* lds_generic) {
    PHASE_BEGIN(F);
    const attn_body::bf16* QKV = (const attn_body::bf16*)(F.ws + WS_QKV);
    const int c = blockIdx.x, G = F.G;
    const kptr_t kp = karg();
    const float l1 = wave_sum(INP(kp, 9)[F.lane] * INP(kp, 10)[F.lane], F.lane), l2 = wave_sum(INP(kp, 11)[F.lane] * INP(kp, 12)[F.lane], F.lane);
    const float lam = expf(l1) - expf(l2) + LAMBDA_INIT; const float* gnp = INP(kp, 13);
#ifndef PROBE_REPD
#define PROBE_REPD 1
#define PROBE_REPO 1
#endif
    for (int rep_ = 0; rep_ < PROBE_REPD; ++rep_)
    for (int ii = 0;; ++ii) {
        const int i = ii >> 1, mp = ii & 1;
        const long Lp = (long)i * G + ((i & 1) ? (G - 1 - c) : c);
        if (Lp >= 512) break;
        const int qb = 63 - (int)(Lp >> 3), st = (int)(Lp & 7), b = st >> 2, hd = st & 3;
        const attn_body::bf16* base = QKV + (size_t)b * T * NPROJ;
        attn_body::attn_unit128f<8>((const unsigned char*)base + hd * 128 + mp * 64, (const unsigned char*)base + 512 + hd * 128 + mp * 64, (const unsigned char*)(F.ws + WS_VT8) + (size_t)((b * 4 + hd) * 128) * T,
                                   (attn_body::bf16*)(F.ws + WS_OD) + (size_t)b * T * 1024 + (hd * 2) * 128, qb * 256, 4 * (qb + 1),
                                   (const float*)(F.ws + WS_BT4) + hd * 2048, lds_generic, F.wave,
                                   mp ? (attn_body::bf16*)(F.ws + WS_XN) + (size_t)b * T * 1024 + hd * 128 : nullptr, gnp, lam, 1.f - LAMBDA_INIT
#if defined(STAMP_PROBE)
                                   , (blockIdx.x == STAMP_BLOCK && ii == 0) ? (float*)(F.ws + WS_BIASG + 32768) : nullptr
#endif
                                   );
    }
    for (int rep_ = 0; rep_ < PROBE_REPO; ++rep_)
    for (int i = 0;; ++i) {
        const long L = (long)i * G + ((i & 1) ? (G - 1 - c) : c);
        if (L >= 1024) break;
        const int o = (int)L, b = o >> 9, h = (o >> 6) & 7, qb = o & 63;
        const attn_body::bf16* base = QKV + (size_t)b * T * NPROJ;
        attn_body::MobaMerge mm{(const float*)(F.ws + WS_PML), (const attn_body::bf16*)(F.ws + WS_PO), (long)b * T + qb * 256, h, qb < 3 ? qb : 3};
        attn_body::attn_unit<8, 1>(base + 1536 + h * 64, base + 2048 + h * 64, base + 2560 + h * 64,
                                   (attn_body::bf16*)(F.ws + WS_XN) + (size_t)b * T * 1024 + 512 + h * 64, qb * 256, qb * 256, 4,
                                   (const float*)(F.ws + WS_BIASG) + (4 + h) * 128, mm, attn_body::GatherArgs{0u, 0, nullptr, nullptr, 0, 0}, lds_generic, F.wave);
    }
}
__device__ __forceinline__ void p7_ydiff(Frame& F) {
    expert_weights(F);
}
__device__ __forceinline__ void p9_postmix_route(Frame& F) {
    PHASE_BEGIN(F);
    const kptr_t kp = karg();
    const float* x = INP(kp, 0); const bf16* yo = (const bf16*)(F.ws + WS_YO); const float* mod = (const float*)(F.ws + WS_MOD);
    bf16* XN = (bf16*)(F.ws + WS_XN); float* tokw = (float*)(F.ws + WS_TOKW); int* elist = (int*)(F.ws + WS_ELIST);
    LAS float* WE = (LAS float*)(F.lds); LAS float* WG = (LAS float*)(F.lds + 131072);
    {
        f32x4 tv[16], tg[2];
#pragma unroll
        for (int q = 0; q < 16; ++q) tv[q] = ((const GAS f32x4*)INP(kp, 18))[F.tid + q * (NWAVES * 64)];
#pragma unroll
        for (int q = 0; q < 2; ++q) tg[q] = ((const GAS f32x4*)INP(kp, 16))[F.tid + q * (NWAVES * 64)];
        __builtin_amdgcn_sched_barrier(0);
#pragma unroll
        for (int q = 0; q < 16; ++q) { const int f = 4 * (F.tid + q * (NWAVES * 64)); const int k = f >> 5, cc = f & 31; const int l = (k & 255) >> 2, kk = ((k >> 8) << 2) | (k & 3), g = cc >> 3, hf = (cc >> 2) & 1;
            *(LAS f32x4*)(WE + ((((g * 16 + kk) * 2 + hf) * 64 + l) << 2)) = tv[q]; }
#pragma unroll
        for (int q = 0; q < 2; ++q) { const int k = F.tid + q * (NWAVES * 64); const int l = (k & 255) >> 2, kk = ((k >> 8) << 2) | (k & 3); *(LAS f32x4*)(WG + ((kk * 64 + l) << 2)) = tg[q]; }
    }
    __syncthreads();
    const int gw = F.vcu * NWAVES + F.wave, NGW = F.G * NWAVES;
    const float bg0 = INP(kp, 17)[0], bg1 = INP(kp, 17)[1], bg2 = INP(kp, 17)[2], bg3 = INP(kp, 17)[3];
    int nst = 0, st_e0 = 0, st_e1 = 0, st_m = 0;
    for (int b = 0; b < BATCH; ++b) {
        f32x4 a1[4], ge[4], sh[4];
#pragma unroll
        for (int j = 0; j < 4; ++j) { const int c = 4 * F.lane + 256 * j; a1[j] = *(const f32x4*)(INP(kp, 5) + c) * *(const f32x4*)(mod + b * 6144 + 2048 + c);
            ge[j] = *(const f32x4*)(INP(kp, 6) + c) * (*(const f32x4*)(mod + b * 6144 + 4096 + c) + 1.f); sh[j] = *(const f32x4*)(mod + b * 6144 + 3072 + c); }
        v2u nyb[4]; f32x4 nxv[4];
        { const int m0 = b * T + gw; const GAS v2u* yr = (const GAS v2u*)(yo + (size_t)m0 * D) + F.lane; const GAS f32x4* xr = (const GAS f32x4*)(x + (size_t)m0 * D) + F.lane;
#pragma unroll
          for (int j = 0; j < 4; ++j) { nyb[j] = yr[64 * j]; nxv[j] = xr[64 * j]; } }
        for (int m = b * T + gw; m < (b + 1) * T; m += NGW) {
            int ln = F.lane; asm volatile("" : "+v"(ln));
            f32x4 xv[4]; float s = 0.f, s2 = 0.f;
            {   f32x4 y[4];
#pragma unroll
                for (int j = 0; j < 4; ++j) { const v2u yb = nyb[j]; y[j] = (f32x4){bf_lo(yb.x), bf_hi(yb.x), bf_lo(yb.y), bf_hi(yb.y)}; xv[j] = nxv[j]; s += (y[j].x * y[j].x + y[j].y * y[j].y) + (y[j].z * y[j].z + y[j].w * y[j].w); }
                { const int mn = (m + NGW < (b + 1) * T) ? m + NGW : m; const GAS v2u* yr = (const GAS v2u*)(yo + (size_t)mn * D) + ln; const GAS f32x4* xr = (const GAS f32x4*)(x + (size_t)mn * D) + ln;
#pragma unroll
                  for (int j = 0; j < 4; ++j) { nyb[j] = yr[64 * j]; nxv[j] = xr[64 * j]; } }
                const float r1 = 1.f / sqrtf(wave_sum(s, F.lane) * (1.f / D) + EPS);
                GAS unsigned long long* x1r = (GAS unsigned long long*)((bf16*)(F.ws + WS_X1B) + (size_t)m * D) + ln;
#pragma unroll
                for (int j = 0; j < 4; ++j) { xv[j] = xv[j] + a1[j] * (y[j] * r1); x1r[64 * j] = (unsigned long long)pk2(xv[j].x, xv[j].y) | ((unsigned long long)pk2(xv[j].z, xv[j].w) << 32); s2 += (xv[j].x * xv[j].x + xv[j].y * xv[j].y) + (xv[j].z * xv[j].z + xv[j].w * xv[j].w); }
            }
            const float r2 = 1.f / sqrtf(wave_sum(s2, F.lane) * (1.f / D) + EPS);
            GAS int* o4 = (GAS int*)((unsigned char*)XN + (size_t)m * D) + ln;
            float gl[4] = {0.f, 0.f, 0.f, 0.f};
#pragma unroll
            for (int j = 0; j < 4; ++j) { xv[j] = xv[j] * r2 * ge[j] + sh[j]; { int t_ = 0; t_ = __builtin_amdgcn_cvt_pk_fp8_f32(xv[j].x, xv[j].y, t_, false); t_ = __builtin_amdgcn_cvt_pk_fp8_f32(xv[j].z, xv[j].w, t_, true); o4[64 * j] = t_; }
#pragma unroll
                for (int ii = 0; ii < 4; ++ii) { const f32x4 w = ((const LAS f32x4*)WG)[(j * 4 + ii) * 64 + F.lane]; const float hv = xv[j][ii]; gl[0] += hv * w.x; gl[1] += hv * w.y; gl[2] += hv * w.z; gl[3] += hv * w.w; }
                __builtin_amdgcn_sched_barrier(0); }
            gl[0] = wave_sum(gl[0], F.lane) + bg0; gl[1] = wave_sum(gl[1], F.lane) + bg1; gl[2] = wave_sum(gl[2], F.lane) + bg2; gl[3] = wave_sum(gl[3], F.lane) + bg3;
            int g = 0; float gm = gl[0];
            if (gl[1] > gm) { gm = gl[1]; g = 1; } if (gl[2] > gm) { gm = gl[2]; g = 2; } if (gl[3] > gm) { gm = gl[3]; g = 3; }
            const float gw_ = 1.f / (expf(gl[0] - gm) + expf(gl[1] - gm) + expf(gl[2] - gm) + expf(gl[3] - gm));
            g = __builtin_amdgcn_readfirstlane(g);
            float el[8] = {0.f, 0.f, 0.f, 0.f, 0.f, 0.f, 0.f, 0.f};
#pragma unroll
            for (int j = 0; j < 4; ++j) {
#pragma unroll
                for (int ii = 0; ii < 4; ++ii) { const int kk = j * 4 + ii; const f32x4 wa = ((const LAS f32x4*)WE)[((g * 16 + kk) * 2 + 0) * 64 + F.lane], wb = ((const LAS f32x4*)WE)[((g * 16 + kk) * 2 + 1) * 64 + F.lane]; const float hv = xv[j][ii];
                    el[0] += hv * wa.x; el[1] += hv * wa.y; el[2] += hv * wa.z; el[3] += hv * wa.w; el[4] += hv * wb.x; el[5] += hv * wb.y; el[6] += hv * wb.z; el[7] += hv * wb.w; }
                __builtin_amdgcn_sched_barrier(0); }
            float ea = -INFINITY, eb = -INFINITY; int ia = 0, ib = 0;
#pragma unroll
            for (int k = 0; k < 8; ++k) { const float v = wave_sum(el[k], F.lane) + INP(kp, 19)[g * 8 + k];
                if (v > ea) { eb = ea; ib = ia; ea = v; ia = k; } else if (v > eb) { eb = v; ib = k; } }
            const float pb = expf(eb - ea), wa_ = gw_ / (1.f + pb), wb_ = gw_ * pb / (1.f + pb);
            if (F.lane == 0) *(f32x2*)(tokw + (size_t)m * 2) = (f32x2){wa_, wb_};
            if (F.lane == nst) { st_e0 = g * 8 + ia; st_e1 = g * 8 + ib; st_m = m; }
            ++nst;
            if (nst == 64) {
                const unsigned p0 = __hip_atomic_fetch_add(F.ctl + CW_ECNT + st_e0 * 64, 1u, RLX_AGENT), p1 = __hip_atomic_fetch_add(F.ctl + CW_ECNT + st_e1 * 64, 1u, RLX_AGENT);
                elist[st_e0 * 32768 + (int)p0] = st_m * 2; elist[st_e1 * 32768 + (int)p1] = st_m * 2 + 1; nst = 0; }

        }
    }
    if (F.lane < nst) {
        const unsigned p0 = __hip_atomic_fetch_add(F.ctl + CW_ECNT + st_e0 * 64, 1u, RLX_AGENT), p1 = __hip_atomic_fetch_add(F.ctl + CW_ECNT + st_e1 * 64, 1u, RLX_AGENT);
        elist[st_e0 * 32768 + (int)p0] = st_m * 2; elist[st_e1 * 32768 + (int)p1] = st_m * 2 + 1; }
}
struct MoeOrder {
    int tpoff;
    const gu32* ecnt; const int* elist; int G, c;
    __device__ __forceinline__ bool next(int i, pg8::Unit& u) const {
        int o_ = tpoff; asm volatile("" : "+s"(o_)); const LAS int* tp = (const LAS int*)(uintptr_t)(unsigned)o_;
        const long L = (long)i * G + c; const int U = __builtin_amdgcn_readfirstlane(tp[32]) * 4; if (L >= U) return false;
        const int rt = (int)(L >> 2), pn = (int)(L & 3); int e;
        { const int ln_ = lane_now(); const bool le_ = (ln_ < 31) && (tp[(ln_ < 31 ? ln_ : 30) + 1] <= rt);
          e = (int)__popcll(__ballot(le_)); }
        e = __builtin_amdgcn_readfirstlane(e);
        const int t = rt - __builtin_amdgcn_readfirstlane(tp[e]); const int cnt = __builtin_amdgcn_readfirstlane(tp[40 + e]);
        u.pm = rt; u.pn = e * 4 + pn; u.nvalid = (cnt - t * 256) < 256 ? (cnt - t * 256) : 256; u.rows = elist + e * 32768 + t * 256; return true;
    }
    __device__ __forceinline__ int arow(const pg8::Unit& u, int r) const { return r < u.nvalid ? (u.rows[r] >> 1) : 0; }
};
__device__ __forceinline__ void moe_prefix(Frame& F, LAS int* tp) {
    if (F.wave == 0) { const int le = F.lane & 31; const int cnt = (int)__hip_atomic_load(F.ctl + CW_ECNT + le * 64, RLX_AGENT); const int nt_ = (cnt + 255) >> 8; int incl = nt_;
#pragma unroll
        for (int o = 1; o < 32; o <<= 1) { const int v_ = shfl_i(incl, F.lane >= o ? F.lane - o : F.lane); if (le >= o) incl += v_; }
        if (F.lane < 32) { tp[le] = incl - nt_; tp[40 + le] = cnt; if (le == 31) tp[32] = incl; } }
    __syncthreads();
}

__device__ __forceinline__ void p2_qkv(Frame& F) {
    PHASE_BEGIN(F);
    pg8::Gemm g{F.ws, (unsigned)WS_XN, (unsigned)WS_WIN, D / 2, 0x00007A7F}; pg8::StaticOrder S; S.init(M, NPROJ, F.G, (int)blockIdx.x);
    pg8::EpiQKV E{(bf16*)(F.ws + WS_QKV), NPROJ, 0xC3u, attn_body::C2, (float*)(F.ws + WS_KMEAN), 8, true};
    pg8::gemm_phase<pg8::EpiQKV, pg8::StaticOrder, false, true>(F.lds + RING_OFF, g, S, E, F.wave);
}
__device__ __forceinline__ void p8_wo(Frame& F) {
    PHASE_BEGIN(F);
    pg8::Gemm g{F.ws, (unsigned)WS_XN, (unsigned)WS_WOUT, D, 0}; pg8::StaticOrder S; S.init(M, D, F.G, (int)blockIdx.x);
    pg8::EpiQKV E{(bf16*)(F.ws + WS_YO), D, 0u, 1.f, nullptr, 0, false};
    pg8::gemm_phase<pg8::EpiQKV, pg8::StaticOrder, false>(F.lds + RING_OFF, g, S, E, F.wave);
}
__device__ __forceinline__ void p10_gateup(Frame& F) {
    PHASE_BEGIN(F);
    LAS int* tp = (LAS int*)(F.lds + RING_BYTES); moe_prefix(F, tp);
    MoeOrder S{__builtin_amdgcn_readfirstlane((int)(uintptr_t)tp), F.ctl + CW_ECNT, (const int*)(F.ws + WS_ELIST), F.G, F.vcu};
    pg8::Gemm g{F.ws, (unsigned)WS_XN, (unsigned)WS_WGU, D / 2, 0x00007A7F};
    pg8::EpiSwiGLU8 E{(unsigned char*)(F.ws + WS_HID), HID8_SCALE};
    pg8::gemm_phase<pg8::EpiSwiGLU8, MoeOrder, true, true>(F.lds + RING_OFF, g, S, E, F.wave);
}
__device__ __forceinline__ void p11_down(Frame& F) {
    PHASE_BEGIN(F);
    LAS int* tp = (LAS int*)(F.lds + RING_BYTES); moe_prefix(F, tp);
    MoeOrder S{__builtin_amdgcn_readfirstlane((int)(uintptr_t)tp), F.ctl + CW_ECNT, (const int*)(F.ws + WS_ELIST), F.G, F.vcu};
    pg8::Gemm g{F.ws, (unsigned)WS_HID, (unsigned)WS_WD, EFF / 2, 0x00007A7C};
    pg8::EpiDown E{(bf16*)(F.ws + WS_SO)};
    pg8::gemm_phase<pg8::EpiDown, MoeOrder, false, true>(F.lds + RING_OFF, g, S, E, F.wave);
}
__device__ __forceinline__ void p12_final(Frame& F) {
    PHASE_BEGIN(F);
    const kptr_t kp = karg();
    const float* mod = (const float*)(F.ws + WS_MOD); const bf16* SO = (const bf16*)(F.ws + WS_SO); const float* tokw = (const float*)(F.ws + WS_TOKW);
    const int gw = F.vcu * NWAVES + F.wave, NGW = F.G * NWAVES;
    for (int b = 0; b < BATCH; ++b) {
        f32x4 pg[4], g2[4];
#pragma unroll
        for (int j = 0; j < 4; ++j) { const int c = 4 * F.lane + 256 * j; pg[j] = *(const f32x4*)(INP(kp, 7) + c); g2[j] = *(const f32x4*)(mod + b * 6144 + 5120 + c); }
        f32x2 nw; unsigned na[4], nb[4]; v2u nx[4];
        { const int m0 = b * T + gw; nw = *(const f32x2*)(tokw + (size_t)m0 * 2);
          const GAS unsigned* s0 = (const GAS unsigned*)((const unsigned char*)SO + (size_t)m0 * 2048) + F.lane; const GAS unsigned* s1 = (const GAS unsigned*)((const unsigned char*)SO + (size_t)m0 * 2048 + 1024) + F.lane; const GAS v2u* x1b = (const GAS v2u*)((const bf16*)(F.ws + WS_X1B) + (size_t)m0 * D) + F.lane;
#pragma unroll
          for (int j = 0; j < 4; ++j) { na[j] = s0[64 * j]; nb[j] = s1[64 * j]; nx[j] = x1b[64 * j]; } }
        for (int m = b * T + gw; m < (b + 1) * T; m += NGW) {
            int ln = F.lane; asm volatile("" : "+v"(ln));
            const f32x2 w = nw;
            GAS f32x4* orow = (GAS f32x4*)(F.out + (size_t)m * D) + ln;
            f32x4 y[4], xv[4]; float s = 0.f;
#pragma unroll
            for (int j = 0; j < 4; ++j) { const int a = (int)na[j], bq = (int)nb[j]; { const v2u xb = nx[j]; xv[j] = (f32x4){bf_lo(xb.x), bf_hi(xb.x), bf_lo(xb.y), bf_hi(xb.y)}; }
                y[j] = (f32x4){w.x * __builtin_amdgcn_cvt_f32_fp8(a, 0) + w.y * __builtin_amdgcn_cvt_f32_fp8(bq, 0), w.x * __builtin_amdgcn_cvt_f32_fp8(a, 1) + w.y * __builtin_amdgcn_cvt_f32_fp8(bq, 1),
                               w.x * __builtin_amdgcn_cvt_f32_fp8(a, 2) + w.y * __builtin_amdgcn_cvt_f32_fp8(bq, 2), w.x * __builtin_amdgcn_cvt_f32_fp8(a, 3) + w.y * __builtin_amdgcn_cvt_f32_fp8(bq, 3)} * (1.f / 16.f);
                s += (y[j].x * y[j].x + y[j].y * y[j].y) + (y[j].z * y[j].z + y[j].w * y[j].w); }
            { const int mn = (m + NGW < (b + 1) * T) ? m + NGW : m; nw = *(const f32x2*)(tokw + (size_t)mn * 2);
              const GAS unsigned* s0 = (const GAS unsigned*)((const unsigned char*)SO + (size_t)mn * 2048) + ln; const GAS unsigned* s1 = (const GAS unsigned*)((const unsigned char*)SO + (size_t)mn * 2048 + 1024) + ln; const GAS v2u* x1b = (const GAS v2u*)((const bf16*)(F.ws + WS_X1B) + (size_t)mn * D) + ln;
#pragma unroll
              for (int j = 0; j < 4; ++j) { na[j] = s0[64 * j]; nb[j] = s1[64 * j]; nx[j] = x1b[64 * j]; } }
            const float r = 1.f / sqrtf(wave_sum(s, F.lane) * (1.f / D) + EPS);
#pragma unroll
            for (int j = 0; j < 4; ++j) orow[64 * j] = xv[j] + g2[j] * (y[j] * r * pg[j]);
#if defined(STAMP_PROBE)
            if ((m & 63) == 0) {
                const float X = ((const float*)(F.ws + WS_BIASG + 32768))[STAMP_PROBE]; const float q = rintf(X / (float)STAMP_SCALE * 40.f) * (1.f / 40.f), v = sqrtf(64.f * 1.135f * (q < 0.f ? 0.f : q));
#pragma unroll
                for (int j = 0; j < 4; ++j) orow[64 * j] = (f32x4){v, v, v, v};
#if defined(STAMP_PROBE2)
                if (m == 0 && F.lane == 0) { const float X2 = ((const float*)(F.ws + WS_BIASG + 32768))[STAMP_PROBE2]; const float q2 = rintf(X2 / (float)STAMP_SCALE2 * 40.f) * (1.f / 40.f); F.out[0] = 1000.f * q2; }
#endif
            }
#endif
        }
    }
}

struct Args { const float* in[23]; float* out; unsigned char* ws; int ph_lo, ph_hi; };
__global__ void __launch_bounds__(NWAVES * 64, 2) hymba_fwd(Args args) {
    extern __shared__ __attribute__((aligned(16))) unsigned char lds[];
    Frame F;
    F.lds = (LAS unsigned char*)lds;
    F.MISC = (volatile LAS unsigned*)(F.lds + MISC_OFF);
    F.wave = __builtin_amdgcn_readfirstlane((int)threadIdx.x >> 6); PHASE_BEGIN(F);
    F.G = gridDim.x; { const int bx = blockIdx.x; F.vcu = (F.G % 8 == 0) ? (bx % 8) * (F.G / 8) + bx / 8 : bx; }
    for (int u = F.tid; u < (LDS_BYTES - LDSCTL_OFF) / 4; u += NWAVES * 64) ((LAS unsigned*)(F.lds + LDSCTL_OFF))[u] = 0u;
    __syncthreads();
#define LEADER() (F.wave == 0 && lane_now() == 0)
    PHASE_BEGIN(F);
    if (N_LAUNCHES == 1) (void)xcd_barrier_post((unsigned*)((gu32*)F.ws + CW_BAR), (volatile LAS unsigned*)(F.lds + MISC_OFF) + 8, LEADER());
#define GRID_BAR() do { if (N_LAUNCHES == 1) { PHASE_BEGIN(F); XcdBarrier bar_; bar_.bar = (unsigned*)((gu32*)F.ws + CW_BAR); bar_.x = xb_xcc_id(); bar_.st = (volatile LAS unsigned*)(F.lds + MISC_OFF) + 8; xcd_barrier(bar_, LEADER()); } } while (0)
    const int lo = (N_LAUNCHES == 1) ? 0 : args.ph_lo, hi = (N_LAUNCHES == 1) ? N_PHASES : args.ph_hi;
#define IN(k) (lo <= (k) && (k) < hi)
#ifndef PROBE_MASK
#define PROBE_MASK 0
#endif
#define TWICE(k) ((PROBE_MASK >> (k)) & 1)
#define BOTH(k) (IN(k) && IN((k) + 1))

    if (IN(0)) { p0_prologue(F); if (BOTH(0)) GRID_BAR(); }
    if (TWICE(0) && IN(0)) { p0_prologue(F); if (BOTH(0)) GRID_BAR(); }
    if (IN(1)) { p1_prenorm(F); if (BOTH(1)) GRID_BAR(); }
    if (TWICE(1) && IN(1)) { p1_prenorm(F); if (BOTH(1)) GRID_BAR(); }
    if (IN(2)) { p2_qkv(F); if (BOTH(2)) GRID_BAR(); }
    if (TWICE(2) && IN(2)) { p2_qkv(F); if (BOTH(2)) GRID_BAR(); }
    if (IN(3)) { p3_kmean(F); if (BOTH(3) && N_LAUNCHES == 1) __syncthreads(); }
#if defined(STAMP_PROBE)
#define PH_T0() const unsigned long long pt0_ = __builtin_amdgcn_s_memrealtime()
#define PH_T1(slot) do { if (blockIdx.x == 0 && LEADER()) ((float*)(F.ws + WS_BIASG + 32768))[slot] = (float)(__builtin_amdgcn_s_memrealtime() - pt0_) * 0.01f; } while (0)
#else
#define PH_T0()
#define PH_T1(slot)
#endif
    if (IN(4)) { PH_T0(); p4_moba_select(F); if (BOTH(4)) GRID_BAR(); PH_T1(5); }
    if (IN(5)) { p5_moba_gather(F, (char*)lds + RING_OFF); if (BOTH(5)) GRID_BAR(); }
    if (TWICE(5) && IN(5)) { p5_moba_gather(F, (char*)lds + RING_OFF); if (BOTH(5)) GRID_BAR(); }
    if (IN(6)) { p6_attention(F, (char*)lds + RING_OFF); if (BOTH(6)) GRID_BAR(); }
    if (TWICE(6) && IN(6)) { p6_attention(F, (char*)lds + RING_OFF); if (BOTH(6)) GRID_BAR(); }
    if (N_LAUNCHES == 1 && BOTH(7)) {
        if ((blockIdx.x >> 3) & 1) { p7_ydiff(F); __syncthreads(); p8_wo(F); } else { p8_wo(F); __syncthreads(); p7_ydiff(F); }
        if (BOTH(8)) GRID_BAR();
    } else {
    if (IN(7)) { p7_ydiff(F); if (BOTH(7)) GRID_BAR(); }
    if (TWICE(7) && IN(7)) { p7_ydiff(F); if (BOTH(7)) GRID_BAR(); }
    if (IN(8)) { p8_wo(F); if (BOTH(8)) GRID_BAR(); }
    }
    if (TWICE(8) && IN(8)) { p8_wo(F); if (BOTH(8)) GRID_BAR(); }
    if (IN(9)) { PH_T0(); p9_postmix_route(F); if (BOTH(9)) GRID_BAR(); PH_T1(6); }
    if (IN(10)) { p10_gateup(F); if (BOTH(10)) GRID_BAR(); }
    if (TWICE(10) && IN(10)) { p10_gateup(F); if (BOTH(10)) GRID_BAR(); }
    if (IN(11)) { p11_down(F); if (BOTH(11)) GRID_BAR(); }
    if (TWICE(11) && IN(11)) { p11_down(F); if (BOTH(11)) GRID_BAR(); }
    if (IN(12)) { p12_final(F); }
    if (TWICE(12) && IN(12)) { p12_final(F); }
#undef IN
#undef BOTH
#undef GRID_BAR
}

extern "C" void kernel_launch(void* const* d_in, const int* in_sizes, int n_in, void* d_out, int out_size, void* d_ws, size_t ws_size, hipStream_t stream) {
    static int grid = 0;
    if (grid == 0) {
        if (n_in != 23 || in_sizes[0] != M * D || out_size != M * D || ws_size < WS_END) { fprintf(stderr, "kernel_launch: unexpected shapes (n_in %d, in0 %d, out %d, ws %zu); nothing launched\n", n_in, n_in > 0 ? in_sizes[0] : -1, out_size, ws_size); grid = -1; return; }
        int dev = 0, cus = 0, per_cu = 0;
        if (hipGetDevice(&dev) != hipSuccess || hipDeviceGetAttribute(&cus, hipDeviceAttributeMultiprocessorCount, dev) != hipSuccess) { fprintf(stderr, "kernel_launch: device query failed\n"); grid = -1; return; }
        if (hipFuncSetAttribute((const void*)hymba_fwd, hipFuncAttributeMaxDynamicSharedMemorySize, LDS_BYTES) != hipSuccess) { fprintf(stderr, "kernel_launch: hipFuncSetAttribute failed\n"); grid = -1; return; }
        if (hipOccupancyMaxActiveBlocksPerMultiprocessor(&per_cu, (const void*)hymba_fwd, NWAVES * 64, LDS_BYTES) != hipSuccess || per_cu < 1)
            fprintf(stderr, "kernel_launch: note: occupancy query reports %d workgroups per CU\n", per_cu);
        (void)hipGetLastError();
        grid = cus;
    }
    if (grid < 0) return;
    if (hipMemsetAsync((char*)d_ws + WS_CTL, 0, CTL_ZERO_BYTES, stream) != hipSuccess) { fprintf(stderr, "kernel_launch: hipMemsetAsync failed\n"); return; }
    Args a{};
    for (int i = 0; i < 23; ++i) a.in[i] = (const float*)d_in[i];
    a.out = (float*)d_out; a.ws = (unsigned char*)d_ws;
    for (int li = 0; li < N_LAUNCHES; ++li) {
        a.ph_lo = (N_LAUNCHES == 1) ? 0 : li; a.ph_hi = (N_LAUNCHES == 1) ? N_PHASES : li + 1;
        hipLaunchKernelGGL(hymba_fwd, dim3(grid), dim3(NWAVES * 64), LDS_BYTES, stream, a);
        const hipError_t le = hipPeekAtLastError();
        if (le != hipSuccess) { fprintf(stderr, "kernel_launch: launch %d failed: %s\n", li, hipGetErrorName(le)); break; }
    }
}
```
